# Optimizing an MI355X kernel written in HIP

```python
import math
import jax, jax.numpy as jnp
from jax import lax
import numpy as np

D_MODEL = 1024
BATCH = 8
SEQ = 2048
DEPTH = 4

MIX_W = 768
XATT_HEADS = 4
XATT_DH = 64
XATT_W = XATT_HEADS * XATT_DH
MEM_LEN = 256
CONV_K = 3
ML_HEADS = 6
ML_DH = MIX_W // ML_HEADS
CHUNK = 128
D_IN_CONV = 3 * MIX_W + XATT_W
D_IN_MLSTM = 4 * MIX_W + 2 * ML_HEADS + XATT_W
N_CONV = (DEPTH + 1) // 2
N_MLSTM = DEPTH // 2
N_EXPERTS = 32
N_GROUPS = 8
EXPERTS_PER_GROUP = N_EXPERTS // N_GROUPS
TOP_K = 2
D_FF = 512
MOE_BLOCK = 128
ALPHA = (2.0 * DEPTH) ** 0.25
BETA = (8.0 * DEPTH) ** -0.25
LN_EPS = 1e-5

kernel_name = "hybrid_conv_mlstm_xattn_moe_deepnorm"


def layer_norm(x, g, b):
    xf = x.astype(jnp.float32)
    mu = jnp.mean(xf, axis=-1, keepdims=True)
    var = jnp.mean(jnp.square(xf - mu), axis=-1, keepdims=True)
    return ((xf - mu) * lax.rsqrt(var + LN_EPS) * g + b).astype(x.dtype)


def conv_mixer(x, w_in, conv_w):
    proj = x @ w_in
    bg = proj[..., :MIX_W]
    cg = proj[..., MIX_W:2 * MIX_W]
    xin = proj[..., 2 * MIX_W:3 * MIX_W]
    q_mem = proj[..., 3 * MIX_W:]
    u = cg * xin
    seq = u.shape[1]
    up = jnp.pad(u, ((0, 0), (CONV_K - 1, 0), (0, 0)))
    c = (conv_w[0] * up[:, 0:seq] + conv_w[1] * up[:, 1:seq + 1] + conv_w[2] * up[:, 2:seq + 2])
    return bg * c, q_mem


def mlstm_cell(q, k, v, log_i, log_f):
    nb, nh, seq, dh = q.shape
    nc = seq // CHUNK
    q = q.reshape(nb, nh, nc, CHUNK, dh)
    k = k.reshape(nb, nh, nc, CHUNK, dh)
    v = v.reshape(nb, nh, nc, CHUNK, dh)
    log_i = log_i.reshape(nb, nh, nc, CHUNK)
    log_f = log_f.reshape(nb, nh, nc, CHUNK)
    b = jnp.cumsum(log_f, axis=-1)
    g = b[..., -1]
    a = g[..., None] - b + log_i

    def step(carry, inp):
        c_st, n_st, m_st = carry
        kc, vc, ac, gc = inp
        m_new = jnp.maximum(gc + m_st, ac.max(-1))
        decay = jnp.exp(gc + m_st - m_new)
        w = jnp.exp(ac - m_new[..., None])
        c_new = decay[..., None, None] * c_st + jnp.einsum('bhl,bhld,bhle->bhde', w, kc, vc)
        n_new = decay[..., None] * n_st + jnp.einsum('bhl,bhld->bhd', w, kc)
        return (c_new, n_new, m_new), (c_st, n_st, m_st)

    init = (jnp.zeros((nb, nh, dh, dh), jnp.float32),
            jnp.zeros((nb, nh, dh), jnp.float32),
            jnp.zeros((nb, nh), jnp.float32))
    xs = (jnp.moveaxis(k, 2, 0), jnp.moveaxis(v, 2, 0), jnp.moveaxis(a, 2, 0), jnp.moveaxis(g, 2, 0))
    _, (c_prev, n_prev, m_prev) = lax.scan(step, init, xs)
    c_prev = jnp.moveaxis(c_prev, 0, 2)
    n_prev = jnp.moveaxis(n_prev, 0, 2)
    m_prev = jnp.moveaxis(m_prev, 0, 2)

    causal = jnp.tril(jnp.ones((CHUNK, CHUNK), dtype=bool))
    d = jnp.where(causal, b[..., :, None] - b[..., None, :] + log_i[..., None, :], -jnp.inf)
    inter = b + m_prev[..., None]
    m_t = jnp.maximum(d.max(-1), inter)
    s = jnp.einsum('bhcld,bhcsd->bhcls', q, k) * jnp.exp(d - m_t[..., None])
    w_inter = jnp.exp(inter - m_t)
    num = (jnp.einsum('bhcls,bhcsd->bhcld', s, v)
           + w_inter[..., None] * jnp.einsum('bhcld,bhcde->bhcle', q, c_prev))
    den = s.sum(-1) + w_inter * jnp.einsum('bhcld,bhcd->bhcl', q, n_prev)
    h = num / jnp.maximum(jnp.abs(den), jnp.exp(-m_t))[..., None]
    return h.reshape(nb, nh, seq, dh)


def mlstm_mixer(x, w_in, gate_b, norm_g):
    nb, seq, _ = x.shape
    proj = x @ w_in
    o0 = 4 * MIX_W

    def heads(t):
        return t.reshape(nb, seq, ML_HEADS, ML_DH).transpose(0, 2, 1, 3).astype(jnp.float32)

    q = heads(proj[..., 0:MIX_W])
    k = heads(proj[..., MIX_W:2 * MIX_W]) * (ML_DH ** -0.5)
    v = heads(proj[..., 2 * MIX_W:3 * MIX_W])
    o_gate = proj[..., 3 * MIX_W:4 * MIX_W]
    log_i = (proj[..., o0:o0 + ML_HEADS] + gate_b[:ML_HEADS]).astype(jnp.float32).transpose(0, 2, 1)
    log_f = jax.nn.log_sigmoid((proj[..., o0 + ML_HEADS:o0 + 2 * ML_HEADS]
                                + gate_b[ML_HEADS:]).astype(jnp.float32)).transpose(0, 2, 1)
    q_mem = proj[..., o0 + 2 * ML_HEADS:]
    h = mlstm_cell(q, k, v, log_i, log_f)
    mu = jnp.mean(h, axis=-1, keepdims=True)
    var = jnp.mean(jnp.square(h - mu), axis=-1, keepdims=True)
    h = ((h - mu) * lax.rsqrt(var + LN_EPS)).transpose(0, 2, 1, 3).reshape(nb, seq, MIX_W)
    h = (h * norm_g).astype(x.dtype)
    return jax.nn.sigmoid(o_gate) * h, q_mem


def cross_attention(q_mem, mem, w_kv):
    nb, seq, _ = q_mem.shape
    kv = mem @ w_kv
    k = kv[..., :XATT_W].reshape(nb, -1, XATT_HEADS, XATT_DH)
    v = kv[..., XATT_W:].reshape(nb, -1, XATT_HEADS, XATT_DH)
    q = q_mem.reshape(nb, seq, XATT_HEADS, XATT_DH)
    s = jnp.einsum('bshd,bmhd->bhsm', q, k).astype(jnp.float32) * (XATT_DH ** -0.5)
    p = jax.nn.softmax(s, axis=-1).astype(v.dtype)
    return jnp.einsum('bhsm,bmhd->bshd', p, v).reshape(nb, seq, XATT_W)


def grouped_moe(x2, router_w, router_b, w_gate, w_up, w_down):
    n_tok, d = x2.shape
    scores = jax.nn.sigmoid((x2 @ router_w).astype(jnp.float32))
    sel = (scores + router_b).reshape(n_tok, N_GROUPS, EXPERTS_PER_GROUP)
    group_score = lax.top_k(sel, TOP_K)[0].sum(-1)
    _, g_idx = lax.top_k(group_score, 1)
    in_group = jnp.take_along_axis(sel, g_idx[:, :, None], axis=1)[:, 0]
    _, local = lax.top_k(in_group, TOP_K)
    expert = g_idx * EXPERTS_PER_GROUP + local
    gates = jnp.take_along_axis(scores, expert, axis=1)
    gates = gates / gates.sum(-1, keepdims=True)

    n_asg = n_tok * TOP_K
    e_flat = expert.reshape(n_asg)
    tok_flat = jnp.repeat(jnp.arange(n_tok, dtype=jnp.int32), TOP_K)
    g_flat = gates.reshape(n_asg)
    counts = jax.ops.segment_sum(jnp.ones((n_asg,), jnp.int32), e_flat, num_segments=N_EXPERTS)
    padded = (counts + MOE_BLOCK - 1) // MOE_BLOCK * MOE_BLOCK
    pad_end = jnp.cumsum(padded)
    pad_start = pad_end - padded
    start = jnp.cumsum(counts) - counts
    order = jnp.argsort(e_flat)
    e_sorted = e_flat[order]
    dest = pad_start[e_sorted] + (jnp.arange(n_asg, dtype=jnp.int32) - start[e_sorted])
    n_rows = ((n_asg + MOE_BLOCK - 1) // MOE_BLOCK + N_EXPERTS) * MOE_BLOCK
    n_blocks = n_rows // MOE_BLOCK
    tok_buf = jnp.zeros((n_rows,), jnp.int32).at[dest].set(tok_flat[order])
    gate_buf = jnp.zeros((n_rows,), x2.dtype).at[dest].set(g_flat[order].astype(x2.dtype))
    block_start = jnp.arange(n_blocks, dtype=jnp.int32) * MOE_BLOCK
    block_expert = jnp.clip(jnp.searchsorted(pad_end, block_start, side='right'), 0, N_EXPERTS - 1)
    xb = x2[tok_buf].reshape(n_blocks, MOE_BLOCK, d)

    def expert_block(args):
        xblk, e = args
        h = jax.nn.silu(xblk @ w_gate[e]) * (xblk @ w_up[e])
        return h @ w_down[e]

    yb = lax.map(expert_block, (xb, block_expert)).reshape(n_rows, d)
    return jnp.zeros_like(x2).at[tok_buf].add(yb * gate_buf[:, None])


def setup_inputs(seed: int = 0) -> dict:
    key = jax.random.key(seed)
    ks = jax.random.split(key, 20)
    f32 = jnp.float32
    nrm = lambda k, s, sc: jax.random.normal(k, s, f32) * sc
    gate_i = nrm(ks[5], (N_MLSTM, ML_HEADS), 0.1)
    gate_f = jax.random.uniform(ks[6], (N_MLSTM, ML_HEADS), f32, 3.0, 6.0)
    return {
        "x": nrm(ks[0], (BATCH, SEQ, D_MODEL), 1.0),
        "mem": nrm(ks[1], (BATCH, MEM_LEN, D_MODEL), 1.0),
        "conv_w_in": nrm(ks[2], (N_CONV, D_MODEL, D_IN_CONV), D_MODEL ** -0.5),
        "conv_w": nrm(ks[3], (N_CONV, CONV_K, MIX_W), CONV_K ** -0.5),
        "mlstm_w_in": nrm(ks[4], (N_MLSTM, D_MODEL, D_IN_MLSTM), D_MODEL ** -0.5),
        "mlstm_gate_b": jnp.concatenate([gate_i, gate_f], axis=-1),
        "mlstm_norm_g": 1.0 + nrm(ks[7], (N_MLSTM, MIX_W), 0.02),
        "w_kv_mem": nrm(ks[8], (DEPTH, D_MODEL, 2 * XATT_W), D_MODEL ** -0.5),
        "w_out": nrm(ks[9], (DEPTH, MIX_W + XATT_W, D_MODEL), (MIX_W + XATT_W) ** -0.5 * BETA),
        "ln1_g": 1.0 + nrm(ks[10], (DEPTH, D_MODEL), 0.02),
        "ln1_b": nrm(ks[11], (DEPTH, D_MODEL), 0.02),
        "ln2_g": 1.0 + nrm(ks[12], (DEPTH, D_MODEL), 0.02),
        "ln2_b": nrm(ks[13], (DEPTH, D_MODEL), 0.02),
        "router_w": nrm(ks[14], (D_MODEL, N_EXPERTS), D_MODEL ** -0.5),
        "router_b": nrm(ks[15], (N_EXPERTS,), 0.01),
        "w_gate": nrm(ks[16], (DEPTH, N_EXPERTS, D_MODEL, D_FF), D_MODEL ** -0.5),
        "w_up": nrm(ks[17], (DEPTH, N_EXPERTS, D_MODEL, D_FF), D_MODEL ** -0.5),
        "w_down": nrm(ks[18], (DEPTH, N_EXPERTS, D_FF, D_MODEL), D_FF ** -0.5 * BETA),
    }


def reference(x, mem, conv_w_in, conv_w, mlstm_w_in, mlstm_gate_b, mlstm_norm_g, w_kv_mem, w_out,
              ln1_g, ln1_b, ln2_g, ln2_b, router_w, router_b, w_gate, w_up, w_down):
    nb, seq, d = x.shape
    for i in range(DEPTH):
        j = i // 2
        if i % 2 == 0:
            h_loc, q_mem = conv_mixer(x, conv_w_in[j], conv_w[j])
        else:
            h_loc, q_mem = mlstm_mixer(x, mlstm_w_in[j], mlstm_gate_b[j], mlstm_norm_g[j])
        h_mem = cross_attention(q_mem, mem, w_kv_mem[i])
        y = jnp.concatenate([h_loc, h_mem], axis=-1) @ w_out[i]
        x = layer_norm(ALPHA * x + y, ln1_g[i], ln1_b[i])
        m = grouped_moe(x.reshape(nb * seq, d), router_w, router_b,
                        w_gate[i], w_up[i], w_down[i]).reshape(nb, seq, d)
        x = layer_norm(ALPHA * x + m, ln2_g[i], ln2_b[i])
    return x
```

```cpp
#include <hip/hip_runtime.h>
#include <stdint.h>
#include <stdio.h>

typedef unsigned short bf16_t;
typedef __attribute__((ext_vector_type(8))) short bf16x8;
typedef __attribute__((ext_vector_type(4))) float f32x4;
typedef __attribute__((ext_vector_type(4))) unsigned u32x4;
typedef __attribute__((ext_vector_type(2))) unsigned u32x2;

#define DI __device__ __forceinline__

constexpr int D = 1024;
constexpr int NBATCH = 8;
constexpr int SEQ = 2048;
constexpr int T = NBATCH * SEQ;
constexpr int DEPTH = 4;
constexpr int MIXW = 768;
constexpr int XH = 4, XDH = 64, XW = 256, MEML = 256;
constexpr int MLH = 6, MLDH = 128, CHUNK = 128, NCH = SEQ / CHUNK;
constexpr int DIN_CONV = 2560, DIN_ML = 3340, LDP_ML = 3328;
constexpr int NE = 32, DFF = 512;
constexpr float ALPHA = 1.681792830507429f;
constexpr float LN_EPS = 1e-5f;

constexpr int NTHREADS = 256;
constexpr int LDK = 72;
constexpr int SMEM_BYTES = 72 * 1024;

constexpr size_t al256(size_t x) { return (x + 255) & ~(size_t)255; }
constexpr size_t WS_CTL   = 0;
constexpr size_t CTL_BYTES = 64 * 1024;
constexpr size_t CTL_CNT  = 32 * 1024;
constexpr size_t WS_XA    = WS_CTL + CTL_BYTES;
constexpr size_t WS_XB    = WS_XA + (size_t)T * D * 4;
constexpr size_t WS_MEMB  = WS_XB + (size_t)T * D * 2;
constexpr size_t WS_KBUF  = WS_MEMB + (size_t)NBATCH * MEML * D * 2;
constexpr size_t WS_VT    = WS_KBUF + (size_t)DEPTH * NBATCH * MEML * XW * 2;
constexpr size_t WS_PROJ  = WS_VT + (size_t)DEPTH * NBATCH * MEML * XW * 2;
constexpr size_t WS_LOGI  = WS_PROJ + (size_t)T * LDP_ML * 2;
constexpr size_t WS_LOGF  = WS_LOGI + (size_t)NBATCH * MLH * SEQ * 4;
constexpr size_t WS_CT    = WS_LOGF + (size_t)NBATCH * MLH * SEQ * 4;
constexpr size_t WS_CPB   = WS_CT + (size_t)48 * NCH * 128 * 128 * 4;
constexpr size_t WS_NLOC  = WS_CPB + (size_t)48 * NCH * 128 * 128 * 2;
constexpr size_t WS_NPREV = WS_NLOC + (size_t)48 * NCH * 128 * 4;
constexpr size_t WS_MLOC  = WS_NPREV + (size_t)48 * NCH * 128 * 4;
constexpr size_t WS_GSUM  = WS_MLOC + al256(48 * NCH * 4);
constexpr size_t WS_MPREV = WS_GSUM + al256(48 * NCH * 4);
constexpr size_t WS_HCAT  = WS_MPREV + al256(48 * NCH * 4);
constexpr size_t WS_Z     = WS_HCAT + (size_t)T * D * 2;
constexpr size_t WS_X1A   = WS_Z + (size_t)T * D * 4;
constexpr size_t WS_X1B   = WS_X1A + (size_t)T * D * 4;
constexpr size_t WS_GATE  = WS_X1B + (size_t)T * D * 2;
constexpr size_t WS_LIST  = WS_GATE + (size_t)T * 2 * 4;
constexpr size_t WS_HBUF  = WS_LIST + (size_t)NE * T * 4;
constexpr size_t WS_YASG  = WS_HBUF + (size_t)T * 2 * DFF * 2;
constexpr size_t WS_TOTAL = WS_YASG + (size_t)T * 2 * D * 2;

struct P {
    const float *x, *mem, *conv_w_in, *conv_w, *ml_w_in, *ml_gate_b, *ml_norm_g, *w_kv, *w_out;
    const float *ln1_g, *ln1_b, *ln2_g, *ln2_b, *router_w, *router_b, *w_gate, *w_up, *w_down;
    float* out;
    char* ws;
};

DI unsigned cvtpk(float lo, float hi) { unsigned r; asm("v_cvt_pk_bf16_f32 %0, %1, %2" : "=v"(r) : "v"(lo), "v"(hi)); return r; }
DI float bf2f(bf16_t v) { return __uint_as_float(((unsigned)v) << 16); }
DI float bflo(unsigned v) { return __uint_as_float(v << 16); }
DI float bfhi(unsigned v) { return __uint_as_float(v & 0xffff0000u); }
DI bf16_t f2bf(float f) { return (bf16_t)(cvtpk(f, f) & 0xffffu); }
DI float sigmoidf_(float x) { return 1.0f / (1.0f + __expf(-x)); }
DI float logsigmoidf_(float x) { return fminf(x, 0.0f) - log1pf(__expf(-fabsf(x))); }
DI float xor_add(float v, int m) { return v + __shfl_xor(v, m, 64); }
DI float xor_max(float v, int m) { return fmaxf(v, __shfl_xor(v, m, 64)); }
DI float wave_sum(float v) { v = xor_add(v, 32); v = xor_add(v, 16); v = xor_add(v, 8); v = xor_add(v, 4); v = xor_add(v, 2); v = xor_add(v, 1); return v; }
DI f32x4 mfma16(bf16x8 a, bf16x8 b, f32x4 c) { return __builtin_amdgcn_mfma_f32_16x16x32_bf16(a, b, c, 0, 0, 0); }

template <class ARow, class BPtr, class Epi>
DI void gemm128(ARow arow, BPtr bptr, int ldb, int K, char* smem, Epi epi) {
    bf16_t* As = (bf16_t*)smem;
    bf16_t* Bs = As + 128 * LDK;
    const int tid = threadIdx.x, lane = tid & 63, wid = tid >> 6;
    const int r = lane & 15, g = lane >> 4;
    const int wm = wid >> 1, wn = wid & 1;
    const int akc = tid & 7, arow0 = tid >> 3;
    const bf16_t* ap0 = arow(arow0) + akc * 8;
    const bf16_t* ap1 = arow(arow0 + 32) + akc * 8;
    const bf16_t* ap2 = arow(arow0 + 64) + akc * 8;
    const bf16_t* ap3 = arow(arow0 + 96) + akc * 8;
    const int kg = tid & 7, ng = tid >> 3;
    const float* bp = bptr(ng) + (size_t)(kg * 8) * ldb;

    u32x4 areg[4];
    f32x4 breg[8];
    f32x4 acc[4][4];
#pragma unroll
    for (int i = 0; i < 4; ++i)
#pragma unroll
        for (int j = 0; j < 4; ++j) acc[i][j] = (f32x4){0.f, 0.f, 0.f, 0.f};

    areg[0] = *(const u32x4*)(ap0); areg[1] = *(const u32x4*)(ap1); areg[2] = *(const u32x4*)(ap2); areg[3] = *(const u32x4*)(ap3);
#pragma unroll
    for (int i = 0; i < 8; ++i) breg[i] = *(const f32x4*)(bp + (size_t)i * ldb);

    for (int k0 = 0; k0 < K; k0 += 64) {
        __syncthreads();
#pragma unroll
        for (int i = 0; i < 4; ++i) *(u32x4*)&As[(arow0 + 32 * i) * LDK + akc * 8] = areg[i];
#pragma unroll
        for (int c = 0; c < 4; ++c) {
            u32x4 w;
            w.x = cvtpk(breg[0][c], breg[1][c]); w.y = cvtpk(breg[2][c], breg[3][c]);
            w.z = cvtpk(breg[4][c], breg[5][c]); w.w = cvtpk(breg[6][c], breg[7][c]);
            *(u32x4*)&Bs[(4 * ng + c) * LDK + kg * 8] = w;
        }
        __syncthreads();
        if (k0 + 64 < K) {
            const int kn = k0 + 64;
            areg[0] = *(const u32x4*)(ap0 + kn); areg[1] = *(const u32x4*)(ap1 + kn);
            areg[2] = *(const u32x4*)(ap2 + kn); areg[3] = *(const u32x4*)(ap3 + kn);
#pragma unroll
            for (int i = 0; i < 8; ++i) breg[i] = *(const f32x4*)(bp + (size_t)(kn + i) * ldb);
        }
#pragma unroll
        for (int kk = 0; kk < 2; ++kk) {
            bf16x8 wf[4], xf[4];
#pragma unroll
            for (int ni = 0; ni < 4; ++ni) wf[ni] = *(const bf16x8*)&Bs[(wn * 64 + ni * 16 + r) * LDK + kk * 32 + 8 * g];
#pragma unroll
            for (int mi = 0; mi < 4; ++mi) xf[mi] = *(const bf16x8*)&As[(wm * 64 + mi * 16 + r) * LDK + kk * 32 + 8 * g];
#pragma unroll
            for (int mi = 0; mi < 4; ++mi)
#pragma unroll
                for (int ni = 0; ni < 4; ++ni) acc[mi][ni] = mfma16(wf[ni], xf[mi], acc[mi][ni]);
        }
    }
    epi(acc);
}

__device__ void phase_prep(const P& p, int bid, int nb) {
    bf16_t* xb = (bf16_t*)(p.ws + WS_XB);
    bf16_t* memb = (bf16_t*)(p.ws + WS_MEMB);
    const size_t nx = (size_t)T * D / 4, nm = (size_t)NBATCH * MEML * D / 4;
    for (size_t i = (size_t)bid * NTHREADS + threadIdx.x; i < nx + nm; i += (size_t)nb * NTHREADS) {
        if (i < nx) { f32x4 v = ((const f32x4*)p.x)[i]; u32x2 w; w.x = cvtpk(v[0], v[1]); w.y = cvtpk(v[2], v[3]); ((u32x2*)xb)[i] = w; }
        else { size_t j = i - nx; f32x4 v = ((const f32x4*)p.mem)[j]; u32x2 w; w.x = cvtpk(v[0], v[1]); w.y = cvtpk(v[2], v[3]); ((u32x2*)memb)[j] = w; }
    }
}

__device__ void phase_kv(const P& p, int bid, int nb, char* smem) {
    const bf16_t* memb = (const bf16_t*)(p.ws + WS_MEMB);
    bf16_t* kbuf = (bf16_t*)(p.ws + WS_KBUF);
    bf16_t* vT = (bf16_t*)(p.ws + WS_VT);
    const int lane = threadIdx.x & 63, wid = threadIdx.x >> 6, r = lane & 15, g = lane >> 4, wm = wid >> 1, wn = wid & 1;
    for (int task = bid; task < DEPTH * 16 * 4; task += nb) {
        const int layer = task >> 6, mt = (task >> 2) & 15, nt = task & 3;
        const float* W = p.w_kv + (size_t)layer * D * 512 + nt * 128;
        gemm128([&](int rr) { return memb + (size_t)(mt * 128 + rr) * D; }, [&](int ng) { return W + 4 * ng; }, 512, D, smem,
                [&](f32x4 (&acc)[4][4]) {
#pragma unroll
                    for (int mi = 0; mi < 4; ++mi)
#pragma unroll
                        for (int ni = 0; ni < 4; ++ni) {
                            const int m = mt * 128 + wm * 64 + mi * 16 + r;
                            const int n = nt * 128 + wn * 64 + ni * 16 + 4 * g;
                            const f32x4 v = acc[mi][ni];
                            if (n < 256) {
                                u32x2 w; w.x = cvtpk(v[0], v[1]); w.y = cvtpk(v[2], v[3]);
                                *(u32x2*)&kbuf[((size_t)layer * 2048 + m) * 256 + n] = w;
                            } else {
                                const int nn = n - 256, b = m >> 8, mm = m & 255;
#pragma unroll
                                for (int i = 0; i < 4; ++i) {
                                    const int h = (nn + i) >> 6, dv = (nn + i) & 63;
                                    vT[((((size_t)layer * 8 + b) * 4 + h) * 64 + dv) * 256 + mm] = f2bf(v[i]);
                                }
                            }
                        }
                });
    }
}

__device__ void phase_inproj(const P& p, int layer, int bid, int nb, char* smem) {
    const bool conv = (layer & 1) == 0;
    const int j = layer >> 1;
    const int NT = conv ? 20 : 27, ldb = conv ? DIN_CONV : DIN_ML, ldp = conv ? DIN_CONV : LDP_ML;
    const float* W = conv ? p.conv_w_in + (size_t)j * D * DIN_CONV : p.ml_w_in + (size_t)j * D * DIN_ML;
    const bf16_t* xb = (const bf16_t*)(p.ws + WS_XB);
    bf16_t* projb = (bf16_t*)(p.ws + WS_PROJ);
    float* logi = (float*)(p.ws + WS_LOGI);
    float* logf = (float*)(p.ws + WS_LOGF);
    const int lane = threadIdx.x & 63, wid = threadIdx.x >> 6, r = lane & 15, g = lane >> 4, wm = wid >> 1, wn = wid & 1;
    for (int task = bid; task < 128 * NT; task += nb) {
        const int nt = task >> 7, mt = task & 127;
        int pcol, ocol;
        if (conv || nt < 24) { pcol = nt * 128; ocol = pcol; }
        else if (nt == 24) { pcol = 3072; ocol = 0; }
        else { pcol = 3084 + (nt - 25) * 128; ocol = 3072 + (nt - 25) * 128; }
        const bool gates = (!conv && nt == 24);
        const float sc = (!conv && nt >= 6 && nt < 12) ? 0.08838834764831845f : 1.0f;
        gemm128([&](int rr) { return xb + (size_t)(mt * 128 + rr) * D; }, [&](int ng) { return W + pcol + 4 * ng; }, ldb, D, smem,
                [&](f32x4 (&acc)[4][4]) {
#pragma unroll
                    for (int mi = 0; mi < 4; ++mi)
#pragma unroll
                        for (int ni = 0; ni < 4; ++ni) {
                            const int m = mt * 128 + wm * 64 + mi * 16 + r;
                            const int n = wn * 64 + ni * 16 + 4 * g;
                            const f32x4 v = acc[mi][ni];
                            if (gates) {
                                if (n < 12) {
                                    const int b = m >> 11, s = m & 2047;
#pragma unroll
                                    for (int i = 0; i < 4; ++i) {
                                        const int col = n + i;
                                        const float val = v[i] + p.ml_gate_b[j * 12 + col];
                                        if (col < 6) logi[(size_t)(b * 6 + col) * SEQ + s] = val;
                                        else logf[(size_t)(b * 6 + col - 6) * SEQ + s] = logsigmoidf_(val);
                                    }
                                }
                            } else {
                                u32x2 w; w.x = cvtpk(v[0] * sc, v[1] * sc); w.y = cvtpk(v[2] * sc, v[3] * sc);
                                *(u32x2*)&projb[(size_t)m * ldp + ocol + n] = w;
                            }
                        }
                });
    }
}

__device__ void phase_convmix(const P& p, int layer, int bid, int nb) {
    const int j = layer >> 1;
    const bf16_t* projb = (const bf16_t*)(p.ws + WS_PROJ);
    bf16_t* hcat = (bf16_t*)(p.ws + WS_HCAT);
    const float* cw = p.conv_w + (size_t)j * 3 * MIXW;
    const int nitem = T * (MIXW / 8);
    for (int it = bid * NTHREADS + threadIdx.x; it < nitem; it += nb * NTHREADS) {
        const int t = it / 96, c8 = (it % 96) * 8;
        const int s = t & 2047;
        const bf16_t* row = projb + (size_t)t * DIN_CONV;
        const u32x4 bg = *(const u32x4*)(row + c8);
        float u[3][8];
#pragma unroll
        for (int d = 0; d < 3; ++d) {
            const int back = 2 - d;
            if (s - back >= 0) {
                const bf16_t* rw = row - (size_t)back * DIN_CONV;
                const u32x4 cg = *(const u32x4*)(rw + MIXW + c8);
                const u32x4 xi = *(const u32x4*)(rw + 2 * MIXW + c8);
#pragma unroll
                for (int q = 0; q < 4; ++q) { u[d][2 * q] = bflo(cg[q]) * bflo(xi[q]); u[d][2 * q + 1] = bfhi(cg[q]) * bfhi(xi[q]); }
            } else {
#pragma unroll
                for (int q = 0; q < 8; ++q) u[d][q] = 0.f;
            }
        }
        float o[8];
#pragma unroll
        for (int q = 0; q < 8; ++q) {
            const float c = cw[c8 + q] * u[0][q] + cw[MIXW + c8 + q] * u[1][q] + cw[2 * MIXW + c8 + q] * u[2][q];
            const float b = (q & 1) ? bfhi(bg[q >> 1]) : bflo(bg[q >> 1]);
            o[q] = b * c;
        }
        u32x4 w; w.x = cvtpk(o[0], o[1]); w.y = cvtpk(o[2], o[3]); w.z = cvtpk(o[4], o[5]); w.w = cvtpk(o[6], o[7]);
        *(u32x4*)(hcat + (size_t)t * D + c8) = w;
    }
}

__device__ void phase_xattn(const P& p, int layer, int bid, int nb, char* smem) {
    const bool conv = (layer & 1) == 0;
    const int ldp = conv ? DIN_CONV : LDP_ML;
    const int qoff = conv ? 3 * MIXW : 3072;
    const bf16_t* projb = (const bf16_t*)(p.ws + WS_PROJ);
    const bf16_t* kbuf = (const bf16_t*)(p.ws + WS_KBUF) + (size_t)layer * 2048 * 256;
    const bf16_t* vT = (const bf16_t*)(p.ws + WS_VT) + (size_t)layer * 8 * 4 * 64 * 256;
    bf16_t* hcat = (bf16_t*)(p.ws + WS_HCAT);
    constexpr int LK = 72, LV = 264;
    bf16_t* Ks = (bf16_t*)smem;
    bf16_t* Vs = Ks + 256 * LK;
    const int tid = threadIdx.x, lane = tid & 63, wid = tid >> 6, r = lane & 15, g = lane >> 4;
    for (int task = bid; task < NBATCH * XH * 32; task += nb) {
        const int b = task >> 7, h = (task >> 5) & 3, qt = task & 31;
        __syncthreads();
#pragma unroll
        for (int i = 0; i < 8; ++i) {
            const int c = tid + 256 * i;
            const int key = c >> 3, kc = c & 7;
            *(u32x4*)&Ks[key * LK + kc * 8] = *(const u32x4*)(kbuf + ((size_t)b * 256 + key) * 256 + h * 64 + kc * 8);
            const int dv = c >> 5, mc = c & 31;
            *(u32x4*)&Vs[dv * LV + mc * 8] = *(const u32x4*)(vT + (((size_t)b * 4 + h) * 64 + dv) * 256 + mc * 8);
        }
        __syncthreads();
        const int tq = b * SEQ + qt * 64 + wid * 16;
        const bf16_t* qrow = projb + (size_t)(tq + r) * ldp + qoff + h * 64;
        bf16x8 qf[2];
        qf[0] = *(const bf16x8*)(qrow + 8 * g);
        qf[1] = *(const bf16x8*)(qrow + 32 + 8 * g);
        f32x4 sacc[16];
#pragma unroll
        for (int kt = 0; kt < 16; ++kt) {
            f32x4 a = (f32x4){0.f, 0.f, 0.f, 0.f};
#pragma unroll
            for (int ks = 0; ks < 2; ++ks) {
                const bf16x8 kf = *(const bf16x8*)&Ks[(kt * 16 + r) * LK + ks * 32 + 8 * g];
                a = mfma16(kf, qf[ks], a);
            }
            sacc[kt] = a;
            if (kt & 1) __builtin_amdgcn_sched_barrier(0);
        }
        float mx = -3.0e38f;
#pragma unroll
        for (int kt = 0; kt < 16; ++kt)
#pragma unroll
            for (int i = 0; i < 4; ++i) { sacc[kt][i] *= 0.125f; mx = fmaxf(mx, sacc[kt][i]); }
        mx = xor_max(mx, 16); mx = xor_max(mx, 32);
        float sum = 0.f;
#pragma unroll
        for (int kt = 0; kt < 16; ++kt)
#pragma unroll
            for (int i = 0; i < 4; ++i) { const float e = __expf(sacc[kt][i] - mx); sacc[kt][i] = e; sum += e; }
        sum = xor_add(sum, 16); sum = xor_add(sum, 32);
        const float inv = 1.0f / sum;
        f32x4 oacc[4];
#pragma unroll
        for (int dt = 0; dt < 4; ++dt) oacc[dt] = (f32x4){0.f, 0.f, 0.f, 0.f};
#pragma unroll
        for (int s2 = 0; s2 < 8; ++s2) {
            u32x4 pw;
            pw.x = cvtpk(sacc[2 * s2][0], sacc[2 * s2][1]); pw.y = cvtpk(sacc[2 * s2][2], sacc[2 * s2][3]);
            pw.z = cvtpk(sacc[2 * s2 + 1][0], sacc[2 * s2 + 1][1]); pw.w = cvtpk(sacc[2 * s2 + 1][2], sacc[2 * s2 + 1][3]);
            const bf16x8 pf = __builtin_bit_cast(bf16x8, pw);
#pragma unroll
            for (int dt = 0; dt < 4; ++dt) {
                const bf16_t* vp = &Vs[(dt * 16 + r) * LV + s2 * 32 + 4 * g];
                const u32x2 v0 = *(const u32x2*)vp;
                const u32x2 v1 = *(const u32x2*)(vp + 16);
                u32x4 vw; vw.x = v0.x; vw.y = v0.y; vw.z = v1.x; vw.w = v1.y;
                oacc[dt] = mfma16(__builtin_bit_cast(bf16x8, vw), pf, oacc[dt]);
            }
            __builtin_amdgcn_sched_barrier(0);
        }
        bf16_t* orow = hcat + (size_t)(tq + r) * D + MIXW + h * 64;
#pragma unroll
        for (int dt = 0; dt < 4; ++dt) {
            u32x2 w; w.x = cvtpk(oacc[dt][0] * inv, oacc[dt][1] * inv); w.y = cvtpk(oacc[dt][2] * inv, oacc[dt][3] * inv);
            *(u32x2*)(orow + dt * 16 + 4 * g) = w;
        }
    }
}

__device__ void phase_ml_local(const P& p, int bid, int nb, char* smem) {
    const bf16_t* projb = (const bf16_t*)(p.ws + WS_PROJ);
    const float* logi = (const float*)(p.ws + WS_LOGI);
    const float* logf = (const float*)(p.ws + WS_LOGF);
    float* CT = (float*)(p.ws + WS_CT);
    float* nloc = (float*)(p.ws + WS_NLOC);
    float* mloc = (float*)(p.ws + WS_MLOC);
    float* gsum = (float*)(p.ws + WS_GSUM);
    constexpr int LS = 136;
    bf16_t* kwT = (bf16_t*)smem;
    bf16_t* vTs = kwT + 128 * LS;
    float* fb = (float*)(vTs + 128 * LS);
    float* fw = fb + 128;
    float* fr = fw + 128;
    const int tid = threadIdx.x, lane = tid & 63, wid = tid >> 6, r = lane & 15, g = lane >> 4;
    for (int task = bid; task < 48 * NCH; task += nb) {
        const int bh = task >> 4, c = task & 15, b = bh / 6, h = bh % 6;
        const int t0 = b * SEQ + c * CHUNK;
        __syncthreads();
        float li = 0.f, cum = 0.f;
        if (tid < 128) { li = logi[(size_t)bh * SEQ + c * CHUNK + tid]; cum = logf[(size_t)bh * SEQ + c * CHUNK + tid]; fb[tid] = cum; }
        __syncthreads();
        for (int off = 1; off < 128; off <<= 1) {
            float add = 0.f;
            if (tid < 128 && tid >= off) add = fb[tid - off];
            __syncthreads();
            if (tid < 128) { cum += add; fb[tid] = cum; }
            __syncthreads();
        }
        const float gtot = fb[127];
        float a = -3.0e38f;
        if (tid < 128) a = gtot - cum + li;
        float wm_ = a;
        wm_ = xor_max(wm_, 32); wm_ = xor_max(wm_, 16); wm_ = xor_max(wm_, 8); wm_ = xor_max(wm_, 4); wm_ = xor_max(wm_, 2); wm_ = xor_max(wm_, 1);
        if (lane == 0) fr[wid] = wm_;
        __syncthreads();
        const float ml = fmaxf(fr[0], fr[1]);
        if (tid < 128) fw[tid] = __expf(a - ml);
        __syncthreads();
        {
            const int s = tid & 127, half = tid >> 7;
            const float w = fw[s];
            const bf16_t* krow = projb + (size_t)(t0 + s) * LDP_ML + MIXW + h * 128;
            const bf16_t* vrow = projb + (size_t)(t0 + s) * LDP_ML + 2 * MIXW + h * 128;
#pragma unroll
            for (int i = 0; i < 8; ++i) {
                const int dc = half * 8 + i;
                const u32x4 kk = *(const u32x4*)(krow + dc * 8);
                const u32x4 vv = *(const u32x4*)(vrow + dc * 8);
#pragma unroll
                for (int q = 0; q < 4; ++q) {
                    kwT[(dc * 8 + 2 * q) * LS + s] = f2bf(bflo(kk[q]) * w);
                    kwT[(dc * 8 + 2 * q + 1) * LS + s] = f2bf(bfhi(kk[q]) * w);
                    vTs[(dc * 8 + 2 * q) * LS + s] = (bf16_t)(vv[q] & 0xffffu);
                    vTs[(dc * 8 + 2 * q + 1) * LS + s] = (bf16_t)(vv[q] >> 16);
                }
            }
        }
        __syncthreads();
        f32x4 acc[2][8];
#pragma unroll
        for (int et = 0; et < 2; ++et)
#pragma unroll
            for (int dt = 0; dt < 8; ++dt) acc[et][dt] = (f32x4){0.f, 0.f, 0.f, 0.f};
#pragma unroll
        for (int ks = 0; ks < 4; ++ks) {
            bf16x8 vf[2];
#pragma unroll
            for (int et = 0; et < 2; ++et) vf[et] = *(const bf16x8*)&vTs[(wid * 32 + et * 16 + r) * LS + ks * 32 + 8 * g];
#pragma unroll
            for (int dt = 0; dt < 8; ++dt) {
                const bf16x8 kf = *(const bf16x8*)&kwT[(dt * 16 + r) * LS + ks * 32 + 8 * g];
#pragma unroll
                for (int et = 0; et < 2; ++et) acc[et][dt] = mfma16(vf[et], kf, acc[et][dt]);
            }
        }
        float* ct = CT + (size_t)task * 128 * 128;
#pragma unroll
        for (int et = 0; et < 2; ++et)
#pragma unroll
            for (int dt = 0; dt < 8; ++dt)
#pragma unroll
                for (int i = 0; i < 4; ++i) ct[(wid * 32 + et * 16 + 4 * g + i) * 128 + dt * 16 + r] = acc[et][dt][i];
        if (tid < 128) {
            float sn = 0.f;
            for (int s = 0; s < 128; ++s) sn += bf2f(kwT[tid * LS + s]);
            nloc[(size_t)task * 128 + tid] = sn;
        }
        if (tid == 0) { mloc[task] = ml; gsum[task] = gtot; }
    }
}

__device__ void phase_ml_scan(const P& p, int bid, int nb) {
    const float* CT = (const float*)(p.ws + WS_CT);
    bf16_t* CPB = (bf16_t*)(p.ws + WS_CPB);
    const float* nloc = (const float*)(p.ws + WS_NLOC);
    float* nprev = (float*)(p.ws + WS_NPREV);
    const float* mloc = (const float*)(p.ws + WS_MLOC);
    const float* gsum = (const float*)(p.ws + WS_GSUM);
    float* mprev = (float*)(p.ws + WS_MPREV);
    const int tid = threadIdx.x;
    for (int task = bid; task < 48 * 16; task += nb) {
        const int bh = task >> 4, sl = task & 15;
        const int idx = sl * 1024 + tid * 4;
        float m = 0.f;
        f32x4 st = (f32x4){0.f, 0.f, 0.f, 0.f};
        float nst = 0.f;
        const bool don = (sl == 0 && tid < 128);
        for (int c = 0; c < NCH; ++c) {
            const int ch = bh * NCH + c;
            const float gg = gsum[ch], ml = mloc[ch];
            const float mnew = fmaxf(gg + m, ml);
            const float decay = __expf(gg + m - mnew), sc = __expf(ml - mnew);
            const f32x4 loc = *(const f32x4*)(CT + (size_t)ch * 16384 + idx);
            u32x2 w; w.x = cvtpk(st[0], st[1]); w.y = cvtpk(st[2], st[3]);
            *(u32x2*)(CPB + (size_t)ch * 16384 + idx) = w;
            st = st * decay + loc * sc;
            if (don) {
                const float nl = nloc[(size_t)ch * 128 + tid];
                nprev[(size_t)ch * 128 + tid] = nst;
                nst = nst * decay + nl * sc;
            }
            if (sl == 0 && tid == 0) mprev[ch] = m;
            m = mnew;
        }
    }
}

__device__ void phase_ml_out(const P& p, int layer, int bid, int nb, char* smem) {
    const int j = layer >> 1;
    const bf16_t* projb = (const bf16_t*)(p.ws + WS_PROJ);
    const float* logi = (const float*)(p.ws + WS_LOGI);
    const float* logf = (const float*)(p.ws + WS_LOGF);
    const bf16_t* CPB = (const bf16_t*)(p.ws + WS_CPB);
    const float* nprev = (const float*)(p.ws + WS_NPREV);
    const float* mprev = (const float*)(p.ws + WS_MPREV);
    bf16_t* hcat = (bf16_t*)(p.ws + WS_HCAT);
    const float* ng_ = p.ml_norm_g + (size_t)j * MIXW;
    constexpr int LS = 136;
    bf16_t* kS = (bf16_t*)smem;
    bf16_t* vTs = kS + 128 * LS;
    float* fb = (float*)(vTs + 128 * LS);
    float* fB = fb + 128;
    float* fA = fB + 128;
    float* fW = fA + 128;
    float* fE = fW + 128;
    float* fN = fE + 128;
    for (int task = bid; task < 48 * NCH; task += nb) {
        int tid = threadIdx.x;
        asm volatile("" : "+v"(tid));
        const int lane = tid & 63, wid = __builtin_amdgcn_readfirstlane(tid >> 6), r = lane & 15, g = lane >> 4;
        const int bh = task >> 4, c = task & 15, b = bh / 6, h = bh % 6;
        const int t0 = b * SEQ + c * CHUNK;
        __syncthreads();
        float li = 0.f, cum = 0.f;
        if (tid < 128) { li = logi[(size_t)bh * SEQ + c * CHUNK + tid]; cum = logf[(size_t)bh * SEQ + c * CHUNK + tid]; fb[tid] = cum; fN[tid] = nprev[(size_t)task * 128 + tid]; }
        __syncthreads();
        for (int off = 1; off < 128; off <<= 1) {
            float add = 0.f;
            if (tid < 128 && tid >= off) add = fb[tid - off];
            __syncthreads();
            if (tid < 128) { cum += add; fb[tid] = cum; }
            __syncthreads();
        }
        const float Bs_ = li - cum;
        float pm = Bs_;
        if (tid < 128) { fB[tid] = Bs_; fb[tid] = pm; }
        __syncthreads();
        for (int off = 1; off < 128; off <<= 1) {
            float o = -3.0e38f;
            if (tid < 128 && tid >= off) o = fb[tid - off];
            __syncthreads();
            if (tid < 128) { pm = fmaxf(pm, o); fb[tid] = pm; }
            __syncthreads();
        }
        if (tid < 128) {
            const float mp = mprev[task];
            const float inter = cum + mp;
            const float ml = fmaxf(cum + pm, inter);
            fA[tid] = cum - ml; fW[tid] = __expf(inter - ml); fE[tid] = __expf(-ml);
        }
        {
#pragma unroll
            for (int i = 0; i < 8; ++i) {
                const int s = (tid >> 4) + 16 * i, dc = tid & 15;
                *(u32x4*)&kS[s * LS + dc * 8] = *(const u32x4*)(projb + (size_t)(t0 + s) * LDP_ML + MIXW + h * 128 + dc * 8);
            }
            const int s = tid & 127, half = tid >> 7;
            const bf16_t* vrow = projb + (size_t)(t0 + s) * LDP_ML + 2 * MIXW + h * 128;
#pragma unroll
            for (int i = 0; i < 8; ++i) {
                const int dc = half * 8 + i;
                const u32x4 vv = *(const u32x4*)(vrow + dc * 8);
#pragma unroll
                for (int q = 0; q < 4; ++q) {
                    vTs[(dc * 8 + 2 * q) * LS + s] = (bf16_t)(vv[q] & 0xffffu);
                    vTs[(dc * 8 + 2 * q + 1) * LS + s] = (bf16_t)(vv[q] >> 16);
                }
            }
        }
        __syncthreads();
        const bf16_t* cp = CPB + (size_t)task * 16384;
#pragma unroll 1
        for (int lt = 0; lt < 2; ++lt) {
            const int l = wid * 32 + lt * 16 + r;
            bf16x8 qf[4];
            float qn;
            {
                const bf16_t* qrow = projb + (size_t)(t0 + l) * LDP_ML + h * 128;
                float part = 0.f;
#pragma unroll
                for (int ks = 0; ks < 4; ++ks) {
                    const u32x4 qq = *(const u32x4*)(qrow + ks * 32 + 8 * g);
                    qf[ks] = __builtin_bit_cast(bf16x8, qq);
#pragma unroll
                    for (int q = 0; q < 4; ++q) part += bflo(qq[q]) * fN[ks * 32 + 8 * g + 2 * q] + bfhi(qq[q]) * fN[ks * 32 + 8 * g + 2 * q + 1];
                }
                part = xor_add(part, 16); part = xor_add(part, 32);
                qn = part;
            }
            f32x4 nacc[8];
#pragma unroll
            for (int et = 0; et < 8; ++et) {
                f32x4 a = (f32x4){0.f, 0.f, 0.f, 0.f};
#pragma unroll
                for (int ks = 0; ks < 4; ++ks) {
                    const bf16x8 cf = *(const bf16x8*)(cp + (et * 16 + r) * 128 + ks * 32 + 8 * g);
                    a = mfma16(cf, qf[ks], a);
                }
                nacc[et] = a;
                if (et & 1) __builtin_amdgcn_sched_barrier(0);
            }
            const float Al = fA[l], wint = fW[l], eml = fE[l];
#pragma unroll
            for (int et = 0; et < 8; ++et) nacc[et] *= wint;
            const int stmax = wid * 2 + lt;
            f32x4 sacc[8];
            float den = 0.f;
#pragma unroll
            for (int st = 0; st < 8; ++st) {
                f32x4 a = (f32x4){0.f, 0.f, 0.f, 0.f};
                if (st <= stmax) {
#pragma unroll
                    for (int ks = 0; ks < 4; ++ks) {
                        const bf16x8 kf = *(const bf16x8*)&kS[(st * 16 + r) * LS + ks * 32 + 8 * g];
                        a = mfma16(kf, qf[ks], a);
                    }
#pragma unroll
                    for (int i = 0; i < 4; ++i) {
                        const int s = st * 16 + 4 * g + i;
                        const float v = (s <= l) ? a[i] * __expf(Al + fB[s]) : 0.f;
                        a[i] = v; den += v;
                    }
                }
                sacc[st] = a;
                __builtin_amdgcn_sched_barrier(0);
            }
            den = xor_add(den, 16); den = xor_add(den, 32);
#pragma unroll
            for (int s2 = 0; s2 < 4; ++s2) {
                if (2 * s2 <= stmax) {
                    u32x4 pw;
                    pw.x = cvtpk(sacc[2 * s2][0], sacc[2 * s2][1]); pw.y = cvtpk(sacc[2 * s2][2], sacc[2 * s2][3]);
                    pw.z = cvtpk(sacc[2 * s2 + 1][0], sacc[2 * s2 + 1][1]); pw.w = cvtpk(sacc[2 * s2 + 1][2], sacc[2 * s2 + 1][3]);
                    const bf16x8 pf = __builtin_bit_cast(bf16x8, pw);
#pragma unroll
                    for (int et = 0; et < 8; ++et) {
                        const bf16_t* vp = &vTs[(et * 16 + r) * LS + s2 * 32 + 4 * g];
                        const u32x2 v0 = *(const u32x2*)vp;
                        const u32x2 v1 = *(const u32x2*)(vp + 16);
                        u32x4 vw; vw.x = v0.x; vw.y = v0.y; vw.z = v1.x; vw.w = v1.y;
                        nacc[et] = mfma16(__builtin_bit_cast(bf16x8, vw), pf, nacc[et]);
                    }
                }
                __builtin_amdgcn_sched_barrier(0);
            }
            const float dd = fmaxf(fabsf(den + wint * qn), eml);
            const float invd = 1.0f / dd;
            float sm = 0.f;
#pragma unroll
            for (int et = 0; et < 8; ++et)
#pragma unroll
                for (int i = 0; i < 4; ++i) { nacc[et][i] *= invd; sm += nacc[et][i]; }
            sm = xor_add(sm, 16); sm = xor_add(sm, 32);
            const float mu = sm * (1.0f / 128.0f);
            float sq = 0.f;
#pragma unroll
            for (int et = 0; et < 8; ++et)
#pragma unroll
                for (int i = 0; i < 4; ++i) { const float dlt = nacc[et][i] - mu; sq += dlt * dlt; }
            sq = xor_add(sq, 16); sq = xor_add(sq, 32);
            const float rstd = rsqrtf(sq * (1.0f / 128.0f) + LN_EPS);
            const size_t trow = (size_t)(t0 + l);
            const bf16_t* og = projb + trow * LDP_ML + 3 * MIXW + h * 128;
            bf16_t* orow = hcat + trow * D + h * 128;
#pragma unroll
            for (int et = 0; et < 8; ++et) {
                const int e = et * 16 + 4 * g;
                const u32x2 ov = *(const u32x2*)(og + e);
                const f32x4 gv = *(const f32x4*)(ng_ + h * 128 + e);
                const float o0 = (nacc[et][0] - mu) * rstd * gv[0] * sigmoidf_(bflo(ov.x));
                const float o1 = (nacc[et][1] - mu) * rstd * gv[1] * sigmoidf_(bfhi(ov.x));
                const float o2 = (nacc[et][2] - mu) * rstd * gv[2] * sigmoidf_(bflo(ov.y));
                const float o3 = (nacc[et][3] - mu) * rstd * gv[3] * sigmoidf_(bfhi(ov.y));
                u32x2 w; w.x = cvtpk(o0, o1); w.y = cvtpk(o2, o3);
                *(u32x2*)(orow + e) = w;
            }
        }
    }
}

__device__ void phase_outproj(const P& p, int layer, int bid, int nb, char* smem) {
    const bf16_t* hcat = (const bf16_t*)(p.ws + WS_HCAT);
    const float* W = p.w_out + (size_t)layer * D * D;
    const float* xres = (layer == 0) ? p.x : (const float*)(p.ws + WS_XA);
    float* z = (float*)(p.ws + WS_Z);
    const int lane = threadIdx.x & 63, wid = threadIdx.x >> 6, r = lane & 15, g = lane >> 4, wm = wid >> 1, wn = wid & 1;
    for (int task = bid; task < 128 * 8; task += nb) {
        const int nt = task >> 7, mt = task & 127;
        gemm128([&](int rr) { return hcat + (size_t)(mt * 128 + rr) * D; }, [&](int ng) { return W + nt * 128 + 4 * ng; }, D, D, smem,
                [&](f32x4 (&acc)[4][4]) {
#pragma unroll
                    for (int mi = 0; mi < 4; ++mi)
#pragma unroll
                        for (int ni = 0; ni < 4; ++ni) {
                            const size_t off = (size_t)(mt * 128 + wm * 64 + mi * 16 + r) * D + nt * 128 + wn * 64 + ni * 16 + 4 * g;
                            const f32x4 xr = *(const f32x4*)(xres + off);
                            *(f32x4*)(z + off) = xr * ALPHA + acc[mi][ni];
                        }
                });
    }
}

__device__ void phase_ln1_route(const P& p, int layer, int bid, int nb, char* smem) {
    const float* z = (const float*)(p.ws + WS_Z);
    float* x1a = (float*)(p.ws + WS_X1A);
    bf16_t* x1b = (bf16_t*)(p.ws + WS_X1B);
    float* gate = (float*)(p.ws + WS_GATE);
    int* list = (int*)(p.ws + WS_LIST);
    int* cnt = (int*)(p.ws + WS_CTL + CTL_CNT) + layer * 32;
    const float* lg = p.ln1_g + (size_t)layer * D;
    const float* lb = p.ln1_b + (size_t)layer * D;
    float* xs = (float*)smem;
    float* red = xs + 8 * 1024;
    float* scs = red + 8 * 8 * 32;
    const int tid = threadIdx.x, lane = tid & 63, wid = tid >> 6;
    for (int task = bid; task < T / 8; task += nb) {
        const int row0 = task * 8;
        __syncthreads();
#pragma unroll
        for (int rr = 0; rr < 2; ++rr) {
            const int lr = wid * 2 + rr;
            const size_t t = (size_t)(row0 + lr);
            f32x4 v[4];
            float s = 0.f;
#pragma unroll
            for (int i = 0; i < 4; ++i) { v[i] = *(const f32x4*)(z + t * D + i * 256 + lane * 4); s += v[i][0] + v[i][1] + v[i][2] + v[i][3]; }
            s = wave_sum(s);
            const float mu = s * (1.0f / D);
            float q = 0.f;
#pragma unroll
            for (int i = 0; i < 4; ++i)
#pragma unroll
                for (int k = 0; k < 4; ++k) { const float d = v[i][k] - mu; q += d * d; }
            q = wave_sum(q);
            const float rstd = rsqrtf(q * (1.0f / D) + LN_EPS);
#pragma unroll
            for (int i = 0; i < 4; ++i) {
                const int col = i * 256 + lane * 4;
                const f32x4 gg = *(const f32x4*)(lg + col), bb = *(const f32x4*)(lb + col);
                f32x4 o = (v[i] - mu) * rstd * gg + bb;
                *(f32x4*)(x1a + t * D + col) = o;
                u32x2 w; w.x = cvtpk(o[0], o[1]); w.y = cvtpk(o[2], o[3]);
                *(u32x2*)(x1b + t * D + col) = w;
                *(f32x4*)(xs + lr * 1024 + col) = o;
            }
        }
        __syncthreads();
        {
            const int e = tid & 31, part = tid >> 5;
            float a[8];
#pragma unroll
            for (int i = 0; i < 8; ++i) a[i] = 0.f;
            for (int d4 = 0; d4 < 32; ++d4) {
                const int d = part * 128 + d4 * 4;
                const float w0 = p.router_w[(size_t)(d + 0) * 32 + e], w1 = p.router_w[(size_t)(d + 1) * 32 + e];
                const float w2 = p.router_w[(size_t)(d + 2) * 32 + e], w3 = p.router_w[(size_t)(d + 3) * 32 + e];
#pragma unroll
                for (int i = 0; i < 8; ++i) {
                    const f32x4 xv = *(const f32x4*)(xs + i * 1024 + d);
                    a[i] += xv[0] * w0 + xv[1] * w1 + xv[2] * w2 + xv[3] * w3;
                }
            }
#pragma unroll
            for (int i = 0; i < 8; ++i) red[(part * 8 + i) * 32 + e] = a[i];
        }
        __syncthreads();
        {
            const int e = tid & 31, i = tid >> 5;
            float s = 0.f;
#pragma unroll
            for (int part = 0; part < 8; ++part) s += red[(part * 8 + i) * 32 + e];
            scs[i * 32 + e] = sigmoidf_(s);
        }
        __syncthreads();
        if (tid < 8) {
            const float* sc = scs + tid * 32;
            int bestg = 0; float bestv = -3.0e38f;
            for (int gi = 0; gi < 8; ++gi) {
                float m1 = -3.0e38f, m2 = -3.0e38f;
                for (int k = 0; k < 4; ++k) {
                    const float v = sc[gi * 4 + k] + p.router_b[gi * 4 + k];
                    if (v > m1) { m2 = m1; m1 = v; } else if (v > m2) { m2 = v; }
                }
                const float gs = m1 + m2;
                if (gs > bestv) { bestv = gs; bestg = gi; }
            }
            int i1 = 0; float v1 = -3.0e38f;
            for (int k = 0; k < 4; ++k) { const float v = sc[bestg * 4 + k] + p.router_b[bestg * 4 + k]; if (v > v1) { v1 = v; i1 = k; } }
            int i2 = 0; float v2 = -3.0e38f;
            for (int k = 0; k < 4; ++k) { if (k == i1) continue; const float v = sc[bestg * 4 + k] + p.router_b[bestg * 4 + k]; if (v > v2) { v2 = v; i2 = k; } }
            const int e1 = bestg * 4 + i1, e2 = bestg * 4 + i2;
            const float s1 = sc[e1], s2 = sc[e2];
            const float inv = 1.0f / (s1 + s2);
            const int t = row0 + tid;
            gate[t * 2] = s1 * inv; gate[t * 2 + 1] = s2 * inv;
            const int p1 = atomicAdd(&cnt[e1], 1);
            list[(size_t)e1 * T + p1] = t * 2;
            const int p2 = atomicAdd(&cnt[e2], 1);
            list[(size_t)e2 * T + p2] = t * 2 + 1;
        }
    }
}

DI void moe_meta(const int* cnt, int* meta) {
    if (threadIdx.x == 0) {
        int base = 0, blk = 0;
        for (int e = 0; e < NE; ++e) {
            const int c = cnt[e];
            meta[e] = base; meta[32 + e] = blk; meta[65 + e] = c;
            base += c; blk += (c + 127) >> 7;
        }
        meta[64] = blk;
    }
    __syncthreads();
}

__device__ void phase_moe_up(const P& p, int layer, int bid, int nb, char* smem) {
    const int* cnt = (const int*)(p.ws + WS_CTL + CTL_CNT) + layer * 32;
    const int* list = (const int*)(p.ws + WS_LIST);
    const bf16_t* x1b = (const bf16_t*)(p.ws + WS_X1B);
    bf16_t* hbuf = (bf16_t*)(p.ws + WS_HBUF);
    int* meta = (int*)(smem + 2 * 128 * LDK * 2);
    const int lane = threadIdx.x & 63, wid = threadIdx.x >> 6, r = lane & 15, g = lane >> 4, wm = wid >> 1, wn = wid & 1;
    __syncthreads();
    moe_meta(cnt, meta);
    const int nrb = meta[64];
    for (int task = bid; task < nrb * 8; task += nb) {
        const int rbi = task >> 3, ft = task & 7;
        int e = 0;
        while (e < NE - 1 && meta[32 + e + 1] <= rbi) ++e;
        const int rb = rbi - meta[32 + e];
        const int cnte = meta[65 + e];
        const int valid = min(128, cnte - rb * 128);
        const int* lst = list + (size_t)e * T + rb * 128;
        const float* Wg = p.w_gate + ((size_t)layer * NE + e) * D * DFF;
        const float* Wu = p.w_up + ((size_t)layer * NE + e) * D * DFF;
        const size_t hrow0 = (size_t)meta[e] + rb * 128;
        gemm128([&](int rr) { const int a = lst[min(rr, valid - 1)]; return x1b + (size_t)(a >> 1) * D; },
                [&](int ng) {
                    const int v4 = 4 * ng, grp = v4 >> 4, wn_ = grp >> 2, ni_ = grp & 3;
                    const int col = ft * 64 + wn_ * 32 + (ni_ & 1) * 16 + (v4 & 15);
                    return ((ni_ >> 1) ? Wu : Wg) + col;
                },
                DFF, D, smem,
                [&](f32x4 (&acc)[4][4]) {
#pragma unroll
                    for (int mi = 0; mi < 4; ++mi) {
                        const int m = wm * 64 + mi * 16 + r;
                        if (m < valid) {
#pragma unroll
                            for (int ni = 0; ni < 2; ++ni) {
                                const f32x4 gv = acc[mi][ni], uv = acc[mi][ni + 2];
                                float hh[4];
#pragma unroll
                                for (int i = 0; i < 4; ++i) hh[i] = gv[i] * sigmoidf_(gv[i]) * uv[i];
                                u32x2 w; w.x = cvtpk(hh[0], hh[1]); w.y = cvtpk(hh[2], hh[3]);
                                *(u32x2*)&hbuf[(hrow0 + m) * DFF + ft * 64 + wn * 32 + ni * 16 + 4 * g] = w;
                            }
                        }
                    }
                });
    }
}

__device__ void phase_moe_down(const P& p, int layer, int bid, int nb, char* smem) {
    const int* cnt = (const int*)(p.ws + WS_CTL + CTL_CNT) + layer * 32;
    const int* list = (const int*)(p.ws + WS_LIST);
    const float* gate = (const float*)(p.ws + WS_GATE);
    const bf16_t* hbuf = (const bf16_t*)(p.ws + WS_HBUF);
    bf16_t* yasg = (bf16_t*)(p.ws + WS_YASG);
    int* meta = (int*)(smem + 2 * 128 * LDK * 2);
    const int lane = threadIdx.x & 63, wid = threadIdx.x >> 6, r = lane & 15, g = lane >> 4, wm = wid >> 1, wn = wid & 1;
    __syncthreads();
    moe_meta(cnt, meta);
    const int nrb = meta[64];
    for (int task = bid; task < nrb * 8; task += nb) {
        const int rbi = task >> 3, nt = task & 7;
        int e = 0;
        while (e < NE - 1 && meta[32 + e + 1] <= rbi) ++e;
        const int rb = rbi - meta[32 + e];
        const int cnte = meta[65 + e];
        const int valid = min(128, cnte - rb * 128);
        const int* lst = list + (size_t)e * T + rb * 128;
        const float* Wd = p.w_down + ((size_t)layer * NE + e) * DFF * D + nt * 128;
        const size_t hrow0 = (size_t)meta[e] + rb * 128;
        gemm128([&](int rr) { return hbuf + (hrow0 + min(rr, valid - 1)) * DFF; }, [&](int ng) { return Wd + 4 * ng; }, D, DFF, smem,
                [&](f32x4 (&acc)[4][4]) {
#pragma unroll
                    for (int mi = 0; mi < 4; ++mi) {
                        const int m = wm * 64 + mi * 16 + r;
                        if (m < valid) {
                            const int a = lst[m];
                            const float gt = gate[a];
#pragma unroll
                            for (int ni = 0; ni < 4; ++ni) {
                                const f32x4 v = acc[mi][ni] * gt;
                                u32x2 w; w.x = cvtpk(v[0], v[1]); w.y = cvtpk(v[2], v[3]);
                                *(u32x2*)&yasg[(size_t)a * D + nt * 128 + wn * 64 + ni * 16 + 4 * g] = w;
                            }
                        }
                    }
                });
    }
}

__device__ void phase_ln2(const P& p, int layer, int bid, int nb) {
    const float* x1a = (const float*)(p.ws + WS_X1A);
    const bf16_t* yasg = (const bf16_t*)(p.ws + WS_YASG);
    float* xa = (layer == DEPTH - 1) ? p.out : (float*)(p.ws + WS_XA);
    bf16_t* xb = (bf16_t*)(p.ws + WS_XB);
    const float* lg = p.ln2_g + (size_t)layer * D;
    const float* lb = p.ln2_b + (size_t)layer * D;
    const int tid = threadIdx.x, lane = tid & 63, wid = tid >> 6;
    for (int t = bid * 4 + wid; t < T; t += nb * 4) {
        f32x4 v[4];
        float s = 0.f;
#pragma unroll
        for (int i = 0; i < 4; ++i) {
            const int col = i * 256 + lane * 4;
            const f32x4 xv = *(const f32x4*)(x1a + (size_t)t * D + col);
            const u32x2 y0 = *(const u32x2*)(yasg + (size_t)(2 * t) * D + col);
            const u32x2 y1 = *(const u32x2*)(yasg + (size_t)(2 * t + 1) * D + col);
            f32x4 o;
            o[0] = xv[0] * ALPHA + (bflo(y0.x) + bflo(y1.x));
            o[1] = xv[1] * ALPHA + (bfhi(y0.x) + bfhi(y1.x));
            o[2] = xv[2] * ALPHA + (bflo(y0.y) + bflo(y1.y));
            o[3] = xv[3] * ALPHA + (bfhi(y0.y) + bfhi(y1.y));
            v[i] = o; s += o[0] + o[1] + o[2] + o[3];
        }
        s = wave_sum(s);
        const float mu = s * (1.0f / D);
        float q = 0.f;
#pragma unroll
        for (int i = 0; i < 4; ++i)
#pragma unroll
            for (int k = 0; k < 4; ++k) { const float d = v[i][k] - mu; q += d * d; }
        q = wave_sum(q);
        const float rstd = rsqrtf(q * (1.0f / D) + LN_EPS);
#pragma unroll
        for (int i = 0; i < 4; ++i) {
            const int col = i * 256 + lane * 4;
            const f32x4 gg = *(const f32x4*)(lg + col), bb = *(const f32x4*)(lb + col);
            const f32x4 o = (v[i] - mu) * rstd * gg + bb;
            *(f32x4*)(xa + (size_t)t * D + col) = o;
            if (layer != DEPTH - 1) { u32x2 w; w.x = cvtpk(o[0], o[1]); w.y = cvtpk(o[2], o[3]); *(u32x2*)(xb + (size_t)t * D + col) = w; }
        }
    }
}

enum { PH_PREP = 0, PH_KV, PH_INPROJ, PH_MIX1, PH_MIX2, PH_MIX3, PH_OUTPROJ, PH_LN1, PH_MOEUP, PH_MOEDOWN, PH_LN2 };

DI void run_phase(const P& p, int ph, int layer, int bid, int nb, char* smem) {
    const bool conv = (layer & 1) == 0;
    switch (ph) {
        case PH_PREP: phase_prep(p, bid, nb); break;
        case PH_KV: phase_kv(p, bid, nb, smem); break;
        case PH_INPROJ: phase_inproj(p, layer, bid, nb, smem); break;
        case PH_MIX1: if (!conv) phase_ml_local(p, bid, nb, smem); break;
        case PH_MIX2: if (!conv) phase_ml_scan(p, bid, nb); break;
        case PH_MIX3:
            if (conv) phase_convmix(p, layer, bid, nb); else phase_ml_out(p, layer, bid, nb, smem);
            phase_xattn(p, layer, bid, nb, smem);
            break;
        case PH_OUTPROJ: phase_outproj(p, layer, bid, nb, smem); break;
        case PH_LN1: phase_ln1_route(p, layer, bid, nb, smem); break;
        case PH_MOEUP: phase_moe_up(p, layer, bid, nb, smem); break;
        case PH_MOEDOWN: phase_moe_down(p, layer, bid, nb, smem); break;
        case PH_LN2: phase_ln2(p, layer, bid, nb); break;
    }
}

__global__ void __launch_bounds__(NTHREADS, 2) k_phase(P p, int ph, int layer) {
    __shared__ __attribute__((aligned(16))) char smem[SMEM_BYTES];
    run_phase(p, ph, layer, blockIdx.x, gridDim.x, smem);
}

extern "C" void kernel_launch(void* const* d_in, const int* in_sizes, int n_in, void* d_out, int out_size, void* d_ws, size_t ws_size,
                              hipStream_t stream) {
    if (ws_size < WS_TOTAL) { fprintf(stderr, "kernel_launch: workspace too small: %zu < %zu\n", ws_size, (size_t)WS_TOTAL); return; }
    P p{};
    p.x = (const float*)d_in[0]; p.mem = (const float*)d_in[1]; p.conv_w_in = (const float*)d_in[2]; p.conv_w = (const float*)d_in[3];
    p.ml_w_in = (const float*)d_in[4]; p.ml_gate_b = (const float*)d_in[5]; p.ml_norm_g = (const float*)d_in[6]; p.w_kv = (const float*)d_in[7];
    p.w_out = (const float*)d_in[8]; p.ln1_g = (const float*)d_in[9]; p.ln1_b = (const float*)d_in[10]; p.ln2_g = (const float*)d_in[11];
    p.ln2_b = (const float*)d_in[12]; p.router_w = (const float*)d_in[13]; p.router_b = (const float*)d_in[14]; p.w_gate = (const float*)d_in[15];
    p.w_up = (const float*)d_in[16]; p.w_down = (const float*)d_in[17];
    p.out = (float*)d_out; p.ws = (char*)d_ws;
    hipMemsetAsync((char*)d_ws + WS_CTL, 0, CTL_BYTES, stream);
    const int grid = 1024;
    k_phase<<<grid, NTHREADS, 0, stream>>>(p, PH_PREP, 0);
    k_phase<<<grid, NTHREADS, 0, stream>>>(p, PH_KV, 0);
    for (int layer = 0; layer < DEPTH; ++layer) {
        const bool conv = (layer & 1) == 0;
        k_phase<<<grid, NTHREADS, 0, stream>>>(p, PH_INPROJ, layer);
        if (!conv) {
            k_phase<<<grid, NTHREADS, 0, stream>>>(p, PH_MIX1, layer);
            k_phase<<<grid, NTHREADS, 0, stream>>>(p, PH_MIX2, layer);
        }
        k_phase<<<grid, NTHREADS, 0, stream>>>(p, PH_MIX3, layer);
        k_phase<<<grid, NTHREADS, 0, stream>>>(p, PH_OUTPROJ, layer);
        k_phase<<<grid, NTHREADS, 0, stream>>>(p, PH_LN1, layer);
        k_phase<<<grid, NTHREADS, 0, stream>>>(p, PH_MOEUP, layer);
        k_phase<<<grid, NTHREADS, 0, stream>>>(p, PH_MOEDOWN, layer);
        k_phase<<<grid, NTHREADS, 0, stream>>>(p, PH_LN2, layer);
    }
}
```

```cpp
#include <hip/hip_runtime.h>
#include <stdint.h>
#include <stdio.h>

typedef unsigned short bf16_t;
typedef __attribute__((ext_vector_type(8))) short bf16x8;
typedef __attribute__((ext_vector_type(4))) float f32x4;
typedef __attribute__((ext_vector_type(4))) unsigned u32x4;
typedef __attribute__((ext_vector_type(2))) unsigned u32x2;

#define DI __device__ __forceinline__

constexpr int D = 1024;
constexpr int NBATCH = 8;
constexpr int SEQ = 2048;
constexpr int T = NBATCH * SEQ;
constexpr int DEPTH = 4;
constexpr int MIXW = 768;
constexpr int XH = 4, XDH = 64, XW = 256, MEML = 256;
constexpr int MLH = 6, MLDH = 128, CHUNK = 128, NCH = SEQ / CHUNK;
constexpr int DIN_CONV = 2560, DIN_ML = 3340, LDP_ML = 3328;
constexpr int NE = 32, DFF = 512;
constexpr float ALPHA = 1.681792830507429f;
constexpr float LN_EPS = 1e-5f;

constexpr int NTHREADS = 256;
constexpr int LDK = 72;
constexpr int SMEM_BYTES = 72 * 1024;

constexpr size_t al256(size_t x) { return (x + 255) & ~(size_t)255; }
constexpr size_t WS_CTL   = 0;
constexpr size_t CTL_BYTES = 64 * 1024;
constexpr size_t CTL_CNT  = 32 * 1024;
constexpr size_t WS_XA    = WS_CTL + CTL_BYTES;
constexpr size_t WS_XB    = WS_XA + (size_t)T * D * 4;
constexpr size_t WS_MEMB  = WS_XB + (size_t)T * D * 2;
constexpr size_t WS_KBUF  = WS_MEMB + (size_t)NBATCH * MEML * D * 2;
constexpr size_t WS_VT    = WS_KBUF + (size_t)DEPTH * NBATCH * MEML * XW * 2;
constexpr size_t WS_PROJ  = WS_VT + (size_t)DEPTH * NBATCH * MEML * XW * 2;
constexpr size_t WS_LOGI  = WS_PROJ + (size_t)T * LDP_ML * 2;
constexpr size_t WS_LOGF  = WS_LOGI + (size_t)NBATCH * MLH * SEQ * 4;
constexpr size_t WS_CT    = WS_LOGF + (size_t)NBATCH * MLH * SEQ * 4;
constexpr size_t WS_CPB   = WS_CT + (size_t)48 * NCH * 128 * 128 * 4;
constexpr size_t WS_NLOC  = WS_CPB + (size_t)48 * NCH * 128 * 128 * 2;
constexpr size_t WS_NPREV = WS_NLOC + (size_t)48 * NCH * 128 * 4;
constexpr size_t WS_MLOC  = WS_NPREV + (size_t)48 * NCH * 128 * 4;
constexpr size_t WS_GSUM  = WS_MLOC + al256(48 * NCH * 4);
constexpr size_t WS_MPREV = WS_GSUM + al256(48 * NCH * 4);
constexpr size_t WS_HCAT  = WS_MPREV + al256(48 * NCH * 4);
constexpr size_t WS_Z     = WS_HCAT + (size_t)T * D * 2;
constexpr size_t WS_X1A   = WS_Z + (size_t)T * D * 4;
constexpr size_t WS_X1B   = WS_X1A + (size_t)T * D * 4;
constexpr size_t WS_GATE  = WS_X1B + (size_t)T * D * 2;
constexpr size_t WS_LIST  = WS_GATE + (size_t)T * 2 * 4;
constexpr size_t WS_HBUF  = WS_LIST + (size_t)NE * T * 4;
constexpr size_t WS_YASG  = WS_HBUF + (size_t)T * 2 * DFF * 2;
constexpr size_t WS_TOTAL = WS_YASG + (size_t)T * 2 * D * 2;

struct P {
    const float *x, *mem, *conv_w_in, *conv_w, *ml_w_in, *ml_gate_b, *ml_norm_g, *w_kv, *w_out;
    const float *ln1_g, *ln1_b, *ln2_g, *ln2_b, *router_w, *router_b, *w_gate, *w_up, *w_down;
    float* out;
    char* ws;
};

DI unsigned cvtpk(float lo, float hi) { unsigned r; asm("v_cvt_pk_bf16_f32 %0, %1, %2" : "=v"(r) : "v"(lo), "v"(hi)); return r; }
DI float bf2f(bf16_t v) { return __uint_as_float(((unsigned)v) << 16); }
DI float bflo(unsigned v) { return __uint_as_float(v << 16); }
DI float bfhi(unsigned v) { return __uint_as_float(v & 0xffff0000u); }
DI bf16_t f2bf(float f) { return (bf16_t)(cvtpk(f, f) & 0xffffu); }
DI float sigmoidf_(float x) { return 1.0f / (1.0f + __expf(-x)); }
DI float logsigmoidf_(float x) { return fminf(x, 0.0f) - log1pf(__expf(-fabsf(x))); }
DI float xor_add(float v, int m) { return v + __shfl_xor(v, m, 64); }
DI float xor_max(float v, int m) { return fmaxf(v, __shfl_xor(v, m, 64)); }
DI float wave_sum(float v) { v = xor_add(v, 32); v = xor_add(v, 16); v = xor_add(v, 8); v = xor_add(v, 4); v = xor_add(v, 2); v = xor_add(v, 1); return v; }
DI int tid_opaque() { int t = threadIdx.x; asm volatile("" : "+v"(t)); return t; }
DI f32x4 mfma16(bf16x8 a, bf16x8 b, f32x4 c) { return __builtin_amdgcn_mfma_f32_16x16x32_bf16(a, b, c, 0, 0, 0); }

template <class ARow, class BPtr, class Epi>
DI void gemm128(ARow arow, BPtr bptr, int ldb, int K, char* smem, Epi epi) {
    bf16_t* As = (bf16_t*)smem;
    bf16_t* Bs = As + 128 * LDK;
    const int tid = tid_opaque(), lane = tid & 63, wid = tid >> 6;
    const int r = lane & 15, g = lane >> 4;
    const int wm = wid >> 1, wn = wid & 1;
    const int akc = tid & 7, arow0 = tid >> 3;
    const bf16_t* ap0 = arow(arow0) + akc * 8;
    const bf16_t* ap1 = arow(arow0 + 32) + akc * 8;
    const bf16_t* ap2 = arow(arow0 + 64) + akc * 8;
    const bf16_t* ap3 = arow(arow0 + 96) + akc * 8;
    const int kg = tid & 7, ng = tid >> 3;
    const float* bp = bptr(ng) + (size_t)(kg * 8) * ldb;

    u32x4 areg[4];
    f32x4 breg[8];
    f32x4 acc[4][4];
#pragma unroll
    for (int i = 0; i < 4; ++i)
#pragma unroll
        for (int j = 0; j < 4; ++j) acc[i][j] = (f32x4){0.f, 0.f, 0.f, 0.f};

    areg[0] = *(const u32x4*)(ap0); areg[1] = *(const u32x4*)(ap1); areg[2] = *(const u32x4*)(ap2); areg[3] = *(const u32x4*)(ap3);
#pragma unroll
    for (int i = 0; i < 8; ++i) breg[i] = *(const f32x4*)(bp + (size_t)i * ldb);

    for (int k0 = 0; k0 < K; k0 += 64) {
        __syncthreads();
#pragma unroll
        for (int i = 0; i < 4; ++i) *(u32x4*)&As[(arow0 + 32 * i) * LDK + akc * 8] = areg[i];
#pragma unroll
        for (int c = 0; c < 4; ++c) {
            u32x4 w;
            w.x = cvtpk(breg[0][c], breg[1][c]); w.y = cvtpk(breg[2][c], breg[3][c]);
            w.z = cvtpk(breg[4][c], breg[5][c]); w.w = cvtpk(breg[6][c], breg[7][c]);
            *(u32x4*)&Bs[(4 * ng + c) * LDK + kg * 8] = w;
        }
        __syncthreads();
        if (k0 + 64 < K) {
            const int kn = k0 + 64;
            areg[0] = *(const u32x4*)(ap0 + kn); areg[1] = *(const u32x4*)(ap1 + kn);
            areg[2] = *(const u32x4*)(ap2 + kn); areg[3] = *(const u32x4*)(ap3 + kn);
#pragma unroll
            for (int i = 0; i < 8; ++i) breg[i] = *(const f32x4*)(bp + (size_t)(kn + i) * ldb);
        }
#pragma unroll
        for (int kk = 0; kk < 2; ++kk) {
            bf16x8 wf[4], xf[4];
#pragma unroll
            for (int ni = 0; ni < 4; ++ni) wf[ni] = *(const bf16x8*)&Bs[(wn * 64 + ni * 16 + r) * LDK + kk * 32 + 8 * g];
#pragma unroll
            for (int mi = 0; mi < 4; ++mi) xf[mi] = *(const bf16x8*)&As[(wm * 64 + mi * 16 + r) * LDK + kk * 32 + 8 * g];
#pragma unroll
            for (int mi = 0; mi < 4; ++mi)
#pragma unroll
                for (int ni = 0; ni < 4; ++ni) acc[mi][ni] = mfma16(wf[ni], xf[mi], acc[mi][ni]);
        }
    }
    epi(acc);
}

DI void phase_prep(const P& p, int bid, int nb) {
    bf16_t* xb = (bf16_t*)(p.ws + WS_XB);
    bf16_t* memb = (bf16_t*)(p.ws + WS_MEMB);
    const size_t nx = (size_t)T * D / 4, nm = (size_t)NBATCH * MEML * D / 4;
    for (size_t i = (size_t)bid * NTHREADS + threadIdx.x; i < nx + nm; i += (size_t)nb * NTHREADS) {
        if (i < nx) { f32x4 v = ((const f32x4*)p.x)[i]; u32x2 w; w.x = cvtpk(v[0], v[1]); w.y = cvtpk(v[2], v[3]); ((u32x2*)xb)[i] = w; }
        else { size_t j = i - nx; f32x4 v = ((const f32x4*)p.mem)[j]; u32x2 w; w.x = cvtpk(v[0], v[1]); w.y = cvtpk(v[2], v[3]); ((u32x2*)memb)[j] = w; }
    }
}

DI void phase_kv(const P& p, int bid, int nb, char* smem) {
    const bf16_t* memb = (const bf16_t*)(p.ws + WS_MEMB);
    bf16_t* kbuf = (bf16_t*)(p.ws + WS_KBUF);
    bf16_t* vT = (bf16_t*)(p.ws + WS_VT);
    const int tid_ = tid_opaque(), lane = tid_ & 63, wid = tid_ >> 6, r = lane & 15, g = lane >> 4, wm = wid >> 1, wn = wid & 1;
    for (int task = bid; task < DEPTH * 16 * 4; task += nb) {
        const int layer = task >> 6, mt = (task >> 2) & 15, nt = task & 3;
        const float* W = p.w_kv + (size_t)layer * D * 512 + nt * 128;
        gemm128([&](int rr) { return memb + (size_t)(mt * 128 + rr) * D; }, [&](int ng) { return W + 4 * ng; }, 512, D, smem,
                [&](f32x4 (&acc)[4][4]) {
#pragma unroll
                    for (int mi = 0; mi < 4; ++mi)
#pragma unroll
                        for (int ni = 0; ni < 4; ++ni) {
                            const int m = mt * 128 + wm * 64 + mi * 16 + r;
                            const int n = nt * 128 + wn * 64 + ni * 16 + 4 * g;
                            const f32x4 v = acc[mi][ni];
                            if (n < 256) {
                                u32x2 w; w.x = cvtpk(v[0], v[1]); w.y = cvtpk(v[2], v[3]);
                                *(u32x2*)&kbuf[((size_t)layer * 2048 + m) * 256 + n] = w;
                            } else {
                                const int nn = n - 256, b = m >> 8, mm = m & 255;
#pragma unroll
                                for (int i = 0; i < 4; ++i) {
                                    const int h = (nn + i) >> 6, dv = (nn + i) & 63;
                                    vT[((((size_t)layer * 8 + b) * 4 + h) * 64 + dv) * 256 + mm] = f2bf(v[i]);
                                }
                            }
                        }
                });
    }
}

DI void phase_inproj(const P& p, int layer, int bid, int nb, char* smem) {
    const bool conv = (layer & 1) == 0;
    const int j = layer >> 1;
    const int NT = conv ? 20 : 27, ldb = conv ? DIN_CONV : DIN_ML, ldp = conv ? DIN_CONV : LDP_ML;
    const float* W = conv ? p.conv_w_in + (size_t)j * D * DIN_CONV : p.ml_w_in + (size_t)j * D * DIN_ML;
    const bf16_t* xb = (const bf16_t*)(p.ws + WS_XB);
    bf16_t* projb = (bf16_t*)(p.ws + WS_PROJ);
    float* logi = (float*)(p.ws + WS_LOGI);
    float* logf = (float*)(p.ws + WS_LOGF);
    const int tid_ = tid_opaque(), lane = tid_ & 63, wid = tid_ >> 6, r = lane & 15, g = lane >> 4, wm = wid >> 1, wn = wid & 1;
    for (int task = bid; task < 128 * NT; task += nb) {
        const int nt = task >> 7, mt = task & 127;
        int pcol, ocol;
        if (conv || nt < 24) { pcol = nt * 128; ocol = pcol; }
        else if (nt == 24) { pcol = 3072; ocol = 0; }
        else { pcol = 3084 + (nt - 25) * 128; ocol = 3072 + (nt - 25) * 128; }
        const bool gates = (!conv && nt == 24);
        const float sc = (!conv && nt >= 6 && nt < 12) ? 0.08838834764831845f : 1.0f;
        gemm128([&](int rr) { return xb + (size_t)(mt * 128 + rr) * D; }, [&](int ng) { return W + pcol + 4 * ng; }, ldb, D, smem,
                [&](f32x4 (&acc)[4][4]) {
#pragma unroll
                    for (int mi = 0; mi < 4; ++mi)
#pragma unroll
                        for (int ni = 0; ni < 4; ++ni) {
                            const int m = mt * 128 + wm * 64 + mi * 16 + r;
                            const int n = wn * 64 + ni * 16 + 4 * g;
                            const f32x4 v = acc[mi][ni];
                            if (gates) {
                                if (n < 12) {
                                    const int b = m >> 11, s = m & 2047;
#pragma unroll
                                    for (int i = 0; i < 4; ++i) {
                                        const int col = n + i;
                                        const float val = v[i] + p.ml_gate_b[j * 12 + col];
                                        if (col < 6) logi[(size_t)(b * 6 + col) * SEQ + s] = val;
                                        else logf[(size_t)(b * 6 + col - 6) * SEQ + s] = logsigmoidf_(val);
                                    }
                                }
                            } else {
                                u32x2 w; w.x = cvtpk(v[0] * sc, v[1] * sc); w.y = cvtpk(v[2] * sc, v[3] * sc);
                                *(u32x2*)&projb[(size_t)m * ldp + ocol + n] = w;
                            }
                        }
                });
    }
}

DI void phase_convmix(const P& p, int layer, int bid, int nb) {
    const int j = layer >> 1;
    const bf16_t* projb = (const bf16_t*)(p.ws + WS_PROJ);
    bf16_t* hcat = (bf16_t*)(p.ws + WS_HCAT);
    const float* cw = p.conv_w + (size_t)j * 3 * MIXW;
    const int nitem = T * (MIXW / 8);
    for (int it = bid * NTHREADS + threadIdx.x; it < nitem; it += nb * NTHREADS) {
        const int t = it / 96, c8 = (it % 96) * 8;
        const int s = t & 2047;
        const bf16_t* row = projb + (size_t)t * DIN_CONV;
        const u32x4 bg = *(const u32x4*)(row + c8);
        float u[3][8];
#pragma unroll
        for (int d = 0; d < 3; ++d) {
            const int back = 2 - d;
            if (s - back >= 0) {
                const bf16_t* rw = row - (size_t)back * DIN_CONV;
                const u32x4 cg = *(const u32x4*)(rw + MIXW + c8);
                const u32x4 xi = *(const u32x4*)(rw + 2 * MIXW + c8);
#pragma unroll
                for (int q = 0; q < 4; ++q) { u[d][2 * q] = bflo(cg[q]) * bflo(xi[q]); u[d][2 * q + 1] = bfhi(cg[q]) * bfhi(xi[q]); }
            } else {
#pragma unroll
                for (int q = 0; q < 8; ++q) u[d][q] = 0.f;
            }
        }
        float o[8];
#pragma unroll
        for (int q = 0; q < 8; ++q) {
            const float c = cw[c8 + q] * u[0][q] + cw[MIXW + c8 + q] * u[1][q] + cw[2 * MIXW + c8 + q] * u[2][q];
            const float b = (q & 1) ? bfhi(bg[q >> 1]) : bflo(bg[q >> 1]);
            o[q] = b * c;
        }
        u32x4 w; w.x = cvtpk(o[0], o[1]); w.y = cvtpk(o[2], o[3]); w.z = cvtpk(o[4], o[5]); w.w = cvtpk(o[6], o[7]);
        *(u32x4*)(hcat + (size_t)t * D + c8) = w;
    }
}

DI void phase_xattn(const P& p, int layer, int bid, int nb, char* smem) {
    const bool conv = (layer & 1) == 0;
    const int ldp = conv ? DIN_CONV : LDP_ML;
    const int qoff = conv ? 3 * MIXW : 3072;
    const bf16_t* projb = (const bf16_t*)(p.ws + WS_PROJ);
    const bf16_t* kbuf = (const bf16_t*)(p.ws + WS_KBUF) + (size_t)layer * 2048 * 256;
    const bf16_t* vT = (const bf16_t*)(p.ws + WS_VT) + (size_t)layer * 8 * 4 * 64 * 256;
    bf16_t* hcat = (bf16_t*)(p.ws + WS_HCAT);
    constexpr int LK = 72, LV = 264;
    bf16_t* Ks = (bf16_t*)smem;
    bf16_t* Vs = Ks + 256 * LK;
    const int tid = tid_opaque(), lane = tid & 63, wid = tid >> 6, r = lane & 15, g = lane >> 4;
    for (int task = bid; task < NBATCH * XH * 32; task += nb) {
        const int b = task >> 7, h = (task >> 5) & 3, qt = task & 31;
        __syncthreads();
#pragma unroll
        for (int i = 0; i < 8; ++i) {
            const int c = tid + 256 * i;
            const int key = c >> 3, kc = c & 7;
            *(u32x4*)&Ks[key * LK + kc * 8] = *(const u32x4*)(kbuf + ((size_t)b * 256 + key) * 256 + h * 64 + kc * 8);
            const int dv = c >> 5, mc = c & 31;
            *(u32x4*)&Vs[dv * LV + mc * 8] = *(const u32x4*)(vT + (((size_t)b * 4 + h) * 64 + dv) * 256 + mc * 8);
        }
        __syncthreads();
        const int tq = b * SEQ + qt * 64 + wid * 16;
        const bf16_t* qrow = projb + (size_t)(tq + r) * ldp + qoff + h * 64;
        bf16x8 qf[2];
        qf[0] = *(const bf16x8*)(qrow + 8 * g);
        qf[1] = *(const bf16x8*)(qrow + 32 + 8 * g);
        f32x4 sacc[16];
#pragma unroll
        for (int kt = 0; kt < 16; ++kt) {
            f32x4 a = (f32x4){0.f, 0.f, 0.f, 0.f};
#pragma unroll
            for (int ks = 0; ks < 2; ++ks) {
                const bf16x8 kf = *(const bf16x8*)&Ks[(kt * 16 + r) * LK + ks * 32 + 8 * g];
                a = mfma16(kf, qf[ks], a);
            }
            sacc[kt] = a;
            if (kt & 1) __builtin_amdgcn_sched_barrier(0);
        }
        float mx = -3.0e38f;
#pragma unroll
        for (int kt = 0; kt < 16; ++kt)
#pragma unroll
            for (int i = 0; i < 4; ++i) { sacc[kt][i] *= 0.125f; mx = fmaxf(mx, sacc[kt][i]); }
        mx = xor_max(mx, 16); mx = xor_max(mx, 32);
        float sum = 0.f;
#pragma unroll
        for (int kt = 0; kt < 16; ++kt)
#pragma unroll
            for (int i = 0; i < 4; ++i) { const float e = __expf(sacc[kt][i] - mx); sacc[kt][i] = e; sum += e; }
        sum = xor_add(sum, 16); sum = xor_add(sum, 32);
        const float inv = 1.0f / sum;
        f32x4 oacc[4];
#pragma unroll
        for (int dt = 0; dt < 4; ++dt) oacc[dt] = (f32x4){0.f, 0.f, 0.f, 0.f};
#pragma unroll
        for (int s2 = 0; s2 < 8; ++s2) {
            u32x4 pw;
            pw.x = cvtpk(sacc[2 * s2][0], sacc[2 * s2][1]); pw.y = cvtpk(sacc[2 * s2][2], sacc[2 * s2][3]);
            pw.z = cvtpk(sacc[2 * s2 + 1][0], sacc[2 * s2 + 1][1]); pw.w = cvtpk(sacc[2 * s2 + 1][2], sacc[2 * s2 + 1][3]);
            const bf16x8 pf = __builtin_bit_cast(bf16x8, pw);
#pragma unroll
            for (int dt = 0; dt < 4; ++dt) {
                const bf16_t* vp = &Vs[(dt * 16 + r) * LV + s2 * 32 + 4 * g];
                const u32x2 v0 = *(const u32x2*)vp;
                const u32x2 v1 = *(const u32x2*)(vp + 16);
                u32x4 vw; vw.x = v0.x; vw.y = v0.y; vw.z = v1.x; vw.w = v1.y;
                oacc[dt] = mfma16(__builtin_bit_cast(bf16x8, vw), pf, oacc[dt]);
            }
            __builtin_amdgcn_sched_barrier(0);
        }
        bf16_t* orow = hcat + (size_t)(tq + r) * D + MIXW + h * 64;
#pragma unroll
        for (int dt = 0; dt < 4; ++dt) {
            u32x2 w; w.x = cvtpk(oacc[dt][0] * inv, oacc[dt][1] * inv); w.y = cvtpk(oacc[dt][2] * inv, oacc[dt][3] * inv);
            *(u32x2*)(orow + dt * 16 + 4 * g) = w;
        }
    }
}

DI void phase_ml_local(const P& p, int bid, int nb, char* smem) {
    const bf16_t* projb = (const bf16_t*)(p.ws + WS_PROJ);
    const float* logi = (const float*)(p.ws + WS_LOGI);
    const float* logf = (const float*)(p.ws + WS_LOGF);
    float* CT = (float*)(p.ws + WS_CT);
    float* nloc = (float*)(p.ws + WS_NLOC);
    float* mloc = (float*)(p.ws + WS_MLOC);
    float* gsum = (float*)(p.ws + WS_GSUM);
    constexpr int LS = 136;
    bf16_t* kwT = (bf16_t*)smem;
    bf16_t* vTs = kwT + 128 * LS;
    float* fb = (float*)(vTs + 128 * LS);
    float* fw = fb + 128;
    float* fr = fw + 128;
    const int tid = tid_opaque(), lane = tid & 63, wid = tid >> 6, r = lane & 15, g = lane >> 4;
    for (int task = bid; task < 48 * NCH; task += nb) {
        const int bh = task >> 4, c = task & 15, b = bh / 6, h = bh % 6;
        const int t0 = b * SEQ + c * CHUNK;
        __syncthreads();
        float li = 0.f, cum = 0.f;
        if (tid < 128) { li = logi[(size_t)bh * SEQ + c * CHUNK + tid]; cum = logf[(size_t)bh * SEQ + c * CHUNK + tid]; fb[tid] = cum; }
        __syncthreads();
        for (int off = 1; off < 128; off <<= 1) {
            float add = 0.f;
            if (tid < 128 && tid >= off) add = fb[tid - off];
            __syncthreads();
            if (tid < 128) { cum += add; fb[tid] = cum; }
            __syncthreads();
        }
        const float gtot = fb[127];
        float a = -3.0e38f;
        if (tid < 128) a = gtot - cum + li;
        float wm_ = a;
        wm_ = xor_max(wm_, 32); wm_ = xor_max(wm_, 16); wm_ = xor_max(wm_, 8); wm_ = xor_max(wm_, 4); wm_ = xor_max(wm_, 2); wm_ = xor_max(wm_, 1);
        if (lane == 0) fr[wid] = wm_;
        __syncthreads();
        const float ml = fmaxf(fr[0], fr[1]);
        if (tid < 128) fw[tid] = __expf(a - ml);
        __syncthreads();
        {
            const int s = tid & 127, half = tid >> 7;
            const float w = fw[s];
            const bf16_t* krow = projb + (size_t)(t0 + s) * LDP_ML + MIXW + h * 128;
            const bf16_t* vrow = projb + (size_t)(t0 + s) * LDP_ML + 2 * MIXW + h * 128;
#pragma unroll
            for (int i = 0; i < 8; ++i) {
                const int dc = half * 8 + i;
                const u32x4 kk = *(const u32x4*)(krow + dc * 8);
                const u32x4 vv = *(const u32x4*)(vrow + dc * 8);
#pragma unroll
                for (int q = 0; q < 4; ++q) {
                    kwT[(dc * 8 + 2 * q) * LS + s] = f2bf(bflo(kk[q]) * w);
                    kwT[(dc * 8 + 2 * q + 1) * LS + s] = f2bf(bfhi(kk[q]) * w);
                    vTs[(dc * 8 + 2 * q) * LS + s] = (bf16_t)(vv[q] & 0xffffu);
                    vTs[(dc * 8 + 2 * q + 1) * LS + s] = (bf16_t)(vv[q] >> 16);
                }
            }
        }
        __syncthreads();
        float* ct = CT + (size_t)task * 128 * 128;
#pragma unroll 1
        for (int et = 0; et < 2; ++et) {
            f32x4 acc[8];
#pragma unroll
            for (int dt = 0; dt < 8; ++dt) acc[dt] = (f32x4){0.f, 0.f, 0.f, 0.f};
#pragma unroll
            for (int ks = 0; ks < 4; ++ks) {
                const bf16x8 vf = *(const bf16x8*)&vTs[(wid * 32 + et * 16 + r) * LS + ks * 32 + 8 * g];
#pragma unroll
                for (int dt = 0; dt < 8; ++dt) {
                    const bf16x8 kf = *(const bf16x8*)&kwT[(dt * 16 + r) * LS + ks * 32 + 8 * g];
                    acc[dt] = mfma16(vf, kf, acc[dt]);
                }
                __builtin_amdgcn_sched_barrier(0);
            }
#pragma unroll
            for (int dt = 0; dt < 8; ++dt)
#pragma unroll
                for (int i = 0; i < 4; ++i) ct[(wid * 32 + et * 16 + 4 * g + i) * 128 + dt * 16 + r] = acc[dt][i];
        }
        if (tid < 128) {
            float sn = 0.f;
            for (int s = 0; s < 128; ++s) sn += bf2f(kwT[tid * LS + s]);
            nloc[(size_t)task * 128 + tid] = sn;
        }
        if (tid == 0) { mloc[task] = ml; gsum[task] = gtot; }
    }
}

DI void phase_ml_scan(const P& p, int bid, int nb) {
    const float* CT = (const float*)(p.ws + WS_CT);
    bf16_t* CPB = (bf16_t*)(p.ws + WS_CPB);
    const float* nloc = (const float*)(p.ws + WS_NLOC);
    float* nprev = (float*)(p.ws + WS_NPREV);
    const float* mloc = (const float*)(p.ws + WS_MLOC);
    const float* gsum = (const float*)(p.ws + WS_GSUM);
    float* mprev = (float*)(p.ws + WS_MPREV);
    const int tid = tid_opaque();
    for (int task = bid; task < 48 * 16; task += nb) {
        const int bh = task >> 4, sl = task & 15;
        const int idx = sl * 1024 + tid * 4;
        float m = 0.f;
        f32x4 st = (f32x4){0.f, 0.f, 0.f, 0.f};
        float nst = 0.f;
        const bool don = (sl == 0 && tid < 128);
        for (int c = 0; c < NCH; ++c) {
            const int ch = bh * NCH + c;
            const float gg = gsum[ch], ml = mloc[ch];
            const float mnew = fmaxf(gg + m, ml);
            const float decay = __expf(gg + m - mnew), sc = __expf(ml - mnew);
            const f32x4 loc = *(const f32x4*)(CT + (size_t)ch * 16384 + idx);
            u32x2 w; w.x = cvtpk(st[0], st[1]); w.y = cvtpk(st[2], st[3]);
            *(u32x2*)(CPB + (size_t)ch * 16384 + idx) = w;
            st = st * decay + loc * sc;
            if (don) {
                const float nl = nloc[(size_t)ch * 128 + tid];
                nprev[(size_t)ch * 128 + tid] = nst;
                nst = nst * decay + nl * sc;
            }
            if (sl == 0 && tid == 0) mprev[ch] = m;
            m = mnew;
        }
    }
}

DI void phase_ml_out(const P& p, int layer, int bid, int nb, char* smem) {
    const int j = layer >> 1;
    const bf16_t* projb = (const bf16_t*)(p.ws + WS_PROJ);
    const float* logi = (const float*)(p.ws + WS_LOGI);
    const float* logf = (const float*)(p.ws + WS_LOGF);
    const bf16_t* CPB = (const bf16_t*)(p.ws + WS_CPB);
    const float* nprev = (const float*)(p.ws + WS_NPREV);
    const float* mprev = (const float*)(p.ws + WS_MPREV);
    bf16_t* hcat = (bf16_t*)(p.ws + WS_HCAT);
    const float* ng_ = p.ml_norm_g + (size_t)j * MIXW;
    constexpr int LS = 136;
    bf16_t* kS = (bf16_t*)smem;
    bf16_t* vTs = kS + 128 * LS;
    float* fb = (float*)(vTs + 128 * LS);
    float* fB = fb + 128;
    float* fA = fB + 128;
    float* fW = fA + 128;
    float* fE = fW + 128;
    float* fN = fE + 128;
    for (int task = bid; task < 48 * NCH; task += nb) {
        const int tid = tid_opaque();
        const int lane = tid & 63, wid = __builtin_amdgcn_readfirstlane(tid >> 6), r = lane & 15, g = lane >> 4;
        const int bh = task >> 4, c = task & 15, b = bh / 6, h = bh % 6;
        const int t0 = b * SEQ + c * CHUNK;
        __syncthreads();
        float li = 0.f, cum = 0.f;
        if (tid < 128) { li = logi[(size_t)bh * SEQ + c * CHUNK + tid]; cum = logf[(size_t)bh * SEQ + c * CHUNK + tid]; fb[tid] = cum; fN[tid] = nprev[(size_t)task * 128 + tid]; }
        __syncthreads();
        for (int off = 1; off < 128; off <<= 1) {
            float add = 0.f;
            if (tid < 128 && tid >= off) add = fb[tid - off];
            __syncthreads();
            if (tid < 128) { cum += add; fb[tid] = cum; }
            __syncthreads();
        }
        const float Bs_ = li - cum;
        float pm = Bs_;
        if (tid < 128) { fB[tid] = Bs_; fb[tid] = pm; }
        __syncthreads();
        for (int off = 1; off < 128; off <<= 1) {
            float o = -3.0e38f;
            if (tid < 128 && tid >= off) o = fb[tid - off];
            __syncthreads();
            if (tid < 128) { pm = fmaxf(pm, o); fb[tid] = pm; }
            __syncthreads();
        }
        if (tid < 128) {
            const float mp = mprev[task];
            const float inter = cum + mp;
            const float ml = fmaxf(cum + pm, inter);
            fA[tid] = cum - ml; fW[tid] = __expf(inter - ml); fE[tid] = __expf(-ml);
        }
        {
#pragma unroll
            for (int i = 0; i < 8; ++i) {
                const int s = (tid >> 4) + 16 * i, dc = tid & 15;
                *(u32x4*)&kS[s * LS + dc * 8] = *(const u32x4*)(projb + (size_t)(t0 + s) * LDP_ML + MIXW + h * 128 + dc * 8);
            }
            const int s = tid & 127, half = tid >> 7;
            const bf16_t* vrow = projb + (size_t)(t0 + s) * LDP_ML + 2 * MIXW + h * 128;
#pragma unroll
            for (int i = 0; i < 8; ++i) {
                const int dc = half * 8 + i;
                const u32x4 vv = *(const u32x4*)(vrow + dc * 8);
#pragma unroll
                for (int q = 0; q < 4; ++q) {
                    vTs[(dc * 8 + 2 * q) * LS + s] = (bf16_t)(vv[q] & 0xffffu);
                    vTs[(dc * 8 + 2 * q + 1) * LS + s] = (bf16_t)(vv[q] >> 16);
                }
            }
        }
        __syncthreads();
        const bf16_t* cp = CPB + (size_t)task * 16384;
#pragma unroll 1
        for (int lt = 0; lt < 2; ++lt) {
            const int l = wid * 32 + lt * 16 + r;
            bf16x8 qf[4];
            float qn;
            {
                const bf16_t* qrow = projb + (size_t)(t0 + l) * LDP_ML + h * 128;
                float part = 0.f;
#pragma unroll
                for (int ks = 0; ks < 4; ++ks) {
                    const u32x4 qq = *(const u32x4*)(qrow + ks * 32 + 8 * g);
                    qf[ks] = __builtin_bit_cast(bf16x8, qq);
#pragma unroll
                    for (int q = 0; q < 4; ++q) part += bflo(qq[q]) * fN[ks * 32 + 8 * g + 2 * q] + bfhi(qq[q]) * fN[ks * 32 + 8 * g + 2 * q + 1];
                }
                part = xor_add(part, 16); part = xor_add(part, 32);
                qn = part;
            }
            __builtin_amdgcn_sched_barrier(0);
            f32x4 nacc[8];
#pragma unroll
            for (int et = 0; et < 8; ++et) {
                f32x4 a = (f32x4){0.f, 0.f, 0.f, 0.f};
#pragma unroll
                for (int ks = 0; ks < 4; ++ks) {
                    const bf16x8 cf = *(const bf16x8*)(cp + (et * 16 + r) * 128 + ks * 32 + 8 * g);
                    a = mfma16(cf, qf[ks], a);
                }
                nacc[et] = a;
                if (et & 1) __builtin_amdgcn_sched_barrier(0);
            }
            const float Al = fA[l], wint = fW[l], eml = fE[l];
#pragma unroll
            for (int et = 0; et < 8; ++et) nacc[et] *= wint;
            const int stmax = wid * 2 + lt;
            float den = 0.f;
#pragma unroll
            for (int s2 = 0; s2 < 4; ++s2) {
                if (2 * s2 <= stmax) {
                    f32x4 sa = (f32x4){0.f, 0.f, 0.f, 0.f}, sb = (f32x4){0.f, 0.f, 0.f, 0.f};
#pragma unroll
                    for (int ks = 0; ks < 4; ++ks) {
                        const bf16x8 kf = *(const bf16x8*)&kS[(s2 * 32 + r) * LS + ks * 32 + 8 * g];
                        sa = mfma16(kf, qf[ks], sa);
                    }
                    if (2 * s2 + 1 <= stmax) {
#pragma unroll
                        for (int ks = 0; ks < 4; ++ks) {
                            const bf16x8 kf = *(const bf16x8*)&kS[(s2 * 32 + 16 + r) * LS + ks * 32 + 8 * g];
                            sb = mfma16(kf, qf[ks], sb);
                        }
                    }
#pragma unroll
                    for (int i = 0; i < 4; ++i) {
                        const int s = s2 * 32 + 4 * g + i;
                        const float va = (s <= l) ? sa[i] * __expf(Al + fB[s]) : 0.f;
                        const float vb = (s + 16 <= l) ? sb[i] * __expf(Al + fB[s + 16]) : 0.f;
                        sa[i] = va; sb[i] = vb; den += va + vb;
                    }
                    u32x4 pw;
                    pw.x = cvtpk(sa[0], sa[1]); pw.y = cvtpk(sa[2], sa[3]);
                    pw.z = cvtpk(sb[0], sb[1]); pw.w = cvtpk(sb[2], sb[3]);
                    const bf16x8 pf = __builtin_bit_cast(bf16x8, pw);
#pragma unroll
                    for (int et = 0; et < 8; ++et) {
                        const bf16_t* vp = &vTs[(et * 16 + r) * LS + s2 * 32 + 4 * g];
                        const u32x2 v0 = *(const u32x2*)vp;
                        const u32x2 v1 = *(const u32x2*)(vp + 16);
                        u32x4 vw; vw.x = v0.x; vw.y = v0.y; vw.z = v1.x; vw.w = v1.y;
                        nacc[et] = mfma16(__builtin_bit_cast(bf16x8, vw), pf, nacc[et]);
                    }
                }
                __builtin_amdgcn_sched_barrier(0);
            }
            den = xor_add(den, 16); den = xor_add(den, 32);
            const float dd = fmaxf(fabsf(den + wint * qn), eml);
            const float invd = 1.0f / dd;
            float sm = 0.f;
#pragma unroll
            for (int et = 0; et < 8; ++et)
#pragma unroll
                for (int i = 0; i < 4; ++i) { nacc[et][i] *= invd; sm += nacc[et][i]; }
            sm = xor_add(sm, 16); sm = xor_add(sm, 32);
            const float mu = sm * (1.0f / 128.0f);
            float sq = 0.f;
#pragma unroll
            for (int et = 0; et < 8; ++et)
#pragma unroll
                for (int i = 0; i < 4; ++i) { const float dlt = nacc[et][i] - mu; sq += dlt * dlt; }
            sq = xor_add(sq, 16); sq = xor_add(sq, 32);
            const float rstd = rsqrtf(sq * (1.0f / 128.0f) + LN_EPS);
            const size_t trow = (size_t)(t0 + l);
            const bf16_t* og = projb + trow * LDP_ML + 3 * MIXW + h * 128;
            bf16_t* orow = hcat + trow * D + h * 128;
#pragma unroll
            for (int et = 0; et < 8; ++et) {
                const int e = et * 16 + 4 * g;
                const u32x2 ov = *(const u32x2*)(og + e);
                const f32x4 gv = *(const f32x4*)(ng_ + h * 128 + e);
                const float o0 = (nacc[et][0] - mu) * rstd * gv[0] * sigmoidf_(bflo(ov.x));
                const float o1 = (nacc[et][1] - mu) * rstd * gv[1] * sigmoidf_(bfhi(ov.x));
                const float o2 = (nacc[et][2] - mu) * rstd * gv[2] * sigmoidf_(bflo(ov.y));
                const float o3 = (nacc[et][3] - mu) * rstd * gv[3] * sigmoidf_(bfhi(ov.y));
                u32x2 w; w.x = cvtpk(o0, o1); w.y = cvtpk(o2, o3);
                *(u32x2*)(orow + e) = w;
                if (et & 1) __builtin_amdgcn_sched_barrier(0);
            }
        }
    }
}

DI void phase_outproj(const P& p, int layer, int bid, int nb, char* smem) {
    const bf16_t* hcat = (const bf16_t*)(p.ws + WS_HCAT);
    const float* W = p.w_out + (size_t)layer * D * D;
    const float* xres = (layer == 0) ? p.x : (const float*)(p.ws + WS_XA);
    float* z = (float*)(p.ws + WS_Z);
    const int tid_ = tid_opaque(), lane = tid_ & 63, wid = tid_ >> 6, r = lane & 15, g = lane >> 4, wm = wid >> 1, wn = wid & 1;
    for (int task = bid; task < 128 * 8; task += nb) {
        const int nt = task >> 7, mt = task & 127;
        gemm128([&](int rr) { return hcat + (size_t)(mt * 128 + rr) * D; }, [&](int ng) { return W + nt * 128 + 4 * ng; }, D, D, smem,
                [&](f32x4 (&acc)[4][4]) {
#pragma unroll
                    for (int mi = 0; mi < 4; ++mi)
#pragma unroll
                        for (int ni = 0; ni < 4; ++ni) {
                            const size_t off = (size_t)(mt * 128 + wm * 64 + mi * 16 + r) * D + nt * 128 + wn * 64 + ni * 16 + 4 * g;
                            const f32x4 xr = *(const f32x4*)(xres + off);
                            *(f32x4*)(z + off) = xr * ALPHA + acc[mi][ni];
                        }
                });
    }
}

DI void phase_ln1_route(const P& p, int layer, int bid, int nb, char* smem) {
    const float* z = (const float*)(p.ws + WS_Z);
    float* x1a = (float*)(p.ws + WS_X1A);
    bf16_t* x1b = (bf16_t*)(p.ws + WS_X1B);
    float* gate = (float*)(p.ws + WS_GATE);
    int* list = (int*)(p.ws + WS_LIST);
    int* cnt = (int*)(p.ws + WS_CTL + CTL_CNT) + layer * 32;
    const float* lg = p.ln1_g + (size_t)layer * D;
    const float* lb = p.ln1_b + (size_t)layer * D;
    float* xs = (float*)smem;
    float* red = xs + 8 * 1024;
    float* scs = red + 8 * 8 * 32;
    const int tid = tid_opaque(), lane = tid & 63, wid = tid >> 6;
    for (int task = bid; task < T / 8; task += nb) {
        const int row0 = task * 8;
        __syncthreads();
#pragma unroll
        for (int rr = 0; rr < 2; ++rr) {
            const int lr = wid * 2 + rr;
            const size_t t = (size_t)(row0 + lr);
            f32x4 v[4];
            float s = 0.f;
#pragma unroll
            for (int i = 0; i < 4; ++i) { v[i] = *(const f32x4*)(z + t * D + i * 256 + lane * 4); s += v[i][0] + v[i][1] + v[i][2] + v[i][3]; }
            s = wave_sum(s);
            const float mu = s * (1.0f / D);
            float q = 0.f;
#pragma unroll
            for (int i = 0; i < 4; ++i)
#pragma unroll
                for (int k = 0; k < 4; ++k) { const float d = v[i][k] - mu; q += d * d; }
            q = wave_sum(q);
            const float rstd = rsqrtf(q * (1.0f / D) + LN_EPS);
#pragma unroll
            for (int i = 0; i < 4; ++i) {
                const int col = i * 256 + lane * 4;
                const f32x4 gg = *(const f32x4*)(lg + col), bb = *(const f32x4*)(lb + col);
                f32x4 o = (v[i] - mu) * rstd * gg + bb;
                *(f32x4*)(x1a + t * D + col) = o;
                u32x2 w; w.x = cvtpk(o[0], o[1]); w.y = cvtpk(o[2], o[3]);
                *(u32x2*)(x1b + t * D + col) = w;
                *(f32x4*)(xs + lr * 1024 + col) = o;
            }
        }
        __syncthreads();
        {
            const int e = tid & 31, part = tid >> 5;
            float a[8];
#pragma unroll
            for (int i = 0; i < 8; ++i) a[i] = 0.f;
            for (int d4 = 0; d4 < 32; ++d4) {
                const int d = part * 128 + d4 * 4;
                const float w0 = p.router_w[(size_t)(d + 0) * 32 + e], w1 = p.router_w[(size_t)(d + 1) * 32 + e];
                const float w2 = p.router_w[(size_t)(d + 2) * 32 + e], w3 = p.router_w[(size_t)(d + 3) * 32 + e];
#pragma unroll
                for (int i = 0; i < 8; ++i) {
                    const f32x4 xv = *(const f32x4*)(xs + i * 1024 + d);
                    a[i] += xv[0] * w0 + xv[1] * w1 + xv[2] * w2 + xv[3] * w3;
                }
            }
#pragma unroll
            for (int i = 0; i < 8; ++i) red[(part * 8 + i) * 32 + e] = a[i];
        }
        __syncthreads();
        {
            const int e = tid & 31, i = tid >> 5;
            float s = 0.f;
#pragma unroll
            for (int part = 0; part < 8; ++part) s += red[(part * 8 + i) * 32 + e];
            scs[i * 32 + e] = sigmoidf_(s);
        }
        __syncthreads();
        if (tid < 8) {
            const float* sc = scs + tid * 32;
            int bestg = 0; float bestv = -3.0e38f;
            for (int gi = 0; gi < 8; ++gi) {
                float m1 = -3.0e38f, m2 = -3.0e38f;
                for (int k = 0; k < 4; ++k) {
                    const float v = sc[gi * 4 + k] + p.router_b[gi * 4 + k];
                    if (v > m1) { m2 = m1; m1 = v; } else if (v > m2) { m2 = v; }
                }
                const float gs = m1 + m2;
                if (gs > bestv) { bestv = gs; bestg = gi; }
            }
            int i1 = 0; float v1 = -3.0e38f;
            for (int k = 0; k < 4; ++k) { const float v = sc[bestg * 4 + k] + p.router_b[bestg * 4 + k]; if (v > v1) { v1 = v; i1 = k; } }
            int i2 = 0; float v2 = -3.0e38f;
            for (int k = 0; k < 4; ++k) { if (k == i1) continue; const float v = sc[bestg * 4 + k] + p.router_b[bestg * 4 + k]; if (v > v2) { v2 = v; i2 = k; } }
            const int e1 = bestg * 4 + i1, e2 = bestg * 4 + i2;
            const float s1 = sc[e1], s2 = sc[e2];
            const float inv = 1.0f / (s1 + s2);
            const int t = row0 + tid;
            gate[t * 2] = s1 * inv; gate[t * 2 + 1] = s2 * inv;
            const int p1 = atomicAdd(&cnt[e1], 1);
            list[(size_t)e1 * T + p1] = t * 2;
            const int p2 = atomicAdd(&cnt[e2], 1);
            list[(size_t)e2 * T + p2] = t * 2 + 1;
        }
    }
}

DI void moe_meta(const int* cnt, int* meta) {
    if (threadIdx.x == 0) {
        int base = 0, blk = 0;
        for (int e = 0; e < NE; ++e) {
            const int c = cnt[e];
            meta[e] = base; meta[32 + e] = blk; meta[65 + e] = c;
            base += c; blk += (c + 127) >> 7;
        }
        meta[64] = blk;
    }
    __syncthreads();
}

DI void phase_moe_up(const P& p, int layer, int bid, int nb, char* smem) {
    const int* cnt = (const int*)(p.ws + WS_CTL + CTL_CNT) + layer * 32;
    const int* list = (const int*)(p.ws + WS_LIST);
    const bf16_t* x1b = (const bf16_t*)(p.ws + WS_X1B);
    bf16_t* hbuf = (bf16_t*)(p.ws + WS_HBUF);
    int* meta = (int*)(smem + 2 * 128 * LDK * 2);
    const int tid_ = tid_opaque(), lane = tid_ & 63, wid = tid_ >> 6, r = lane & 15, g = lane >> 4, wm = wid >> 1, wn = wid & 1;
    __syncthreads();
    moe_meta(cnt, meta);
    const int nrb = meta[64];
    for (int task = bid; task < nrb * 8; task += nb) {
        const int rbi = task >> 3, ft = task & 7;
        int e = 0;
        while (e < NE - 1 && meta[32 + e + 1] <= rbi) ++e;
        const int rb = rbi - meta[32 + e];
        const int cnte = meta[65 + e];
        const int valid = min(128, cnte - rb * 128);
        const int* lst = list + (size_t)e * T + rb * 128;
        const float* Wg = p.w_gate + ((size_t)layer * NE + e) * D * DFF;
        const float* Wu = p.w_up + ((size_t)layer * NE + e) * D * DFF;
        const size_t hrow0 = (size_t)meta[e] + rb * 128;
        gemm128([&](int rr) { const int a = lst[min(rr, valid - 1)]; return x1b + (size_t)(a >> 1) * D; },
                [&](int ng) {
                    const int v4 = 4 * ng, grp = v4 >> 4, wn_ = grp >> 2, ni_ = grp & 3;
                    const int col = ft * 64 + wn_ * 32 + (ni_ & 1) * 16 + (v4 & 15);
                    return ((ni_ >> 1) ? Wu : Wg) + col;
                },
                DFF, D, smem,
                [&](f32x4 (&acc)[4][4]) {
#pragma unroll
                    for (int mi = 0; mi < 4; ++mi) {
                        const int m = wm * 64 + mi * 16 + r;
                        if (m < valid) {
#pragma unroll
                            for (int ni = 0; ni < 2; ++ni) {
                                const f32x4 gv = acc[mi][ni], uv = acc[mi][ni + 2];
                                float hh[4];
#pragma unroll
                                for (int i = 0; i < 4; ++i) hh[i] = gv[i] * sigmoidf_(gv[i]) * uv[i];
                                u32x2 w; w.x = cvtpk(hh[0], hh[1]); w.y = cvtpk(hh[2], hh[3]);
                                *(u32x2*)&hbuf[(hrow0 + m) * DFF + ft * 64 + wn * 32 + ni * 16 + 4 * g] = w;
                            }
                        }
                    }
                });
    }
}

DI void phase_moe_down(const P& p, int layer, int bid, int nb, char* smem) {
    const int* cnt = (const int*)(p.ws + WS_CTL + CTL_CNT) + layer * 32;
    const int* list = (const int*)(p.ws + WS_LIST);
    const float* gate = (const float*)(p.ws + WS_GATE);
    const bf16_t* hbuf = (const bf16_t*)(p.ws + WS_HBUF);
    bf16_t* yasg = (bf16_t*)(p.ws + WS_YASG);
    int* meta = (int*)(smem + 2 * 128 * LDK * 2);
    const int tid_ = tid_opaque(), lane = tid_ & 63, wid = tid_ >> 6, r = lane & 15, g = lane >> 4, wm = wid >> 1, wn = wid & 1;
    __syncthreads();
    moe_meta(cnt, meta);
    const int nrb = meta[64];
    for (int task = bid; task < nrb * 8; task += nb) {
        const int rbi = task >> 3, nt = task & 7;
        int e = 0;
        while (e < NE - 1 && meta[32 + e + 1] <= rbi) ++e;
        const int rb = rbi - meta[32 + e];
        const int cnte = meta[65 + e];
        const int valid = min(128, cnte - rb * 128);
        const int* lst = list + (size_t)e * T + rb * 128;
        const float* Wd = p.w_down + ((size_t)layer * NE + e) * DFF * D + nt * 128;
        const size_t hrow0 = (size_t)meta[e] + rb * 128;
        gemm128([&](int rr) { return hbuf + (hrow0 + min(rr, valid - 1)) * DFF; }, [&](int ng) { return Wd + 4 * ng; }, D, DFF, smem,
                [&](f32x4 (&acc)[4][4]) {
#pragma unroll
                    for (int mi = 0; mi < 4; ++mi) {
                        const int m = wm * 64 + mi * 16 + r;
                        if (m < valid) {
                            const int a = lst[m];
                            const float gt = gate[a];
#pragma unroll
                            for (int ni = 0; ni < 4; ++ni) {
                                const f32x4 v = acc[mi][ni] * gt;
                                u32x2 w; w.x = cvtpk(v[0], v[1]); w.y = cvtpk(v[2], v[3]);
                                *(u32x2*)&yasg[(size_t)a * D + nt * 128 + wn * 64 + ni * 16 + 4 * g] = w;
                            }
                        }
                    }
                });
    }
}

DI void phase_ln2(const P& p, int layer, int bid, int nb) {
    const float* x1a = (const float*)(p.ws + WS_X1A);
    const bf16_t* yasg = (const bf16_t*)(p.ws + WS_YASG);
    float* xa = (layer == DEPTH - 1) ? p.out : (float*)(p.ws + WS_XA);
    bf16_t* xb = (bf16_t*)(p.ws + WS_XB);
    const float* lg = p.ln2_g + (size_t)layer * D;
    const float* lb = p.ln2_b + (size_t)layer * D;
    const int tid = tid_opaque(), lane = tid & 63, wid = tid >> 6;
    for (int t = bid * 4 + wid; t < T; t += nb * 4) {
        f32x4 v[4];
        float s = 0.f;
#pragma unroll
        for (int i = 0; i < 4; ++i) {
            const int col = i * 256 + lane * 4;
            const f32x4 xv = *(const f32x4*)(x1a + (size_t)t * D + col);
            const u32x2 y0 = *(const u32x2*)(yasg + (size_t)(2 * t) * D + col);
            const u32x2 y1 = *(const u32x2*)(yasg + (size_t)(2 * t + 1) * D + col);
            f32x4 o;
            o[0] = xv[0] * ALPHA + (bflo(y0.x) + bflo(y1.x));
            o[1] = xv[1] * ALPHA + (bfhi(y0.x) + bfhi(y1.x));
            o[2] = xv[2] * ALPHA + (bflo(y0.y) + bflo(y1.y));
            o[3] = xv[3] * ALPHA + (bfhi(y0.y) + bfhi(y1.y));
            v[i] = o; s += o[0] + o[1] + o[2] + o[3];
        }
        s = wave_sum(s);
        const float mu = s * (1.0f / D);
        float q = 0.f;
#pragma unroll
        for (int i = 0; i < 4; ++i)
#pragma unroll
            for (int k = 0; k < 4; ++k) { const float d = v[i][k] - mu; q += d * d; }
        q = wave_sum(q);
        const float rstd = rsqrtf(q * (1.0f / D) + LN_EPS);
#pragma unroll
        for (int i = 0; i < 4; ++i) {
            const int col = i * 256 + lane * 4;
            const f32x4 gg = *(const f32x4*)(lg + col), bb = *(const f32x4*)(lb + col);
            const f32x4 o = (v[i] - mu) * rstd * gg + bb;
            *(f32x4*)(xa + (size_t)t * D + col) = o;
            if (layer != DEPTH - 1) { u32x2 w; w.x = cvtpk(o[0], o[1]); w.y = cvtpk(o[2], o[3]); *(u32x2*)(xb + (size_t)t * D + col) = w; }
        }
    }
}

#define XB_TMO      128
#define XB_XCNT(j)  (256  + 64 * (j))
#define XB_XSUB(j)  (1280 + 64 * (j))
#define XB_XGEN(j)  (2304 + 64 * (j))
#define XB_TOP      3328
#define XB_TOPGEN   3392
#define XCD_BAR_WORDS 3456
#define XB_SPIN_CAP (1u << 20)
#define LAS __attribute__((address_space(3)))
DI unsigned xb_ld(unsigned* p_) { return __hip_atomic_load(p_, __ATOMIC_RELAXED, __HIP_MEMORY_SCOPE_AGENT); }
DI unsigned xb_add(unsigned* p_, unsigned v) { return __hip_atomic_fetch_add(p_, v, __ATOMIC_RELAXED, __HIP_MEMORY_SCOPE_AGENT); }
DI unsigned xb_xcc_id() { return (unsigned)__builtin_amdgcn_s_getreg((3 << 11) | 20) & 0xFu; }
#define XB_SPIN(cond, bar) do { unsigned _sp = 0; while (cond) { __builtin_amdgcn_s_sleep(1); \
    if ((++_sp & 255u) == 0u) { if (xb_ld(&(bar)[XB_TMO])) break; if (_sp > XB_SPIN_CAP) { atomicAdd(&(bar)[XB_TMO], 1u); break; } } } } while (0)
struct XcdBarrier { unsigned* bar; unsigned x; volatile LAS unsigned* st; };
DI XcdBarrier xcd_barrier_post(unsigned* bar, volatile LAS unsigned* st) {
    XcdBarrier b; b.bar = bar; b.x = xb_xcc_id(); b.st = st;
    if (threadIdx.x == 0) (void)xb_add(&bar[XB_XCNT(b.x)], 1u);
    return b;
}
DI void xcd_barrier_complete(unsigned* bar, unsigned x, unsigned& nloc, unsigned& nx) {
    const unsigned G = gridDim.x * gridDim.y * gridDim.z;
    unsigned sum, cnt, mine, sp = 0u;
    for (;;) {
        sum = 0u; cnt = 0u; mine = 0u;
#pragma unroll
        for (unsigned j = 0; j < 16; ++j) { const unsigned c = xb_ld(&bar[XB_XCNT(j)]); sum += c; cnt += (c > 0u) ? 1u : 0u; mine = (j == x) ? c : mine; }
        if (sum == G) break;
        __builtin_amdgcn_s_sleep(1);
        if ((++sp & 255u) == 0u) { if (xb_ld(&bar[XB_TMO])) break; if (sp > XB_SPIN_CAP) { atomicAdd(&bar[XB_TMO], 1u); break; } }
    }
    nloc = mine > 0u ? mine : 1u; nx = cnt > 0u ? cnt : 1u;
}
DI void xcd_barrier(const XcdBarrier& b) {
    asm volatile("s_waitcnt vmcnt(0)" ::: "memory");
    __syncthreads();
    if (threadIdx.x == 0) {
        unsigned* bar = b.bar;
        __builtin_amdgcn_s_waitcnt(0);
        unsigned nloc = b.st[0], nx = b.st[1];
        if (nloc == 0u) { xcd_barrier_complete(bar, b.x, nloc, nx); b.st[0] = nloc; b.st[1] = nx; }
        const unsigned old = xb_add(&bar[XB_XSUB(b.x)], 1u);
        const unsigned gen = old / nloc;
        if (old + 1u == (gen + 1u) * nloc) {
            __builtin_amdgcn_fence(__ATOMIC_RELEASE, "agent");
            asm volatile("s_waitcnt vmcnt(0)" ::: "memory");
            const unsigned og = xb_add(&bar[XB_TOP], 1u);
            const unsigned tg = og / nx;
            if (og + 1u == (tg + 1u) * nx) xb_add(&bar[XB_TOPGEN], 1u);
            else XB_SPIN(xb_ld(&bar[XB_TOPGEN]) == tg, bar);
            __builtin_amdgcn_fence(__ATOMIC_ACQUIRE, "agent");
            xb_add(&bar[XB_XGEN(b.x)], 1u);
            asm volatile("s_waitcnt vmcnt(0)" ::: "memory");
        } else {
            XB_SPIN(xb_ld(&bar[XB_XGEN(b.x)]) == gen, bar);
            __builtin_amdgcn_fence(__ATOMIC_ACQUIRE, "agent");
            asm volatile("s_waitcnt vmcnt(0)" ::: "memory");
        }
    }
    __syncthreads();
}

enum { PH_INPROJ = 0, PH_MIX1, PH_MIX2, PH_MIX3, PH_OUTPROJ, PH_LN1, PH_MOEUP, PH_MOEDOWN, PH_LN2, PH_PER_LAYER, PH_PREP = 100 };

DI void run_phase(const P& p, int ph, int layer, int bid, int nb, char* smem) {
    const bool conv = (layer & 1) == 0;
    if (ph == PH_PREP) phase_prep(p, bid, nb);
    if (ph == PH_INPROJ) {
        if (layer == 0) phase_kv(p, bid, nb, smem);
        phase_inproj(p, layer, bid, nb, smem);
    }
    if (ph == PH_MIX1) phase_ml_local(p, bid, nb, smem);
    if (ph == PH_MIX2) phase_ml_scan(p, bid, nb);
    if (ph == PH_MIX3) {
        if (conv) phase_convmix(p, layer, bid, nb);
        else phase_ml_out(p, layer, bid, nb, smem);
    }
    if (ph == PH_MIX1 || (ph == PH_MIX3 && conv)) phase_xattn(p, layer, bid, nb, smem);
    if (ph == PH_OUTPROJ) phase_outproj(p, layer, bid, nb, smem);
    if (ph == PH_LN1) phase_ln1_route(p, layer, bid, nb, smem);
    if (ph == PH_MOEUP) phase_moe_up(p, layer, bid, nb, smem);
    if (ph == PH_MOEDOWN) phase_moe_down(p, layer, bid, nb, smem);
    if (ph == PH_LN2) phase_ln2(p, layer, bid, nb);
}

__global__ void __launch_bounds__(NTHREADS, 2) mega(P p) {
    __shared__ __attribute__((aligned(16))) char smem[SMEM_BYTES];
    const int bid = blockIdx.x, nb = gridDim.x;
    volatile LAS unsigned* st = (volatile LAS unsigned*)(smem + SMEM_BYTES - 16);
    if (threadIdx.x == 0) { st[0] = 0u; st[1] = 0u; }
    __syncthreads();
    XcdBarrier xb = xcd_barrier_post((unsigned*)(p.ws + WS_CTL), st);
#pragma unroll 1
    for (int s = -1; s < DEPTH * PH_PER_LAYER; ++s) {
        int ph = (s < 0) ? (int)PH_PREP : s % PH_PER_LAYER;
        int layer = (s < 0) ? 0 : s / PH_PER_LAYER;
        if ((layer & 1) == 0 && (ph == PH_MIX1 || ph == PH_MIX2)) continue;
        asm volatile("" : "+s"(ph), "+s"(layer));
        P q = p;
        asm volatile("" : "+s"(q.ws));
        run_phase(q, ph, layer, bid, nb, smem);
        xcd_barrier(xb);
    }
}

extern "C" void kernel_launch(void* const* d_in, const int* in_sizes, int n_in, void* d_out, int out_size, void* d_ws, size_t ws_size,
                              hipStream_t stream) {
    if (ws_size < WS_TOTAL) { fprintf(stderr, "kernel_launch: workspace too small: %zu < %zu\n", ws_size, (size_t)WS_TOTAL); return; }
    static int grid_blocks = 0;
    if (!grid_blocks) {
        int dev = 0, cus = 0, per_cu = 0;
        (void)hipGetDevice(&dev);
        (void)hipDeviceGetAttribute(&cus, hipDeviceAttributeMultiprocessorCount, dev);
        if (hipOccupancyMaxActiveBlocksPerMultiprocessor(&per_cu, (const void*)mega, NTHREADS, 0) != hipSuccess) per_cu = 0;
        if (per_cu > 2) per_cu = 2;
        if (per_cu < 1 || cus < 1) { fprintf(stderr, "kernel_launch: occupancy query failed (per_cu=%d cus=%d)\n", per_cu, cus); return; }
        grid_blocks = cus * per_cu;
    }
    P p{};
    p.x = (const float*)d_in[0]; p.mem = (const float*)d_in[1]; p.conv_w_in = (const float*)d_in[2]; p.conv_w = (const float*)d_in[3];
    p.ml_w_in = (const float*)d_in[4]; p.ml_gate_b = (const float*)d_in[5]; p.ml_norm_g = (const float*)d_in[6]; p.w_kv = (const float*)d_in[7];
    p.w_out = (const float*)d_in[8]; p.ln1_g = (const float*)d_in[9]; p.ln1_b = (const float*)d_in[10]; p.ln2_g = (const float*)d_in[11];
    p.ln2_b = (const float*)d_in[12]; p.router_w = (const float*)d_in[13]; p.router_b = (const float*)d_in[14]; p.w_gate = (const float*)d_in[15];
    p.w_up = (const float*)d_in[16]; p.w_down = (const float*)d_in[17];
    p.out = (float*)d_out; p.ws = (char*)d_ws;
    (void)hipMemsetAsync((char*)d_ws + WS_CTL, 0, CTL_BYTES, stream);
    void* args[] = {&p};
    hipError_t e = hipLaunchCooperativeKernel((const void*)mega, dim3(grid_blocks), dim3(NTHREADS), args, 0, stream);
    if (e != hipSuccess) fprintf(stderr, "kernel_launch: cooperative launch failed: %s (grid %d)\n", hipGetErrorString(e), grid_blocks);
}
```

```cpp
#include <hip/hip_runtime.h>
#include <stdint.h>
#include <stdio.h>

typedef unsigned short bf16_t;
typedef __attribute__((ext_vector_type(8))) short bf16x8;
typedef __attribute__((ext_vector_type(4))) float f32x4;
typedef __attribute__((ext_vector_type(4))) unsigned u32x4;
typedef __attribute__((ext_vector_type(2))) unsigned u32x2;

#define DI __device__ __forceinline__
#define LAS __attribute__((address_space(3)))

constexpr int D = 1024;
constexpr int NBATCH = 8;
constexpr int SEQ = 2048;
constexpr int T = NBATCH * SEQ;
constexpr int DEPTH = 4;
constexpr int MIXW = 768;
constexpr int XH = 4, XDH = 64, XW = 256, MEML = 256;
constexpr int MLH = 6, MLDH = 128, CHUNK = 128, NCH = SEQ / CHUNK;
constexpr int DIN_CONV = 2560, DIN_ML = 3340, LDP_ML = 3328, NV_ML = 3584;
constexpr int NE = 32, DFF = 512;
constexpr float ALPHA = 1.681792830507429f;
constexpr float LN_EPS = 1e-5f;

constexpr int NTHREADS = 512;
constexpr int NWAVES = 8;
constexpr int STAGE_BYTES = 131072;
constexpr int META_OFF = STAGE_BYTES;
constexpr int SMEM_BYTES = STAGE_BYTES + 4096;

constexpr size_t al256(size_t x) { return (x + 255) & ~(size_t)255; }
constexpr size_t WS_CTL   = 0;
constexpr size_t CTL_BYTES = 64 * 1024;
constexpr size_t CTL_CNT  = 32 * 1024;
constexpr size_t WS_XA    = WS_CTL + CTL_BYTES;
constexpr size_t WS_XB    = WS_XA + (size_t)T * D * 4;
constexpr size_t WS_MEMB  = WS_XB + (size_t)T * D * 2;
constexpr size_t WS_KBUF  = WS_MEMB + (size_t)NBATCH * MEML * D * 2;
constexpr size_t WS_VT    = WS_KBUF + (size_t)DEPTH * NBATCH * MEML * XW * 2;
constexpr size_t WS_PROJ  = WS_VT + (size_t)DEPTH * NBATCH * MEML * XW * 2;
constexpr size_t WS_Z     = WS_PROJ;
constexpr size_t WS_LOGI  = WS_PROJ + (size_t)T * LDP_ML * 2;
constexpr size_t WS_LOGF  = WS_LOGI + (size_t)NBATCH * MLH * SEQ * 4;
constexpr size_t WS_CT    = WS_LOGF + (size_t)NBATCH * MLH * SEQ * 4;
constexpr size_t WS_CPB   = WS_CT + (size_t)48 * NCH * 128 * 128 * 4;
constexpr size_t WS_NLOC  = WS_CPB + (size_t)48 * NCH * 128 * 128 * 2;
constexpr size_t WS_NPREV = WS_NLOC + (size_t)48 * NCH * 128 * 4;
constexpr size_t WS_MLOC  = WS_NPREV + (size_t)48 * NCH * 128 * 4;
constexpr size_t WS_GSUM  = WS_MLOC + al256(48 * NCH * 4);
constexpr size_t WS_MPREV = WS_GSUM + al256(48 * NCH * 4);
constexpr size_t WS_HCAT  = WS_MPREV + al256(48 * NCH * 4);
constexpr size_t WS_X1A   = WS_HCAT + (size_t)T * D * 2;
constexpr size_t WS_X1B   = WS_X1A + (size_t)T * D * 4;
constexpr size_t WS_GATE  = WS_X1B + (size_t)T * D * 2;
constexpr size_t WS_LIST  = WS_GATE + (size_t)T * 2 * 4;
constexpr size_t WS_HBUF  = WS_LIST + (size_t)NE * T * 4;
constexpr size_t WS_YASG  = WS_HBUF + (size_t)T * 2 * DFF * 2;
constexpr size_t WS_WIN   = WS_YASG + (size_t)T * 2 * D * 2;
constexpr size_t WS_WKV   = WS_WIN + ((size_t)2 * DIN_CONV + (size_t)2 * NV_ML) * D * 2;
constexpr size_t WS_WOUT  = WS_WKV + (size_t)DEPTH * 512 * D * 2;
constexpr size_t WS_WGU   = WS_WOUT + (size_t)DEPTH * D * D * 2;
constexpr size_t WS_WD    = WS_WGU + (size_t)DEPTH * NE * 1024 * D * 2;
constexpr size_t WS_RWT   = WS_WD + (size_t)DEPTH * NE * D * DFF * 2;
constexpr size_t WS_TOTAL = WS_RWT + (size_t)2 * NE * D * 2;

struct P {
    const float *x, *mem, *conv_w_in, *conv_w, *ml_w_in, *ml_gate_b, *ml_norm_g, *w_kv, *w_out;
    const float *ln1_g, *ln1_b, *ln2_g, *ln2_b, *router_w, *router_b, *w_gate, *w_up, *w_down;
    float* out;
    char* ws;
};

DI unsigned cvtpk(float lo, float hi) { unsigned r; asm("v_cvt_pk_bf16_f32 %0, %1, %2" : "=v"(r) : "v"(lo), "v"(hi)); return r; }
DI float bf2f(bf16_t v) { return __uint_as_float(((unsigned)v) << 16); }
DI float bflo(unsigned v) { return __uint_as_float(v << 16); }
DI float bfhi(unsigned v) { return __uint_as_float(v & 0xffff0000u); }
DI bf16_t f2bf(float f) { return (bf16_t)(cvtpk(f, f) & 0xffffu); }
DI float sigmoidf_(float x) { return 1.0f / (1.0f + __expf(-x)); }
DI float logsigmoidf_(float x) { return fminf(x, 0.0f) - log1pf(__expf(-fabsf(x))); }
DI float xor_add(float v, int m) { return v + __shfl_xor(v, m, 64); }
DI float xor_max(float v, int m) { return fmaxf(v, __shfl_xor(v, m, 64)); }
DI float wave_sum(float v) { v = xor_add(v, 32); v = xor_add(v, 16); v = xor_add(v, 8); v = xor_add(v, 4); v = xor_add(v, 2); v = xor_add(v, 1); return v; }
DI int tid_opaque() { int t = threadIdx.x; asm volatile("" : "+v"(t)); return t; }
DI f32x4 mfma16(bf16x8 a, bf16x8 b, f32x4 c) { return __builtin_amdgcn_mfma_f32_16x16x32_bf16(a, b, c, 0, 0, 0); }

namespace g8 {
constexpr int BM = 256, BK = 64, HALF = 128, HTB = HALF * BK * 2, NXCD = 8, WGM = 8;
DI int lds_byte(int r, int c) { const int st = (r >> 4) * 2 + (c >> 5), rr = r & 15, cc = c & 31, ob = rr * 64 + cc * 2; return st * 1024 + (ob ^ (((ob >> 9) & 1) << 5)); }
DI void stage_rc(int b, int& R, int& C) { const int st = b / 1024, sb = b % 1024, swz = sb ^ (((sb >> 9) & 1) << 5); R = (st >> 1) * 16 + swz / 64; C = (st & 1) * 32 + (swz % 64) / 2; }
DI int perm32(int rho) { const int n = rho >> 4, i = rho & 15; return 8 * (i >> 2) + 4 * n + (i & 3); }
DI int xcd_remap(int L, int n) { const int q = n / NXCD, r = n % NXCD, xcd = L % NXCD, off = L / NXCD; return (xcd < r ? xcd * (q + 1) : r * (q + 1) + (xcd - r) * q) + off; }

struct Unit { int pm, pn, e, valid, rbase; };
DI const char* uni(const char* p_) {
    const unsigned long long v = (unsigned long long)p_;
    const unsigned lo = (unsigned)__builtin_amdgcn_readfirstlane((int)(unsigned)v), hi = (unsigned)__builtin_amdgcn_readfirstlane((int)(unsigned)(v >> 32));
    return (const char*)(((unsigned long long)hi << 32) | lo);
}

template <bool GATHER, class Epi, class Sched>
DI void gemm_phase(LAS unsigned char* lds, const int K, const Sched& S, const Epi& E) {
    const int tid = tid_opaque(), wid = __builtin_amdgcn_readfirstlane(tid >> 6), lane = tid & 63, wr = wid >> 2, wc = wid & 3, fr = lane & 15, fq = lane >> 4;
    const int nt = K / BK;
    int R0, C0, R1, C1;
    stage_rc(tid * 16, R0, C0); stage_rc(tid * 16 + 8192, R1, C1);
    const int Rb0 = Epi::PERM ? ((R0 & ~31) + perm32(R0 & 31)) : R0, Rb1 = Epi::PERM ? ((R1 & ~31) + perm32(R1 & 31)) : R1;
    const size_t kstep = (size_t)(BK * 2);
    const size_t hstep = (size_t)HALF * K * 2;
    const unsigned vB0 = (unsigned)(Rb0 * K + C0) * 2u, vB1 = (unsigned)(Rb1 * K + C1) * 2u;
    const unsigned ldsw = (unsigned)wid * 1024u;
    const int aoff = lds_byte(wr * 64 + fr, fq * 8), boff = lds_byte(wc * 32 + fr, fq * 8);
#define G8_SA(b, h) (((b) * 2 + (h)) * HTB)
#define G8_SB(b, h) ((4 + (b) * 2 + (h)) * HTB)
#define G8_STAGE(bufoff, gbase, v0, v1) do { \
        __builtin_amdgcn_global_load_lds((const unsigned*)((const char*)(gbase) + (v0)), (LAS unsigned*)(lds + (bufoff) + ldsw), 16, 0, 0); \
        __builtin_amdgcn_global_load_lds((const unsigned*)((const char*)(gbase) + (v1)), (LAS unsigned*)(lds + (bufoff) + ldsw + 8192), 16, 0, 0); } while (0)
#define G8_LDA(dst, b, h) do { _Pragma("unroll") for (int m = 0; m < 4; ++m) _Pragma("unroll") for (int k = 0; k < 2; ++k) dst[m][k] = *(const LAS bf16x8*)(lds + G8_SA(b, h) + aoff + m * 2048 + k * 1024); } while (0)
#define G8_LDB(dst, b, h) do { _Pragma("unroll") for (int n = 0; n < 2; ++n) _Pragma("unroll") for (int k = 0; k < 2; ++k) dst[n][k] = *(const LAS bf16x8*)(lds + G8_SB(b, h) + boff + n * 2048 + k * 1024); } while (0)
#define G8_MMA(ai, bj, At, Bt) do { __builtin_amdgcn_s_setprio(1); _Pragma("unroll") for (int m = 0; m < 4; ++m) _Pragma("unroll") for (int n = 0; n < 2; ++n) _Pragma("unroll") for (int k = 0; k < 2; ++k) \
        acc[ai][bj][m][n] = __builtin_amdgcn_mfma_f32_16x16x32_bf16(Bt[n][k], At[m][k], acc[ai][bj][m][n], 0, 0, 0); __builtin_amdgcn_s_setprio(0); } while (0)
#define G8_WAIT_V(n) asm volatile("s_waitcnt vmcnt(" #n ")" ::: "memory")
#define G8_WAIT_L(n) asm volatile("s_waitcnt lgkmcnt(" #n ")" ::: "memory")
#define G8_BAR __builtin_amdgcn_s_barrier()
#define G8_SCHED __builtin_amdgcn_sched_barrier(0)
    Unit cur, nxt;
    int ui = 0;
    if (!S.next(0, cur)) return;
    f32x4 acc[2][2][4][2];
#pragma unroll
    for (int a = 0; a < 2; ++a)
#pragma unroll
        for (int b = 0; b < 2; ++b)
#pragma unroll
            for (int m = 0; m < 4; ++m)
#pragma unroll
                for (int n = 0; n < 2; ++n) acc[a][b][m][n] = (f32x4){0.f, 0.f, 0.f, 0.f};
    bf16x8 At[4][2], B0[2][2], B1[2][2];
    const char* cA = S.a_base(cur);
    const char* cB = S.b_base(cur);
    unsigned cv00, cv01, cv10, cv11, nv00, nv01, nv10, nv11;
    {
        int rows[2][2];
        S.a_rows(cur, R0, R1, rows);
        cv00 = (unsigned)(rows[0][0] * K + C0) * 2u; cv01 = (unsigned)(rows[0][1] * K + C1) * 2u;
        cv10 = (unsigned)(rows[1][0] * K + C0) * 2u; cv11 = (unsigned)(rows[1][1] * K + C1) * 2u;
        nv00 = cv00; nv01 = cv01; nv10 = cv10; nv11 = cv11;
    }
    G8_STAGE(G8_SB(0, 0), uni(cB), vB0, vB1); G8_STAGE(G8_SA(0, 0), uni(cA), cv00, cv01); G8_STAGE(G8_SB(0, 1), uni(cB + hstep), vB0, vB1); G8_STAGE(G8_SA(0, 1), uni(cA), cv10, cv11);
    if (wr == 1) G8_BAR;
    G8_WAIT_V(4); G8_BAR;
    G8_STAGE(G8_SB(1, 0), uni(cB + kstep), vB0, vB1); G8_STAGE(G8_SA(1, 0), uni(cA + kstep), cv00, cv01); G8_STAGE(G8_SB(1, 1), uni(cB + hstep + kstep), vB0, vB1);
    G8_WAIT_V(6); G8_BAR;
    for (;;) {
        const bool has_next = S.next(ui + 1, nxt);
        const char* nA = has_next ? S.a_base(nxt) : cA;
        const char* nB = has_next ? S.b_base(nxt) : cB;
        if (GATHER) {
            if (has_next) {
                int rows[2][2];
                S.a_rows(nxt, R0, R1, rows);
                nv00 = (unsigned)(rows[0][0] * K + C0) * 2u; nv01 = (unsigned)(rows[0][1] * K + C1) * 2u;
                nv10 = (unsigned)(rows[1][0] * K + C0) * 2u; nv11 = (unsigned)(rows[1][1] * K + C1) * 2u;
            } else { nv00 = cv00; nv01 = cv01; nv10 = cv10; nv11 = cv11; }
        }
        for (int t = 0; t < nt; t += 2) {
            const bool last = (t == nt - 2);
            const char* a1 = uni(cA + (size_t)(t + 1) * kstep);
            const char* a2 = uni(last ? nA : cA + (size_t)(t + 2) * kstep);
            const char* b2 = uni(last ? nB : cB + (size_t)(t + 2) * kstep);
            const char* a3 = uni(a2 + kstep);
            const char* b3 = uni(b2 + kstep);
            const char* b2h = uni(b2 + hstep);
            const char* b3h = uni(b3 + hstep);
            unsigned x00 = cv00, x01 = cv01, x10 = cv10, x11 = cv11;
            if (GATHER) { x00 = last ? nv00 : cv00; x01 = last ? nv01 : cv01; x10 = last ? nv10 : cv10; x11 = last ? nv11 : cv11; }
            G8_LDB(B0, 0, 0); G8_SCHED; G8_LDA(At, 0, 0); G8_STAGE(G8_SA(1, 1), a1, cv10, cv11);
            G8_WAIT_L(8); G8_BAR; G8_WAIT_L(0); G8_MMA(0, 0, At, B0); G8_BAR; G8_SCHED;
            G8_LDB(B1, 0, 1); G8_STAGE(G8_SB(0, 0), b2, vB0, vB1);
            G8_BAR; G8_WAIT_L(0); G8_MMA(0, 1, At, B1); G8_BAR;
            G8_LDA(At, 0, 1); G8_STAGE(G8_SA(0, 0), a2, x00, x01);
            G8_BAR; G8_WAIT_L(0); G8_MMA(1, 0, At, B0); G8_BAR; G8_SCHED;
            G8_STAGE(G8_SB(0, 1), b2h, vB0, vB1);
            G8_WAIT_V(6); G8_BAR; G8_MMA(1, 1, At, B1); G8_BAR;
            G8_LDB(B0, 1, 0); G8_SCHED; G8_LDA(At, 1, 0); G8_STAGE(G8_SA(0, 1), a2, x10, x11);
            G8_WAIT_L(8); G8_BAR; G8_WAIT_L(0); G8_MMA(0, 0, At, B0); G8_BAR; G8_SCHED;
            G8_LDB(B1, 1, 1); G8_STAGE(G8_SB(1, 0), b3, vB0, vB1);
            G8_BAR; G8_WAIT_L(0); G8_MMA(0, 1, At, B1); G8_BAR;
            G8_LDA(At, 1, 1); G8_STAGE(G8_SA(1, 0), a3, x00, x01);
            G8_BAR; G8_WAIT_L(0); G8_MMA(1, 0, At, B0); G8_BAR; G8_SCHED;
            G8_STAGE(G8_SB(1, 1), b3h, vB0, vB1);
            G8_WAIT_V(6); G8_BAR; G8_MMA(1, 1, At, B1); G8_BAR;
        }
        E(acc, cur, wr, wc, fr, fq);
        if (!has_next) break;
#pragma unroll
        for (int a = 0; a < 2; ++a)
#pragma unroll
            for (int b = 0; b < 2; ++b)
#pragma unroll
                for (int m = 0; m < 4; ++m)
#pragma unroll
                    for (int n = 0; n < 2; ++n) acc[a][b][m][n] = (f32x4){0.f, 0.f, 0.f, 0.f};
        cur = nxt; cA = nA; cB = nB; ++ui;
        if (GATHER) { cv00 = nv00; cv01 = nv01; cv10 = nv10; cv11 = nv11; }
    }
    G8_WAIT_V(0);
    if (wr == 0) G8_BAR;
    G8_BAR;
#undef G8_SA
#undef G8_SB
#undef G8_STAGE
#undef G8_LDA
#undef G8_LDB
#undef G8_MMA
#undef G8_WAIT_V
#undef G8_WAIT_L
#undef G8_BAR
#undef G8_SCHED
}

struct DenseSched {
    const char* A; const char* Bt; int K, nM, nN, nwg, G, c;
    DI void init(const void* A_, const void* Bt_, int M, int N, int K_, int G_, int c_) { A = (const char*)A_; Bt = (const char*)Bt_; K = K_; nM = M / BM; nN = N / BM; nwg = nM * nN; G = G_; c = c_; }
    DI bool next(int i, Unit& u) const {
        const int L = i * G + c;
        if (L >= nwg) return false;
        const int wgid = xcd_remap(L, nwg);
        const int nig = WGM * nN, gid = wgid / nig, fm = gid * WGM, gsz = (nM - fm) < WGM ? (nM - fm) : WGM;
        u.pm = fm + ((wgid % nig) % gsz); u.pn = (wgid % nig) / gsz; u.e = 0; u.valid = 256; u.rbase = 0;
        return true;
    }
    DI const char* a_base(const Unit& u) const { return A + (size_t)u.pm * 256 * K * 2; }
    DI const char* b_base(const Unit& u) const { return Bt + (size_t)u.pn * 256 * K * 2; }
    DI void a_rows(const Unit&, int R0, int R1, int (&rows)[2][2]) const { rows[0][0] = R0; rows[0][1] = R1; rows[1][0] = 128 + R0; rows[1][1] = 128 + R1; }
};
}

template <class ColPtr>
DI void transpose_tile(ColPtr colptr, int ld, int k0, int v0, bf16_t* dst, int K, float* tile, int tid) {
    constexpr int TS = 129;
    __syncthreads();
#pragma unroll
    for (int i = 0; i < 4; ++i) {
        const int idx = tid + NTHREADS * i;
        const int kr = idx >> 5, c4 = idx & 31;
        float sc;
        const float* src = colptr(v0 + 4 * c4, sc);
        f32x4 v = (f32x4){0.f, 0.f, 0.f, 0.f};
        if (src) v = *(const f32x4*)(src + (size_t)(k0 + kr) * ld);
        float* tp = tile + kr * TS + 4 * c4;
        tp[0] = v[0] * sc; tp[1] = v[1] * sc; tp[2] = v[2] * sc; tp[3] = v[3] * sc;
    }
    __syncthreads();
#pragma unroll
    for (int i = 0; i < 2; ++i) {
        const int ch = tid + NTHREADS * i;
        const int vr = ch >> 3, kc = ch & 7;
        const float* tp = tile + (kc * 8) * TS + vr;
        u32x4 w;
        w.x = cvtpk(tp[0], tp[TS]); w.y = cvtpk(tp[2 * TS], tp[3 * TS]); w.z = cvtpk(tp[4 * TS], tp[5 * TS]); w.w = cvtpk(tp[6 * TS], tp[7 * TS]);
        *(u32x4*)(dst + (size_t)(v0 + vr) * K + k0 + kc * 8) = w;
    }
}

DI void phase_prep(const P& p, int bid, int nb, char* smem) {
    const int tid = tid_opaque();
    bf16_t* xb = (bf16_t*)(p.ws + WS_XB);
    bf16_t* memb = (bf16_t*)(p.ws + WS_MEMB);
    {
        const size_t nx = (size_t)T * D / 4, nm = (size_t)NBATCH * MEML * D / 4;
        for (size_t i = (size_t)bid * NTHREADS + tid; i < nx + nm; i += (size_t)nb * NTHREADS) {
            if (i < nx) { f32x4 v = ((const f32x4*)p.x)[i]; u32x2 w; w.x = cvtpk(v[0], v[1]); w.y = cvtpk(v[2], v[3]); ((u32x2*)xb)[i] = w; }
            else { size_t j = i - nx; f32x4 v = ((const f32x4*)p.mem)[j]; u32x2 w; w.x = cvtpk(v[0], v[1]); w.y = cvtpk(v[2], v[3]); ((u32x2*)memb)[j] = w; }
        }
    }
    {
        bf16_t* rwt = (bf16_t*)(p.ws + WS_RWT);
        for (int i = bid * NTHREADS + tid; i < NE * D; i += nb * NTHREADS) {
            const int e = i >> 10, d = i & 1023;
            const float w = p.router_w[(size_t)d * NE + e];
            const bf16_t hi = f2bf(w);
            rwt[i] = hi; rwt[NE * D + i] = f2bf(w - bf2f(hi));
        }
    }
    float* tile = (float*)smem;
    constexpr int T_CONV = 16 * 20, T_ML = 16 * 28, T_KV = 16 * 4, T_OUT = 16 * 8, T_GU = 16 * 8, T_D = 8 * 8;
    constexpr int N0 = 2 * T_CONV, N1 = N0 + 2 * T_ML, N2 = N1 + 4 * T_KV, N3 = N2 + 4 * T_OUT, N4 = N3 + DEPTH * NE * T_GU, N5 = N4 + DEPTH * NE * T_D;
    for (int it = bid; it < N5; it += nb) {
        if (it < N0) {
            const int j = it / T_CONV, q = it % T_CONV, kt = q / 20, vt = q % 20;
            const float* W = p.conv_w_in + (size_t)j * D * DIN_CONV;
            transpose_tile([&](int v4, float& sc) { sc = 1.0f; return W + v4; }, DIN_CONV, kt * 64, vt * 128,
                           (bf16_t*)(p.ws + WS_WIN) + (size_t)j * DIN_CONV * D, D, tile, tid);
        } else if (it < N1) {
            const int r = it - N0, j = r / T_ML, q = r % T_ML, kt = q / 28, vt = q % 28;
            const float* W = p.ml_w_in + (size_t)j * D * DIN_ML;
            transpose_tile([&](int v4, float& sc) -> const float* {
                               sc = (v4 >= MIXW && v4 < 2 * MIXW) ? 0.08838834764831845f : 1.0f;
                               if (v4 < 3072) return W + v4;
                               if (v4 < 3328) return W + 3084 + (v4 - 3072);
                               if (v4 < 3340) return W + 3072 + (v4 - 3328);
                               return nullptr; },
                           DIN_ML, kt * 64, vt * 128, (bf16_t*)(p.ws + WS_WIN) + ((size_t)2 * DIN_CONV + (size_t)j * NV_ML) * D, D, tile, tid);
        } else if (it < N2) {
            const int r = it - N1, l = r / T_KV, q = r % T_KV, kt = q / 4, vt = q % 4;
            const float* W = p.w_kv + (size_t)l * D * 512;
            transpose_tile([&](int v4, float& sc) { sc = 1.0f; return W + v4; }, 512, kt * 64, vt * 128, (bf16_t*)(p.ws + WS_WKV) + (size_t)l * 512 * D, D, tile, tid);
        } else if (it < N3) {
            const int r = it - N2, l = r / T_OUT, q = r % T_OUT, kt = q / 8, vt = q % 8;
            const float* W = p.w_out + (size_t)l * D * D;
            transpose_tile([&](int v4, float& sc) { sc = 1.0f; return W + v4; }, D, kt * 64, vt * 128, (bf16_t*)(p.ws + WS_WOUT) + (size_t)l * D * D, D, tile, tid);
        } else if (it < N4) {
            const int r = it - N3, le = r / T_GU, q = r % T_GU, kt = q / 8, vt = q % 8;
            const float* Wg = p.w_gate + (size_t)le * D * DFF;
            const float* Wu = p.w_up + (size_t)le * D * DFF;
            transpose_tile([&](int v4, float& sc) { sc = 1.0f; const int grp = v4 >> 7; return ((grp & 1) ? Wu : Wg) + (grp >> 1) * 128 + (v4 & 127); },
                           DFF, kt * 64, vt * 128, (bf16_t*)(p.ws + WS_WGU) + (size_t)le * 1024 * D, D, tile, tid);
        } else {
            const int r = it - N4, le = r / T_D, q = r % T_D, kt = q / 8, vt = q % 8;
            const float* W = p.w_down + (size_t)le * DFF * D;
            transpose_tile([&](int v4, float& sc) { sc = 1.0f; return W + v4; }, D, kt * 64, vt * 128, (bf16_t*)(p.ws + WS_WD) + (size_t)le * D * DFF, DFF, tile, tid);
        }
    }
}

DI void store8_bf16(bf16_t* p8, const f32x4& v0, const f32x4& v1) {
    u32x4 w; w.x = cvtpk(v0[0], v0[1]); w.y = cvtpk(v0[2], v0[3]); w.z = cvtpk(v1[0], v1[1]); w.w = cvtpk(v1[2], v1[3]);
    *(u32x4*)p8 = w;
}

struct EpiTileBf16 {
    static constexpr bool PERM = true;
    bf16_t* O; int ldc; size_t pm_stride, pn_stride;
    DI void operator()(const f32x4 (&acc)[2][2][4][2], const g8::Unit& u, int wr, int wc, int fr, int fq) const {
        bf16_t* base = O + (size_t)u.pm * pm_stride + (size_t)u.pn * pn_stride + (size_t)(wr * 64 + fr) * ldc + wc * 32 + 8 * fq;
#pragma unroll
        for (int ai = 0; ai < 2; ++ai)
#pragma unroll
            for (int m = 0; m < 4; ++m)
                {
#pragma unroll
                    for (int bj = 0; bj < 2; ++bj) store8_bf16(base + (size_t)(ai * 128 + m * 16) * ldc + bj * 128, acc[ai][bj][m][0], acc[ai][bj][m][1]); __builtin_amdgcn_sched_barrier(0); }
    }
};

struct KSched {
    const char* memb; const char* wkv; int G, c;
    DI bool next(int i, g8::Unit& u) const { const int L = i * G + c; if (L >= 32) return false; u.pm = L & 7; u.pn = L >> 3; u.e = 0; u.valid = 256; u.rbase = 0; return true; }
    DI const char* a_base(const g8::Unit& u) const { return memb + (size_t)u.pm * 256 * D * 2; }
    DI const char* b_base(const g8::Unit& u) const { return wkv + (size_t)u.pn * 512 * D * 2; }
    DI void a_rows(const g8::Unit&, int R0, int R1, int (&rows)[2][2]) const { rows[0][0] = R0; rows[0][1] = R1; rows[1][0] = 128 + R0; rows[1][1] = 128 + R1; }
};
struct VSched {
    const char* memb; const char* wkv; int G, c;
    DI bool next(int i, g8::Unit& u) const { const int L = i * G + c - 32; if (L < 0 || L >= 32) return false; u.pm = L >> 3; u.pn = L & 7; u.e = 0; u.valid = 256; u.rbase = 0; return true; }
    DI const char* a_base(const g8::Unit& u) const { return wkv + ((size_t)u.pm * 512 + 256) * D * 2; }
    DI const char* b_base(const g8::Unit& u) const { return memb + (size_t)u.pn * 256 * D * 2; }
    DI void a_rows(const g8::Unit&, int R0, int R1, int (&rows)[2][2]) const { rows[0][0] = R0; rows[0][1] = R1; rows[1][0] = 128 + R0; rows[1][1] = 128 + R1; }
};
DI void phase_kv(const P& p, int bid, int nb, char* smem) {
    const char* memb = p.ws + WS_MEMB;
    const char* wkv = p.ws + WS_WKV;
    {
        KSched S{memb, wkv, nb, bid};
        EpiTileBf16 E{(bf16_t*)(p.ws + WS_KBUF), 256, (size_t)256 * 256, (size_t)2048 * 256};
        g8::gemm_phase<false>((LAS unsigned char*)smem, D, S, E);
    }
    {
        VSched S{memb, wkv, nb, bid};
        EpiTileBf16 E{(bf16_t*)(p.ws + WS_VT), 256, (size_t)8 * 256 * 256, (size_t)256 * 256};
        g8::gemm_phase<false>((LAS unsigned char*)smem, D, S, E);
    }
}

struct EpiInproj {
    static constexpr bool PERM = true;
    bf16_t* projb; int ldp; int gate_pn; const float* gate_b; float* logi; float* logf;
    DI void operator()(const f32x4 (&acc)[2][2][4][2], const g8::Unit& u, int wr, int wc, int fr, int fq) const {
        if (u.pn != gate_pn) {
            bf16_t* base = projb + (size_t)(u.pm * 256 + wr * 64 + fr) * ldp + u.pn * 256 + wc * 32 + 8 * fq;
#pragma unroll
            for (int ai = 0; ai < 2; ++ai)
#pragma unroll
                for (int m = 0; m < 4; ++m)
                    {
#pragma unroll
                        for (int bj = 0; bj < 2; ++bj) store8_bf16(base + (size_t)(ai * 128 + m * 16) * ldp + bj * 128, acc[ai][bj][m][0], acc[ai][bj][m][1]); __builtin_amdgcn_sched_barrier(0); }
        } else if (wc == 0 && fq < 2) {
#pragma unroll
            for (int ai = 0; ai < 2; ++ai)
#pragma unroll
                for (int m = 0; m < 4; ++m) {
                    const int t = u.pm * 256 + ai * 128 + wr * 64 + m * 16 + fr;
                    const int b = t >> 11, s = t & 2047;
#pragma unroll
                    for (int n = 0; n < 2; ++n)
#pragma unroll
                        for (int i = 0; i < 4; ++i) {
                            const int col = 8 * fq + 4 * n + i;
                            if (col < 12) {
                                const float val = acc[ai][0][m][n][i] + gate_b[col];
                                if (col < 6) logi[(size_t)(b * 6 + col) * SEQ + s] = val;
                                else logf[(size_t)(b * 6 + col - 6) * SEQ + s] = logsigmoidf_(val);
                            }
                        }
                    __builtin_amdgcn_sched_barrier(0);
                }
        }
    }
};
DI void phase_inproj(const P& p, int layer, int bid, int nb, char* smem) {
    const bool conv = (layer & 1) == 0;
    const int j = layer >> 1;
    const bf16_t* W = (const bf16_t*)(p.ws + WS_WIN) + (conv ? (size_t)j * DIN_CONV * D : ((size_t)2 * DIN_CONV + (size_t)j * NV_ML) * D);
    g8::DenseSched S; S.init(p.ws + WS_XB, W, T, conv ? DIN_CONV : NV_ML, D, nb, bid);
    EpiInproj E{(bf16_t*)(p.ws + WS_PROJ), conv ? DIN_CONV : LDP_ML, conv ? -1 : 13, p.ml_gate_b + j * 12, (float*)(p.ws + WS_LOGI), (float*)(p.ws + WS_LOGF)};
    g8::gemm_phase<false>((LAS unsigned char*)smem, D, S, E);
}

struct EpiOutproj {
    static constexpr bool PERM = false;
    const float* xres; float* z;
    DI void operator()(const f32x4 (&acc)[2][2][4][2], const g8::Unit& u, int wr, int wc, int fr, int fq) const {
        const size_t off0 = (size_t)(u.pm * 256 + wr * 64 + fr) * D + u.pn * 256 + wc * 32 + 4 * fq;
#pragma unroll
        for (int ai = 0; ai < 2; ++ai)
#pragma unroll
            for (int m = 0; m < 4; ++m)
#pragma unroll
                for (int bj = 0; bj < 2; ++bj)
#pragma unroll
                    for (int n = 0; n < 2; ++n) {
                        const size_t off = off0 + (size_t)(ai * 128 + m * 16) * D + bj * 128 + n * 16;
                        const f32x4 xr = *(const f32x4*)(xres + off);
                        *(f32x4*)(z + off) = xr * ALPHA + acc[ai][bj][m][n];
                        if (n == 1) __builtin_amdgcn_sched_barrier(0);
                    }
    }
};
DI void phase_outproj(const P& p, int layer, int bid, int nb, char* smem) {
    g8::DenseSched S; S.init(p.ws + WS_HCAT, (const bf16_t*)(p.ws + WS_WOUT) + (size_t)layer * D * D, T, D, D, nb, bid);
    EpiOutproj E{(layer == 0) ? p.x : (const float*)(p.ws + WS_XA), (float*)(p.ws + WS_Z)};
    g8::gemm_phase<false>((LAS unsigned char*)smem, D, S, E);
}

DI void moe_meta(const int* cnt, int* meta) {
    __syncthreads();
    if (threadIdx.x == 0) {
        int base = 0, blk = 0;
        for (int e = 0; e < NE; ++e) {
            const int c = __hip_atomic_load(cnt + e, __ATOMIC_RELAXED, __HIP_MEMORY_SCOPE_AGENT);
            meta[e] = base; meta[32 + e] = blk; meta[65 + e] = c;
            base += c; blk += (c + 255) >> 8;
        }
        meta[64] = blk;
    }
    __syncthreads();
}
struct MoeSched {
    const int* meta; const int* list; const char* A; const char* Bt; size_t b_estride; int K, G, c, nunits;
    DI bool next(int i, g8::Unit& u) const {
        const int L = i * G + c;
        if (L >= nunits) return false;
        const int w = g8::xcd_remap(L, nunits);
        const int rti = w >> 2;
        int e = 0;
        while (e < NE - 1 && __builtin_amdgcn_readfirstlane(meta[32 + e + 1]) <= rti) ++e;
        u.e = e; u.pm = rti - __builtin_amdgcn_readfirstlane(meta[32 + e]); u.pn = w & 3;
        const int left = __builtin_amdgcn_readfirstlane(meta[65 + e]) - u.pm * 256;
        u.valid = left < 256 ? left : 256;
        u.rbase = __builtin_amdgcn_readfirstlane(meta[e]);
        return true;
    }
    DI const char* b_base(const g8::Unit& u) const { return Bt + (size_t)u.e * b_estride + (size_t)u.pn * 256 * K * 2; }
};
struct MoeUpSched : MoeSched {
    DI const char* a_base(const g8::Unit&) const { return A; }
    DI void a_rows(const g8::Unit& u, int R0, int R1, int (&rows)[2][2]) const {
        const int* lst = list + (size_t)u.e * T + u.pm * 256;
        const int vm = u.valid - 1;
        rows[0][0] = lst[min(R0, vm)] >> 1; rows[0][1] = lst[min(R1, vm)] >> 1;
        rows[1][0] = lst[min(128 + R0, vm)] >> 1; rows[1][1] = lst[min(128 + R1, vm)] >> 1;
    }
};
struct MoeDownSched : MoeSched {
    DI const char* a_base(const g8::Unit& u) const { return A + ((size_t)u.rbase + (size_t)u.pm * 256) * K * 2; }
    DI void a_rows(const g8::Unit&, int R0, int R1, int (&rows)[2][2]) const { rows[0][0] = R0; rows[0][1] = R1; rows[1][0] = 128 + R0; rows[1][1] = 128 + R1; }
};

struct EpiMoeUp {
    static constexpr bool PERM = true;
    const int* meta; bf16_t* hbuf;
    DI void operator()(const f32x4 (&acc)[2][2][4][2], const g8::Unit& u, int wr, int wc, int fr, int fq) const {
        const size_t hrow0 = (size_t)u.rbase + (size_t)u.pm * 256;
#pragma unroll
        for (int ai = 0; ai < 2; ++ai)
#pragma unroll
            for (int m = 0; m < 4; ++m) {
                const int row = ai * 128 + wr * 64 + m * 16 + fr;
                if (row < u.valid) {
                    f32x4 h0, h1;
#pragma unroll
                    for (int i = 0; i < 4; ++i) {
                        const float g0 = acc[ai][0][m][0][i], g1 = acc[ai][0][m][1][i];
                        h0[i] = g0 * sigmoidf_(g0) * acc[ai][1][m][0][i];
                        h1[i] = g1 * sigmoidf_(g1) * acc[ai][1][m][1][i];
                    }
                    store8_bf16(hbuf + (hrow0 + row) * DFF + u.pn * 128 + wc * 32 + 8 * fq, h0, h1);
                }
                __builtin_amdgcn_sched_barrier(0);
            }
    }
};
DI void phase_moe_up(const P& p, int layer, int bid, int nb, char* smem) {
    int* meta = (int*)(smem + META_OFF);
    moe_meta((const int*)(p.ws + WS_CTL + CTL_CNT) + layer * 32, meta);
    MoeUpSched S;
    S.meta = meta; S.list = (const int*)(p.ws + WS_LIST); S.A = p.ws + WS_X1B; S.Bt = p.ws + WS_WGU + (size_t)layer * NE * 1024 * D * 2;
    S.b_estride = (size_t)1024 * D * 2; S.K = D; S.G = nb; S.c = bid; S.nunits = meta[64] * 4;
    EpiMoeUp E{meta, (bf16_t*)(p.ws + WS_HBUF)};
    g8::gemm_phase<true>((LAS unsigned char*)smem, D, S, E);
}

struct EpiMoeDown {
    static constexpr bool PERM = true;
    const int* list; const float* gate; bf16_t* yasg;
    DI void operator()(const f32x4 (&acc)[2][2][4][2], const g8::Unit& u, int wr, int wc, int fr, int fq) const {
        const int* lst = list + (size_t)u.e * T + u.pm * 256;
#pragma unroll
        for (int ai = 0; ai < 2; ++ai)
#pragma unroll
            for (int m = 0; m < 4; ++m) {
                const int row = ai * 128 + wr * 64 + m * 16 + fr;
                if (row < u.valid) {
                    const int a = lst[row];
                    const float gt = gate[a];
                    bf16_t* dst = yasg + (size_t)a * D + u.pn * 256 + wc * 32 + 8 * fq;
#pragma unroll
                    for (int bj = 0; bj < 2; ++bj) store8_bf16(dst + bj * 128, acc[ai][bj][m][0] * gt, acc[ai][bj][m][1] * gt);
                }
                __builtin_amdgcn_sched_barrier(0);
            }
    }
};
DI void phase_moe_down(const P& p, int layer, int bid, int nb, char* smem) {
    int* meta = (int*)(smem + META_OFF);
    moe_meta((const int*)(p.ws + WS_CTL + CTL_CNT) + layer * 32, meta);
    MoeDownSched S;
    S.meta = meta; S.list = (const int*)(p.ws + WS_LIST); S.A = p.ws + WS_HBUF; S.Bt = p.ws + WS_WD + (size_t)layer * NE * D * DFF * 2;
    S.b_estride = (size_t)D * DFF * 2; S.K = DFF; S.G = nb; S.c = bid; S.nunits = meta[64] * 4;
    EpiMoeDown E{(const int*)(p.ws + WS_LIST), (const float*)(p.ws + WS_GATE), (bf16_t*)(p.ws + WS_YASG)};
    g8::gemm_phase<false>((LAS unsigned char*)smem, DFF, S, E);
}

DI void phase_convmix(const P& p, int layer, int bid, int nb) {
    const int j = layer >> 1;
    const int tid = tid_opaque();
    const bf16_t* projb = (const bf16_t*)(p.ws + WS_PROJ);
    bf16_t* hcat = (bf16_t*)(p.ws + WS_HCAT);
    const float* cw = p.conv_w + (size_t)j * 3 * MIXW;
    const int nitem = T * (MIXW / 8);
    for (int it = bid * NTHREADS + tid; it < nitem; it += nb * NTHREADS) {
        const int t = it / 96, c8 = (it % 96) * 8;
        const int s = t & 2047;
        const bf16_t* row = projb + (size_t)t * DIN_CONV;
        const u32x4 bg = *(const u32x4*)(row + c8);
        float u[3][8];
#pragma unroll
        for (int d = 0; d < 3; ++d) {
            const int back = 2 - d;
            if (s - back >= 0) {
                const bf16_t* rw = row - (size_t)back * DIN_CONV;
                const u32x4 cg = *(const u32x4*)(rw + MIXW + c8);
                const u32x4 xi = *(const u32x4*)(rw + 2 * MIXW + c8);
#pragma unroll
                for (int q = 0; q < 4; ++q) { u[d][2 * q] = bflo(cg[q]) * bflo(xi[q]); u[d][2 * q + 1] = bfhi(cg[q]) * bfhi(xi[q]); }
            } else {
#pragma unroll
                for (int q = 0; q < 8; ++q) u[d][q] = 0.f;
            }
        }
        float o[8];
#pragma unroll
        for (int q = 0; q < 8; ++q) {
            const float c = cw[c8 + q] * u[0][q] + cw[MIXW + c8 + q] * u[1][q] + cw[2 * MIXW + c8 + q] * u[2][q];
            const float b = (q & 1) ? bfhi(bg[q >> 1]) : bflo(bg[q >> 1]);
            o[q] = b * c;
        }
        u32x4 w; w.x = cvtpk(o[0], o[1]); w.y = cvtpk(o[2], o[3]); w.z = cvtpk(o[4], o[5]); w.w = cvtpk(o[6], o[7]);
        *(u32x4*)(hcat + (size_t)t * D + c8) = w;
    }
}

DI void phase_xattn(const P& p, int layer, int bid, int nb, char* smem) {
    const bool conv = (layer & 1) == 0;
    const int ldp = conv ? DIN_CONV : LDP_ML;
    const int qoff = conv ? 3 * MIXW : 3072;
    const bf16_t* projb = (const bf16_t*)(p.ws + WS_PROJ);
    const bf16_t* kbuf = (const bf16_t*)(p.ws + WS_KBUF) + (size_t)layer * 2048 * 256;
    const bf16_t* vT = (const bf16_t*)(p.ws + WS_VT) + (size_t)layer * 8 * 256 * 256;
    bf16_t* hcat = (bf16_t*)(p.ws + WS_HCAT);
    constexpr int LK = 72, LV = 264;
    bf16_t* Ks = (bf16_t*)smem;
    bf16_t* Vs = Ks + 256 * LK;
    for (int task = bid; task < NBATCH * XH * 16; task += nb) {
        const int tid = tid_opaque(), lane = tid & 63, wid = tid >> 6, r = lane & 15, g = lane >> 4;
        const int b = task >> 6, h = (task >> 4) & 3, qt = task & 15;
        __syncthreads();
#pragma unroll
        for (int i = 0; i < 4; ++i) {
            const int key = (tid >> 3) + 64 * i, kc = tid & 7;
            *(u32x4*)&Ks[key * LK + kc * 8] = *(const u32x4*)(kbuf + ((size_t)b * 256 + key) * 256 + h * 64 + kc * 8);
            const int dv = (tid >> 5) + 16 * i, mc = tid & 31;
            *(u32x4*)&Vs[dv * LV + mc * 8] = *(const u32x4*)(vT + (((size_t)b * 4 + h) * 64 + dv) * 256 + mc * 8);
        }
        __syncthreads();
        const int tq = b * SEQ + qt * 128 + wid * 16;
        const bf16_t* qrow = projb + (size_t)(tq + r) * ldp + qoff + h * 64;
        bf16x8 qf[2];
        qf[0] = *(const bf16x8*)(qrow + 8 * g);
        qf[1] = *(const bf16x8*)(qrow + 32 + 8 * g);
        f32x4 sacc[16];
#pragma unroll
        for (int kt = 0; kt < 16; ++kt) {
            f32x4 a = (f32x4){0.f, 0.f, 0.f, 0.f};
#pragma unroll
            for (int ks = 0; ks < 2; ++ks) {
                const bf16x8 kf = *(const bf16x8*)&Ks[(kt * 16 + r) * LK + ks * 32 + 8 * g];
                a = mfma16(kf, qf[ks], a);
            }
            sacc[kt] = a;
            if (kt & 1) __builtin_amdgcn_sched_barrier(0);
        }
        float mx = -3.0e38f;
#pragma unroll
        for (int kt = 0; kt < 16; ++kt)
#pragma unroll
            for (int i = 0; i < 4; ++i) { sacc[kt][i] *= 0.125f; mx = fmaxf(mx, sacc[kt][i]); }
        mx = xor_max(mx, 16); mx = xor_max(mx, 32);
        float sum = 0.f;
#pragma unroll
        for (int kt = 0; kt < 16; ++kt)
#pragma unroll
            for (int i = 0; i < 4; ++i) { const float e = __expf(sacc[kt][i] - mx); sacc[kt][i] = e; sum += e; }
        sum = xor_add(sum, 16); sum = xor_add(sum, 32);
        const float inv = 1.0f / sum;
        f32x4 oacc[4];
#pragma unroll
        for (int dt = 0; dt < 4; ++dt) oacc[dt] = (f32x4){0.f, 0.f, 0.f, 0.f};
#pragma unroll
        for (int s2 = 0; s2 < 8; ++s2) {
            u32x4 pw;
            pw.x = cvtpk(sacc[2 * s2][0], sacc[2 * s2][1]); pw.y = cvtpk(sacc[2 * s2][2], sacc[2 * s2][3]);
            pw.z = cvtpk(sacc[2 * s2 + 1][0], sacc[2 * s2 + 1][1]); pw.w = cvtpk(sacc[2 * s2 + 1][2], sacc[2 * s2 + 1][3]);
            const bf16x8 pf = __builtin_bit_cast(bf16x8, pw);
#pragma unroll
            for (int dt = 0; dt < 4; ++dt) {
                const bf16_t* vp = &Vs[(dt * 16 + r) * LV + s2 * 32 + 4 * g];
                const u32x2 v0 = *(const u32x2*)vp;
                const u32x2 v1 = *(const u32x2*)(vp + 16);
                u32x4 vw; vw.x = v0.x; vw.y = v0.y; vw.z = v1.x; vw.w = v1.y;
                oacc[dt] = mfma16(__builtin_bit_cast(bf16x8, vw), pf, oacc[dt]);
            }
            __builtin_amdgcn_sched_barrier(0);
        }
        bf16_t* orow = hcat + (size_t)(tq + r) * D + MIXW + h * 64;
#pragma unroll
        for (int dt = 0; dt < 4; ++dt) {
            u32x2 w; w.x = cvtpk(oacc[dt][0] * inv, oacc[dt][1] * inv); w.y = cvtpk(oacc[dt][2] * inv, oacc[dt][3] * inv);
            *(u32x2*)(orow + dt * 16 + 4 * g) = w;
        }
    }
}

DI void phase_ml_local(const P& p, int bid, int nb, char* smem) {
    const bf16_t* projb = (const bf16_t*)(p.ws + WS_PROJ);
    const float* logi = (const float*)(p.ws + WS_LOGI);
    const float* logf = (const float*)(p.ws + WS_LOGF);
    float* CT = (float*)(p.ws + WS_CT);
    float* nloc = (float*)(p.ws + WS_NLOC);
    float* mloc = (float*)(p.ws + WS_MLOC);
    float* gsum = (float*)(p.ws + WS_GSUM);
    constexpr int LS = 136;
    bf16_t* kwT = (bf16_t*)smem;
    bf16_t* vTs = kwT + 128 * LS;
    float* fb = (float*)(vTs + 128 * LS);
    float* fw = fb + 128;
    float* fr = fw + 128;
    for (int task = bid; task < 48 * NCH; task += nb) {
        const int tid = tid_opaque(), lane = tid & 63, wid = tid >> 6, r = lane & 15, g = lane >> 4;
        const int bh = task >> 4, c = task & 15, b = bh / 6, h = bh % 6;
        const int t0 = b * SEQ + c * CHUNK;
        __syncthreads();
        float li = 0.f, cum = 0.f;
        if (tid < 128) { li = logi[(size_t)bh * SEQ + c * CHUNK + tid]; cum = logf[(size_t)bh * SEQ + c * CHUNK + tid]; fb[tid] = cum; }
        __syncthreads();
        for (int off = 1; off < 128; off <<= 1) {
            float add = 0.f;
            if (tid < 128 && tid >= off) add = fb[tid - off];
            __syncthreads();
            if (tid < 128) { cum += add; fb[tid] = cum; }
            __syncthreads();
        }
        const float gtot = fb[127];
        float a = -3.0e38f;
        if (tid < 128) a = gtot - cum + li;
        float wm_ = a;
        wm_ = xor_max(wm_, 32); wm_ = xor_max(wm_, 16); wm_ = xor_max(wm_, 8); wm_ = xor_max(wm_, 4); wm_ = xor_max(wm_, 2); wm_ = xor_max(wm_, 1);
        if (lane == 0) fr[wid] = wm_;
        __syncthreads();
        const float ml = fmaxf(fr[0], fr[1]);
        if (tid < 128) fw[tid] = __expf(a - ml);
        __syncthreads();
        {
            const int s = tid & 127, quarter = tid >> 7;
            const float w = fw[s];
            const bf16_t* krow = projb + (size_t)(t0 + s) * LDP_ML + MIXW + h * 128;
            const bf16_t* vrow = projb + (size_t)(t0 + s) * LDP_ML + 2 * MIXW + h * 128;
#pragma unroll
            for (int i = 0; i < 4; ++i) {
                const int dc = quarter * 4 + i;
                const u32x4 kk = *(const u32x4*)(krow + dc * 8);
                const u32x4 vv = *(const u32x4*)(vrow + dc * 8);
#pragma unroll
                for (int q = 0; q < 4; ++q) {
                    kwT[(dc * 8 + 2 * q) * LS + s] = f2bf(bflo(kk[q]) * w);
                    kwT[(dc * 8 + 2 * q + 1) * LS + s] = f2bf(bfhi(kk[q]) * w);
                    vTs[(dc * 8 + 2 * q) * LS + s] = (bf16_t)(vv[q] & 0xffffu);
                    vTs[(dc * 8 + 2 * q + 1) * LS + s] = (bf16_t)(vv[q] >> 16);
                }
            }
        }
        __syncthreads();
        float* ct = CT + (size_t)task * 128 * 128;
        {
            f32x4 acc[8];
#pragma unroll
            for (int dt = 0; dt < 8; ++dt) acc[dt] = (f32x4){0.f, 0.f, 0.f, 0.f};
#pragma unroll
            for (int ks = 0; ks < 4; ++ks) {
                const bf16x8 vf = *(const bf16x8*)&vTs[(wid * 16 + r) * LS + ks * 32 + 8 * g];
#pragma unroll
                for (int dt = 0; dt < 8; ++dt) {
                    const bf16x8 kf = *(const bf16x8*)&kwT[(dt * 16 + r) * LS + ks * 32 + 8 * g];
                    acc[dt] = mfma16(vf, kf, acc[dt]);
                }
                __builtin_amdgcn_sched_barrier(0);
            }
#pragma unroll
            for (int dt = 0; dt < 8; ++dt)
#pragma unroll
                for (int i = 0; i < 4; ++i) ct[(wid * 16 + 4 * g + i) * 128 + dt * 16 + r] = acc[dt][i];
        }
        if (tid < 128) {
            float sn = 0.f;
            for (int s = 0; s < 128; ++s) sn += bf2f(kwT[tid * LS + s]);
            nloc[(size_t)task * 128 + tid] = sn;
        }
        if (tid == 0) { mloc[task] = ml; gsum[task] = gtot; }
    }
}

DI void phase_ml_scan(const P& p, int bid, int nb) {
    const float* CT = (const float*)(p.ws + WS_CT);
    bf16_t* CPB = (bf16_t*)(p.ws + WS_CPB);
    const float* nloc = (const float*)(p.ws + WS_NLOC);
    float* nprev = (float*)(p.ws + WS_NPREV);
    const float* mloc = (const float*)(p.ws + WS_MLOC);
    const float* gsum = (const float*)(p.ws + WS_GSUM);
    float* mprev = (float*)(p.ws + WS_MPREV);
    const int tid = tid_opaque();
    for (int task = bid; task < 48 * 8; task += nb) {
        const int bh = task >> 3, sl = task & 7;
        const int idx = sl * 2048 + tid * 4;
        float m = 0.f;
        f32x4 st = (f32x4){0.f, 0.f, 0.f, 0.f};
        float nst = 0.f;
        const bool don = (sl == 0 && tid < 128);
        for (int c = 0; c < NCH; ++c) {
            const int ch = bh * NCH + c;
            const float gg = gsum[ch], ml = mloc[ch];
            const float mnew = fmaxf(gg + m, ml);
            const float decay = __expf(gg + m - mnew), sc = __expf(ml - mnew);
            const f32x4 loc = *(const f32x4*)(CT + (size_t)ch * 16384 + idx);
            u32x2 w; w.x = cvtpk(st[0], st[1]); w.y = cvtpk(st[2], st[3]);
            *(u32x2*)(CPB + (size_t)ch * 16384 + idx) = w;
            st = st * decay + loc * sc;
            if (don) {
                const float nl = nloc[(size_t)ch * 128 + tid];
                nprev[(size_t)ch * 128 + tid] = nst;
                nst = nst * decay + nl * sc;
            }
            if (sl == 0 && tid == 0) mprev[ch] = m;
            m = mnew;
        }
    }
}

DI void phase_ml_out(const P& p, int layer, int bid, int nb, char* smem) {
    const int j = layer >> 1;
    const bf16_t* projb = (const bf16_t*)(p.ws + WS_PROJ);
    const float* logi = (const float*)(p.ws + WS_LOGI);
    const float* logf = (const float*)(p.ws + WS_LOGF);
    const bf16_t* CPB = (const bf16_t*)(p.ws + WS_CPB);
    const float* nprev = (const float*)(p.ws + WS_NPREV);
    const float* mprev = (const float*)(p.ws + WS_MPREV);
    bf16_t* hcat = (bf16_t*)(p.ws + WS_HCAT);
    const float* ng_ = p.ml_norm_g + (size_t)j * MIXW;
    constexpr int LS = 136;
    bf16_t* kS = (bf16_t*)smem;
    bf16_t* vTs = kS + 128 * LS;
    float* fb = (float*)(vTs + 128 * LS);
    float* fB = fb + 128;
    float* fA = fB + 128;
    float* fW = fA + 128;
    float* fE = fW + 128;
    float* fN = fE + 128;
    for (int task = bid; task < 48 * NCH; task += nb) {
        const int tid = tid_opaque();
        const int lane = tid & 63, wid = __builtin_amdgcn_readfirstlane(tid >> 6), r = lane & 15, g = lane >> 4;
        const int bh = task >> 4, c = task & 15, b = bh / 6, h = bh % 6;
        const int t0 = b * SEQ + c * CHUNK;
        __syncthreads();
        float li = 0.f, cum = 0.f;
        if (tid < 128) { li = logi[(size_t)bh * SEQ + c * CHUNK + tid]; cum = logf[(size_t)bh * SEQ + c * CHUNK + tid]; fb[tid] = cum; fN[tid] = nprev[(size_t)task * 128 + tid]; }
        __syncthreads();
        for (int off = 1; off < 128; off <<= 1) {
            float add = 0.f;
            if (tid < 128 && tid >= off) add = fb[tid - off];
            __syncthreads();
            if (tid < 128) { cum += add; fb[tid] = cum; }
            __syncthreads();
        }
        const float Bs_ = li - cum;
        float pm = Bs_;
        if (tid < 128) { fB[tid] = Bs_; fb[tid] = pm; }
        __syncthreads();
        for (int off = 1; off < 128; off <<= 1) {
            float o = -3.0e38f;
            if (tid < 128 && tid >= off) o = fb[tid - off];
            __syncthreads();
            if (tid < 128) { pm = fmaxf(pm, o); fb[tid] = pm; }
            __syncthreads();
        }
        if (tid < 128) {
            const float mp = mprev[task];
            const float inter = cum + mp;
            const float ml = fmaxf(cum + pm, inter);
            fA[tid] = cum - ml; fW[tid] = __expf(inter - ml); fE[tid] = __expf(-ml);
        }
        {
#pragma unroll
            for (int i = 0; i < 4; ++i) {
                const int s = (tid >> 4) + 32 * i, dc = tid & 15;
                *(u32x4*)&kS[s * LS + dc * 8] = *(const u32x4*)(projb + (size_t)(t0 + s) * LDP_ML + MIXW + h * 128 + dc * 8);
            }
            const int s = tid & 127, quarter = tid >> 7;
            const bf16_t* vrow = projb + (size_t)(t0 + s) * LDP_ML + 2 * MIXW + h * 128;
#pragma unroll
            for (int i = 0; i < 4; ++i) {
                const int dc = quarter * 4 + i;
                const u32x4 vv = *(const u32x4*)(vrow + dc * 8);
#pragma unroll
                for (int q = 0; q < 4; ++q) {
                    vTs[(dc * 8 + 2 * q) * LS + s] = (bf16_t)(vv[q] & 0xffffu);
                    vTs[(dc * 8 + 2 * q + 1) * LS + s] = (bf16_t)(vv[q] >> 16);
                }
            }
        }
        __syncthreads();
        const bf16_t* cp = CPB + (size_t)task * 16384;
        {
            const int l = wid * 16 + r;
            bf16x8 qf[4];
            float qn;
            {
                const bf16_t* qrow = projb + (size_t)(t0 + l) * LDP_ML + h * 128;
                float part = 0.f;
#pragma unroll
                for (int ks = 0; ks < 4; ++ks) {
                    const u32x4 qq = *(const u32x4*)(qrow + ks * 32 + 8 * g);
                    qf[ks] = __builtin_bit_cast(bf16x8, qq);
#pragma unroll
                    for (int q = 0; q < 4; ++q) part += bflo(qq[q]) * fN[ks * 32 + 8 * g + 2 * q] + bfhi(qq[q]) * fN[ks * 32 + 8 * g + 2 * q + 1];
                }
                part = xor_add(part, 16); part = xor_add(part, 32);
                qn = part;
            }
            __builtin_amdgcn_sched_barrier(0);
            f32x4 nacc[8];
#pragma unroll
            for (int et = 0; et < 8; ++et) {
                f32x4 a = (f32x4){0.f, 0.f, 0.f, 0.f};
#pragma unroll
                for (int ks = 0; ks < 4; ++ks) {
                    const bf16x8 cf = *(const bf16x8*)(cp + (et * 16 + r) * 128 + ks * 32 + 8 * g);
                    a = mfma16(cf, qf[ks], a);
                }
                nacc[et] = a;
                if (et & 1) __builtin_amdgcn_sched_barrier(0);
            }
            const float Al = fA[l], wint = fW[l], eml = fE[l];
#pragma unroll
            for (int et = 0; et < 8; ++et) nacc[et] *= wint;
            const int stmax = wid;
            float den = 0.f;
#pragma unroll
            for (int s2 = 0; s2 < 4; ++s2) {
                if (2 * s2 <= stmax) {
                    f32x4 sa = (f32x4){0.f, 0.f, 0.f, 0.f}, sb = (f32x4){0.f, 0.f, 0.f, 0.f};
#pragma unroll
                    for (int ks = 0; ks < 4; ++ks) {
                        const bf16x8 kf = *(const bf16x8*)&kS[(s2 * 32 + r) * LS + ks * 32 + 8 * g];
                        sa = mfma16(kf, qf[ks], sa);
                    }
                    if (2 * s2 + 1 <= stmax) {
#pragma unroll
                        for (int ks = 0; ks < 4; ++ks) {
                            const bf16x8 kf = *(const bf16x8*)&kS[(s2 * 32 + 16 + r) * LS + ks * 32 + 8 * g];
                            sb = mfma16(kf, qf[ks], sb);
                        }
                    }
#pragma unroll
                    for (int i = 0; i < 4; ++i) {
                        const int s = s2 * 32 + 4 * g + i;
                        const float va = (s <= l) ? sa[i] * __expf(Al + fB[s]) : 0.f;
                        const float vb = (s + 16 <= l) ? sb[i] * __expf(Al + fB[s + 16]) : 0.f;
                        sa[i] = va; sb[i] = vb; den += va + vb;
                    }
                    u32x4 pw;
                    pw.x = cvtpk(sa[0], sa[1]); pw.y = cvtpk(sa[2], sa[3]);
                    pw.z = cvtpk(sb[0], sb[1]); pw.w = cvtpk(sb[2], sb[3]);
                    const bf16x8 pf = __builtin_bit_cast(bf16x8, pw);
#pragma unroll
                    for (int et = 0; et < 8; ++et) {
                        const bf16_t* vp = &vTs[(et * 16 + r) * LS + s2 * 32 + 4 * g];
                        const u32x2 v0 = *(const u32x2*)vp;
                        const u32x2 v1 = *(const u32x2*)(vp + 16);
                        u32x4 vw; vw.x = v0.x; vw.y = v0.y; vw.z = v1.x; vw.w = v1.y;
                        nacc[et] = mfma16(__builtin_bit_cast(bf16x8, vw), pf, nacc[et]);
                    }
                }
                __builtin_amdgcn_sched_barrier(0);
            }
            den = xor_add(den, 16); den = xor_add(den, 32);
            const float dd = fmaxf(fabsf(den + wint * qn), eml);
            const float invd = 1.0f / dd;
            float sm = 0.f;
#pragma unroll
            for (int et = 0; et < 8; ++et)
#pragma unroll
                for (int i = 0; i < 4; ++i) { nacc[et][i] *= invd; sm += nacc[et][i]; }
            sm = xor_add(sm, 16); sm = xor_add(sm, 32);
            const float mu = sm * (1.0f / 128.0f);
            float sq = 0.f;
#pragma unroll
            for (int et = 0; et < 8; ++et)
#pragma unroll
                for (int i = 0; i < 4; ++i) { const float dlt = nacc[et][i] - mu; sq += dlt * dlt; }
            sq = xor_add(sq, 16); sq = xor_add(sq, 32);
            const float rstd = rsqrtf(sq * (1.0f / 128.0f) + LN_EPS);
            const size_t trow = (size_t)(t0 + l);
            const bf16_t* og = projb + trow * LDP_ML + 3 * MIXW + h * 128;
            bf16_t* orow = hcat + trow * D + h * 128;
#pragma unroll
            for (int et = 0; et < 8; ++et) {
                const int e = et * 16 + 4 * g;
                const u32x2 ov = *(const u32x2*)(og + e);
                const f32x4 gv = *(const f32x4*)(ng_ + h * 128 + e);
                const float o0 = (nacc[et][0] - mu) * rstd * gv[0] * sigmoidf_(bflo(ov.x));
                const float o1 = (nacc[et][1] - mu) * rstd * gv[1] * sigmoidf_(bfhi(ov.x));
                const float o2 = (nacc[et][2] - mu) * rstd * gv[2] * sigmoidf_(bflo(ov.y));
                const float o3 = (nacc[et][3] - mu) * rstd * gv[3] * sigmoidf_(bfhi(ov.y));
                u32x2 w; w.x = cvtpk(o0, o1); w.y = cvtpk(o2, o3);
                *(u32x2*)(orow + e) = w;
                if (et & 1) __builtin_amdgcn_sched_barrier(0);
            }
        }
    }
}

DI void phase_ln1_route(const P& p, int layer, int bid, int nb, char* smem) {
    const float* z = (const float*)(p.ws + WS_Z);
    float* x1a = (float*)(p.ws + WS_X1A);
    bf16_t* x1b = (bf16_t*)(p.ws + WS_X1B);
    float* gate = (float*)(p.ws + WS_GATE);
    int* list = (int*)(p.ws + WS_LIST);
    int* cnt = (int*)(p.ws + WS_CTL + CTL_CNT) + layer * 32;
    const bf16_t* rwh = (const bf16_t*)(p.ws + WS_RWT);
    const bf16_t* rwl = rwh + NE * D;
    const float* lg = p.ln1_g + (size_t)layer * D;
    const float* lb = p.ln1_b + (size_t)layer * D;
    constexpr int XS = 1028;
    float* xs = (float*)smem;
    float* red = xs + 16 * XS;
    float* scs = red + 8 * 16 * 32;
    for (int task = bid; task < T / 16; task += nb) {
        const int tid = tid_opaque(), lane = tid & 63, wid = tid >> 6, r = lane & 15, g = lane >> 4;
        const int row0 = task * 16;
        __syncthreads();
#pragma unroll
        for (int rr = 0; rr < 2; ++rr) {
            const int lr = wid * 2 + rr;
            const size_t t = (size_t)(row0 + lr);
            f32x4 v[4];
            float s = 0.f;
#pragma unroll
            for (int i = 0; i < 4; ++i) { v[i] = *(const f32x4*)(z + t * D + i * 256 + lane * 4); s += v[i][0] + v[i][1] + v[i][2] + v[i][3]; }
            s = wave_sum(s);
            const float mu = s * (1.0f / D);
            float q = 0.f;
#pragma unroll
            for (int i = 0; i < 4; ++i)
#pragma unroll
                for (int k = 0; k < 4; ++k) { const float d = v[i][k] - mu; q += d * d; }
            q = wave_sum(q);
            const float rstd = rsqrtf(q * (1.0f / D) + LN_EPS);
#pragma unroll
            for (int i = 0; i < 4; ++i) {
                const int col = i * 256 + lane * 4;
                const f32x4 gg = *(const f32x4*)(lg + col), bb = *(const f32x4*)(lb + col);
                const f32x4 o = (v[i] - mu) * rstd * gg + bb;
                *(f32x4*)(x1a + t * D + col) = o;
                u32x2 w; w.x = cvtpk(o[0], o[1]); w.y = cvtpk(o[2], o[3]);
                *(u32x2*)(x1b + t * D + col) = w;
                *(f32x4*)(xs + lr * XS + col) = o;
            }
        }
        __syncthreads();
        {
            f32x4 acc0 = (f32x4){0.f, 0.f, 0.f, 0.f}, acc1 = (f32x4){0.f, 0.f, 0.f, 0.f};
#pragma unroll
            for (int ks = 0; ks < 4; ++ks) {
                const int k = wid * 128 + ks * 32 + 8 * g;
                const f32x4 xa0 = *(const f32x4*)(xs + r * XS + k), xa1 = *(const f32x4*)(xs + r * XS + k + 4);
                u32x4 hw, lw;
                hw.x = cvtpk(xa0[0], xa0[1]); hw.y = cvtpk(xa0[2], xa0[3]); hw.z = cvtpk(xa1[0], xa1[1]); hw.w = cvtpk(xa1[2], xa1[3]);
                lw.x = cvtpk(xa0[0] - bflo(hw.x), xa0[1] - bfhi(hw.x)); lw.y = cvtpk(xa0[2] - bflo(hw.y), xa0[3] - bfhi(hw.y));
                lw.z = cvtpk(xa1[0] - bflo(hw.z), xa1[1] - bfhi(hw.z)); lw.w = cvtpk(xa1[2] - bflo(hw.w), xa1[3] - bfhi(hw.w));
                const bf16x8 xh = __builtin_bit_cast(bf16x8, hw), xl = __builtin_bit_cast(bf16x8, lw);
                const bf16x8 wh0 = *(const bf16x8*)(rwh + (size_t)r * D + k), wl0 = *(const bf16x8*)(rwl + (size_t)r * D + k);
                const bf16x8 wh1 = *(const bf16x8*)(rwh + (size_t)(16 + r) * D + k), wl1 = *(const bf16x8*)(rwl + (size_t)(16 + r) * D + k);
                acc0 = mfma16(wh0, xh, acc0); acc0 = mfma16(wh0, xl, acc0); acc0 = mfma16(wl0, xh, acc0);
                acc1 = mfma16(wh1, xh, acc1); acc1 = mfma16(wh1, xl, acc1); acc1 = mfma16(wl1, xh, acc1);
            }
            *(f32x4*)(red + (wid * 16 + r) * 32 + 4 * g) = acc0;
            *(f32x4*)(red + (wid * 16 + r) * 32 + 16 + 4 * g) = acc1;
        }
        __syncthreads();
        {
            const int e = tid & 31, i = tid >> 5;
            float s = 0.f;
#pragma unroll
            for (int w = 0; w < 8; ++w) s += red[(w * 16 + i) * 32 + e];
            scs[i * 32 + e] = sigmoidf_(s);
        }
        __syncthreads();
        if (tid < 16) {
            const float* sc = scs + tid * 32;
            int bestg = 0; float bestv = -3.0e38f;
            for (int gi = 0; gi < 8; ++gi) {
                float m1 = -3.0e38f, m2 = -3.0e38f;
                for (int k = 0; k < 4; ++k) {
                    const float v = sc[gi * 4 + k] + p.router_b[gi * 4 + k];
                    if (v > m1) { m2 = m1; m1 = v; } else if (v > m2) { m2 = v; }
                }
                const float gs = m1 + m2;
                if (gs > bestv) { bestv = gs; bestg = gi; }
            }
            int i1 = 0; float v1 = -3.0e38f;
            for (int k = 0; k < 4; ++k) { const float v = sc[bestg * 4 + k] + p.router_b[bestg * 4 + k]; if (v > v1) { v1 = v; i1 = k; } }
            int i2 = 0; float v2 = -3.0e38f;
            for (int k = 0; k < 4; ++k) { if (k == i1) continue; const float v = sc[bestg * 4 + k] + p.router_b[bestg * 4 + k]; if (v > v2) { v2 = v; i2 = k; } }
            const int e1 = bestg * 4 + i1, e2 = bestg * 4 + i2;
            const float s1 = sc[e1], s2 = sc[e2];
            const float inv = 1.0f / (s1 + s2);
            const int t = row0 + tid;
            gate[t * 2] = s1 * inv; gate[t * 2 + 1] = s2 * inv;
            const int p1 = atomicAdd(&cnt[e1], 1);
            list[(size_t)e1 * T + p1] = t * 2;
            const int p2 = atomicAdd(&cnt[e2], 1);
            list[(size_t)e2 * T + p2] = t * 2 + 1;
        }
    }
}

DI void phase_ln2(const P& p, int layer, int bid, int nb) {
    const float* x1a = (const float*)(p.ws + WS_X1A);
    const bf16_t* yasg = (const bf16_t*)(p.ws + WS_YASG);
    float* xa = (layer == DEPTH - 1) ? p.out : (float*)(p.ws + WS_XA);
    bf16_t* xb = (bf16_t*)(p.ws + WS_XB);
    const float* lg = p.ln2_g + (size_t)layer * D;
    const float* lb = p.ln2_b + (size_t)layer * D;
    const int tid = tid_opaque(), lane = tid & 63, wid = tid >> 6;
    for (int t = bid * NWAVES + wid; t < T; t += nb * NWAVES) {
        f32x4 v[4];
        float s = 0.f;
#pragma unroll
        for (int i = 0; i < 4; ++i) {
            const int col = i * 256 + lane * 4;
            const f32x4 xv = *(const f32x4*)(x1a + (size_t)t * D + col);
            const u32x2 y0 = *(const u32x2*)(yasg + (size_t)(2 * t) * D + col);
            const u32x2 y1 = *(const u32x2*)(yasg + (size_t)(2 * t + 1) * D + col);
            f32x4 o;
            o[0] = xv[0] * ALPHA + (bflo(y0.x) + bflo(y1.x));
            o[1] = xv[1] * ALPHA + (bfhi(y0.x) + bfhi(y1.x));
            o[2] = xv[2] * ALPHA + (bflo(y0.y) + bflo(y1.y));
            o[3] = xv[3] * ALPHA + (bfhi(y0.y) + bfhi(y1.y));
            v[i] = o; s += o[0] + o[1] + o[2] + o[3];
        }
        s = wave_sum(s);
        const float mu = s * (1.0f / D);
        float q = 0.f;
#pragma unroll
        for (int i = 0; i < 4; ++i)
#pragma unroll
            for (int k = 0; k < 4; ++k) { const float d = v[i][k] - mu; q += d * d; }
        q = wave_sum(q);
        const float rstd = rsqrtf(q * (1.0f / D) + LN_EPS);
#pragma unroll
        for (int i = 0; i < 4; ++i) {
            const int col = i * 256 + lane * 4;
            const f32x4 gg = *(const f32x4*)(lg + col), bb = *(const f32x4*)(lb + col);
            const f32x4 o = (v[i] - mu) * rstd * gg + bb;
            *(f32x4*)(xa + (size_t)t * D + col) = o;
            if (layer != DEPTH - 1) { u32x2 w; w.x = cvtpk(o[0], o[1]); w.y = cvtpk(o[2], o[3]); *(u32x2*)(xb + (size_t)t * D + col) = w; }
        }
    }
}

#define XB_TMO      128
#define XB_XCNT(j)  (256  + 64 * (j))
#define XB_XSUB(j)  (1280 + 64 * (j))
#define XB_XGEN(j)  (2304 + 64 * (j))
#define XB_TOP      3328
#define XB_TOPGEN   3392
#define XCD_BAR_WORDS 3456
#define XB_SPIN_CAP (1u << 20)
DI unsigned xb_ld(unsigned* p_) { return __hip_atomic_load(p_, __ATOMIC_RELAXED, __HIP_MEMORY_SCOPE_AGENT); }
DI unsigned xb_add(unsigned* p_, unsigned v) { return __hip_atomic_fetch_add(p_, v, __ATOMIC_RELAXED, __HIP_MEMORY_SCOPE_AGENT); }
DI unsigned xb_xcc_id() { return (unsigned)__builtin_amdgcn_s_getreg((3 << 11) | 20) & 0xFu; }
#define XB_SPIN(cond, bar) do { unsigned _sp = 0; while (cond) { __builtin_amdgcn_s_sleep(1); \
    if ((++_sp & 255u) == 0u) { if (xb_ld(&(bar)[XB_TMO])) break; if (_sp > XB_SPIN_CAP) { atomicAdd(&(bar)[XB_TMO], 1u); break; } } } } while (0)
struct XcdBarrier { unsigned* bar; unsigned x; volatile LAS unsigned* st; };
DI XcdBarrier xcd_barrier_post(unsigned* bar, volatile LAS unsigned* st) {
    XcdBarrier b; b.bar = bar; b.x = xb_xcc_id(); b.st = st;
    if (threadIdx.x == 0) (void)xb_add(&bar[XB_XCNT(b.x)], 1u);
    return b;
}
DI void xcd_barrier_complete(unsigned* bar, unsigned x, unsigned& nloc, unsigned& nx) {
    const unsigned G = gridDim.x * gridDim.y * gridDim.z;
    unsigned sum, cnt, mine, sp = 0u;
    for (;;) {
        sum = 0u; cnt = 0u; mine = 0u;
#pragma unroll
        for (unsigned j = 0; j < 16; ++j) { const unsigned c = xb_ld(&bar[XB_XCNT(j)]); sum += c; cnt += (c > 0u) ? 1u : 0u; mine = (j == x) ? c : mine; }
        if (sum == G) break;
        __builtin_amdgcn_s_sleep(1);
        if ((++sp & 255u) == 0u) { if (xb_ld(&bar[XB_TMO])) break; if (sp > XB_SPIN_CAP) { atomicAdd(&bar[XB_TMO], 1u); break; } }
    }
    nloc = mine > 0u ? mine : 1u; nx = cnt > 0u ? cnt : 1u;
}
DI void xcd_barrier(const XcdBarrier& b) {
    asm volatile("s_waitcnt vmcnt(0)" ::: "memory");
    __syncthreads();
    if (threadIdx.x == 0) {
        unsigned* bar = b.bar;
        __builtin_amdgcn_s_waitcnt(0);
        unsigned nloc = b.st[0], nx = b.st[1];
        if (nloc == 0u) { xcd_barrier_complete(bar, b.x, nloc, nx); b.st[0] = nloc; b.st[1] = nx; }
        const unsigned old = xb_add(&bar[XB_XSUB(b.x)], 1u);
        const unsigned gen = old / nloc;
        if (old + 1u == (gen + 1u) * nloc) {
            __builtin_amdgcn_fence(__ATOMIC_RELEASE, "agent");
            asm volatile("s_waitcnt vmcnt(0)" ::: "memory");
            const unsigned og = xb_add(&bar[XB_TOP], 1u);
            const unsigned tg = og / nx;
            if (og + 1u == (tg + 1u) * nx) xb_add(&bar[XB_TOPGEN], 1u);
            else XB_SPIN(xb_ld(&bar[XB_TOPGEN]) == tg, bar);
            __builtin_amdgcn_fence(__ATOMIC_ACQUIRE, "agent");
            xb_add(&bar[XB_XGEN(b.x)], 1u);
            asm volatile("s_waitcnt vmcnt(0)" ::: "memory");
        } else {
            XB_SPIN(xb_ld(&bar[XB_XGEN(b.x)]) == gen, bar);
            __builtin_amdgcn_fence(__ATOMIC_ACQUIRE, "agent");
            asm volatile("s_waitcnt vmcnt(0)" ::: "memory");
        }
    }
    __syncthreads();
}

enum { PH_INPROJ = 0, PH_MIX1, PH_MIX2, PH_MIX3, PH_OUTPROJ, PH_LN1, PH_MOEUP, PH_MOEDOWN, PH_LN2, PH_PER_LAYER, PH_PREP = 100, PH_KV = 101 };

DI void run_phase(const P& p, int ph, int layer, int bid, int nb, char* smem) {
    const bool conv = (layer & 1) == 0;
    if (ph == PH_PREP) phase_prep(p, bid, nb, smem);
    if (ph == PH_KV) phase_kv(p, bid, nb, smem);
    if (ph == PH_INPROJ) phase_inproj(p, layer, bid, nb, smem);
    if (ph == PH_MIX1) phase_ml_local(p, bid, nb, smem);
    if (ph == PH_MIX2) phase_ml_scan(p, bid, nb);
    if (ph == PH_MIX3) {
        if (conv) phase_convmix(p, layer, bid, nb);
        else phase_ml_out(p, layer, bid, nb, smem);
    }
    if (ph == PH_MIX1 || (ph == PH_MIX3 && conv)) phase_xattn(p, layer, bid, nb, smem);
    if (ph == PH_OUTPROJ) phase_outproj(p, layer, bid, nb, smem);
    if (ph == PH_LN1) phase_ln1_route(p, layer, bid, nb, smem);
    if (ph == PH_MOEUP) phase_moe_up(p, layer, bid, nb, smem);
    if (ph == PH_MOEDOWN) phase_moe_down(p, layer, bid, nb, smem);
    if (ph == PH_LN2) phase_ln2(p, layer, bid, nb);
}

__global__ void __launch_bounds__(NTHREADS, 2) mega(P p) {
    __shared__ __attribute__((aligned(16))) char smem[SMEM_BYTES];
    const int bid = blockIdx.x, nb = gridDim.x;
    volatile LAS unsigned* st = (volatile LAS unsigned*)(smem + SMEM_BYTES - 16);
    if (threadIdx.x == 0) { st[0] = 0u; st[1] = 0u; }
    __syncthreads();
    XcdBarrier xb = xcd_barrier_post((unsigned*)(p.ws + WS_CTL), st);
#pragma unroll 1
    for (int s = -2; s < DEPTH * PH_PER_LAYER; ++s) {
        int ph = (s == -2) ? (int)PH_PREP : (s == -1) ? (int)PH_KV : s % PH_PER_LAYER;
        int layer = (s < 0) ? 0 : s / PH_PER_LAYER;
        if ((layer & 1) == 0 && (ph == PH_MIX1 || ph == PH_MIX2)) continue;
        asm volatile("" : "+s"(ph), "+s"(layer));
        P q = p;
        asm volatile("" : "+s"(q.ws));
        run_phase(q, ph, layer, bid, nb, smem);
#ifdef PROBE_MASK
        if (ph < 31 && ((PROBE_MASK >> ph) & 1)) { __syncthreads(); run_phase(q, ph, layer, bid, nb, smem); }
#endif
        if (ph != PH_KV) xcd_barrier(xb);
    }
}

extern "C" void kernel_launch(void* const* d_in, const int* in_sizes, int n_in, void* d_out, int out_size, void* d_ws, size_t ws_size,
                              hipStream_t stream) {
    if (ws_size < WS_TOTAL) { fprintf(stderr, "kernel_launch: workspace too small: %zu < %zu\n", ws_size, (size_t)WS_TOTAL); return; }
    static int grid_blocks = 0;
    if (!grid_blocks) {
        int dev = 0, cus = 0, per_cu = 0;
        (void)hipGetDevice(&dev);
        (void)hipDeviceGetAttribute(&cus, hipDeviceAttributeMultiprocessorCount, dev);
        if (hipOccupancyMaxActiveBlocksPerMultiprocessor(&per_cu, (const void*)mega, NTHREADS, 0) != hipSuccess) per_cu = 0;
        if (per_cu < 1 || cus < 1) { fprintf(stderr, "kernel_launch: occupancy query failed (per_cu=%d cus=%d)\n", per_cu, cus); return; }
        grid_blocks = cus;
    }
    P p{};
    p.x = (const float*)d_in[0]; p.mem = (const float*)d_in[1]; p.conv_w_in = (const float*)d_in[2]; p.conv_w = (const float*)d_in[3];
    p.ml_w_in = (const float*)d_in[4]; p.ml_gate_b = (const float*)d_in[5]; p.ml_norm_g = (const float*)d_in[6]; p.w_kv = (const float*)d_in[7];
    p.w_out = (const float*)d_in[8]; p.ln1_g = (const float*)d_in[9]; p.ln1_b = (const float*)d_in[10]; p.ln2_g = (const float*)d_in[11];
    p.ln2_b = (const float*)d_in[12]; p.router_w = (const float*)d_in[13]; p.router_b = (const float*)d_in[14]; p.w_gate = (const float*)d_in[15];
    p.w_up = (const float*)d_in[16]; p.w_down = (const float*)d_in[17];
    p.out = (float*)d_out; p.ws = (char*)d_ws;
    (void)hipMemsetAsync((char*)d_ws + WS_CTL, 0, CTL_BYTES, stream);
    void* args[] = {&p};
    hipError_t e = hipLaunchCooperativeKernel((const void*)mega, dim3(grid_blocks), dim3(NTHREADS), args, 0, stream);
    if (e != hipSuccess) fprintf(stderr, "kernel_launch: cooperative launch failed: %s (grid %d)\n", hipGetErrorString(e), grid_blocks);
}
```

```cpp
#include <hip/hip_runtime.h>
#include <stdint.h>
#include <stdio.h>

typedef unsigned short bf16_t;
typedef __attribute__((ext_vector_type(8))) short bf16x8;
typedef __attribute__((ext_vector_type(4))) float f32x4;
typedef __attribute__((ext_vector_type(4))) unsigned u32x4;
typedef __attribute__((ext_vector_type(2))) unsigned u32x2;

#define DI __device__ __forceinline__
#define LAS __attribute__((address_space(3)))

constexpr int D = 1024;
constexpr int NBATCH = 8;
constexpr int SEQ = 2048;
constexpr int T = NBATCH * SEQ;
constexpr int DEPTH = 4;
constexpr int MIXW = 768;
constexpr int XH = 4, XDH = 64, XW = 256, MEML = 256;
constexpr int MLH = 6, MLDH = 128, CHUNK = 128, NCH = SEQ / CHUNK;
constexpr int DIN_CONV = 2560, DIN_ML = 3340, LDP_ML = 3328, NV_ML = 3584;
constexpr int NE = 32, DFF = 512;
constexpr float ALPHA = 1.681792830507429f;
constexpr float LN_EPS = 1e-5f;

constexpr int NTHREADS = 512;
constexpr int NWAVES = 8;
constexpr int STAGE_BYTES = 131072;
constexpr int META_OFF = STAGE_BYTES;
constexpr int SMEM_BYTES = STAGE_BYTES + 4096;

constexpr size_t al256(size_t x) { return (x + 255) & ~(size_t)255; }
constexpr size_t WS_CTL   = 0;
constexpr size_t CTL_BYTES = 64 * 1024;
constexpr size_t CTL_CNT  = 32 * 1024;
constexpr int CNT_STRIDE = 64;
constexpr size_t WS_XB    = WS_CTL + CTL_BYTES;
constexpr size_t WS_MEMB  = WS_XB + (size_t)T * D * 2;
constexpr size_t WS_KBUF  = WS_MEMB + (size_t)NBATCH * MEML * D * 2;
constexpr size_t WS_VT    = WS_KBUF + (size_t)DEPTH * NBATCH * MEML * XW * 2;
constexpr size_t WS_PROJ  = WS_VT + (size_t)DEPTH * NBATCH * MEML * XW * 2;
constexpr size_t WS_Z     = WS_PROJ;
constexpr size_t WS_LOGI  = WS_PROJ + (size_t)T * LDP_ML * 2;
constexpr size_t WS_LOGF  = WS_LOGI + (size_t)NBATCH * MLH * SEQ * 4;
constexpr size_t WS_CT    = WS_LOGF + (size_t)NBATCH * MLH * SEQ * 4;
constexpr size_t WS_CPB   = WS_CT + (size_t)48 * NCH * 128 * 128 * 4;
constexpr size_t WS_NLOC  = WS_CPB + (size_t)48 * NCH * 128 * 128 * 2;
constexpr size_t WS_NPREV = WS_NLOC + (size_t)48 * NCH * 128 * 4;
constexpr size_t WS_MLOC  = WS_NPREV + (size_t)48 * NCH * 128 * 4;
constexpr size_t WS_GSUM  = WS_MLOC + al256(48 * NCH * 4);
constexpr size_t WS_MPREV = WS_GSUM + al256(48 * NCH * 4);
constexpr size_t WS_HCAT  = WS_MPREV + al256(48 * NCH * 4);
constexpr size_t WS_X1B   = WS_HCAT + (size_t)T * D * 2;
constexpr size_t WS_GATE  = WS_X1B + (size_t)T * D * 2;
constexpr size_t WS_LIST  = WS_GATE + (size_t)T * 2 * 4;
constexpr size_t WS_HBUF  = WS_LIST + (size_t)NE * T * 4;
constexpr size_t WS_YASG  = WS_HBUF + (size_t)T * 2 * DFF * 2;
constexpr size_t WS_WIN   = WS_YASG + (size_t)T * 2 * D * 2;
constexpr size_t WS_WKV   = WS_WIN + ((size_t)2 * DIN_CONV + (size_t)2 * NV_ML) * D * 2;
constexpr size_t WS_WOUT  = WS_WKV + (size_t)DEPTH * 512 * D * 2;
constexpr size_t WS_WGU   = WS_WOUT + (size_t)DEPTH * D * D * 2;
constexpr size_t WS_WD    = WS_WGU + (size_t)DEPTH * NE * 1024 * D * 2;
constexpr size_t WS_RWT   = WS_WD + (size_t)DEPTH * NE * D * DFF * 2;
constexpr size_t WS_TOTAL = WS_RWT + (size_t)2 * NE * D * 2;

struct P {
    const float *x, *mem, *conv_w_in, *conv_w, *ml_w_in, *ml_gate_b, *ml_norm_g, *w_kv, *w_out;
    const float *ln1_g, *ln1_b, *ln2_g, *ln2_b, *router_w, *router_b, *w_gate, *w_up, *w_down;
    float* out;
    char* ws;
};

DI unsigned cvtpk(float lo, float hi) { unsigned r; asm("v_cvt_pk_bf16_f32 %0, %1, %2" : "=v"(r) : "v"(lo), "v"(hi)); return r; }
DI float bf2f(bf16_t v) { return __uint_as_float(((unsigned)v) << 16); }
DI float bflo(unsigned v) { return __uint_as_float(v << 16); }
DI float bfhi(unsigned v) { return __uint_as_float(v & 0xffff0000u); }
DI bf16_t f2bf(float f) { return (bf16_t)(cvtpk(f, f) & 0xffffu); }
DI float sigmoidf_(float x) { return 1.0f / (1.0f + __expf(-x)); }
DI float logsigmoidf_(float x) { return fminf(x, 0.0f) - log1pf(__expf(-fabsf(x))); }
DI float xor_add(float v, int m) { return v + __shfl_xor(v, m, 64); }
DI float xor_max(float v, int m) { return fmaxf(v, __shfl_xor(v, m, 64)); }
DI float wave_sum(float v) { v = xor_add(v, 32); v = xor_add(v, 16); v = xor_add(v, 8); v = xor_add(v, 4); v = xor_add(v, 2); v = xor_add(v, 1); return v; }
DI int tid_opaque() { int t = threadIdx.x; asm volatile("" : "+v"(t)); return t; }
DI f32x4 mfma16(bf16x8 a, bf16x8 b, f32x4 c) { return __builtin_amdgcn_mfma_f32_16x16x32_bf16(a, b, c, 0, 0, 0); }

namespace g8 {
constexpr int BM = 256, BK = 64, HALF = 128, HTB = HALF * BK * 2, NXCD = 8, WGM = 8;
DI int lds_byte(int r, int c) { const int st = (r >> 4) * 2 + (c >> 5), rr = r & 15, cc = c & 31, ob = rr * 64 + cc * 2; return st * 1024 + (ob ^ (((ob >> 9) & 1) << 5)); }
DI void stage_rc(int b, int& R, int& C) { const int st = b / 1024, sb = b % 1024, swz = sb ^ (((sb >> 9) & 1) << 5); R = (st >> 1) * 16 + swz / 64; C = (st & 1) * 32 + (swz % 64) / 2; }
DI int perm32(int rho) { const int n = rho >> 4, i = rho & 15; return 8 * (i >> 2) + 4 * n + (i & 3); }
DI int xcd_remap(int L, int n) { const int q = n / NXCD, r = n % NXCD, xcd = L % NXCD, off = L / NXCD; return (xcd < r ? xcd * (q + 1) : r * (q + 1) + (xcd - r) * q) + off; }

struct Unit { int pm, pn, e, valid, rbase; };
DI const char* uni(const char* p_) {
    const unsigned long long v = (unsigned long long)p_;
    const unsigned lo = (unsigned)__builtin_amdgcn_readfirstlane((int)(unsigned)v), hi = (unsigned)__builtin_amdgcn_readfirstlane((int)(unsigned)(v >> 32));
    return (const char*)(((unsigned long long)hi << 32) | lo);
}

template <bool GATHER, class Epi, class Sched>
DI void gemm_phase(LAS unsigned char* lds, const int K, const Sched& S, const Epi& E) {
    const int tid = tid_opaque(), wid = __builtin_amdgcn_readfirstlane(tid >> 6), lane = tid & 63, wr = wid >> 2, wc = wid & 3, fr = lane & 15, fq = lane >> 4;
    const int nt = K / BK;
    const size_t kstep = (size_t)(BK * 2);
    const size_t hstep = (size_t)HALF * K * 2;
    unsigned vB0, vB1;
    {
        int R0, C0, R1, C1;
        stage_rc(tid * 16, R0, C0); stage_rc(tid * 16 + 8192, R1, C1);
        const int Rb0 = Epi::PERM ? ((R0 & ~31) + perm32(R0 & 31)) : R0, Rb1 = Epi::PERM ? ((R1 & ~31) + perm32(R1 & 31)) : R1;
        vB0 = (unsigned)(Rb0 * K + C0) * 2u; vB1 = (unsigned)(Rb1 * K + C1) * 2u;
    }
    const unsigned ldsw = (unsigned)wid * 1024u;
    const int aoff = lds_byte(wr * 64 + fr, fq * 8), boff = lds_byte(wc * 32 + fr, fq * 8);
#define G8_SA(b, h) (((b) * 2 + (h)) * HTB)
#define G8_SB(b, h) ((4 + (b) * 2 + (h)) * HTB)
#define G8_STAGE(bufoff, gbase, v0, v1) do { unsigned _o0 = (v0), _o1 = (v1); asm volatile("" : "+v"(_o0), "+v"(_o1));     \
        __builtin_amdgcn_global_load_lds((const unsigned*)((const char*)(gbase) + _o0), (LAS unsigned*)(lds + (bufoff) + ldsw), 16, 0, 0); \
        __builtin_amdgcn_global_load_lds((const unsigned*)((const char*)(gbase) + _o1), (LAS unsigned*)(lds + (bufoff) + ldsw + 8192), 16, 0, 0); } while (0)
#define G8_LDA(dst, b, h) do { _Pragma("unroll") for (int m = 0; m < 4; ++m) _Pragma("unroll") for (int k = 0; k < 2; ++k) dst[m][k] = *(const LAS bf16x8*)(lds + G8_SA(b, h) + aoff + m * 2048 + k * 1024); } while (0)
#define G8_LDB(dst, b, h) do { _Pragma("unroll") for (int n = 0; n < 2; ++n) _Pragma("unroll") for (int k = 0; k < 2; ++k) dst[n][k] = *(const LAS bf16x8*)(lds + G8_SB(b, h) + boff + n * 2048 + k * 1024); } while (0)
#define G8_MMA(ai, bj, At, Bt) do { __builtin_amdgcn_s_setprio(1); _Pragma("unroll") for (int m = 0; m < 4; ++m) _Pragma("unroll") for (int n = 0; n < 2; ++n) _Pragma("unroll") for (int k = 0; k < 2; ++k) \
        acc[ai][bj][m][n] = __builtin_amdgcn_mfma_f32_16x16x32_bf16(Bt[n][k], At[m][k], acc[ai][bj][m][n], 0, 0, 0); __builtin_amdgcn_s_setprio(0); } while (0)
#define G8_WAIT_V(n) asm volatile("s_waitcnt vmcnt(" #n ")" ::: "memory")
#define G8_WAIT_L(n) asm volatile("s_waitcnt lgkmcnt(" #n ")" ::: "memory")
#define G8_BAR __builtin_amdgcn_s_barrier()
#define G8_SCHED __builtin_amdgcn_sched_barrier(0)
    Unit cur, nxt;
    int ui = 0;
    if (!S.next(0, cur)) return;
    f32x4 acc[2][2][4][2];
#pragma unroll
    for (int a = 0; a < 2; ++a)
#pragma unroll
        for (int b = 0; b < 2; ++b)
#pragma unroll
            for (int m = 0; m < 4; ++m)
#pragma unroll
                for (int n = 0; n < 2; ++n) acc[a][b][m][n] = (f32x4){0.f, 0.f, 0.f, 0.f};
    bf16x8 At[4][2], B0[2][2], B1[2][2];
    const char* cA = S.a_base(cur);
    const char* cB = S.b_base(cur);
    unsigned cv00, cv01, cv10, cv11, nv00, nv01, nv10, nv11;
    {
        int R0, C0, R1, C1;
        stage_rc(tid * 16, R0, C0); stage_rc(tid * 16 + 8192, R1, C1);
        int rows[2][2];
        S.a_rows(cur, R0, R1, rows);
        cv00 = (unsigned)(rows[0][0] * K + C0) * 2u; cv01 = (unsigned)(rows[0][1] * K + C1) * 2u;
        cv10 = (unsigned)(rows[1][0] * K + C0) * 2u; cv11 = (unsigned)(rows[1][1] * K + C1) * 2u;
        nv00 = cv00; nv01 = cv01; nv10 = cv10; nv11 = cv11;
    }
    G8_STAGE(G8_SB(0, 0), uni(cB), vB0, vB1); G8_STAGE(G8_SA(0, 0), uni(cA), cv00, cv01); G8_STAGE(G8_SB(0, 1), uni(cB + hstep), vB0, vB1); G8_STAGE(G8_SA(0, 1), uni(cA), cv10, cv11);
    if (wr == 1) G8_BAR;
    G8_WAIT_V(4); G8_BAR;
    G8_STAGE(G8_SB(1, 0), uni(cB + kstep), vB0, vB1); G8_STAGE(G8_SA(1, 0), uni(cA + kstep), cv00, cv01); G8_STAGE(G8_SB(1, 1), uni(cB + hstep + kstep), vB0, vB1);
    G8_WAIT_V(6); G8_BAR;
    for (;;) {
        const bool has_next = S.next(ui + 1, nxt);
        const char* nA = has_next ? S.a_base(nxt) : cA;
        const char* nB = has_next ? S.b_base(nxt) : cB;
        if (GATHER) {
            if (has_next) {
                const int tid2 = tid_opaque();
                int R0, C0, R1, C1;
                stage_rc(tid2 * 16, R0, C0); stage_rc(tid2 * 16 + 8192, R1, C1);
                int rows[2][2];
                S.a_rows(nxt, R0, R1, rows);
                nv00 = (unsigned)(rows[0][0] * K + C0) * 2u; nv01 = (unsigned)(rows[0][1] * K + C1) * 2u;
                nv10 = (unsigned)(rows[1][0] * K + C0) * 2u; nv11 = (unsigned)(rows[1][1] * K + C1) * 2u;
            } else { nv00 = cv00; nv01 = cv01; nv10 = cv10; nv11 = cv11; }
        }
        for (int t = 0; t < nt; t += 2) {
            const bool last = (t == nt - 2);
            const char* a1 = uni(cA + (size_t)(t + 1) * kstep);
            const char* a2 = uni(last ? nA : cA + (size_t)(t + 2) * kstep);
            const char* b2 = uni(last ? nB : cB + (size_t)(t + 2) * kstep);
            const char* a3 = uni(a2 + kstep);
            const char* b3 = uni(b2 + kstep);
            const char* b2h = uni(b2 + hstep);
            const char* b3h = uni(b3 + hstep);
            unsigned x00 = cv00, x01 = cv01, x10 = cv10, x11 = cv11;
            if (GATHER) { x00 = last ? nv00 : cv00; x01 = last ? nv01 : cv01; x10 = last ? nv10 : cv10; x11 = last ? nv11 : cv11; }
            G8_LDB(B0, 0, 0); G8_SCHED; G8_LDA(At, 0, 0); G8_STAGE(G8_SA(1, 1), a1, cv10, cv11);
            G8_WAIT_L(8); G8_BAR; G8_WAIT_L(0); G8_MMA(0, 0, At, B0); G8_BAR; G8_SCHED;
            G8_LDB(B1, 0, 1); G8_STAGE(G8_SB(0, 0), b2, vB0, vB1);
            G8_BAR; G8_WAIT_L(0); G8_MMA(0, 1, At, B1); G8_BAR;
            G8_LDA(At, 0, 1); G8_STAGE(G8_SA(0, 0), a2, x00, x01);
            G8_BAR; G8_WAIT_L(0); G8_MMA(1, 0, At, B0); G8_BAR; G8_SCHED;
            G8_STAGE(G8_SB(0, 1), b2h, vB0, vB1);
            G8_WAIT_V(6); G8_BAR; G8_MMA(1, 1, At, B1); G8_BAR;
            G8_LDB(B0, 1, 0); G8_SCHED; G8_LDA(At, 1, 0); G8_STAGE(G8_SA(0, 1), a2, x10, x11);
            G8_WAIT_L(8); G8_BAR; G8_WAIT_L(0); G8_MMA(0, 0, At, B0); G8_BAR; G8_SCHED;
            G8_LDB(B1, 1, 1); G8_STAGE(G8_SB(1, 0), b3, vB0, vB1);
            G8_BAR; G8_WAIT_L(0); G8_MMA(0, 1, At, B1); G8_BAR;
            G8_LDA(At, 1, 1); G8_STAGE(G8_SA(1, 0), a3, x00, x01);
            G8_BAR; G8_WAIT_L(0); G8_MMA(1, 0, At, B0); G8_BAR; G8_SCHED;
            G8_STAGE(G8_SB(1, 1), b3h, vB0, vB1);
            G8_WAIT_V(6); G8_BAR; G8_MMA(1, 1, At, B1); G8_BAR;
        }
        E(acc, cur, wr, wc, fr, fq);
        if (!has_next) break;
#pragma unroll
        for (int a = 0; a < 2; ++a)
#pragma unroll
            for (int b = 0; b < 2; ++b)
#pragma unroll
                for (int m = 0; m < 4; ++m)
#pragma unroll
                    for (int n = 0; n < 2; ++n) acc[a][b][m][n] = (f32x4){0.f, 0.f, 0.f, 0.f};
        cur = nxt; cA = nA; cB = nB; ++ui;
        if (GATHER) { cv00 = nv00; cv01 = nv01; cv10 = nv10; cv11 = nv11; }
    }
    G8_WAIT_V(0);
    if (wr == 0) G8_BAR;
    G8_BAR;
#undef G8_SA
#undef G8_SB
#undef G8_STAGE
#undef G8_LDA
#undef G8_LDB
#undef G8_MMA
#undef G8_WAIT_V
#undef G8_WAIT_L
#undef G8_BAR
#undef G8_SCHED
}

struct DenseSched {
    const char* A; const char* Bt; int K, nM, nN, nwg, G, c;
    DI void init(const void* A_, const void* Bt_, int M, int N, int K_, int G_, int c_) { A = (const char*)A_; Bt = (const char*)Bt_; K = K_; nM = M / BM; nN = N / BM; nwg = nM * nN; G = G_; c = c_; }
    DI bool next(int i, Unit& u) const {
        const int L = i * G + c;
        if (L >= nwg) return false;
        const int wgid = xcd_remap(L, nwg);
        const int nig = WGM * nN, gid = wgid / nig, fm = gid * WGM, gsz = (nM - fm) < WGM ? (nM - fm) : WGM;
        u.pm = fm + ((wgid % nig) % gsz); u.pn = (wgid % nig) / gsz; u.e = 0; u.valid = 256; u.rbase = 0;
        return true;
    }
    DI const char* a_base(const Unit& u) const { return A + (size_t)u.pm * 256 * K * 2; }
    DI const char* b_base(const Unit& u) const { return Bt + (size_t)u.pn * 256 * K * 2; }
    DI void a_rows(const Unit&, int R0, int R1, int (&rows)[2][2]) const { rows[0][0] = R0; rows[0][1] = R1; rows[1][0] = 128 + R0; rows[1][1] = 128 + R1; }
};
}

template <class ColPtr>
DI void transpose_tile(ColPtr colptr, int ld, int k0, int v0, bf16_t* dst, int K, float* tile, int tid) {
    constexpr int TS = 129;
    __syncthreads();
#pragma unroll
    for (int i = 0; i < 4; ++i) {
        const int idx = tid + NTHREADS * i;
        const int kr = idx >> 5, c4 = idx & 31;
        float sc;
        const float* src = colptr(v0 + 4 * c4, sc);
        f32x4 v = (f32x4){0.f, 0.f, 0.f, 0.f};
        if (src) v = *(const f32x4*)(src + (size_t)(k0 + kr) * ld);
        float* tp = tile + kr * TS + 4 * c4;
        tp[0] = v[0] * sc; tp[1] = v[1] * sc; tp[2] = v[2] * sc; tp[3] = v[3] * sc;
    }
    __syncthreads();
#pragma unroll
    for (int i = 0; i < 2; ++i) {
        const int ch = tid + NTHREADS * i;
        const int vr = ch >> 3, kc = ch & 7;
        const float* tp = tile + (kc * 8) * TS + vr;
        u32x4 w;
        w.x = cvtpk(tp[0], tp[TS]); w.y = cvtpk(tp[2 * TS], tp[3 * TS]); w.z = cvtpk(tp[4 * TS], tp[5 * TS]); w.w = cvtpk(tp[6 * TS], tp[7 * TS]);
        *(u32x4*)(dst + (size_t)(v0 + vr) * K + k0 + kc * 8) = w;
    }
}

DI void phase_prep(const P& p, int bid, int nb, char* smem) {
    const int tid = tid_opaque();
    bf16_t* xb = (bf16_t*)(p.ws + WS_XB);
    bf16_t* memb = (bf16_t*)(p.ws + WS_MEMB);
    {
        const size_t nx = (size_t)T * D / 4, nm = (size_t)NBATCH * MEML * D / 4;
        for (size_t i = (size_t)bid * NTHREADS + tid; i < nx + nm; i += (size_t)nb * NTHREADS) {
            if (i < nx) { f32x4 v = ((const f32x4*)p.x)[i]; u32x2 w; w.x = cvtpk(v[0], v[1]); w.y = cvtpk(v[2], v[3]); ((u32x2*)xb)[i] = w; }
            else { size_t j = i - nx; f32x4 v = ((const f32x4*)p.mem)[j]; u32x2 w; w.x = cvtpk(v[0], v[1]); w.y = cvtpk(v[2], v[3]); ((u32x2*)memb)[j] = w; }
        }
    }
    {
        bf16_t* rwt = (bf16_t*)(p.ws + WS_RWT);
        for (int i = bid * NTHREADS + tid; i < NE * D; i += nb * NTHREADS) {
            const int e = i >> 10, d = i & 1023;
            const float w = p.router_w[(size_t)d * NE + e];
            const bf16_t hi = f2bf(w);
            rwt[i] = hi; rwt[NE * D + i] = f2bf(w - bf2f(hi));
        }
    }
    float* tile = (float*)smem;
    constexpr int T_CONV = 16 * 20, T_ML = 16 * 28, T_KV = 16 * 4, T_OUT = 16 * 8, T_GU = 16 * 8, T_D = 8 * 8;
    constexpr int N0 = 2 * T_CONV, N1 = N0 + 2 * T_ML, N2 = N1 + 4 * T_KV, N3 = N2 + 4 * T_OUT, N4 = N3 + DEPTH * NE * T_GU, N5 = N4 + DEPTH * NE * T_D;
    for (int it = bid; it < N5; it += nb) {
        if (it < N0) {
            const int j = it / T_CONV, q = it % T_CONV, kt = q / 20, vt = q % 20;
            const float* W = p.conv_w_in + (size_t)j * D * DIN_CONV;
            transpose_tile([&](int v4, float& sc) { sc = 1.0f; return W + v4; }, DIN_CONV, kt * 64, vt * 128,
                           (bf16_t*)(p.ws + WS_WIN) + (size_t)j * DIN_CONV * D, D, tile, tid);
        } else if (it < N1) {
            const int r = it - N0, j = r / T_ML, q = r % T_ML, kt = q / 28, vt = q % 28;
            const float* W = p.ml_w_in + (size_t)j * D * DIN_ML;
            transpose_tile([&](int v4, float& sc) -> const float* {
                               sc = (v4 >= MIXW && v4 < 2 * MIXW) ? 0.08838834764831845f : 1.0f;
                               if (v4 < 3072) return W + v4;
                               if (v4 < 3328) return W + 3084 + (v4 - 3072);
                               if (v4 < 3340) return W + 3072 + (v4 - 3328);
                               return nullptr; },
                           DIN_ML, kt * 64, vt * 128, (bf16_t*)(p.ws + WS_WIN) + ((size_t)2 * DIN_CONV + (size_t)j * NV_ML) * D, D, tile, tid);
        } else if (it < N2) {
            const int r = it - N1, l = r / T_KV, q = r % T_KV, kt = q / 4, vt = q % 4;
            const float* W = p.w_kv + (size_t)l * D * 512;
            transpose_tile([&](int v4, float& sc) { sc = 1.0f; return W + v4; }, 512, kt * 64, vt * 128, (bf16_t*)(p.ws + WS_WKV) + (size_t)l * 512 * D, D, tile, tid);
        } else if (it < N3) {
            const int r = it - N2, l = r / T_OUT, q = r % T_OUT, kt = q / 8, vt = q % 8;
            const float* W = p.w_out + (size_t)l * D * D;
            transpose_tile([&](int v4, float& sc) { sc = 1.0f; return W + v4; }, D, kt * 64, vt * 128, (bf16_t*)(p.ws + WS_WOUT) + (size_t)l * D * D, D, tile, tid);
        } else if (it < N4) {
            const int r = it - N3, le = r / T_GU, q = r % T_GU, kt = q / 8, vt = q % 8;
            const float* Wg = p.w_gate + (size_t)le * D * DFF;
            const float* Wu = p.w_up + (size_t)le * D * DFF;
            transpose_tile([&](int v4, float& sc) { sc = 1.0f; const int grp = v4 >> 7; return ((grp & 1) ? Wu : Wg) + (grp >> 1) * 128 + (v4 & 127); },
                           DFF, kt * 64, vt * 128, (bf16_t*)(p.ws + WS_WGU) + (size_t)le * 1024 * D, D, tile, tid);
        } else {
            const int r = it - N4, le = r / T_D, q = r % T_D, kt = q / 8, vt = q % 8;
            const float* W = p.w_down + (size_t)le * DFF * D;
            transpose_tile([&](int v4, float& sc) { sc = 1.0f; return W + v4; }, D, kt * 64, vt * 128, (bf16_t*)(p.ws + WS_WD) + (size_t)le * D * DFF, DFF, tile, tid);
        }
    }
}

DI void store8_bf16(bf16_t* p8, const f32x4& v0, const f32x4& v1) {
    u32x4 w; w.x = cvtpk(v0[0], v0[1]); w.y = cvtpk(v0[2], v0[3]); w.z = cvtpk(v1[0], v1[1]); w.w = cvtpk(v1[2], v1[3]);
    *(u32x4*)p8 = w;
}

struct EpiTileBf16 {
    static constexpr bool PERM = true;
    bf16_t* O; int ldc; size_t pm_stride, pn_stride;
    DI void operator()(const f32x4 (&acc)[2][2][4][2], const g8::Unit& u, int wr, int wc, int fr, int fq) const {
        bf16_t* base = O + (size_t)u.pm * pm_stride + (size_t)u.pn * pn_stride + (size_t)(wr * 64 + fr) * ldc + wc * 32 + 8 * fq;
#pragma unroll
        for (int ai = 0; ai < 2; ++ai)
#pragma unroll
            for (int m = 0; m < 4; ++m)
                {
#pragma unroll
                    for (int bj = 0; bj < 2; ++bj) store8_bf16(base + (size_t)(ai * 128 + m * 16) * ldc + bj * 128, acc[ai][bj][m][0], acc[ai][bj][m][1]); __builtin_amdgcn_sched_barrier(0); }
    }
};

struct KSched {
    const char* memb; const char* wkv; int G, c;
    DI bool next(int i, g8::Unit& u) const { const int L = i * G + c; if (L >= 32) return false; u.pm = L & 7; u.pn = L >> 3; u.e = 0; u.valid = 256; u.rbase = 0; return true; }
    DI const char* a_base(const g8::Unit& u) const { return memb + (size_t)u.pm * 256 * D * 2; }
    DI const char* b_base(const g8::Unit& u) const { return wkv + (size_t)u.pn * 512 * D * 2; }
    DI void a_rows(const g8::Unit&, int R0, int R1, int (&rows)[2][2]) const { rows[0][0] = R0; rows[0][1] = R1; rows[1][0] = 128 + R0; rows[1][1] = 128 + R1; }
};
struct VSched {
    const char* memb; const char* wkv; int G, c;
    DI bool next(int i, g8::Unit& u) const { const int L = i * G + c - 32; if (L < 0 || L >= 32) return false; u.pm = L >> 3; u.pn = L & 7; u.e = 0; u.valid = 256; u.rbase = 0; return true; }
    DI const char* a_base(const g8::Unit& u) const { return wkv + ((size_t)u.pm * 512 + 256) * D * 2; }
    DI const char* b_base(const g8::Unit& u) const { return memb + (size_t)u.pn * 256 * D * 2; }
    DI void a_rows(const g8::Unit&, int R0, int R1, int (&rows)[2][2]) const { rows[0][0] = R0; rows[0][1] = R1; rows[1][0] = 128 + R0; rows[1][1] = 128 + R1; }
};
DI void phase_kv(const P& p, int bid, int nb, char* smem) {
    const char* memb = p.ws + WS_MEMB;
    const char* wkv = p.ws + WS_WKV;
    {
        KSched S{memb, wkv, nb, bid};
        EpiTileBf16 E{(bf16_t*)(p.ws + WS_KBUF), 256, (size_t)256 * 256, (size_t)2048 * 256};
        g8::gemm_phase<false>((LAS unsigned char*)smem, D, S, E);
    }
    {
        VSched S{memb, wkv, nb, bid};
        EpiTileBf16 E{(bf16_t*)(p.ws + WS_VT), 256, (size_t)8 * 256 * 256, (size_t)256 * 256};
        g8::gemm_phase<false>((LAS unsigned char*)smem, D, S, E);
    }
}

struct EpiInproj {
    static constexpr bool PERM = true;
    bf16_t* projb; int ldp; int gate_pn; const float* gate_b; float* logi; float* logf;
    DI void operator()(const f32x4 (&acc)[2][2][4][2], const g8::Unit& u, int wr, int wc, int fr, int fq) const {
        if (u.pn != gate_pn) {
            bf16_t* base = projb + (size_t)(u.pm * 256 + wr * 64 + fr) * ldp + u.pn * 256 + wc * 32 + 8 * fq;
#pragma unroll
            for (int ai = 0; ai < 2; ++ai)
#pragma unroll
                for (int m = 0; m < 4; ++m)
                    {
#pragma unroll
                        for (int bj = 0; bj < 2; ++bj) store8_bf16(base + (size_t)(ai * 128 + m * 16) * ldp + bj * 128, acc[ai][bj][m][0], acc[ai][bj][m][1]); __builtin_amdgcn_sched_barrier(0); }
        } else if (wc == 0 && fq < 2) {
#pragma unroll
            for (int ai = 0; ai < 2; ++ai)
#pragma unroll
                for (int m = 0; m < 4; ++m) {
                    const int t = u.pm * 256 + ai * 128 + wr * 64 + m * 16 + fr;
                    const int b = t >> 11, s = t & 2047;
#pragma unroll
                    for (int n = 0; n < 2; ++n)
#pragma unroll
                        for (int i = 0; i < 4; ++i) {
                            const int col = 8 * fq + 4 * n + i;
                            if (col < 12) {
                                const float val = acc[ai][0][m][n][i] + gate_b[col];
                                if (col < 6) logi[(size_t)(b * 6 + col) * SEQ + s] = val;
                                else logf[(size_t)(b * 6 + col - 6) * SEQ + s] = logsigmoidf_(val);
                            }
                        }
                    __builtin_amdgcn_sched_barrier(0);
                }
        }
    }
};
DI void phase_inproj(const P& p, int layer, int bid, int nb, char* smem) {
    const bool conv = (layer & 1) == 0;
    const int j = layer >> 1;
    const bf16_t* W = (const bf16_t*)(p.ws + WS_WIN) + (conv ? (size_t)j * DIN_CONV * D : ((size_t)2 * DIN_CONV + (size_t)j * NV_ML) * D);
    g8::DenseSched S; S.init(p.ws + WS_XB, W, T, conv ? DIN_CONV : NV_ML, D, nb, bid);
    EpiInproj E{(bf16_t*)(p.ws + WS_PROJ), conv ? DIN_CONV : LDP_ML, conv ? -1 : 13, p.ml_gate_b + j * 12, (float*)(p.ws + WS_LOGI), (float*)(p.ws + WS_LOGF)};
    g8::gemm_phase<false>((LAS unsigned char*)smem, D, S, E);
}

struct EpiOutproj {
    static constexpr bool PERM = true;
    const bf16_t* xres; bf16_t* z;
    DI void operator()(const f32x4 (&acc)[2][2][4][2], const g8::Unit& u, int wr, int wc, int fr, int fq) const {
        const size_t off0 = (size_t)(u.pm * 256 + wr * 64 + fr) * D + u.pn * 256 + wc * 32 + 8 * fq;
#pragma unroll
        for (int ai = 0; ai < 2; ++ai)
#pragma unroll
            for (int m = 0; m < 4; ++m) {
#pragma unroll
                for (int bj = 0; bj < 2; ++bj) {
                    const size_t off = off0 + (size_t)(ai * 128 + m * 16) * D + bj * 128;
                    const u32x4 xr = *(const u32x4*)(xres + off);
                    f32x4 v0 = acc[ai][bj][m][0], v1 = acc[ai][bj][m][1];
                    v0[0] += ALPHA * bflo(xr.x); v0[1] += ALPHA * bfhi(xr.x); v0[2] += ALPHA * bflo(xr.y); v0[3] += ALPHA * bfhi(xr.y);
                    v1[0] += ALPHA * bflo(xr.z); v1[1] += ALPHA * bfhi(xr.z); v1[2] += ALPHA * bflo(xr.w); v1[3] += ALPHA * bfhi(xr.w);
                    store8_bf16(z + off, v0, v1);
                }
                __builtin_amdgcn_sched_barrier(0);
            }
    }
};
DI void phase_outproj(const P& p, int layer, int bid, int nb, char* smem) {
    g8::DenseSched S; S.init(p.ws + WS_HCAT, (const bf16_t*)(p.ws + WS_WOUT) + (size_t)layer * D * D, T, D, D, nb, bid);
    EpiOutproj E{(const bf16_t*)(p.ws + WS_XB), (bf16_t*)(p.ws + WS_Z)};
    g8::gemm_phase<false>((LAS unsigned char*)smem, D, S, E);
}

DI void moe_meta(const int* cnt, int* meta) {
    __syncthreads();
    const int t = threadIdx.x;
    if (t < NE) meta[65 + t] = __hip_atomic_load(cnt + t * CNT_STRIDE, __ATOMIC_RELAXED, __HIP_MEMORY_SCOPE_AGENT);
    __syncthreads();
    if (t == 0) {
        int base = 0, blk = 0;
#pragma unroll 1
        for (int e = 0; e < NE; ++e) {
            const int c = meta[65 + e];
            meta[e] = base; meta[32 + e] = blk;
            base += c; blk += (c + 255) >> 8;
        }
        meta[64] = blk;
    }
    __syncthreads();
    if (t < 160) {
        int e = 0;
#pragma unroll 1
        for (int q = 1; q < NE; ++q) e += (meta[32 + q] <= t) ? 1 : 0;
        meta[128 + t] = e;
    }
    __syncthreads();
}
struct MoeSched {
    const int* meta; const int* list; const char* A; const char* Bt; size_t b_estride; int K, G, c, nunits;
    DI bool next(int i, g8::Unit& u) const {
        const int L = i * G + c;
        if (L >= nunits) return false;
        const int w = g8::xcd_remap(L, nunits);
        const int rti = w >> 2;
        const int e = __builtin_amdgcn_readfirstlane(meta[128 + rti]);
        u.e = e; u.pm = rti - __builtin_amdgcn_readfirstlane(meta[32 + e]); u.pn = w & 3;
        const int left = __builtin_amdgcn_readfirstlane(meta[65 + e]) - u.pm * 256;
        u.valid = left < 256 ? left : 256;
        u.rbase = __builtin_amdgcn_readfirstlane(meta[e]);
        return true;
    }
    DI const char* b_base(const g8::Unit& u) const { return Bt + (size_t)u.e * b_estride + (size_t)u.pn * 256 * K * 2; }
};
struct MoeUpSched : MoeSched {
    DI const char* a_base(const g8::Unit&) const { return A; }
    DI void a_rows(const g8::Unit& u, int R0, int R1, int (&rows)[2][2]) const {
        const int* lst = list + (size_t)u.e * T + u.pm * 256;
        const int vm = u.valid - 1;
        rows[0][0] = lst[min(R0, vm)] >> 1; rows[0][1] = lst[min(R1, vm)] >> 1;
        rows[1][0] = lst[min(128 + R0, vm)] >> 1; rows[1][1] = lst[min(128 + R1, vm)] >> 1;
    }
};
struct MoeDownSched : MoeSched {
    DI const char* a_base(const g8::Unit& u) const { return A + ((size_t)u.rbase + (size_t)u.pm * 256) * K * 2; }
    DI void a_rows(const g8::Unit&, int R0, int R1, int (&rows)[2][2]) const { rows[0][0] = R0; rows[0][1] = R1; rows[1][0] = 128 + R0; rows[1][1] = 128 + R1; }
};

struct EpiMoeUp {
    static constexpr bool PERM = true;
    const int* meta; bf16_t* hbuf;
    DI void operator()(const f32x4 (&acc)[2][2][4][2], const g8::Unit& u, int wr, int wc, int fr, int fq) const {
        const size_t hrow0 = (size_t)u.rbase + (size_t)u.pm * 256;
#pragma unroll
        for (int ai = 0; ai < 2; ++ai)
#pragma unroll
            for (int m = 0; m < 4; ++m) {
                const int row = ai * 128 + wr * 64 + m * 16 + fr;
                if (row < u.valid) {
                    f32x4 h0, h1;
#pragma unroll
                    for (int i = 0; i < 4; ++i) {
                        const float g0 = acc[ai][0][m][0][i], g1 = acc[ai][0][m][1][i];
                        h0[i] = g0 * sigmoidf_(g0) * acc[ai][1][m][0][i];
                        h1[i] = g1 * sigmoidf_(g1) * acc[ai][1][m][1][i];
                    }
                    store8_bf16(hbuf + (hrow0 + row) * DFF + u.pn * 128 + wc * 32 + 8 * fq, h0, h1);
                }
                __builtin_amdgcn_sched_barrier(0);
            }
    }
};
DI void phase_moe_up(const P& p, int layer, int bid, int nb, char* smem) {
    int* meta = (int*)(smem + META_OFF);
    moe_meta((const int*)(p.ws + WS_CTL + CTL_CNT) + layer * 32 * CNT_STRIDE, meta);
    MoeUpSched S;
    S.meta = meta; S.list = (const int*)(p.ws + WS_LIST); S.A = p.ws + WS_X1B; S.Bt = p.ws + WS_WGU + (size_t)layer * NE * 1024 * D * 2;
    S.b_estride = (size_t)1024 * D * 2; S.K = D; S.G = nb; S.c = bid; S.nunits = meta[64] * 4;
    EpiMoeUp E{meta, (bf16_t*)(p.ws + WS_HBUF)};
    g8::gemm_phase<true>((LAS unsigned char*)smem, D, S, E);
}

struct EpiMoeDown {
    static constexpr bool PERM = true;
    const int* list; const float* gate; bf16_t* yasg;
    DI void operator()(const f32x4 (&acc)[2][2][4][2], const g8::Unit& u, int wr, int wc, int fr, int fq) const {
        const int* lst = list + (size_t)u.e * T + u.pm * 256;
#pragma unroll
        for (int ai = 0; ai < 2; ++ai)
#pragma unroll
            for (int m = 0; m < 4; ++m) {
                const int row = ai * 128 + wr * 64 + m * 16 + fr;
                if (row < u.valid) {
                    const int a = lst[row];
                    const float gt = gate[a];
                    bf16_t* dst = yasg + (size_t)a * D + u.pn * 256 + wc * 32 + 8 * fq;
#pragma unroll
                    for (int bj = 0; bj < 2; ++bj) store8_bf16(dst + bj * 128, acc[ai][bj][m][0] * gt, acc[ai][bj][m][1] * gt);
                }
                __builtin_amdgcn_sched_barrier(0);
            }
    }
};
DI void phase_moe_down(const P& p, int layer, int bid, int nb, char* smem) {
    int* meta = (int*)(smem + META_OFF);
    moe_meta((const int*)(p.ws + WS_CTL + CTL_CNT) + layer * 32 * CNT_STRIDE, meta);
    MoeDownSched S;
    S.meta = meta; S.list = (const int*)(p.ws + WS_LIST); S.A = p.ws + WS_HBUF; S.Bt = p.ws + WS_WD + (size_t)layer * NE * D * DFF * 2;
    S.b_estride = (size_t)D * DFF * 2; S.K = DFF; S.G = nb; S.c = bid; S.nunits = meta[64] * 4;
    EpiMoeDown E{(const int*)(p.ws + WS_LIST), (const float*)(p.ws + WS_GATE), (bf16_t*)(p.ws + WS_YASG)};
    g8::gemm_phase<false>((LAS unsigned char*)smem, DFF, S, E);
}

DI void phase_convmix(const P& p, int layer, int bid, int nb) {
    const int j = layer >> 1;
    const int tid = tid_opaque();
    const bf16_t* projb = (const bf16_t*)(p.ws + WS_PROJ);
    bf16_t* hcat = (bf16_t*)(p.ws + WS_HCAT);
    const float* cw = p.conv_w + (size_t)j * 3 * MIXW;
    const int nitem = T * (MIXW / 8);
    for (int it = bid * NTHREADS + tid; it < nitem; it += nb * NTHREADS) {
        const int t = it / 96, c8 = (it % 96) * 8;
        const int s = t & 2047;
        const bf16_t* row = projb + (size_t)t * DIN_CONV;
        const u32x4 bg = *(const u32x4*)(row + c8);
        float u[3][8];
#pragma unroll
        for (int d = 0; d < 3; ++d) {
            const int back = 2 - d;
            if (s - back >= 0) {
                const bf16_t* rw = row - (size_t)back * DIN_CONV;
                const u32x4 cg = *(const u32x4*)(rw + MIXW + c8);
                const u32x4 xi = *(const u32x4*)(rw + 2 * MIXW + c8);
#pragma unroll
                for (int q = 0; q < 4; ++q) { u[d][2 * q] = bflo(cg[q]) * bflo(xi[q]); u[d][2 * q + 1] = bfhi(cg[q]) * bfhi(xi[q]); }
            } else {
#pragma unroll
                for (int q = 0; q < 8; ++q) u[d][q] = 0.f;
            }
        }
        float o[8];
#pragma unroll
        for (int q = 0; q < 8; ++q) {
            const float c = cw[c8 + q] * u[0][q] + cw[MIXW + c8 + q] * u[1][q] + cw[2 * MIXW + c8 + q] * u[2][q];
            const float b = (q & 1) ? bfhi(bg[q >> 1]) : bflo(bg[q >> 1]);
            o[q] = b * c;
        }
        u32x4 w; w.x = cvtpk(o[0], o[1]); w.y = cvtpk(o[2], o[3]); w.z = cvtpk(o[4], o[5]); w.w = cvtpk(o[6], o[7]);
        *(u32x4*)(hcat + (size_t)t * D + c8) = w;
    }
}

DI void phase_xattn(const P& p, int layer, int bid, int nb, char* smem) {
    const bool conv = (layer & 1) == 0;
    const int ldp = conv ? DIN_CONV : LDP_ML;
    const int qoff = conv ? 3 * MIXW : 3072;
    const bf16_t* projb = (const bf16_t*)(p.ws + WS_PROJ);
    const bf16_t* kbuf = (const bf16_t*)(p.ws + WS_KBUF) + (size_t)layer * 2048 * 256;
    const bf16_t* vT = (const bf16_t*)(p.ws + WS_VT) + (size_t)layer * 8 * 256 * 256;
    bf16_t* hcat = (bf16_t*)(p.ws + WS_HCAT);
    constexpr int LK = 72, LV = 264;
    bf16_t* Ks = (bf16_t*)smem;
    bf16_t* Vs = Ks + 256 * LK;
    for (int task = bid; task < NBATCH * XH * 16; task += nb) {
        const int tid = tid_opaque(), lane = tid & 63, wid = tid >> 6, r = lane & 15, g = lane >> 4;
        const int b = task >> 6, h = (task >> 4) & 3, qt = task & 15;
        __syncthreads();
#pragma unroll
        for (int i = 0; i < 4; ++i) {
            const int key = (tid >> 3) + 64 * i, kc = tid & 7;
            *(u32x4*)&Ks[key * LK + kc * 8] = *(const u32x4*)(kbuf + ((size_t)b * 256 + key) * 256 + h * 64 + kc * 8);
            const int dv = (tid >> 5) + 16 * i, mc = tid & 31;
            *(u32x4*)&Vs[dv * LV + mc * 8] = *(const u32x4*)(vT + (((size_t)b * 4 + h) * 64 + dv) * 256 + mc * 8);
        }
        __syncthreads();
        const int tq = b * SEQ + qt * 128 + wid * 16;
        const bf16_t* qrow = projb + (size_t)(tq + r) * ldp + qoff + h * 64;
        bf16x8 qf[2];
        qf[0] = *(const bf16x8*)(qrow + 8 * g);
        qf[1] = *(const bf16x8*)(qrow + 32 + 8 * g);
        f32x4 sacc[16];
#pragma unroll
        for (int kt = 0; kt < 16; ++kt) {
            f32x4 a = (f32x4){0.f, 0.f, 0.f, 0.f};
#pragma unroll
            for (int ks = 0; ks < 2; ++ks) {
                const bf16x8 kf = *(const bf16x8*)&Ks[(kt * 16 + r) * LK + ks * 32 + 8 * g];
                a = mfma16(kf, qf[ks], a);
            }
            sacc[kt] = a;
            if (kt & 1) __builtin_amdgcn_sched_barrier(0);
        }
        float mx = -3.0e38f;
#pragma unroll
        for (int kt = 0; kt < 16; ++kt)
#pragma unroll
            for (int i = 0; i < 4; ++i) { sacc[kt][i] *= 0.125f; mx = fmaxf(mx, sacc[kt][i]); }
        mx = xor_max(mx, 16); mx = xor_max(mx, 32);
        float sum = 0.f;
#pragma unroll
        for (int kt = 0; kt < 16; ++kt)
#pragma unroll
            for (int i = 0; i < 4; ++i) { const float e = __expf(sacc[kt][i] - mx); sacc[kt][i] = e; sum += e; }
        sum = xor_add(sum, 16); sum = xor_add(sum, 32);
        const float inv = 1.0f / sum;
        f32x4 oacc[4];
#pragma unroll
        for (int dt = 0; dt < 4; ++dt) oacc[dt] = (f32x4){0.f, 0.f, 0.f, 0.f};
#pragma unroll
        for (int s2 = 0; s2 < 8; ++s2) {
            u32x4 pw;
            pw.x = cvtpk(sacc[2 * s2][0], sacc[2 * s2][1]); pw.y = cvtpk(sacc[2 * s2][2], sacc[2 * s2][3]);
            pw.z = cvtpk(sacc[2 * s2 + 1][0], sacc[2 * s2 + 1][1]); pw.w = cvtpk(sacc[2 * s2 + 1][2], sacc[2 * s2 + 1][3]);
            const bf16x8 pf = __builtin_bit_cast(bf16x8, pw);
#pragma unroll
            for (int dt = 0; dt < 4; ++dt) {
                const bf16_t* vp = &Vs[(dt * 16 + r) * LV + s2 * 32 + 4 * g];
                const u32x2 v0 = *(const u32x2*)vp;
                const u32x2 v1 = *(const u32x2*)(vp + 16);
                u32x4 vw; vw.x = v0.x; vw.y = v0.y; vw.z = v1.x; vw.w = v1.y;
                oacc[dt] = mfma16(__builtin_bit_cast(bf16x8, vw), pf, oacc[dt]);
            }
            __builtin_amdgcn_sched_barrier(0);
        }
        bf16_t* orow = hcat + (size_t)(tq + r) * D + MIXW + h * 64;
#pragma unroll
        for (int dt = 0; dt < 4; ++dt) {
            u32x2 w; w.x = cvtpk(oacc[dt][0] * inv, oacc[dt][1] * inv); w.y = cvtpk(oacc[dt][2] * inv, oacc[dt][3] * inv);
            *(u32x2*)(orow + dt * 16 + 4 * g) = w;
        }
    }
}

DI void phase_ml_local(const P& p, int bid, int nb, char* smem) {
    const bf16_t* projb = (const bf16_t*)(p.ws + WS_PROJ);
    const float* logi = (const float*)(p.ws + WS_LOGI);
    const float* logf = (const float*)(p.ws + WS_LOGF);
    float* CT = (float*)(p.ws + WS_CT);
    float* nloc = (float*)(p.ws + WS_NLOC);
    float* mloc = (float*)(p.ws + WS_MLOC);
    float* gsum = (float*)(p.ws + WS_GSUM);
    constexpr int LS = 136;
    bf16_t* kwT = (bf16_t*)smem;
    bf16_t* vTs = kwT + 128 * LS;
    float* fb = (float*)(vTs + 128 * LS);
    float* fw = fb + 128;
    float* fr = fw + 128;
    for (int task = bid; task < 48 * NCH; task += nb) {
        const int tid = tid_opaque(), lane = tid & 63, wid = tid >> 6, r = lane & 15, g = lane >> 4;
        const int bh = task >> 4, c = task & 15, b = bh / 6, h = bh % 6;
        const int t0 = b * SEQ + c * CHUNK;
        __syncthreads();
        float li = 0.f, cum = 0.f;
        if (tid < 128) { li = logi[(size_t)bh * SEQ + c * CHUNK + tid]; cum = logf[(size_t)bh * SEQ + c * CHUNK + tid]; fb[tid] = cum; }
        __syncthreads();
        for (int off = 1; off < 128; off <<= 1) {
            float add = 0.f;
            if (tid < 128 && tid >= off) add = fb[tid - off];
            __syncthreads();
            if (tid < 128) { cum += add; fb[tid] = cum; }
            __syncthreads();
        }
        const float gtot = fb[127];
        float a = -3.0e38f;
        if (tid < 128) a = gtot - cum + li;
        float wm_ = a;
        wm_ = xor_max(wm_, 32); wm_ = xor_max(wm_, 16); wm_ = xor_max(wm_, 8); wm_ = xor_max(wm_, 4); wm_ = xor_max(wm_, 2); wm_ = xor_max(wm_, 1);
        if (lane == 0) fr[wid] = wm_;
        __syncthreads();
        const float ml = fmaxf(fr[0], fr[1]);
        if (tid < 128) fw[tid] = __expf(a - ml);
        __syncthreads();
        {
            const int s = tid & 127, quarter = tid >> 7;
            const float w = fw[s];
            const bf16_t* krow = projb + (size_t)(t0 + s) * LDP_ML + MIXW + h * 128;
            const bf16_t* vrow = projb + (size_t)(t0 + s) * LDP_ML + 2 * MIXW + h * 128;
#pragma unroll
            for (int i = 0; i < 4; ++i) {
                const int dc = quarter * 4 + i;
                const u32x4 kk = *(const u32x4*)(krow + dc * 8);
                const u32x4 vv = *(const u32x4*)(vrow + dc * 8);
#pragma unroll
                for (int q = 0; q < 4; ++q) {
                    kwT[(dc * 8 + 2 * q) * LS + s] = f2bf(bflo(kk[q]) * w);
                    kwT[(dc * 8 + 2 * q + 1) * LS + s] = f2bf(bfhi(kk[q]) * w);
                    vTs[(dc * 8 + 2 * q) * LS + s] = (bf16_t)(vv[q] & 0xffffu);
                    vTs[(dc * 8 + 2 * q + 1) * LS + s] = (bf16_t)(vv[q] >> 16);
                }
            }
        }
        __syncthreads();
        float* ct = CT + (size_t)task * 128 * 128;
        {
            f32x4 acc[8];
#pragma unroll
            for (int dt = 0; dt < 8; ++dt) acc[dt] = (f32x4){0.f, 0.f, 0.f, 0.f};
#pragma unroll
            for (int ks = 0; ks < 4; ++ks) {
                const bf16x8 vf = *(const bf16x8*)&vTs[(wid * 16 + r) * LS + ks * 32 + 8 * g];
#pragma unroll
                for (int dt = 0; dt < 8; ++dt) {
                    const bf16x8 kf = *(const bf16x8*)&kwT[(dt * 16 + r) * LS + ks * 32 + 8 * g];
                    acc[dt] = mfma16(vf, kf, acc[dt]);
                }
                __builtin_amdgcn_sched_barrier(0);
            }
#pragma unroll
            for (int dt = 0; dt < 8; ++dt)
#pragma unroll
                for (int i = 0; i < 4; ++i) ct[(wid * 16 + 4 * g + i) * 128 + dt * 16 + r] = acc[dt][i];
        }
        if (tid < 128) {
            float sn = 0.f;
            for (int s = 0; s < 128; ++s) sn += bf2f(kwT[tid * LS + s]);
            nloc[(size_t)task * 128 + tid] = sn;
        }
        if (tid == 0) { mloc[task] = ml; gsum[task] = gtot; }
    }
}

DI void phase_ml_scan(const P& p, int bid, int nb) {
    const float* CT = (const float*)(p.ws + WS_CT);
    bf16_t* CPB = (bf16_t*)(p.ws + WS_CPB);
    const float* nloc = (const float*)(p.ws + WS_NLOC);
    float* nprev = (float*)(p.ws + WS_NPREV);
    const float* mloc = (const float*)(p.ws + WS_MLOC);
    const float* gsum = (const float*)(p.ws + WS_GSUM);
    float* mprev = (float*)(p.ws + WS_MPREV);
    const int tid = tid_opaque();
    for (int task = bid; task < 48 * 8; task += nb) {
        const int bh = task >> 3, sl = task & 7;
        const int idx = sl * 2048 + tid * 4;
        float m = 0.f;
        f32x4 st = (f32x4){0.f, 0.f, 0.f, 0.f};
        float nst = 0.f;
        const bool don = (sl == 0 && tid < 128);
        for (int c = 0; c < NCH; ++c) {
            const int ch = bh * NCH + c;
            const float gg = gsum[ch], ml = mloc[ch];
            const float mnew = fmaxf(gg + m, ml);
            const float decay = __expf(gg + m - mnew), sc = __expf(ml - mnew);
            const f32x4 loc = *(const f32x4*)(CT + (size_t)ch * 16384 + idx);
            u32x2 w; w.x = cvtpk(st[0], st[1]); w.y = cvtpk(st[2], st[3]);
            *(u32x2*)(CPB + (size_t)ch * 16384 + idx) = w;
            st = st * decay + loc * sc;
            if (don) {
                const float nl = nloc[(size_t)ch * 128 + tid];
                nprev[(size_t)ch * 128 + tid] = nst;
                nst = nst * decay + nl * sc;
            }
            if (sl == 0 && tid == 0) mprev[ch] = m;
            m = mnew;
        }
    }
}

DI void phase_ml_out(const P& p, int layer, int bid, int nb, char* smem) {
    const int j = layer >> 1;
    const bf16_t* projb = (const bf16_t*)(p.ws + WS_PROJ);
    const float* logi = (const float*)(p.ws + WS_LOGI);
    const float* logf = (const float*)(p.ws + WS_LOGF);
    const bf16_t* CPB = (const bf16_t*)(p.ws + WS_CPB);
    const float* nprev = (const float*)(p.ws + WS_NPREV);
    const float* mprev = (const float*)(p.ws + WS_MPREV);
    bf16_t* hcat = (bf16_t*)(p.ws + WS_HCAT);
    const float* ng_ = p.ml_norm_g + (size_t)j * MIXW;
    constexpr int LS = 136;
    bf16_t* kS = (bf16_t*)smem;
    bf16_t* vTs = kS + 128 * LS;
    float* fb = (float*)(vTs + 128 * LS);
    float* fB = fb + 128;
    float* fA = fB + 128;
    float* fW = fA + 128;
    float* fE = fW + 128;
    float* fN = fE + 128;
    for (int task = bid; task < 48 * NCH; task += nb) {
        const int tid = tid_opaque();
        const int lane = tid & 63, wid = __builtin_amdgcn_readfirstlane(tid >> 6), r = lane & 15, g = lane >> 4;
        const int bh = task >> 4, c = task & 15, b = bh / 6, h = bh % 6;
        const int t0 = b * SEQ + c * CHUNK;
        __syncthreads();
        float li = 0.f, cum = 0.f;
        if (tid < 128) { li = logi[(size_t)bh * SEQ + c * CHUNK + tid]; cum = logf[(size_t)bh * SEQ + c * CHUNK + tid]; fb[tid] = cum; fN[tid] = nprev[(size_t)task * 128 + tid]; }
        __syncthreads();
        for (int off = 1; off < 128; off <<= 1) {
            float add = 0.f;
            if (tid < 128 && tid >= off) add = fb[tid - off];
            __syncthreads();
            if (tid < 128) { cum += add; fb[tid] = cum; }
            __syncthreads();
        }
        const float Bs_ = li - cum;
        float pm = Bs_;
        if (tid < 128) { fB[tid] = Bs_; fb[tid] = pm; }
        __syncthreads();
        for (int off = 1; off < 128; off <<= 1) {
            float o = -3.0e38f;
            if (tid < 128 && tid >= off) o = fb[tid - off];
            __syncthreads();
            if (tid < 128) { pm = fmaxf(pm, o); fb[tid] = pm; }
            __syncthreads();
        }
        if (tid < 128) {
            const float mp = mprev[task];
            const float inter = cum + mp;
            const float ml = fmaxf(cum + pm, inter);
            fA[tid] = cum - ml; fW[tid] = __expf(inter - ml); fE[tid] = __expf(-ml);
        }
        {
#pragma unroll
            for (int i = 0; i < 4; ++i) {
                const int s = (tid >> 4) + 32 * i, dc = tid & 15;
                *(u32x4*)&kS[s * LS + dc * 8] = *(const u32x4*)(projb + (size_t)(t0 + s) * LDP_ML + MIXW + h * 128 + dc * 8);
            }
            const int s = tid & 127, quarter = tid >> 7;
            const bf16_t* vrow = projb + (size_t)(t0 + s) * LDP_ML + 2 * MIXW + h * 128;
#pragma unroll
            for (int i = 0; i < 4; ++i) {
                const int dc = quarter * 4 + i;
                const u32x4 vv = *(const u32x4*)(vrow + dc * 8);
#pragma unroll
                for (int q = 0; q < 4; ++q) {
                    vTs[(dc * 8 + 2 * q) * LS + s] = (bf16_t)(vv[q] & 0xffffu);
                    vTs[(dc * 8 + 2 * q + 1) * LS + s] = (bf16_t)(vv[q] >> 16);
                }
            }
        }
        __syncthreads();
        const bf16_t* cp = CPB + (size_t)task * 16384;
        {
            const int l = wid * 16 + r;
            bf16x8 qf[4];
            float qn;
            {
                const bf16_t* qrow = projb + (size_t)(t0 + l) * LDP_ML + h * 128;
                float part = 0.f;
#pragma unroll
                for (int ks = 0; ks < 4; ++ks) {
                    const u32x4 qq = *(const u32x4*)(qrow + ks * 32 + 8 * g);
                    qf[ks] = __builtin_bit_cast(bf16x8, qq);
#pragma unroll
                    for (int q = 0; q < 4; ++q) part += bflo(qq[q]) * fN[ks * 32 + 8 * g + 2 * q] + bfhi(qq[q]) * fN[ks * 32 + 8 * g + 2 * q + 1];
                }
                part = xor_add(part, 16); part = xor_add(part, 32);
                qn = part;
            }
            __builtin_amdgcn_sched_barrier(0);
            f32x4 nacc[8];
#pragma unroll
            for (int et = 0; et < 8; ++et) {
                f32x4 a = (f32x4){0.f, 0.f, 0.f, 0.f};
#pragma unroll
                for (int ks = 0; ks < 4; ++ks) {
                    const bf16x8 cf = *(const bf16x8*)(cp + (et * 16 + r) * 128 + ks * 32 + 8 * g);
                    a = mfma16(cf, qf[ks], a);
                }
                nacc[et] = a;
                if (et & 1) __builtin_amdgcn_sched_barrier(0);
            }
            const float Al = fA[l], wint = fW[l], eml = fE[l];
#pragma unroll
            for (int et = 0; et < 8; ++et) nacc[et] *= wint;
            const int stmax = wid;
            float den = 0.f;
#pragma unroll
            for (int s2 = 0; s2 < 4; ++s2) {
                if (2 * s2 <= stmax) {
                    f32x4 sa = (f32x4){0.f, 0.f, 0.f, 0.f}, sb = (f32x4){0.f, 0.f, 0.f, 0.f};
#pragma unroll
                    for (int ks = 0; ks < 4; ++ks) {
                        const bf16x8 kf = *(const bf16x8*)&kS[(s2 * 32 + r) * LS + ks * 32 + 8 * g];
                        sa = mfma16(kf, qf[ks], sa);
                    }
                    if (2 * s2 + 1 <= stmax) {
#pragma unroll
                        for (int ks = 0; ks < 4; ++ks) {
                            const bf16x8 kf = *(const bf16x8*)&kS[(s2 * 32 + 16 + r) * LS + ks * 32 + 8 * g];
                            sb = mfma16(kf, qf[ks], sb);
                        }
                    }
#pragma unroll
                    for (int i = 0; i < 4; ++i) {
                        const int s = s2 * 32 + 4 * g + i;
                        const float va = (s <= l) ? sa[i] * __expf(Al + fB[s]) : 0.f;
                        const float vb = (s + 16 <= l) ? sb[i] * __expf(Al + fB[s + 16]) : 0.f;
                        sa[i] = va; sb[i] = vb; den += va + vb;
                    }
                    u32x4 pw;
                    pw.x = cvtpk(sa[0], sa[1]); pw.y = cvtpk(sa[2], sa[3]);
                    pw.z = cvtpk(sb[0], sb[1]); pw.w = cvtpk(sb[2], sb[3]);
                    const bf16x8 pf = __builtin_bit_cast(bf16x8, pw);
#pragma unroll
                    for (int et = 0; et < 8; ++et) {
                        const bf16_t* vp = &vTs[(et * 16 + r) * LS + s2 * 32 + 4 * g];
                        const u32x2 v0 = *(const u32x2*)vp;
                        const u32x2 v1 = *(const u32x2*)(vp + 16);
                        u32x4 vw; vw.x = v0.x; vw.y = v0.y; vw.z = v1.x; vw.w = v1.y;
                        nacc[et] = mfma16(__builtin_bit_cast(bf16x8, vw), pf, nacc[et]);
                    }
                }
                __builtin_amdgcn_sched_barrier(0);
            }
            den = xor_add(den, 16); den = xor_add(den, 32);
            const float dd = fmaxf(fabsf(den + wint * qn), eml);
            const float invd = 1.0f / dd;
            float sm = 0.f;
#pragma unroll
            for (int et = 0; et < 8; ++et)
#pragma unroll
                for (int i = 0; i < 4; ++i) { nacc[et][i] *= invd; sm += nacc[et][i]; }
            sm = xor_add(sm, 16); sm = xor_add(sm, 32);
            const float mu = sm * (1.0f / 128.0f);
            float sq = 0.f;
#pragma unroll
            for (int et = 0; et < 8; ++et)
#pragma unroll
                for (int i = 0; i < 4; ++i) { const float dlt = nacc[et][i] - mu; sq += dlt * dlt; }
            sq = xor_add(sq, 16); sq = xor_add(sq, 32);
            const float rstd = rsqrtf(sq * (1.0f / 128.0f) + LN_EPS);
            const size_t trow = (size_t)(t0 + l);
            const bf16_t* og = projb + trow * LDP_ML + 3 * MIXW + h * 128;
            bf16_t* orow = hcat + trow * D + h * 128;
#pragma unroll
            for (int et = 0; et < 8; ++et) {
                const int e = et * 16 + 4 * g;
                const u32x2 ov = *(const u32x2*)(og + e);
                const f32x4 gv = *(const f32x4*)(ng_ + h * 128 + e);
                const float o0 = (nacc[et][0] - mu) * rstd * gv[0] * sigmoidf_(bflo(ov.x));
                const float o1 = (nacc[et][1] - mu) * rstd * gv[1] * sigmoidf_(bfhi(ov.x));
                const float o2 = (nacc[et][2] - mu) * rstd * gv[2] * sigmoidf_(bflo(ov.y));
                const float o3 = (nacc[et][3] - mu) * rstd * gv[3] * sigmoidf_(bfhi(ov.y));
                u32x2 w; w.x = cvtpk(o0, o1); w.y = cvtpk(o2, o3);
                *(u32x2*)(orow + e) = w;
                if (et & 1) __builtin_amdgcn_sched_barrier(0);
            }
        }
    }
}

constexpr int LN1_MAXT = 8;
DI void phase_ln1_route(const P& p, int layer, int bid, int nb, char* smem) {
    const bf16_t* z = (const bf16_t*)(p.ws + WS_Z);
    bf16_t* x1b = (bf16_t*)(p.ws + WS_X1B);
    float* gate = (float*)(p.ws + WS_GATE);
    int* list = (int*)(p.ws + WS_LIST);
    int* cnt = (int*)(p.ws + WS_CTL + CTL_CNT) + layer * 32 * CNT_STRIDE;
    const bf16_t* rwh = (const bf16_t*)(p.ws + WS_RWT);
    const bf16_t* rwl = rwh + NE * D;
    const float* lg = p.ln1_g + (size_t)layer * D;
    const float* lb = p.ln1_b + (size_t)layer * D;
    constexpr int XS = 1028;
    float* xs = (float*)smem;
    float* red = xs + 16 * XS;
    float* scs = red + 8 * 16 * 32;
    int* lcnt = (int*)(scs + 16 * 32);
    int* gbase = lcnt + 32;
    int* sel = gbase + 32;
    {
        const int tid0 = threadIdx.x;
        __syncthreads();
        if (tid0 < 32) lcnt[tid0] = 0;
    }
    int ti = 0;
    for (int task = bid; task < T / 16; task += nb, ++ti) {
        const int tid = tid_opaque(), lane = tid & 63, wid = tid >> 6, r = lane & 15, g = lane >> 4;
        const int row0 = task * 16;
        __syncthreads();
#pragma unroll
        for (int rr = 0; rr < 2; ++rr) {
            const int lr = wid * 2 + rr;
            const size_t t = (size_t)(row0 + lr);
            float v[2][8];
            float s = 0.f;
#pragma unroll
            for (int i = 0; i < 2; ++i) {
                const u32x4 zz = *(const u32x4*)(z + t * D + i * 512 + lane * 8);
#pragma unroll
                for (int q = 0; q < 4; ++q) { v[i][2 * q] = bflo(zz[q]); v[i][2 * q + 1] = bfhi(zz[q]); s += v[i][2 * q] + v[i][2 * q + 1]; }
            }
            s = wave_sum(s);
            const float mu = s * (1.0f / D);
            float q2 = 0.f;
#pragma unroll
            for (int i = 0; i < 2; ++i)
#pragma unroll
                for (int k = 0; k < 8; ++k) { const float d = v[i][k] - mu; q2 += d * d; }
            q2 = wave_sum(q2);
            const float rstd = rsqrtf(q2 * (1.0f / D) + LN_EPS);
#pragma unroll
            for (int i = 0; i < 2; ++i) {
                const int col = i * 512 + lane * 8;
                const f32x4 g0 = *(const f32x4*)(lg + col), g1 = *(const f32x4*)(lg + col + 4), b0 = *(const f32x4*)(lb + col), b1 = *(const f32x4*)(lb + col + 4);
                f32x4 o0, o1;
#pragma unroll
                for (int k = 0; k < 4; ++k) { o0[k] = (v[i][k] - mu) * rstd * g0[k] + b0[k]; o1[k] = (v[i][4 + k] - mu) * rstd * g1[k] + b1[k]; }
                u32x4 w; w.x = cvtpk(o0[0], o0[1]); w.y = cvtpk(o0[2], o0[3]); w.z = cvtpk(o1[0], o1[1]); w.w = cvtpk(o1[2], o1[3]);
                *(u32x4*)(x1b + t * D + col) = w;
                *(f32x4*)(xs + lr * XS + col) = o0;
                *(f32x4*)(xs + lr * XS + col + 4) = o1;
            }
        }
        __syncthreads();
        {
            f32x4 acc0 = (f32x4){0.f, 0.f, 0.f, 0.f}, acc1 = (f32x4){0.f, 0.f, 0.f, 0.f};
#pragma unroll
            for (int ks = 0; ks < 4; ++ks) {
                const int k = wid * 128 + ks * 32 + 8 * g;
                const f32x4 xa0 = *(const f32x4*)(xs + r * XS + k), xa1 = *(const f32x4*)(xs + r * XS + k + 4);
                u32x4 hw, lw;
                hw.x = cvtpk(xa0[0], xa0[1]); hw.y = cvtpk(xa0[2], xa0[3]); hw.z = cvtpk(xa1[0], xa1[1]); hw.w = cvtpk(xa1[2], xa1[3]);
                lw.x = cvtpk(xa0[0] - bflo(hw.x), xa0[1] - bfhi(hw.x)); lw.y = cvtpk(xa0[2] - bflo(hw.y), xa0[3] - bfhi(hw.y));
                lw.z = cvtpk(xa1[0] - bflo(hw.z), xa1[1] - bfhi(hw.z)); lw.w = cvtpk(xa1[2] - bflo(hw.w), xa1[3] - bfhi(hw.w));
                const bf16x8 xh = __builtin_bit_cast(bf16x8, hw), xl = __builtin_bit_cast(bf16x8, lw);
                const bf16x8 wh0 = *(const bf16x8*)(rwh + (size_t)r * D + k), wl0 = *(const bf16x8*)(rwl + (size_t)r * D + k);
                const bf16x8 wh1 = *(const bf16x8*)(rwh + (size_t)(16 + r) * D + k), wl1 = *(const bf16x8*)(rwl + (size_t)(16 + r) * D + k);
                acc0 = mfma16(wh0, xh, acc0); acc0 = mfma16(wh0, xl, acc0); acc0 = mfma16(wl0, xh, acc0);
                acc1 = mfma16(wh1, xh, acc1); acc1 = mfma16(wh1, xl, acc1); acc1 = mfma16(wl1, xh, acc1);
            }
            *(f32x4*)(red + (wid * 16 + r) * 32 + 4 * g) = acc0;
            *(f32x4*)(red + (wid * 16 + r) * 32 + 16 + 4 * g) = acc1;
        }
        __syncthreads();
        {
            const int e = tid & 31, i = tid >> 5;
            float s = 0.f;
#pragma unroll
            for (int w = 0; w < 8; ++w) s += red[(w * 16 + i) * 32 + e];
            scs[i * 32 + e] = sigmoidf_(s);
        }
        __syncthreads();
        if (tid < 16) {
            const float* sc = scs + tid * 32;
            int bestg = 0; float bestv = -3.0e38f;
            for (int gi = 0; gi < 8; ++gi) {
                float m1 = -3.0e38f, m2 = -3.0e38f;
                for (int k = 0; k < 4; ++k) {
                    const float v = sc[gi * 4 + k] + p.router_b[gi * 4 + k];
                    if (v > m1) { m2 = m1; m1 = v; } else if (v > m2) { m2 = v; }
                }
                const float gs = m1 + m2;
                if (gs > bestv) { bestv = gs; bestg = gi; }
            }
            int i1 = 0; float v1 = -3.0e38f;
            for (int k = 0; k < 4; ++k) { const float v = sc[bestg * 4 + k] + p.router_b[bestg * 4 + k]; if (v > v1) { v1 = v; i1 = k; } }
            int i2 = 0; float v2 = -3.0e38f;
            for (int k = 0; k < 4; ++k) { if (k == i1) continue; const float v = sc[bestg * 4 + k] + p.router_b[bestg * 4 + k]; if (v > v2) { v2 = v; i2 = k; } }
            const int e1 = bestg * 4 + i1, e2 = bestg * 4 + i2;
            const float s1 = sc[e1], s2 = sc[e2];
            const float inv = 1.0f / (s1 + s2);
            const int t = row0 + tid;
            gate[t * 2] = s1 * inv; gate[t * 2 + 1] = s2 * inv;
            const int lp1 = atomicAdd(&lcnt[e1], 1);
            const int lp2 = atomicAdd(&lcnt[e2], 1);
            if (ti < LN1_MAXT) { sel[(ti * 16 + tid) * 2] = e1 | (lp1 << 8); sel[(ti * 16 + tid) * 2 + 1] = e2 | (lp2 << 8); }
        }
    }
    __syncthreads();
    if (threadIdx.x < 32) { const int c = lcnt[threadIdx.x]; gbase[threadIdx.x] = c ? atomicAdd(&cnt[threadIdx.x * CNT_STRIDE], c) : 0; }
    __syncthreads();
    if ((int)threadIdx.x < ti * 32) {
        const int tl = threadIdx.x >> 5, rw = (threadIdx.x >> 1) & 15, k = threadIdx.x & 1;
        const int sv = sel[threadIdx.x];
        const int e = sv & 255, lp = sv >> 8;
        list[(size_t)e * T + gbase[e] + lp] = ((bid + tl * nb) * 16 + rw) * 2 + k;
    }
}

DI void phase_ln2(const P& p, int layer, int bid, int nb) {
    const bf16_t* x1b = (const bf16_t*)(p.ws + WS_X1B);
    const bf16_t* yasg = (const bf16_t*)(p.ws + WS_YASG);
    bf16_t* xb = (bf16_t*)(p.ws + WS_XB);
    const float* lg = p.ln2_g + (size_t)layer * D;
    const float* lb = p.ln2_b + (size_t)layer * D;
    const int tid = tid_opaque(), lane = tid & 63, wid = tid >> 6;
    for (int t = bid * NWAVES + wid; t < T; t += nb * NWAVES) {
        float v[2][8];
        float s = 0.f;
#pragma unroll
        for (int i = 0; i < 2; ++i) {
            const int col = i * 512 + lane * 8;
            const u32x4 xv = *(const u32x4*)(x1b + (size_t)t * D + col);
            const u32x4 y0 = *(const u32x4*)(yasg + (size_t)(2 * t) * D + col);
            const u32x4 y1 = *(const u32x4*)(yasg + (size_t)(2 * t + 1) * D + col);
#pragma unroll
            for (int q = 0; q < 4; ++q) {
                v[i][2 * q] = bflo(xv[q]) * ALPHA + (bflo(y0[q]) + bflo(y1[q]));
                v[i][2 * q + 1] = bfhi(xv[q]) * ALPHA + (bfhi(y0[q]) + bfhi(y1[q]));
                s += v[i][2 * q] + v[i][2 * q + 1];
            }
        }
        s = wave_sum(s);
        const float mu = s * (1.0f / D);
        float q2 = 0.f;
#pragma unroll
        for (int i = 0; i < 2; ++i)
#pragma unroll
            for (int k = 0; k < 8; ++k) { const float d = v[i][k] - mu; q2 += d * d; }
        q2 = wave_sum(q2);
        const float rstd = rsqrtf(q2 * (1.0f / D) + LN_EPS);
#pragma unroll
        for (int i = 0; i < 2; ++i) {
            const int col = i * 512 + lane * 8;
            const f32x4 g0 = *(const f32x4*)(lg + col), g1 = *(const f32x4*)(lg + col + 4), b0 = *(const f32x4*)(lb + col), b1 = *(const f32x4*)(lb + col + 4);
            f32x4 o0, o1;
#pragma unroll
            for (int k = 0; k < 4; ++k) { o0[k] = (v[i][k] - mu) * rstd * g0[k] + b0[k]; o1[k] = (v[i][4 + k] - mu) * rstd * g1[k] + b1[k]; }
            if (layer == DEPTH - 1) {
                *(f32x4*)(p.out + (size_t)t * D + col) = o0;
                *(f32x4*)(p.out + (size_t)t * D + col + 4) = o1;
            } else {
                u32x4 w; w.x = cvtpk(o0[0], o0[1]); w.y = cvtpk(o0[2], o0[3]); w.z = cvtpk(o1[0], o1[1]); w.w = cvtpk(o1[2], o1[3]);
                *(u32x4*)(xb + (size_t)t * D + col) = w;
            }
        }
    }
}

#define XB_TMO      128
#define XB_XCNT(j)  (256  + 64 * (j))
#define XB_XSUB(j)  (1280 + 64 * (j))
#define XB_XGEN(j)  (2304 + 64 * (j))
#define XB_TOP      3328
#define XB_TOPGEN   3392
#define XCD_BAR_WORDS 3456
#define XB_SPIN_CAP (1u << 20)
DI unsigned xb_ld(unsigned* p_) { return __hip_atomic_load(p_, __ATOMIC_RELAXED, __HIP_MEMORY_SCOPE_AGENT); }
DI unsigned xb_add(unsigned* p_, unsigned v) { return __hip_atomic_fetch_add(p_, v, __ATOMIC_RELAXED, __HIP_MEMORY_SCOPE_AGENT); }
DI unsigned xb_xcc_id() { return (unsigned)__builtin_amdgcn_s_getreg((3 << 11) | 20) & 0xFu; }
#define XB_SPIN(cond, bar) do { unsigned _sp = 0; while (cond) { __builtin_amdgcn_s_sleep(1); \
    if ((++_sp & 255u) == 0u) { if (xb_ld(&(bar)[XB_TMO])) break; if (_sp > XB_SPIN_CAP) { atomicAdd(&(bar)[XB_TMO], 1u); break; } } } } while (0)
struct XcdBarrier { unsigned* bar; unsigned x; volatile LAS unsigned* st; };
DI XcdBarrier xcd_barrier_post(unsigned* bar, volatile LAS unsigned* st) {
    XcdBarrier b; b.bar = bar; b.x = xb_xcc_id(); b.st = st;
    if (threadIdx.x == 0) (void)xb_add(&bar[XB_XCNT(b.x)], 1u);
    return b;
}
DI void xcd_barrier_complete(unsigned* bar, unsigned x, unsigned& nloc, unsigned& nx) {
    const unsigned G = gridDim.x * gridDim.y * gridDim.z;
    unsigned sum, cnt, mine, sp = 0u;
    for (;;) {
        sum = 0u; cnt = 0u; mine = 0u;
#pragma unroll
        for (unsigned j = 0; j < 16; ++j) { const unsigned c = xb_ld(&bar[XB_XCNT(j)]); sum += c; cnt += (c > 0u) ? 1u : 0u; mine = (j == x) ? c : mine; }
        if (sum == G) break;
        __builtin_amdgcn_s_sleep(1);
        if ((++sp & 255u) == 0u) { if (xb_ld(&bar[XB_TMO])) break; if (sp > XB_SPIN_CAP) { atomicAdd(&bar[XB_TMO], 1u); break; } }
    }
    nloc = mine > 0u ? mine : 1u; nx = cnt > 0u ? cnt : 1u;
}
DI void xcd_barrier(const XcdBarrier& b) {
    asm volatile("s_waitcnt vmcnt(0)" ::: "memory");
    __syncthreads();
    if (threadIdx.x == 0) {
        unsigned* bar = b.bar;
        __builtin_amdgcn_s_waitcnt(0);
        unsigned nloc = b.st[0], nx = b.st[1];
        if (nloc == 0u) { xcd_barrier_complete(bar, b.x, nloc, nx); b.st[0] = nloc; b.st[1] = nx; }
        const unsigned old = xb_add(&bar[XB_XSUB(b.x)], 1u);
        const unsigned gen = old / nloc;
        if (old + 1u == (gen + 1u) * nloc) {
            __builtin_amdgcn_fence(__ATOMIC_RELEASE, "agent");
            asm volatile("s_waitcnt vmcnt(0)" ::: "memory");
            const unsigned og = xb_add(&bar[XB_TOP], 1u);
            const unsigned tg = og / nx;
            if (og + 1u == (tg + 1u) * nx) xb_add(&bar[XB_TOPGEN], 1u);
            else XB_SPIN(xb_ld(&bar[XB_TOPGEN]) == tg, bar);
            __builtin_amdgcn_fence(__ATOMIC_ACQUIRE, "agent");
            xb_add(&bar[XB_XGEN(b.x)], 1u);
            asm volatile("s_waitcnt vmcnt(0)" ::: "memory");
        } else {
            XB_SPIN(xb_ld(&bar[XB_XGEN(b.x)]) == gen, bar);
            __builtin_amdgcn_fence(__ATOMIC_ACQUIRE, "agent");
            asm volatile("s_waitcnt vmcnt(0)" ::: "memory");
        }
    }
    __syncthreads();
}

enum { PH_INPROJ = 0, PH_MIX1, PH_MIX2, PH_MIX3, PH_OUTPROJ, PH_LN1, PH_MOEUP, PH_MOEDOWN, PH_LN2, PH_PER_LAYER, PH_PREP = 100, PH_KV = 101 };

DI void run_phase(const P& p, int ph, int layer, int bid, int nb, char* smem) {
    const bool conv = (layer & 1) == 0;
    if (ph == PH_PREP) phase_prep(p, bid, nb, smem);
    if (ph == PH_KV) phase_kv(p, bid, nb, smem);
    if (ph == PH_INPROJ) phase_inproj(p, layer, bid, nb, smem);
    if (ph == PH_MIX1) phase_ml_local(p, bid, nb, smem);
    if (ph == PH_MIX2) phase_ml_scan(p, bid, nb);
    if (ph == PH_MIX3) {
        if (conv) phase_convmix(p, layer, bid, nb);
        else phase_ml_out(p, layer, bid, nb, smem);
    }
    if (ph == PH_MIX1 || (ph == PH_MIX3 && conv)) phase_xattn(p, layer, bid, nb, smem);
    if (ph == PH_OUTPROJ) phase_outproj(p, layer, bid, nb, smem);
    if (ph == PH_LN1) phase_ln1_route(p, layer, bid, nb, smem);
    if (ph == PH_MOEUP) phase_moe_up(p, layer, bid, nb, smem);
    if (ph == PH_MOEDOWN) phase_moe_down(p, layer, bid, nb, smem);
    if (ph == PH_LN2) phase_ln2(p, layer, bid, nb);
}

__global__ void __launch_bounds__(NTHREADS, 2) mega(P p) {
    __shared__ __attribute__((aligned(16))) char smem[SMEM_BYTES];
    const int bid = blockIdx.x, nb = gridDim.x;
    volatile LAS unsigned* st = (volatile LAS unsigned*)(smem + SMEM_BYTES - 16);
    if (threadIdx.x == 0) { st[0] = 0u; st[1] = 0u; }
    __syncthreads();
    XcdBarrier xb = xcd_barrier_post((unsigned*)(p.ws + WS_CTL), st);
#pragma unroll 1
    for (int s = -2; s < DEPTH * PH_PER_LAYER; ++s) {
        int ph = (s == -2) ? (int)PH_PREP : (s == -1) ? (int)PH_KV : s % PH_PER_LAYER;
        int layer = (s < 0) ? 0 : s / PH_PER_LAYER;
        if ((layer & 1) == 0 && (ph == PH_MIX1 || ph == PH_MIX2)) continue;
        asm volatile("" : "+s"(ph), "+s"(layer));
        P q = p;
        asm volatile("" : "+s"(q.ws));
        run_phase(q, ph, layer, bid, nb, smem);
#ifdef PROBE_MASK
        if (ph < 31 && ((PROBE_MASK >> ph) & 1)) { __syncthreads(); run_phase(q, ph, layer, bid, nb, smem); }
#endif
        if (ph != PH_KV) xcd_barrier(xb);
    }
}

extern "C" void kernel_launch(void* const* d_in, const int* in_sizes, int n_in, void* d_out, int out_size, void* d_ws, size_t ws_size,
                              hipStream_t stream) {
    if (ws_size < WS_TOTAL) { fprintf(stderr, "kernel_launch: workspace too small: %zu < %zu\n", ws_size, (size_t)WS_TOTAL); return; }
    static int grid_blocks = 0;
    if (!grid_blocks) {
        int dev = 0, cus = 0, per_cu = 0;
        (void)hipGetDevice(&dev);
        (void)hipDeviceGetAttribute(&cus, hipDeviceAttributeMultiprocessorCount, dev);
        if (hipOccupancyMaxActiveBlocksPerMultiprocessor(&per_cu, (const void*)mega, NTHREADS, 0) != hipSuccess) per_cu = 0;
        if (per_cu < 1 || cus < 1) { fprintf(stderr, "kernel_launch: occupancy query failed (per_cu=%d cus=%d)\n", per_cu, cus); return; }
        grid_blocks = cus;
    }
    P p{};
    p.x = (const float*)d_in[0]; p.mem = (const float*)d_in[1]; p.conv_w_in = (const float*)d_in[2]; p.conv_w = (const float*)d_in[3];
    p.ml_w_in = (const float*)d_in[4]; p.ml_gate_b = (const float*)d_in[5]; p.ml_norm_g = (const float*)d_in[6]; p.w_kv = (const float*)d_in[7];
    p.w_out = (const float*)d_in[8]; p.ln1_g = (const float*)d_in[9]; p.ln1_b = (const float*)d_in[10]; p.ln2_g = (const float*)d_in[11];
    p.ln2_b = (const float*)d_in[12]; p.router_w = (const float*)d_in[13]; p.router_b = (const float*)d_in[14]; p.w_gate = (const float*)d_in[15];
    p.w_up = (const float*)d_in[16]; p.w_down = (const float*)d_in[17];
    p.out = (float*)d_out; p.ws = (char*)d_ws;
    (void)hipMemsetAsync((char*)d_ws + WS_CTL, 0, CTL_BYTES, stream);
    void* args[] = {&p};
    hipError_t e = hipLaunchCooperativeKernel((const void*)mega, dim3(grid_blocks), dim3(NTHREADS), args, 0, stream);
    if (e != hipSuccess) fprintf(stderr, "kernel_launch: cooperative launch failed: %s (grid %d)\n", hipGetErrorString(e), grid_blocks);
}
```

```cpp
#include <hip/hip_runtime.h>
#include <stdint.h>
#include <stdio.h>

typedef unsigned short bf16_t;
typedef __attribute__((ext_vector_type(8))) short bf16x8;
typedef __attribute__((ext_vector_type(4))) float f32x4;
typedef __attribute__((ext_vector_type(4))) unsigned u32x4;
typedef __attribute__((ext_vector_type(2))) unsigned u32x2;

#define DI __device__ __forceinline__
#define LAS __attribute__((address_space(3)))

constexpr int D = 1024;
constexpr int NBATCH = 8;
constexpr int SEQ = 2048;
constexpr int T = NBATCH * SEQ;
constexpr int DEPTH = 4;
constexpr int MIXW = 768;
constexpr int XH = 4, XDH = 64, XW = 256, MEML = 256;
constexpr int MLH = 6, MLDH = 128, CHUNK = 128, NCH = SEQ / CHUNK;
constexpr int DIN_CONV = 2560, DIN_ML = 3340, LDP_ML = 3328, NV_ML = 3584;
constexpr int NE = 32, DFF = 512;
constexpr float ALPHA = 1.681792830507429f;
constexpr float LN_EPS = 1e-5f;

constexpr int NTHREADS = 512;
constexpr int NWAVES = 8;
constexpr int STAGE_BYTES = 131072;
constexpr int META_OFF = STAGE_BYTES;
constexpr int SMEM_BYTES = STAGE_BYTES + 4096;

constexpr size_t al256(size_t x) { return (x + 255) & ~(size_t)255; }
constexpr size_t WS_CTL   = 0;
constexpr size_t CTL_BYTES = 64 * 1024;
constexpr size_t CTL_CNT  = 32 * 1024;
constexpr int CNT_STRIDE = 64;
constexpr size_t CTL_TQ   = 16 * 1024;
constexpr size_t WS_XB    = WS_CTL + CTL_BYTES;
constexpr size_t WS_MEMB  = WS_XB + (size_t)T * D * 2;
constexpr size_t WS_KBUF  = WS_MEMB + (size_t)NBATCH * MEML * D * 2;
constexpr size_t WS_VT    = WS_KBUF + (size_t)DEPTH * NBATCH * MEML * XW * 2;
constexpr size_t WS_PROJ  = WS_VT + (size_t)DEPTH * NBATCH * MEML * XW * 2;
constexpr size_t WS_Z     = WS_PROJ;
constexpr size_t WS_LOGI  = WS_PROJ + (size_t)T * LDP_ML * 2;
constexpr size_t WS_LOGF  = WS_LOGI + (size_t)NBATCH * MLH * SEQ * 4;
constexpr size_t WS_CT    = WS_LOGF + (size_t)NBATCH * MLH * SEQ * 4;
constexpr size_t WS_CPB   = WS_CT + (size_t)48 * NCH * 128 * 128 * 4;
constexpr size_t WS_NLOC  = WS_CPB + (size_t)48 * NCH * 128 * 128 * 2;
constexpr size_t WS_NPREV = WS_NLOC + (size_t)48 * NCH * 128 * 4;
constexpr size_t WS_MLOC  = WS_NPREV + (size_t)48 * NCH * 128 * 4;
constexpr size_t WS_GSUM  = WS_MLOC + al256(48 * NCH * 4);
constexpr size_t WS_MPREV = WS_GSUM + al256(48 * NCH * 4);
constexpr size_t WS_HCAT  = WS_MPREV + al256(48 * NCH * 4);
constexpr size_t WS_X1B   = WS_HCAT + (size_t)T * D * 2;
constexpr size_t WS_GATE  = WS_X1B + (size_t)T * D * 2;
constexpr size_t WS_LIST  = WS_GATE + (size_t)T * 2 * 4;
constexpr size_t WS_HBUF  = WS_LIST + (size_t)NE * T * 4;
constexpr size_t WS_YASG  = WS_HBUF + (size_t)T * 2 * DFF * 2;
constexpr size_t WS_WIN   = WS_YASG + (size_t)T * 2 * D * 2;
constexpr size_t WS_WKV   = WS_WIN + ((size_t)2 * DIN_CONV + (size_t)2 * NV_ML) * D * 2;
constexpr size_t WS_WOUT  = WS_WKV + (size_t)DEPTH * 512 * D * 2;
constexpr size_t WS_WGU   = WS_WOUT + (size_t)DEPTH * D * D * 2;
constexpr size_t WS_WD    = WS_WGU + (size_t)DEPTH * NE * 1024 * D * 2;
constexpr size_t WS_RWT   = WS_WD + (size_t)DEPTH * NE * D * DFF * 2;
constexpr size_t WS_TOTAL = WS_RWT + (size_t)2 * NE * D * 2;

struct P {
    const float *x, *mem, *conv_w_in, *conv_w, *ml_w_in, *ml_gate_b, *ml_norm_g, *w_kv, *w_out;
    const float *ln1_g, *ln1_b, *ln2_g, *ln2_b, *router_w, *router_b, *w_gate, *w_up, *w_down;
    float* out;
    char* ws;
};

DI unsigned cvtpk(float lo, float hi) { unsigned r; asm("v_cvt_pk_bf16_f32 %0, %1, %2" : "=v"(r) : "v"(lo), "v"(hi)); return r; }
DI float bf2f(bf16_t v) { return __uint_as_float(((unsigned)v) << 16); }
DI float bflo(unsigned v) { return __uint_as_float(v << 16); }
DI float bfhi(unsigned v) { return __uint_as_float(v & 0xffff0000u); }
DI bf16_t f2bf(float f) { return (bf16_t)(cvtpk(f, f) & 0xffffu); }
DI float sigmoidf_(float x) { return 1.0f / (1.0f + __expf(-x)); }
DI float logsigmoidf_(float x) { return fminf(x, 0.0f) - log1pf(__expf(-fabsf(x))); }
DI float xor_add(float v, int m) { return v + __shfl_xor(v, m, 64); }
DI float xor_max(float v, int m) { return fmaxf(v, __shfl_xor(v, m, 64)); }
DI float wave_sum(float v) { v = xor_add(v, 32); v = xor_add(v, 16); v = xor_add(v, 8); v = xor_add(v, 4); v = xor_add(v, 2); v = xor_add(v, 1); return v; }
DI int tid_opaque() { int t = threadIdx.x; asm volatile("" : "+v"(t)); return t; }
DI f32x4 mfma16(bf16x8 a, bf16x8 b, f32x4 c) { return __builtin_amdgcn_mfma_f32_16x16x32_bf16(a, b, c, 0, 0, 0); }

namespace g8 {
constexpr int BM = 256, BK = 64, HALF = 128, HTB = HALF * BK * 2, NXCD = 8, WGM = 8;
DI int lds_byte(int r, int c) { const int st = (r >> 4) * 2 + (c >> 5), rr = r & 15, cc = c & 31, ob = rr * 64 + cc * 2; return st * 1024 + (ob ^ (((ob >> 9) & 1) << 5)); }
DI void stage_rc(int b, int& R, int& C) { const int st = b / 1024, sb = b % 1024, swz = sb ^ (((sb >> 9) & 1) << 5); R = (st >> 1) * 16 + swz / 64; C = (st & 1) * 32 + (swz % 64) / 2; }
DI int perm32(int rho) { const int n = rho >> 4, i = rho & 15; return 8 * (i >> 2) + 4 * n + (i & 3); }
DI int xcd_remap(int L, int n) { const int q = n / NXCD, r = n % NXCD, xcd = L % NXCD, off = L / NXCD; return (xcd < r ? xcd * (q + 1) : r * (q + 1) + (xcd - r) * q) + off; }

struct Unit { int pm, pn, e, valid, rbase; };
DI const char* uni(const char* p_) {
    const unsigned long long v = (unsigned long long)p_;
    const unsigned lo = (unsigned)__builtin_amdgcn_readfirstlane((int)(unsigned)v), hi = (unsigned)__builtin_amdgcn_readfirstlane((int)(unsigned)(v >> 32));
    return (const char*)(((unsigned long long)hi << 32) | lo);
}

template <bool GATHER, class Epi, class Sched>
DI void gemm_phase(LAS unsigned char* lds, const int K, const Sched& S, const Epi& E) {
    const int tid = tid_opaque(), wid = __builtin_amdgcn_readfirstlane(tid >> 6), lane = tid & 63, wr = wid >> 2, wc = wid & 3, fr = lane & 15, fq = lane >> 4;
    const int nt = K / BK;
    const size_t kstep = (size_t)(BK * 2);
    const size_t hstep = (size_t)HALF * K * 2;
    unsigned vB0, vB1;
    {
        int R0, C0, R1, C1;
        stage_rc(tid * 16, R0, C0); stage_rc(tid * 16 + 8192, R1, C1);
        const int Rb0 = Epi::PERM ? ((R0 & ~31) + perm32(R0 & 31)) : R0, Rb1 = Epi::PERM ? ((R1 & ~31) + perm32(R1 & 31)) : R1;
        vB0 = (unsigned)(Rb0 * K + C0) * 2u; vB1 = (unsigned)(Rb1 * K + C1) * 2u;
    }
    const unsigned ldsw = (unsigned)wid * 1024u;
    const int aoff = lds_byte(wr * 64 + fr, fq * 8), boff = lds_byte(wc * 32 + fr, fq * 8);
#define G8_SA(b, h) (((b) * 2 + (h)) * HTB)
#define G8_SB(b, h) ((4 + (b) * 2 + (h)) * HTB)
#define G8_STAGE(bufoff, gbase, v0, v1) do { unsigned _o0 = (v0), _o1 = (v1); asm volatile("" : "+v"(_o0), "+v"(_o1));     \
        __builtin_amdgcn_global_load_lds((const unsigned*)((const char*)(gbase) + _o0), (LAS unsigned*)(lds + (bufoff) + ldsw), 16, 0, 0); \
        __builtin_amdgcn_global_load_lds((const unsigned*)((const char*)(gbase) + _o1), (LAS unsigned*)(lds + (bufoff) + ldsw + 8192), 16, 0, 0); } while (0)
#define G8_LDA(dst, b, h) do { _Pragma("unroll") for (int m = 0; m < 4; ++m) _Pragma("unroll") for (int k = 0; k < 2; ++k) dst[m][k] = *(const LAS bf16x8*)(lds + G8_SA(b, h) + aoff + m * 2048 + k * 1024); } while (0)
#define G8_LDB(dst, b, h) do { _Pragma("unroll") for (int n = 0; n < 2; ++n) _Pragma("unroll") for (int k = 0; k < 2; ++k) dst[n][k] = *(const LAS bf16x8*)(lds + G8_SB(b, h) + boff + n * 2048 + k * 1024); } while (0)
#define G8_MMA(ai, bj, At, Bt) do { __builtin_amdgcn_s_setprio(1); _Pragma("unroll") for (int m = 0; m < 4; ++m) _Pragma("unroll") for (int n = 0; n < 2; ++n) _Pragma("unroll") for (int k = 0; k < 2; ++k) \
        acc[ai][bj][m][n] = __builtin_amdgcn_mfma_f32_16x16x32_bf16(Bt[n][k], At[m][k], acc[ai][bj][m][n], 0, 0, 0); __builtin_amdgcn_s_setprio(0); } while (0)
#define G8_WAIT_V(n) asm volatile("s_waitcnt vmcnt(" #n ")" ::: "memory")
#define G8_WAIT_L(n) asm volatile("s_waitcnt lgkmcnt(" #n ")" ::: "memory")
#define G8_BAR __builtin_amdgcn_s_barrier()
#define G8_SCHED __builtin_amdgcn_sched_barrier(0)
    Unit cur, nxt;
    int ui = 0;
    if (!S.next(0, cur)) return;
    f32x4 acc[2][2][4][2];
#pragma unroll
    for (int a = 0; a < 2; ++a)
#pragma unroll
        for (int b = 0; b < 2; ++b)
#pragma unroll
            for (int m = 0; m < 4; ++m)
#pragma unroll
                for (int n = 0; n < 2; ++n) acc[a][b][m][n] = (f32x4){0.f, 0.f, 0.f, 0.f};
    bf16x8 At[4][2], B0[2][2], B1[2][2];
    const char* cA = S.a_base(cur);
    const char* cB = S.b_base(cur);
    unsigned cv00, cv01, cv10, cv11, nv00, nv01, nv10, nv11;
    {
        int R0, C0, R1, C1;
        stage_rc(tid * 16, R0, C0); stage_rc(tid * 16 + 8192, R1, C1);
        int rows[2][2];
        S.a_rows(cur, R0, R1, rows);
        cv00 = (unsigned)(rows[0][0] * K + C0) * 2u; cv01 = (unsigned)(rows[0][1] * K + C1) * 2u;
        cv10 = (unsigned)(rows[1][0] * K + C0) * 2u; cv11 = (unsigned)(rows[1][1] * K + C1) * 2u;
        nv00 = cv00; nv01 = cv01; nv10 = cv10; nv11 = cv11;
    }
    G8_STAGE(G8_SB(0, 0), uni(cB), vB0, vB1); G8_STAGE(G8_SA(0, 0), uni(cA), cv00, cv01); G8_STAGE(G8_SB(0, 1), uni(cB + hstep), vB0, vB1); G8_STAGE(G8_SA(0, 1), uni(cA), cv10, cv11);
    if (wr == 1) G8_BAR;
    G8_WAIT_V(4); G8_BAR;
    G8_STAGE(G8_SB(1, 0), uni(cB + kstep), vB0, vB1); G8_STAGE(G8_SA(1, 0), uni(cA + kstep), cv00, cv01); G8_STAGE(G8_SB(1, 1), uni(cB + hstep + kstep), vB0, vB1);
    G8_WAIT_V(6); G8_BAR;
    for (;;) {
        const bool has_next = S.next(ui + 1, nxt);
        const char* nA = has_next ? S.a_base(nxt) : cA;
        const char* nB = has_next ? S.b_base(nxt) : cB;
        if (GATHER) {
            if (has_next) {
                const int tid2 = tid_opaque();
                int R0, C0, R1, C1;
                stage_rc(tid2 * 16, R0, C0); stage_rc(tid2 * 16 + 8192, R1, C1);
                int rows[2][2];
                S.a_rows(nxt, R0, R1, rows);
                nv00 = (unsigned)(rows[0][0] * K + C0) * 2u; nv01 = (unsigned)(rows[0][1] * K + C1) * 2u;
                nv10 = (unsigned)(rows[1][0] * K + C0) * 2u; nv11 = (unsigned)(rows[1][1] * K + C1) * 2u;
            } else { nv00 = cv00; nv01 = cv01; nv10 = cv10; nv11 = cv11; }
        }
        for (int t = 0; t < nt; t += 2) {
            const bool last = (t == nt - 2);
            const char* a1 = uni(cA + (size_t)(t + 1) * kstep);
            const char* a2 = uni(last ? nA : cA + (size_t)(t + 2) * kstep);
            const char* b2 = uni(last ? nB : cB + (size_t)(t + 2) * kstep);
            const char* a3 = uni(a2 + kstep);
            const char* b3 = uni(b2 + kstep);
            const char* b2h = uni(b2 + hstep);
            const char* b3h = uni(b3 + hstep);
            unsigned x00 = cv00, x01 = cv01, x10 = cv10, x11 = cv11;
            if (GATHER) { x00 = last ? nv00 : cv00; x01 = last ? nv01 : cv01; x10 = last ? nv10 : cv10; x11 = last ? nv11 : cv11; }
            G8_LDB(B0, 0, 0); G8_SCHED; G8_LDA(At, 0, 0); G8_STAGE(G8_SA(1, 1), a1, cv10, cv11);
            G8_WAIT_L(8); G8_BAR; G8_WAIT_L(0); G8_MMA(0, 0, At, B0); G8_BAR; G8_SCHED;
            G8_LDB(B1, 0, 1); G8_STAGE(G8_SB(0, 0), b2, vB0, vB1);
            G8_BAR; G8_WAIT_L(0); G8_MMA(0, 1, At, B1); G8_BAR;
            G8_LDA(At, 0, 1); G8_STAGE(G8_SA(0, 0), a2, x00, x01);
            G8_BAR; G8_WAIT_L(0); G8_MMA(1, 0, At, B0); G8_BAR; G8_SCHED;
            G8_STAGE(G8_SB(0, 1), b2h, vB0, vB1);
            G8_WAIT_V(6); G8_BAR; G8_MMA(1, 1, At, B1); G8_BAR;
            G8_LDB(B0, 1, 0); G8_SCHED; G8_LDA(At, 1, 0); G8_STAGE(G8_SA(0, 1), a2, x10, x11);
            G8_WAIT_L(8); G8_BAR; G8_WAIT_L(0); G8_MMA(0, 0, At, B0); G8_BAR; G8_SCHED;
            G8_LDB(B1, 1, 1); G8_STAGE(G8_SB(1, 0), b3, vB0, vB1);
            G8_BAR; G8_WAIT_L(0); G8_MMA(0, 1, At, B1); G8_BAR;
            G8_LDA(At, 1, 1); G8_STAGE(G8_SA(1, 0), a3, x00, x01);
            G8_BAR; G8_WAIT_L(0); G8_MMA(1, 0, At, B0); G8_BAR; G8_SCHED;
            G8_STAGE(G8_SB(1, 1), b3h, vB0, vB1);
            G8_WAIT_V(6); G8_BAR; G8_MMA(1, 1, At, B1); G8_BAR;
        }
        E(acc, cur, wr, wc, fr, fq);
        if (!has_next) break;
#pragma unroll
        for (int a = 0; a < 2; ++a)
#pragma unroll
            for (int b = 0; b < 2; ++b)
#pragma unroll
                for (int m = 0; m < 4; ++m)
#pragma unroll
                    for (int n = 0; n < 2; ++n) acc[a][b][m][n] = (f32x4){0.f, 0.f, 0.f, 0.f};
        cur = nxt; cA = nA; cB = nB; ++ui;
        if (GATHER) { cv00 = nv00; cv01 = nv01; cv10 = nv10; cv11 = nv11; }
    }
    G8_WAIT_V(0);
    if (wr == 0) G8_BAR;
    G8_BAR;
#undef G8_SA
#undef G8_SB
#undef G8_STAGE
#undef G8_LDA
#undef G8_LDB
#undef G8_MMA
#undef G8_WAIT_V
#undef G8_WAIT_L
#undef G8_BAR
#undef G8_SCHED
}

struct DenseSched {
    const char* A; const char* Bt; int K, nM, nN, nwg, G, c;
    DI void init(const void* A_, const void* Bt_, int M, int N, int K_, int G_, int c_) { A = (const char*)A_; Bt = (const char*)Bt_; K = K_; nM = M / BM; nN = N / BM; nwg = nM * nN; G = G_; c = c_; }
    DI bool next(int i, Unit& u) const {
        const int L = i * G + c;
        if (L >= nwg) return false;
        const int wgid = xcd_remap(L, nwg);
        const int nig = WGM * nN, gid = wgid / nig, fm = gid * WGM, gsz = (nM - fm) < WGM ? (nM - fm) : WGM;
        u.pm = fm + ((wgid % nig) % gsz); u.pn = (wgid % nig) / gsz; u.e = 0; u.valid = 256; u.rbase = 0;
        return true;
    }
    DI const char* a_base(const Unit& u) const { return A + (size_t)u.pm * 256 * K * 2; }
    DI const char* b_base(const Unit& u) const { return Bt + (size_t)u.pn * 256 * K * 2; }
    DI void a_rows(const Unit&, int R0, int R1, int (&rows)[2][2]) const { rows[0][0] = R0; rows[0][1] = R1; rows[1][0] = 128 + R0; rows[1][1] = 128 + R1; }
};
}

struct TJ { const float* s[4]; float sc[4]; bf16_t* d[2]; };

template <class ColPtr>
DI void tj_make(TJ& j, ColPtr colptr, int ld, int k0, int v0, bf16_t* dst, int K, int tid) {
#pragma unroll
    for (int i = 0; i < 4; ++i) {
        const int idx = tid + NTHREADS * i, kr = idx >> 5, c4 = idx & 31;
        float sc;
        const float* src = colptr(v0 + 4 * c4, sc);
        j.s[i] = src + (size_t)(k0 + kr) * ld; j.sc[i] = sc;
    }
#pragma unroll
    for (int i = 0; i < 2; ++i) {
        const int ch = tid + NTHREADS * i, vr = ch >> 3, kc = ch & 7;
        j.d[i] = dst + (size_t)(v0 + vr) * K + k0 + kc * 8;
    }
}
DI void tj_load(const TJ& j, f32x4 (&v)[4]) {
#pragma unroll
    for (int i = 0; i < 4; ++i) v[i] = *(const f32x4*)j.s[i];
}
DI void tj_finish(const TJ& j, const f32x4 (&v)[4], float* tile, int tid) {
    constexpr int TS = 129;
    __syncthreads();
#pragma unroll
    for (int i = 0; i < 4; ++i) {
        const int idx = tid + NTHREADS * i, kr = idx >> 5, c4 = idx & 31;
        float* tp = tile + kr * TS + 4 * c4;
        tp[0] = v[i][0] * j.sc[i]; tp[1] = v[i][1] * j.sc[i]; tp[2] = v[i][2] * j.sc[i]; tp[3] = v[i][3] * j.sc[i];
    }
    __syncthreads();
#pragma unroll
    for (int i = 0; i < 2; ++i) {
        const int ch = tid + NTHREADS * i, vr = ch >> 3, kc = ch & 7;
        const float* tp = tile + (kc * 8) * TS + vr;
        u32x4 w;
        w.x = cvtpk(tp[0], tp[TS]); w.y = cvtpk(tp[2 * TS], tp[3 * TS]); w.z = cvtpk(tp[4 * TS], tp[5 * TS]); w.w = cvtpk(tp[6 * TS], tp[7 * TS]);
        *(u32x4*)j.d[i] = w;
    }
}

constexpr int MOE_TILES_PER_LAYER = NE * (16 * 8 + 8 * 8);
DI void moe_tile_job(const P& p, int q, int tid, TJ& j) {
    const int layer = q / MOE_TILES_PER_LAYER, r = q % MOE_TILES_PER_LAYER;
    if (r < NE * 128) {
        const int le = layer * NE + (r >> 7), qq = r & 127, kt = qq >> 3, vt = qq & 7;
        const float* Wg = p.w_gate + (size_t)le * D * DFF;
        const float* Wu = p.w_up + (size_t)le * D * DFF;
        tj_make(j, [&](int v4, float& sc) { sc = 1.0f; const int grp = v4 >> 7; return ((grp & 1) ? Wu : Wg) + (grp >> 1) * 128 + (v4 & 127); },
                DFF, kt * 64, vt * 128, (bf16_t*)(p.ws + WS_WGU) + (size_t)le * 1024 * D, D, tid);
    } else {
        const int r2 = r - NE * 128, le = layer * NE + (r2 >> 6), qq = r2 & 63, kt = qq >> 3, vt = qq & 7;
        const float* W = p.w_down + (size_t)le * DFF * D;
        tj_make(j, [&](int v4, float& sc) { sc = 1.0f; return W + v4; }, D, kt * 64, vt * 128, (bf16_t*)(p.ws + WS_WD) + (size_t)le * D * DFF, DFF, tid);
    }
}

constexpr int PT_CONV = 16 * 20, PT_ML = 16 * 28, PT_KV = 16 * 4, PT_OUT = 16 * 8;
constexpr int PN0 = 2 * PT_CONV, PN1 = PN0 + 2 * PT_ML, PN2 = PN1 + 4 * PT_KV, PN3 = PN2 + 4 * PT_OUT, PN5 = PN3 + MOE_TILES_PER_LAYER;
DI void prep_tile_job(const P& p, int it, int tid, TJ& j) {
    if (it < PN0) {
        const int jj = it / PT_CONV, q = it % PT_CONV, kt = q / 20, vt = q % 20;
        const float* W = p.conv_w_in + (size_t)jj * D * DIN_CONV;
        tj_make(j, [&](int v4, float& sc) { sc = 1.0f; return W + v4; }, DIN_CONV, kt * 64, vt * 128, (bf16_t*)(p.ws + WS_WIN) + (size_t)jj * DIN_CONV * D, D, tid);
    } else if (it < PN1) {
        const int r = it - PN0, jj = r / PT_ML, q = r % PT_ML, kt = q / 28, vt = q % 28;
        const float* W = p.ml_w_in + (size_t)jj * D * DIN_ML;
        tj_make(j, [&](int v4, float& sc) -> const float* {
                    sc = (v4 >= MIXW && v4 < 2 * MIXW) ? 0.08838834764831845f : 1.0f;
                    if (v4 < 3072) return W + v4;
                    if (v4 < 3328) return W + 3084 + (v4 - 3072);
                    if (v4 < 3340) return W + 3072 + (v4 - 3328);
                    sc = 0.0f; return W; },
                DIN_ML, kt * 64, vt * 128, (bf16_t*)(p.ws + WS_WIN) + ((size_t)2 * DIN_CONV + (size_t)jj * NV_ML) * D, D, tid);
    } else if (it < PN2) {
        const int r = it - PN1, l = r / PT_KV, q = r % PT_KV, kt = q / 4, vt = q % 4;
        const float* W = p.w_kv + (size_t)l * D * 512;
        tj_make(j, [&](int v4, float& sc) { sc = 1.0f; return W + v4; }, 512, kt * 64, vt * 128, (bf16_t*)(p.ws + WS_WKV) + (size_t)l * 512 * D, D, tid);
    } else if (it < PN3) {
        const int r = it - PN2, l = r / PT_OUT, q = r % PT_OUT, kt = q / 8, vt = q % 8;
        const float* W = p.w_out + (size_t)l * D * D;
        tj_make(j, [&](int v4, float& sc) { sc = 1.0f; return W + v4; }, D, kt * 64, vt * 128, (bf16_t*)(p.ws + WS_WOUT) + (size_t)l * D * D, D, tid);
    } else {
        moe_tile_job(p, it - PN3, tid, j);
    }
}

DI void phase_prep(const P& p, int bid, int nb, char* smem) {
    const int tid = tid_opaque();
    bf16_t* xb = (bf16_t*)(p.ws + WS_XB);
    bf16_t* memb = (bf16_t*)(p.ws + WS_MEMB);
    {
        const size_t nx = (size_t)T * D / 4, nm = (size_t)NBATCH * MEML * D / 4;
        for (size_t i = (size_t)bid * NTHREADS + tid; i < nx + nm; i += (size_t)nb * NTHREADS) {
            if (i < nx) { f32x4 v = ((const f32x4*)p.x)[i]; u32x2 w; w.x = cvtpk(v[0], v[1]); w.y = cvtpk(v[2], v[3]); ((u32x2*)xb)[i] = w; }
            else { size_t j = i - nx; f32x4 v = ((const f32x4*)p.mem)[j]; u32x2 w; w.x = cvtpk(v[0], v[1]); w.y = cvtpk(v[2], v[3]); ((u32x2*)memb)[j] = w; }
        }
    }
    {
        bf16_t* rwt = (bf16_t*)(p.ws + WS_RWT);
        for (int i = bid * NTHREADS + tid; i < NE * D; i += nb * NTHREADS) {
            const int e = i >> 10, d = i & 1023;
            const float w = p.router_w[(size_t)d * NE + e];
            const bf16_t hi = f2bf(w);
            rwt[i] = hi; rwt[NE * D + i] = f2bf(w - bf2f(hi));
        }
    }
    float* tile = (float*)smem;
    if (bid < PN5) {
        TJ cur; f32x4 cv[4];
        prep_tile_job(p, bid, tid, cur); tj_load(cur, cv);
        for (int it = bid; it < PN5; it += nb) {
            TJ nxt; f32x4 nv[4];
            const bool hn = it + nb < PN5;
            if (hn) { prep_tile_job(p, it + nb, tid, nxt); tj_load(nxt, nv); }
            tj_finish(cur, cv, tile, tid);
            if (hn) { cur = nxt;
#pragma unroll
                for (int i = 0; i < 4; ++i) cv[i] = nv[i]; }
        }
    }
}

DI void moe_steal(const P& p, int budget, int limit, char* smem) {
    volatile int* qslot = (volatile int*)(smem + META_OFF + 2048);
    unsigned* tq = (unsigned*)(p.ws + WS_CTL + CTL_TQ);
    const int tid = tid_opaque();
    if (budget <= 0) return;
    __syncthreads();
    if (tid == 0) qslot[0] = (int)__hip_atomic_fetch_add(tq, 1u, __ATOMIC_RELAXED, __HIP_MEMORY_SCOPE_AGENT);
    __syncthreads();
    int q = qslot[0] + MOE_TILES_PER_LAYER;
    if (q >= DEPTH * MOE_TILES_PER_LAYER) return;
    TJ cur; f32x4 cv[4];
    moe_tile_job(p, q, tid, cur); tj_load(cur, cv);
    for (int n = 1;; ++n) {
        const bool want = (n < budget) && (q < limit);
        int qn = DEPTH * MOE_TILES_PER_LAYER;
        if (want) {
            if (tid == 0) qslot[1] = (int)__hip_atomic_fetch_add(tq, 1u, __ATOMIC_RELAXED, __HIP_MEMORY_SCOPE_AGENT);
            __syncthreads();
            qn = qslot[1] + MOE_TILES_PER_LAYER;
        }
        const bool hn = qn < DEPTH * MOE_TILES_PER_LAYER;
        TJ nxt; f32x4 nv[4];
        if (hn) { moe_tile_job(p, qn, tid, nxt); tj_load(nxt, nv); }
        tj_finish(cur, cv, (float*)smem, tid);
        if (!hn) break;
        cur = nxt; q = qn;
#pragma unroll
        for (int i = 0; i < 4; ++i) cv[i] = nv[i];
    }
}

DI void store8_bf16(bf16_t* p8, const f32x4& v0, const f32x4& v1) {
    u32x4 w; w.x = cvtpk(v0[0], v0[1]); w.y = cvtpk(v0[2], v0[3]); w.z = cvtpk(v1[0], v1[1]); w.w = cvtpk(v1[2], v1[3]);
    *(u32x4*)p8 = w;
}

struct EpiTileBf16 {
    static constexpr bool PERM = true;
    bf16_t* O; int ldc; size_t pm_stride, pn_stride;
    DI void operator()(const f32x4 (&acc)[2][2][4][2], const g8::Unit& u, int wr, int wc, int fr, int fq) const {
        bf16_t* base = O + (size_t)u.pm * pm_stride + (size_t)u.pn * pn_stride + (size_t)(wr * 64 + fr) * ldc + wc * 32 + 8 * fq;
#pragma unroll
        for (int ai = 0; ai < 2; ++ai)
#pragma unroll
            for (int m = 0; m < 4; ++m)
                {
#pragma unroll
                    for (int bj = 0; bj < 2; ++bj) store8_bf16(base + (size_t)(ai * 128 + m * 16) * ldc + bj * 128, acc[ai][bj][m][0], acc[ai][bj][m][1]); __builtin_amdgcn_sched_barrier(0); }
    }
};

DI int slack_budget(int nunits, int G, int c, int per_unit) {
    const int mine = (c < nunits) ? (nunits - 1 - c) / G + 1 : 0, most = (nunits + G - 1) / G;
    return (most - mine) * per_unit;
}
constexpr int STEAL_K1024 = 9, STEAL_K512 = 4;

struct KSched {
    const char* memb; const char* wkv; int G, c;
    DI bool next(int i, g8::Unit& u) const { const int L = i * G + c; if (L >= 32) return false; u.pm = L & 7; u.pn = L >> 3; u.e = 0; u.valid = 256; u.rbase = 0; return true; }
    DI const char* a_base(const g8::Unit& u) const { return memb + (size_t)u.pm * 256 * D * 2; }
    DI const char* b_base(const g8::Unit& u) const { return wkv + (size_t)u.pn * 512 * D * 2; }
    DI void a_rows(const g8::Unit&, int R0, int R1, int (&rows)[2][2]) const { rows[0][0] = R0; rows[0][1] = R1; rows[1][0] = 128 + R0; rows[1][1] = 128 + R1; }
};
struct VSched {
    const char* memb; const char* wkv; int G, c;
    DI bool next(int i, g8::Unit& u) const { const int L = i * G + c - 32; if (L < 0 || L >= 32) return false; u.pm = L >> 3; u.pn = L & 7; u.e = 0; u.valid = 256; u.rbase = 0; return true; }
    DI const char* a_base(const g8::Unit& u) const { return wkv + ((size_t)u.pm * 512 + 256) * D * 2; }
    DI const char* b_base(const g8::Unit& u) const { return memb + (size_t)u.pn * 256 * D * 2; }
    DI void a_rows(const g8::Unit&, int R0, int R1, int (&rows)[2][2]) const { rows[0][0] = R0; rows[0][1] = R1; rows[1][0] = 128 + R0; rows[1][1] = 128 + R1; }
};
DI void phase_kv(const P& p, int bid, int nb, char* smem) {
    const char* memb = p.ws + WS_MEMB;
    const char* wkv = p.ws + WS_WKV;
    {
        KSched S{memb, wkv, nb, bid};
        EpiTileBf16 E{(bf16_t*)(p.ws + WS_KBUF), 256, (size_t)256 * 256, (size_t)2048 * 256};
        g8::gemm_phase<false>((LAS unsigned char*)smem, D, S, E);
    }
    {
        VSched S{memb, wkv, nb, bid};
        EpiTileBf16 E{(bf16_t*)(p.ws + WS_VT), 256, (size_t)8 * 256 * 256, (size_t)256 * 256};
        g8::gemm_phase<false>((LAS unsigned char*)smem, D, S, E);
    }
    if (bid >= 64) moe_steal(p, STEAL_K1024, DEPTH * MOE_TILES_PER_LAYER, smem);
}

struct EpiInproj {
    static constexpr bool PERM = true;
    bf16_t* projb; int ldp; int gate_pn; const float* gate_b; float* logi; float* logf;
    DI void operator()(const f32x4 (&acc)[2][2][4][2], const g8::Unit& u, int wr, int wc, int fr, int fq) const {
        if (u.pn != gate_pn) {
            bf16_t* base = projb + (size_t)(u.pm * 256 + wr * 64 + fr) * ldp + u.pn * 256 + wc * 32 + 8 * fq;
#pragma unroll
            for (int ai = 0; ai < 2; ++ai)
#pragma unroll
                for (int m = 0; m < 4; ++m)
                    {
#pragma unroll
                        for (int bj = 0; bj < 2; ++bj) store8_bf16(base + (size_t)(ai * 128 + m * 16) * ldp + bj * 128, acc[ai][bj][m][0], acc[ai][bj][m][1]); __builtin_amdgcn_sched_barrier(0); }
        } else if (wc == 0 && fq < 2) {
#pragma unroll
            for (int ai = 0; ai < 2; ++ai)
#pragma unroll
                for (int m = 0; m < 4; ++m) {
                    const int t = u.pm * 256 + ai * 128 + wr * 64 + m * 16 + fr;
                    const int b = t >> 11, s = t & 2047;
#pragma unroll
                    for (int n = 0; n < 2; ++n)
#pragma unroll
                        for (int i = 0; i < 4; ++i) {
                            const int col = 8 * fq + 4 * n + i;
                            if (col < 12) {
                                const float val = acc[ai][0][m][n][i] + gate_b[col];
                                if (col < 6) logi[(size_t)(b * 6 + col) * SEQ + s] = val;
                                else logf[(size_t)(b * 6 + col - 6) * SEQ + s] = logsigmoidf_(val);
                            }
                        }
                    __builtin_amdgcn_sched_barrier(0);
                }
        }
    }
};
DI void phase_inproj(const P& p, int layer, int bid, int nb, char* smem) {
    const bool conv = (layer & 1) == 0;
    const int j = layer >> 1;
    const bf16_t* W = (const bf16_t*)(p.ws + WS_WIN) + (conv ? (size_t)j * DIN_CONV * D : ((size_t)2 * DIN_CONV + (size_t)j * NV_ML) * D);
    g8::DenseSched S; S.init(p.ws + WS_XB, W, T, conv ? DIN_CONV : NV_ML, D, nb, bid);
    EpiInproj E{(bf16_t*)(p.ws + WS_PROJ), conv ? DIN_CONV : LDP_ML, conv ? -1 : 13, p.ml_gate_b + j * 12, (float*)(p.ws + WS_LOGI), (float*)(p.ws + WS_LOGF)};
    g8::gemm_phase<false>((LAS unsigned char*)smem, D, S, E);
    moe_steal(p, slack_budget(S.nwg, nb, bid, STEAL_K1024), DEPTH * MOE_TILES_PER_LAYER, smem);
}

struct EpiOutproj {
    static constexpr bool PERM = true;
    const bf16_t* xres; bf16_t* z;
    DI void operator()(const f32x4 (&acc)[2][2][4][2], const g8::Unit& u, int wr, int wc, int fr, int fq) const {
        const size_t off0 = (size_t)(u.pm * 256 + wr * 64 + fr) * D + u.pn * 256 + wc * 32 + 8 * fq;
#pragma unroll
        for (int ai = 0; ai < 2; ++ai)
#pragma unroll
            for (int m = 0; m < 4; ++m) {
#pragma unroll
                for (int bj = 0; bj < 2; ++bj) {
                    const size_t off = off0 + (size_t)(ai * 128 + m * 16) * D + bj * 128;
                    const u32x4 xr = *(const u32x4*)(xres + off);
                    f32x4 v0 = acc[ai][bj][m][0], v1 = acc[ai][bj][m][1];
                    v0[0] += ALPHA * bflo(xr.x); v0[1] += ALPHA * bfhi(xr.x); v0[2] += ALPHA * bflo(xr.y); v0[3] += ALPHA * bfhi(xr.y);
                    v1[0] += ALPHA * bflo(xr.z); v1[1] += ALPHA * bfhi(xr.z); v1[2] += ALPHA * bflo(xr.w); v1[3] += ALPHA * bfhi(xr.w);
                    store8_bf16(z + off, v0, v1);
                }
                __builtin_amdgcn_sched_barrier(0);
            }
    }
};
DI void phase_outproj(const P& p, int layer, int bid, int nb, char* smem) {
    g8::DenseSched S; S.init(p.ws + WS_HCAT, (const bf16_t*)(p.ws + WS_WOUT) + (size_t)layer * D * D, T, D, D, nb, bid);
    EpiOutproj E{(const bf16_t*)(p.ws + WS_XB), (bf16_t*)(p.ws + WS_Z)};
    g8::gemm_phase<false>((LAS unsigned char*)smem, D, S, E);
}

DI void moe_meta(const int* cnt, int* meta) {
    __syncthreads();
    const int t = tid_opaque();
    if (t < NE) meta[65 + t] = __hip_atomic_load(cnt + t * CNT_STRIDE, __ATOMIC_RELAXED, __HIP_MEMORY_SCOPE_AGENT);
    __syncthreads();
    if (t == 0) {
        int base = 0, blk = 0;
#pragma unroll 1
        for (int e = 0; e < NE; ++e) {
            const int c = meta[65 + e];
            meta[e] = base; meta[32 + e] = blk;
            base += c; blk += (c + 255) >> 8;
        }
        meta[64] = blk;
    }
    __syncthreads();
    if (t < 160) {
        int e = 0;
#pragma unroll 1
        for (int q = 1; q < NE; ++q) e += (meta[32 + q] <= t) ? 1 : 0;
        meta[128 + t] = e;
    }
    __syncthreads();
}
struct MoeSched {
    const int* meta; const int* list; const char* A; const char* Bt; size_t b_estride; int K, G, c, nunits;
    DI bool next(int i, g8::Unit& u) const {
        const int L = i * G + c;
        if (L >= nunits) return false;
        const int w = g8::xcd_remap(L, nunits);
        const int rti = w >> 2;
        const int e = __builtin_amdgcn_readfirstlane(meta[128 + rti]);
        u.e = e; u.pm = rti - __builtin_amdgcn_readfirstlane(meta[32 + e]); u.pn = w & 3;
        const int left = __builtin_amdgcn_readfirstlane(meta[65 + e]) - u.pm * 256;
        u.valid = left < 256 ? left : 256;
        u.rbase = __builtin_amdgcn_readfirstlane(meta[e]);
        return true;
    }
    DI const char* b_base(const g8::Unit& u) const { return Bt + (size_t)u.e * b_estride + (size_t)u.pn * 256 * K * 2; }
};
struct MoeUpSched : MoeSched {
    DI const char* a_base(const g8::Unit&) const { return A; }
    DI void a_rows(const g8::Unit& u, int R0, int R1, int (&rows)[2][2]) const {
        const int* lst = list + (size_t)u.e * T + u.pm * 256;
        const int vm = u.valid - 1;
        rows[0][0] = lst[min(R0, vm)] >> 1; rows[0][1] = lst[min(R1, vm)] >> 1;
        rows[1][0] = lst[min(128 + R0, vm)] >> 1; rows[1][1] = lst[min(128 + R1, vm)] >> 1;
    }
};
struct MoeDownSched : MoeSched {
    DI const char* a_base(const g8::Unit& u) const { return A + ((size_t)u.rbase + (size_t)u.pm * 256) * K * 2; }
    DI void a_rows(const g8::Unit&, int R0, int R1, int (&rows)[2][2]) const { rows[0][0] = R0; rows[0][1] = R1; rows[1][0] = 128 + R0; rows[1][1] = 128 + R1; }
};

struct EpiMoeUp {
    static constexpr bool PERM = true;
    const int* meta; bf16_t* hbuf;
    DI void operator()(const f32x4 (&acc)[2][2][4][2], const g8::Unit& u, int wr, int wc, int fr, int fq) const {
        const size_t hrow0 = (size_t)u.rbase + (size_t)u.pm * 256;
#pragma unroll
        for (int ai = 0; ai < 2; ++ai)
#pragma unroll
            for (int m = 0; m < 4; ++m) {
                const int row = ai * 128 + wr * 64 + m * 16 + fr;
                if (row < u.valid) {
                    f32x4 h0, h1;
#pragma unroll
                    for (int i = 0; i < 4; ++i) {
                        const float g0 = acc[ai][0][m][0][i], g1 = acc[ai][0][m][1][i];
                        h0[i] = g0 * sigmoidf_(g0) * acc[ai][1][m][0][i];
                        h1[i] = g1 * sigmoidf_(g1) * acc[ai][1][m][1][i];
                    }
                    store8_bf16(hbuf + (hrow0 + row) * DFF + u.pn * 128 + wc * 32 + 8 * fq, h0, h1);
                }
                __builtin_amdgcn_sched_barrier(0);
            }
    }
};
DI void phase_moe_up(const P& p, int layer, int bid, int nb, char* smem) {
    int* meta = (int*)(smem + META_OFF);
    moe_meta((const int*)(p.ws + WS_CTL + CTL_CNT) + layer * 32 * CNT_STRIDE, meta);
    MoeUpSched S;
    S.meta = meta; S.list = (const int*)(p.ws + WS_LIST); S.A = p.ws + WS_X1B; S.Bt = p.ws + WS_WGU + (size_t)layer * NE * 1024 * D * 2;
    S.b_estride = (size_t)1024 * D * 2; S.K = D; S.G = nb; S.c = bid; S.nunits = meta[64] * 4;
    EpiMoeUp E{meta, (bf16_t*)(p.ws + WS_HBUF)};
    g8::gemm_phase<true>((LAS unsigned char*)smem, D, S, E);
    moe_steal(p, slack_budget(S.nunits, nb, bid, STEAL_K1024), DEPTH * MOE_TILES_PER_LAYER, smem);
}

struct EpiMoeDown {
    static constexpr bool PERM = true;
    const int* list; const float* gate; bf16_t* yasg;
    DI void operator()(const f32x4 (&acc)[2][2][4][2], const g8::Unit& u, int wr, int wc, int fr, int fq) const {
        const int* lst = list + (size_t)u.e * T + u.pm * 256;
#pragma unroll
        for (int ai = 0; ai < 2; ++ai)
#pragma unroll
            for (int m = 0; m < 4; ++m) {
                const int row = ai * 128 + wr * 64 + m * 16 + fr;
                if (row < u.valid) {
                    const int a = lst[row];
                    const float gt = gate[a];
                    bf16_t* dst = yasg + (size_t)a * D + u.pn * 256 + wc * 32 + 8 * fq;
#pragma unroll
                    for (int bj = 0; bj < 2; ++bj) store8_bf16(dst + bj * 128, acc[ai][bj][m][0] * gt, acc[ai][bj][m][1] * gt);
                }
                __builtin_amdgcn_sched_barrier(0);
            }
    }
};
DI void phase_moe_down(const P& p, int layer, int bid, int nb, char* smem) {
    int* meta = (int*)(smem + META_OFF);
    moe_meta((const int*)(p.ws + WS_CTL + CTL_CNT) + layer * 32 * CNT_STRIDE, meta);
    MoeDownSched S;
    S.meta = meta; S.list = (const int*)(p.ws + WS_LIST); S.A = p.ws + WS_HBUF; S.Bt = p.ws + WS_WD + (size_t)layer * NE * D * DFF * 2;
    S.b_estride = (size_t)D * DFF * 2; S.K = DFF; S.G = nb; S.c = bid; S.nunits = meta[64] * 4;
    EpiMoeDown E{(const int*)(p.ws + WS_LIST), (const float*)(p.ws + WS_GATE), (bf16_t*)(p.ws + WS_YASG)};
    g8::gemm_phase<false>((LAS unsigned char*)smem, DFF, S, E);
    moe_steal(p, slack_budget(S.nunits, nb, bid, STEAL_K512), DEPTH * MOE_TILES_PER_LAYER, smem);
}

DI void phase_convmix(const P& p, int layer, int bid, int nb) {
    const int j = layer >> 1;
    const int tid = tid_opaque();
    const bf16_t* projb = (const bf16_t*)(p.ws + WS_PROJ);
    bf16_t* hcat = (bf16_t*)(p.ws + WS_HCAT);
    const float* cw = p.conv_w + (size_t)j * 3 * MIXW;
    const int nitem = T * (MIXW / 8);
    for (int it = bid * NTHREADS + tid; it < nitem; it += nb * NTHREADS) {
        const int t = it / 96, c8 = (it % 96) * 8;
        const int s = t & 2047;
        const bf16_t* row = projb + (size_t)t * DIN_CONV;
        const u32x4 bg = *(const u32x4*)(row + c8);
        float u[3][8];
#pragma unroll
        for (int d = 0; d < 3; ++d) {
            const int back = 2 - d;
            if (s - back >= 0) {
                const bf16_t* rw = row - (size_t)back * DIN_CONV;
                const u32x4 cg = *(const u32x4*)(rw + MIXW + c8);
                const u32x4 xi = *(const u32x4*)(rw + 2 * MIXW + c8);
#pragma unroll
                for (int q = 0; q < 4; ++q) { u[d][2 * q] = bflo(cg[q]) * bflo(xi[q]); u[d][2 * q + 1] = bfhi(cg[q]) * bfhi(xi[q]); }
            } else {
#pragma unroll
                for (int q = 0; q < 8; ++q) u[d][q] = 0.f;
            }
        }
        float o[8];
#pragma unroll
        for (int q = 0; q < 8; ++q) {
            const float c = cw[c8 + q] * u[0][q] + cw[MIXW + c8 + q] * u[1][q] + cw[2 * MIXW + c8 + q] * u[2][q];
            const float b = (q & 1) ? bfhi(bg[q >> 1]) : bflo(bg[q >> 1]);
            o[q] = b * c;
        }
        u32x4 w; w.x = cvtpk(o[0], o[1]); w.y = cvtpk(o[2], o[3]); w.z = cvtpk(o[4], o[5]); w.w = cvtpk(o[6], o[7]);
        *(u32x4*)(hcat + (size_t)t * D + c8) = w;
    }
}

DI void phase_xattn(const P& p, int layer, int bid, int nb, char* smem) {
    const bool conv = (layer & 1) == 0;
    const int ldp = conv ? DIN_CONV : LDP_ML;
    const int qoff = conv ? 3 * MIXW : 3072;
    const bf16_t* projb = (const bf16_t*)(p.ws + WS_PROJ);
    const bf16_t* kbuf = (const bf16_t*)(p.ws + WS_KBUF) + (size_t)layer * 2048 * 256;
    const bf16_t* vT = (const bf16_t*)(p.ws + WS_VT) + (size_t)layer * 8 * 256 * 256;
    bf16_t* hcat = (bf16_t*)(p.ws + WS_HCAT);
    constexpr int LK = 72, LV = 264;
    bf16_t* Ks = (bf16_t*)smem;
    bf16_t* Vs = Ks + 256 * LK;
    for (int task = bid; task < NBATCH * XH * 16; task += nb) {
        const int tid = tid_opaque(), lane = tid & 63, wid = tid >> 6, r = lane & 15, g = lane >> 4;
        const int b = task >> 6, h = (task >> 4) & 3, qt = task & 15;
        __syncthreads();
#pragma unroll
        for (int i = 0; i < 4; ++i) {
            const int key = (tid >> 3) + 64 * i, kc = tid & 7;
            *(u32x4*)&Ks[key * LK + kc * 8] = *(const u32x4*)(kbuf + ((size_t)b * 256 + key) * 256 + h * 64 + kc * 8);
            const int dv = (tid >> 5) + 16 * i, mc = tid & 31;
            *(u32x4*)&Vs[dv * LV + mc * 8] = *(const u32x4*)(vT + (((size_t)b * 4 + h) * 64 + dv) * 256 + mc * 8);
        }
        __syncthreads();
        const int tq = b * SEQ + qt * 128 + wid * 16;
        const bf16_t* qrow = projb + (size_t)(tq + r) * ldp + qoff + h * 64;
        bf16x8 qf[2];
        qf[0] = *(const bf16x8*)(qrow + 8 * g);
        qf[1] = *(const bf16x8*)(qrow + 32 + 8 * g);
        f32x4 sacc[16];
#pragma unroll
        for (int kt = 0; kt < 16; ++kt) {
            f32x4 a = (f32x4){0.f, 0.f, 0.f, 0.f};
#pragma unroll
            for (int ks = 0; ks < 2; ++ks) {
                const bf16x8 kf = *(const bf16x8*)&Ks[(kt * 16 + r) * LK + ks * 32 + 8 * g];
                a = mfma16(kf, qf[ks], a);
            }
            sacc[kt] = a;
            if (kt & 1) __builtin_amdgcn_sched_barrier(0);
        }
        float mx = -3.0e38f;
#pragma unroll
        for (int kt = 0; kt < 16; ++kt)
#pragma unroll
            for (int i = 0; i < 4; ++i) { sacc[kt][i] *= 0.125f; mx = fmaxf(mx, sacc[kt][i]); }
        mx = xor_max(mx, 16); mx = xor_max(mx, 32);
        float sum = 0.f;
#pragma unroll
        for (int kt = 0; kt < 16; ++kt)
#pragma unroll
            for (int i = 0; i < 4; ++i) { const float e = __expf(sacc[kt][i] - mx); sacc[kt][i] = e; sum += e; }
        sum = xor_add(sum, 16); sum = xor_add(sum, 32);
        const float inv = 1.0f / sum;
        f32x4 oacc[4];
#pragma unroll
        for (int dt = 0; dt < 4; ++dt) oacc[dt] = (f32x4){0.f, 0.f, 0.f, 0.f};
#pragma unroll
        for (int s2 = 0; s2 < 8; ++s2) {
            u32x4 pw;
            pw.x = cvtpk(sacc[2 * s2][0], sacc[2 * s2][1]); pw.y = cvtpk(sacc[2 * s2][2], sacc[2 * s2][3]);
            pw.z = cvtpk(sacc[2 * s2 + 1][0], sacc[2 * s2 + 1][1]); pw.w = cvtpk(sacc[2 * s2 + 1][2], sacc[2 * s2 + 1][3]);
            const bf16x8 pf = __builtin_bit_cast(bf16x8, pw);
#pragma unroll
            for (int dt = 0; dt < 4; ++dt) {
                const bf16_t* vp = &Vs[(dt * 16 + r) * LV + s2 * 32 + 4 * g];
                const u32x2 v0 = *(const u32x2*)vp;
                const u32x2 v1 = *(const u32x2*)(vp + 16);
                u32x4 vw; vw.x = v0.x; vw.y = v0.y; vw.z = v1.x; vw.w = v1.y;
                oacc[dt] = mfma16(__builtin_bit_cast(bf16x8, vw), pf, oacc[dt]);
            }
            __builtin_amdgcn_sched_barrier(0);
        }
        bf16_t* orow = hcat + (size_t)(tq + r) * D + MIXW + h * 64;
#pragma unroll
        for (int dt = 0; dt < 4; ++dt) {
            u32x2 w; w.x = cvtpk(oacc[dt][0] * inv, oacc[dt][1] * inv); w.y = cvtpk(oacc[dt][2] * inv, oacc[dt][3] * inv);
            *(u32x2*)(orow + dt * 16 + 4 * g) = w;
        }
    }
}

DI void phase_ml_local(const P& p, int bid, int nb, char* smem) {
    const bf16_t* projb = (const bf16_t*)(p.ws + WS_PROJ);
    const float* logi = (const float*)(p.ws + WS_LOGI);
    const float* logf = (const float*)(p.ws + WS_LOGF);
    float* CT = (float*)(p.ws + WS_CT);
    float* nloc = (float*)(p.ws + WS_NLOC);
    float* mloc = (float*)(p.ws + WS_MLOC);
    float* gsum = (float*)(p.ws + WS_GSUM);
    constexpr int LS = 136;
    bf16_t* kwT = (bf16_t*)smem;
    bf16_t* vTs = kwT + 128 * LS;
    float* fb = (float*)(vTs + 128 * LS);
    float* fw = fb + 128;
    float* fr = fw + 128;
    for (int task = bid; task < 48 * NCH; task += nb) {
        const int tid = tid_opaque(), lane = tid & 63, wid = tid >> 6, r = lane & 15, g = lane >> 4;
        const int bh = task >> 4, c = task & 15, b = bh / 6, h = bh % 6;
        const int t0 = b * SEQ + c * CHUNK;
        __syncthreads();
        if (wid == 0) {
            const float* lfp = logf + (size_t)bh * SEQ + c * CHUNK + 2 * lane;
            const float* lip = logi + (size_t)bh * SEQ + c * CHUNK + 2 * lane;
            const float f0 = lfp[0], f1 = lfp[1], i0 = lip[0], i1 = lip[1];
            float ps = f0 + f1;
#pragma unroll
            for (int off = 1; off < 64; off <<= 1) { const float y = __shfl_up(ps, off, 64); if (lane >= off) ps += y; }
            const float gtot = __shfl(ps, 63, 64);
            const float b0 = ps - f1, b1 = ps;
            const float a0 = gtot - b0 + i0, a1 = gtot - b1 + i1;
            float mx = fmaxf(a0, a1);
            mx = xor_max(mx, 32); mx = xor_max(mx, 16); mx = xor_max(mx, 8); mx = xor_max(mx, 4); mx = xor_max(mx, 2); mx = xor_max(mx, 1);
            fw[2 * lane] = __expf(a0 - mx); fw[2 * lane + 1] = __expf(a1 - mx);
            if (lane == 0) { fr[0] = mx; fr[1] = gtot; }
        }
        __syncthreads();
        const float ml = fr[0], gtot = fr[1];
        {
            const int s = tid & 127, quarter = tid >> 7;
            const float w = fw[s];
            const bf16_t* krow = projb + (size_t)(t0 + s) * LDP_ML + MIXW + h * 128;
            const bf16_t* vrow = projb + (size_t)(t0 + s) * LDP_ML + 2 * MIXW + h * 128;
#pragma unroll
            for (int i = 0; i < 4; ++i) {
                const int dc = quarter * 4 + i;
                const u32x4 kk = *(const u32x4*)(krow + dc * 8);
                const u32x4 vv = *(const u32x4*)(vrow + dc * 8);
#pragma unroll
                for (int q = 0; q < 4; ++q) {
                    kwT[(dc * 8 + 2 * q) * LS + s] = f2bf(bflo(kk[q]) * w);
                    kwT[(dc * 8 + 2 * q + 1) * LS + s] = f2bf(bfhi(kk[q]) * w);
                    vTs[(dc * 8 + 2 * q) * LS + s] = (bf16_t)(vv[q] & 0xffffu);
                    vTs[(dc * 8 + 2 * q + 1) * LS + s] = (bf16_t)(vv[q] >> 16);
                }
            }
        }
        __syncthreads();
        float* ct = CT + (size_t)task * 128 * 128;
        {
            f32x4 acc[8];
#pragma unroll
            for (int dt = 0; dt < 8; ++dt) acc[dt] = (f32x4){0.f, 0.f, 0.f, 0.f};
#pragma unroll
            for (int ks = 0; ks < 4; ++ks) {
                const bf16x8 vf = *(const bf16x8*)&vTs[(wid * 16 + r) * LS + ks * 32 + 8 * g];
#pragma unroll
                for (int dt = 0; dt < 8; ++dt) {
                    const bf16x8 kf = *(const bf16x8*)&kwT[(dt * 16 + r) * LS + ks * 32 + 8 * g];
                    acc[dt] = mfma16(vf, kf, acc[dt]);
                }
                __builtin_amdgcn_sched_barrier(0);
            }
#pragma unroll
            for (int dt = 0; dt < 8; ++dt)
#pragma unroll
                for (int i = 0; i < 4; ++i) ct[(wid * 16 + 4 * g + i) * 128 + dt * 16 + r] = acc[dt][i];
        }
        if (tid < 128) {
            float sn = 0.f;
            for (int s = 0; s < 128; ++s) sn += bf2f(kwT[tid * LS + s]);
            nloc[(size_t)task * 128 + tid] = sn;
        }
        if (tid == 0) { mloc[task] = ml; gsum[task] = gtot; }
    }
}

DI void phase_ml_scan(const P& p, int bid, int nb) {
    const float* CT = (const float*)(p.ws + WS_CT);
    bf16_t* CPB = (bf16_t*)(p.ws + WS_CPB);
    const float* nloc = (const float*)(p.ws + WS_NLOC);
    float* nprev = (float*)(p.ws + WS_NPREV);
    const float* mloc = (const float*)(p.ws + WS_MLOC);
    const float* gsum = (const float*)(p.ws + WS_GSUM);
    float* mprev = (float*)(p.ws + WS_MPREV);
    const int tid = tid_opaque();
    for (int task = bid; task < 48 * 8; task += nb) {
        const int bh = task >> 3, sl = task & 7;
        const int idx = sl * 2048 + tid * 4;
        float m = 0.f;
        f32x4 st = (f32x4){0.f, 0.f, 0.f, 0.f};
        float nst = 0.f;
        const bool don = (sl == 0 && tid < 128);
        for (int c = 0; c < NCH; ++c) {
            const int ch = bh * NCH + c;
            const float gg = gsum[ch], ml = mloc[ch];
            const float mnew = fmaxf(gg + m, ml);
            const float decay = __expf(gg + m - mnew), sc = __expf(ml - mnew);
            const f32x4 loc = *(const f32x4*)(CT + (size_t)ch * 16384 + idx);
            u32x2 w; w.x = cvtpk(st[0], st[1]); w.y = cvtpk(st[2], st[3]);
            *(u32x2*)(CPB + (size_t)ch * 16384 + idx) = w;
            st = st * decay + loc * sc;
            if (don) {
                const float nl = nloc[(size_t)ch * 128 + tid];
                nprev[(size_t)ch * 128 + tid] = nst;
                nst = nst * decay + nl * sc;
            }
            if (sl == 0 && tid == 0) mprev[ch] = m;
            m = mnew;
        }
    }
}

DI void phase_ml_out(const P& p, int layer, int bid, int nb, char* smem) {
    const int j = layer >> 1;
    const bf16_t* projb = (const bf16_t*)(p.ws + WS_PROJ);
    const float* logi = (const float*)(p.ws + WS_LOGI);
    const float* logf = (const float*)(p.ws + WS_LOGF);
    const bf16_t* CPB = (const bf16_t*)(p.ws + WS_CPB);
    const float* nprev = (const float*)(p.ws + WS_NPREV);
    const float* mprev = (const float*)(p.ws + WS_MPREV);
    bf16_t* hcat = (bf16_t*)(p.ws + WS_HCAT);
    const float* ng_ = p.ml_norm_g + (size_t)j * MIXW;
    constexpr int LS = 136;
    bf16_t* kS = (bf16_t*)smem;
    bf16_t* vTs = kS + 128 * LS;
    float* fb = (float*)(vTs + 128 * LS);
    float* fB = fb + 128;
    float* fA = fB + 128;
    float* fW = fA + 128;
    float* fE = fW + 128;
    float* fN = fE + 128;
    for (int task = bid; task < 48 * NCH; task += nb) {
        const int tid = tid_opaque();
        const int lane = tid & 63, wid = __builtin_amdgcn_readfirstlane(tid >> 6), r = lane & 15, g = lane >> 4;
        const int bh = task >> 4, c = task & 15, b = bh / 6, h = bh % 6;
        const int t0 = b * SEQ + c * CHUNK;
        __syncthreads();
        if (wid == 0) {
            const float* lfp = logf + (size_t)bh * SEQ + c * CHUNK + 2 * lane;
            const float* lip = logi + (size_t)bh * SEQ + c * CHUNK + 2 * lane;
            const float f0 = lfp[0], f1 = lfp[1], i0 = lip[0], i1 = lip[1];
            const float mp = mprev[task];
            float ps = f0 + f1;
#pragma unroll
            for (int off = 1; off < 64; off <<= 1) { const float y = __shfl_up(ps, off, 64); if (lane >= off) ps += y; }
            const float b0 = ps - f1, b1 = ps;
            const float B0 = i0 - b0, B1 = i1 - b1;
            float pm = fmaxf(B0, B1);
#pragma unroll
            for (int off = 1; off < 64; off <<= 1) { const float y = __shfl_up(pm, off, 64); if (lane >= off) pm = fmaxf(pm, y); }
            float pmx = __shfl_up(pm, 1, 64);
            if (lane == 0) pmx = -3.0e38f;
            const float pm0 = fmaxf(pmx, B0), pm1 = pm;
            const float in0 = b0 + mp, in1 = b1 + mp;
            const float m0 = fmaxf(b0 + pm0, in0), m1 = fmaxf(b1 + pm1, in1);
            fB[2 * lane] = B0; fB[2 * lane + 1] = B1;
            fA[2 * lane] = b0 - m0; fA[2 * lane + 1] = b1 - m1;
            fW[2 * lane] = __expf(in0 - m0); fW[2 * lane + 1] = __expf(in1 - m1);
            fE[2 * lane] = __expf(-m0); fE[2 * lane + 1] = __expf(-m1);
        } else if (wid == 1) {
            fN[2 * lane] = nprev[(size_t)task * 128 + 2 * lane]; fN[2 * lane + 1] = nprev[(size_t)task * 128 + 2 * lane + 1];
        }
        {
#pragma unroll
            for (int i = 0; i < 4; ++i) {
                const int s = (tid >> 4) + 32 * i, dc = tid & 15;
                *(u32x4*)&kS[s * LS + dc * 8] = *(const u32x4*)(projb + (size_t)(t0 + s) * LDP_ML + MIXW + h * 128 + dc * 8);
            }
            const int s = tid & 127, quarter = tid >> 7;
            const bf16_t* vrow = projb + (size_t)(t0 + s) * LDP_ML + 2 * MIXW + h * 128;
#pragma unroll
            for (int i = 0; i < 4; ++i) {
                const int dc = quarter * 4 + i;
                const u32x4 vv = *(const u32x4*)(vrow + dc * 8);
#pragma unroll
                for (int q = 0; q < 4; ++q) {
                    vTs[(dc * 8 + 2 * q) * LS + s] = (bf16_t)(vv[q] & 0xffffu);
                    vTs[(dc * 8 + 2 * q + 1) * LS + s] = (bf16_t)(vv[q] >> 16);
                }
            }
        }
        __syncthreads();
        const bf16_t* cp = CPB + (size_t)task * 16384;
        {
            const int l = wid * 16 + r;
            bf16x8 qf[4];
            float qn;
            {
                const bf16_t* qrow = projb + (size_t)(t0 + l) * LDP_ML + h * 128;
                float part = 0.f;
#pragma unroll
                for (int ks = 0; ks < 4; ++ks) {
                    const u32x4 qq = *(const u32x4*)(qrow + ks * 32 + 8 * g);
                    qf[ks] = __builtin_bit_cast(bf16x8, qq);
#pragma unroll
                    for (int q = 0; q < 4; ++q) part += bflo(qq[q]) * fN[ks * 32 + 8 * g + 2 * q] + bfhi(qq[q]) * fN[ks * 32 + 8 * g + 2 * q + 1];
                }
                part = xor_add(part, 16); part = xor_add(part, 32);
                qn = part;
            }
            __builtin_amdgcn_sched_barrier(0);
            f32x4 nacc[8];
#pragma unroll
            for (int et = 0; et < 8; ++et) {
                f32x4 a = (f32x4){0.f, 0.f, 0.f, 0.f};
#pragma unroll
                for (int ks = 0; ks < 4; ++ks) {
                    const bf16x8 cf = *(const bf16x8*)(cp + (et * 16 + r) * 128 + ks * 32 + 8 * g);
                    a = mfma16(cf, qf[ks], a);
                }
                nacc[et] = a;
                if (et & 1) __builtin_amdgcn_sched_barrier(0);
            }
            const float Al = fA[l], wint = fW[l], eml = fE[l];
#pragma unroll
            for (int et = 0; et < 8; ++et) nacc[et] *= wint;
            const int stmax = wid;
            float den = 0.f;
#pragma unroll
            for (int s2 = 0; s2 < 4; ++s2) {
                if (2 * s2 <= stmax) {
                    f32x4 sa = (f32x4){0.f, 0.f, 0.f, 0.f}, sb = (f32x4){0.f, 0.f, 0.f, 0.f};
#pragma unroll
                    for (int ks = 0; ks < 4; ++ks) {
                        const bf16x8 kf = *(const bf16x8*)&kS[(s2 * 32 + r) * LS + ks * 32 + 8 * g];
                        sa = mfma16(kf, qf[ks], sa);
                    }
                    if (2 * s2 + 1 <= stmax) {
#pragma unroll
                        for (int ks = 0; ks < 4; ++ks) {
                            const bf16x8 kf = *(const bf16x8*)&kS[(s2 * 32 + 16 + r) * LS + ks * 32 + 8 * g];
                            sb = mfma16(kf, qf[ks], sb);
                        }
                    }
#pragma unroll
                    for (int i = 0; i < 4; ++i) {
                        const int s = s2 * 32 + 4 * g + i;
                        const float va = (s <= l) ? sa[i] * __expf(Al + fB[s]) : 0.f;
                        const float vb = (s + 16 <= l) ? sb[i] * __expf(Al + fB[s + 16]) : 0.f;
                        sa[i] = va; sb[i] = vb; den += va + vb;
                    }
                    u32x4 pw;
                    pw.x = cvtpk(sa[0], sa[1]); pw.y = cvtpk(sa[2], sa[3]);
                    pw.z = cvtpk(sb[0], sb[1]); pw.w = cvtpk(sb[2], sb[3]);
                    const bf16x8 pf = __builtin_bit_cast(bf16x8, pw);
#pragma unroll
                    for (int et = 0; et < 8; ++et) {
                        const bf16_t* vp = &vTs[(et * 16 + r) * LS + s2 * 32 + 4 * g];
                        const u32x2 v0 = *(const u32x2*)vp;
                        const u32x2 v1 = *(const u32x2*)(vp + 16);
                        u32x4 vw; vw.x = v0.x; vw.y = v0.y; vw.z = v1.x; vw.w = v1.y;
                        nacc[et] = mfma16(__builtin_bit_cast(bf16x8, vw), pf, nacc[et]);
                    }
                }
                __builtin_amdgcn_sched_barrier(0);
            }
            den = xor_add(den, 16); den = xor_add(den, 32);
            const float dd = fmaxf(fabsf(den + wint * qn), eml);
            const float invd = 1.0f / dd;
            float sm = 0.f;
#pragma unroll
            for (int et = 0; et < 8; ++et)
#pragma unroll
                for (int i = 0; i < 4; ++i) { nacc[et][i] *= invd; sm += nacc[et][i]; }
            sm = xor_add(sm, 16); sm = xor_add(sm, 32);
            const float mu = sm * (1.0f / 128.0f);
            float sq = 0.f;
#pragma unroll
            for (int et = 0; et < 8; ++et)
#pragma unroll
                for (int i = 0; i < 4; ++i) { const float dlt = nacc[et][i] - mu; sq += dlt * dlt; }
            sq = xor_add(sq, 16); sq = xor_add(sq, 32);
            const float rstd = rsqrtf(sq * (1.0f / 128.0f) + LN_EPS);
            const size_t trow = (size_t)(t0 + l);
            const bf16_t* og = projb + trow * LDP_ML + 3 * MIXW + h * 128;
            bf16_t* orow = hcat + trow * D + h * 128;
#pragma unroll
            for (int et = 0; et < 8; ++et) {
                const int e = et * 16 + 4 * g;
                const u32x2 ov = *(const u32x2*)(og + e);
                const f32x4 gv = *(const f32x4*)(ng_ + h * 128 + e);
                const float o0 = (nacc[et][0] - mu) * rstd * gv[0] * sigmoidf_(bflo(ov.x));
                const float o1 = (nacc[et][1] - mu) * rstd * gv[1] * sigmoidf_(bfhi(ov.x));
                const float o2 = (nacc[et][2] - mu) * rstd * gv[2] * sigmoidf_(bflo(ov.y));
                const float o3 = (nacc[et][3] - mu) * rstd * gv[3] * sigmoidf_(bfhi(ov.y));
                u32x2 w; w.x = cvtpk(o0, o1); w.y = cvtpk(o2, o3);
                *(u32x2*)(orow + e) = w;
                if (et & 1) __builtin_amdgcn_sched_barrier(0);
            }
        }
    }
}

constexpr int LN1_MAXT = 8;
DI void phase_ln1_route(const P& p, int layer, int bid, int nb, char* smem) {
    const bf16_t* z = (const bf16_t*)(p.ws + WS_Z);
    bf16_t* x1b = (bf16_t*)(p.ws + WS_X1B);
    float* gate = (float*)(p.ws + WS_GATE);
    int* list = (int*)(p.ws + WS_LIST);
    int* cnt = (int*)(p.ws + WS_CTL + CTL_CNT) + layer * 32 * CNT_STRIDE;
    const bf16_t* rwh = (const bf16_t*)(p.ws + WS_RWT);
    const bf16_t* rwl = rwh + NE * D;
    const float* lg = p.ln1_g + (size_t)layer * D;
    const float* lb = p.ln1_b + (size_t)layer * D;
    constexpr int XS = 1028;
    float* xs = (float*)smem;
    float* red = xs + 16 * XS;
    float* scs = red + 8 * 16 * 32;
    int* lcnt = (int*)(scs + 16 * 32);
    int* gbase = lcnt + 32;
    int* sel = gbase + 32;
    const int tid = tid_opaque(), lane = tid & 63, wid = tid >> 6, r = lane & 15, g = lane >> 4;
    __syncthreads();
    if (tid < 32) lcnt[tid] = 0;
    const float rb_e = p.router_b[tid & 31];
    bf16x8 wh[4][2], wl[4][2];
#pragma unroll
    for (int ks = 0; ks < 4; ++ks)
#pragma unroll
        for (int nt = 0; nt < 2; ++nt) {
            const size_t o = (size_t)(nt * 16 + r) * D + wid * 128 + ks * 32 + 8 * g;
            wh[ks][nt] = *(const bf16x8*)(rwh + o); wl[ks][nt] = *(const bf16x8*)(rwl + o);
        }
    f32x4 lgv[2][2], lbv[2][2];
#pragma unroll
    for (int i = 0; i < 2; ++i) { const int col = i * 512 + lane * 8; lgv[i][0] = *(const f32x4*)(lg + col); lgv[i][1] = *(const f32x4*)(lg + col + 4); lbv[i][0] = *(const f32x4*)(lb + col); lbv[i][1] = *(const f32x4*)(lb + col + 4); }
    u32x4 zn[2][2];
    if (bid < T / 16) {
#pragma unroll
        for (int rr = 0; rr < 2; ++rr)
#pragma unroll
            for (int i = 0; i < 2; ++i) zn[rr][i] = *(const u32x4*)(z + (size_t)(bid * 16 + wid * 2 + rr) * D + i * 512 + lane * 8);
    }
    int ti = 0;
    for (int task = bid; task < T / 16; task += nb, ++ti) {
        const int row0 = task * 16;
        u32x4 zc[2][2];
#pragma unroll
        for (int rr = 0; rr < 2; ++rr)
#pragma unroll
            for (int i = 0; i < 2; ++i) zc[rr][i] = zn[rr][i];
        if (task + nb < T / 16) {
#pragma unroll
            for (int rr = 0; rr < 2; ++rr)
#pragma unroll
                for (int i = 0; i < 2; ++i) zn[rr][i] = *(const u32x4*)(z + (size_t)((task + nb) * 16 + wid * 2 + rr) * D + i * 512 + lane * 8);
        }
        __syncthreads();
#pragma unroll
        for (int rr = 0; rr < 2; ++rr) {
            const int lr = wid * 2 + rr;
            const size_t t = (size_t)(row0 + lr);
            float v[2][8];
            float s = 0.f;
#pragma unroll
            for (int i = 0; i < 2; ++i) {
#pragma unroll
                for (int q = 0; q < 4; ++q) { v[i][2 * q] = bflo(zc[rr][i][q]); v[i][2 * q + 1] = bfhi(zc[rr][i][q]); s += v[i][2 * q] + v[i][2 * q + 1]; }
            }
            s = wave_sum(s);
            const float mu = s * (1.0f / D);
            float q2 = 0.f;
#pragma unroll
            for (int i = 0; i < 2; ++i)
#pragma unroll
                for (int k = 0; k < 8; ++k) { const float d = v[i][k] - mu; q2 += d * d; }
            q2 = wave_sum(q2);
            const float rstd = rsqrtf(q2 * (1.0f / D) + LN_EPS);
#pragma unroll
            for (int i = 0; i < 2; ++i) {
                const int col = i * 512 + lane * 8;
                const f32x4 g0 = lgv[i][0], g1 = lgv[i][1], b0 = lbv[i][0], b1 = lbv[i][1];
                f32x4 o0, o1;
#pragma unroll
                for (int k = 0; k < 4; ++k) { o0[k] = (v[i][k] - mu) * rstd * g0[k] + b0[k]; o1[k] = (v[i][4 + k] - mu) * rstd * g1[k] + b1[k]; }
                u32x4 w; w.x = cvtpk(o0[0], o0[1]); w.y = cvtpk(o0[2], o0[3]); w.z = cvtpk(o1[0], o1[1]); w.w = cvtpk(o1[2], o1[3]);
                *(u32x4*)(x1b + t * D + col) = w;
                *(f32x4*)(xs + lr * XS + col) = o0;
                *(f32x4*)(xs + lr * XS + col + 4) = o1;
            }
        }
        __syncthreads();
        {
            f32x4 acc0 = (f32x4){0.f, 0.f, 0.f, 0.f}, acc1 = (f32x4){0.f, 0.f, 0.f, 0.f};
#pragma unroll
            for (int ks = 0; ks < 4; ++ks) {
                const int k = wid * 128 + ks * 32 + 8 * g;
                const f32x4 xa0 = *(const f32x4*)(xs + r * XS + k), xa1 = *(const f32x4*)(xs + r * XS + k + 4);
                u32x4 hw, lw;
                hw.x = cvtpk(xa0[0], xa0[1]); hw.y = cvtpk(xa0[2], xa0[3]); hw.z = cvtpk(xa1[0], xa1[1]); hw.w = cvtpk(xa1[2], xa1[3]);
                lw.x = cvtpk(xa0[0] - bflo(hw.x), xa0[1] - bfhi(hw.x)); lw.y = cvtpk(xa0[2] - bflo(hw.y), xa0[3] - bfhi(hw.y));
                lw.z = cvtpk(xa1[0] - bflo(hw.z), xa1[1] - bfhi(hw.z)); lw.w = cvtpk(xa1[2] - bflo(hw.w), xa1[3] - bfhi(hw.w));
                const bf16x8 xh = __builtin_bit_cast(bf16x8, hw), xl = __builtin_bit_cast(bf16x8, lw);
                acc0 = mfma16(wh[ks][0], xh, acc0); acc0 = mfma16(wh[ks][0], xl, acc0); acc0 = mfma16(wl[ks][0], xh, acc0);
                acc1 = mfma16(wh[ks][1], xh, acc1); acc1 = mfma16(wh[ks][1], xl, acc1); acc1 = mfma16(wl[ks][1], xh, acc1);
            }
            *(f32x4*)(red + (wid * 16 + r) * 32 + 4 * g) = acc0;
            *(f32x4*)(red + (wid * 16 + r) * 32 + 16 + 4 * g) = acc1;
        }
        __syncthreads();
        {
            const int e = tid & 31, i = tid >> 5;
            float s = 0.f;
#pragma unroll
            for (int w = 0; w < 8; ++w) s += red[(w * 16 + i) * 32 + e];
            const float sc = sigmoidf_(s), sv = sc + rb_e;
            const float a1 = __shfl_xor(sv, 1, 64), a2 = __shfl_xor(sv, 2, 64), a3 = __shfl_xor(sv, 3, 64);
            const float c1 = __shfl_xor(sc, 1, 64), c2 = __shfl_xor(sc, 2, 64), c3 = __shfl_xor(sc, 3, 64);
            const float lo1 = fminf(sv, a1), hi1 = fmaxf(sv, a1), lo2 = fminf(a2, a3), hi2 = fmaxf(a2, a3);
            float bv = fmaxf(hi1, hi2) + fmaxf(fminf(hi1, hi2), fmaxf(lo1, lo2));
            int bg = e >> 2;
#pragma unroll
            for (int m = 4; m <= 16; m <<= 1) {
                const float ov = __shfl_xor(bv, m, 64); const int og = __shfl_xor(bg, m, 64);
                if (ov > bv || (ov == bv && og < bg)) { bv = ov; bg = og; }
            }
            if (e == bg * 4) {
                const float vv[4] = {sv, a1, a2, a3}, cc[4] = {sc, c1, c2, c3};
                int i1 = 0; float v1 = vv[0];
#pragma unroll
                for (int k = 1; k < 4; ++k) if (vv[k] > v1) { v1 = vv[k]; i1 = k; }
                int i2 = -1; float v2 = -3.0e38f, s1 = cc[0], s2 = 0.f;
#pragma unroll
                for (int k = 0; k < 4; ++k) { if (k == i1) s1 = cc[k]; }
#pragma unroll
                for (int k = 0; k < 4; ++k) if (k != i1 && vv[k] > v2) { v2 = vv[k]; i2 = k; s2 = cc[k]; }
                const int e1 = bg * 4 + i1, e2 = bg * 4 + i2;
                const float inv = 1.0f / (s1 + s2);
                const int t = row0 + i;
                gate[t * 2] = s1 * inv; gate[t * 2 + 1] = s2 * inv;
                const int lp1 = atomicAdd(&lcnt[e1], 1);
                const int lp2 = atomicAdd(&lcnt[e2], 1);
                if (ti < LN1_MAXT) { sel[(ti * 16 + i) * 2] = e1 | (lp1 << 8); sel[(ti * 16 + i) * 2 + 1] = e2 | (lp2 << 8); }
            }
        }
    }
    __syncthreads();
    const int tz = tid_opaque();
    if (tz < 32) { const int c = lcnt[tz]; gbase[tz] = c ? atomicAdd(&cnt[tz * CNT_STRIDE], c) : 0; }
    __syncthreads();
    if (tz < ti * 32) {
        const int tl = tz >> 5, rw = (tz >> 1) & 15, k = tz & 1;
        const int sv = sel[tz];
        const int e = sv & 255, lp = sv >> 8;
        list[(size_t)e * T + gbase[e] + lp] = ((bid + tl * nb) * 16 + rw) * 2 + k;
    }
}

DI void phase_ln2(const P& p, int layer, int bid, int nb) {
    const bf16_t* x1b = (const bf16_t*)(p.ws + WS_X1B);
    const bf16_t* yasg = (const bf16_t*)(p.ws + WS_YASG);
    bf16_t* xb = (bf16_t*)(p.ws + WS_XB);
    const float* lg = p.ln2_g + (size_t)layer * D;
    const float* lb = p.ln2_b + (size_t)layer * D;
    const int tid = tid_opaque(), lane = tid & 63, wid = tid >> 6;
    f32x4 lgv[2][2], lbv[2][2];
#pragma unroll
    for (int i = 0; i < 2; ++i) { const int col = i * 512 + lane * 8; lgv[i][0] = *(const f32x4*)(lg + col); lgv[i][1] = *(const f32x4*)(lg + col + 4); lbv[i][0] = *(const f32x4*)(lb + col); lbv[i][1] = *(const f32x4*)(lb + col + 4); }
    for (int t = bid * NWAVES + wid; t < T; t += nb * NWAVES) {
        float v[2][8];
        float s = 0.f;
#pragma unroll
        for (int i = 0; i < 2; ++i) {
            const int col = i * 512 + lane * 8;
            const u32x4 xv = *(const u32x4*)(x1b + (size_t)t * D + col);
            const u32x4 y0 = *(const u32x4*)(yasg + (size_t)(2 * t) * D + col);
            const u32x4 y1 = *(const u32x4*)(yasg + (size_t)(2 * t + 1) * D + col);
#pragma unroll
            for (int q = 0; q < 4; ++q) {
                v[i][2 * q] = bflo(xv[q]) * ALPHA + (bflo(y0[q]) + bflo(y1[q]));
                v[i][2 * q + 1] = bfhi(xv[q]) * ALPHA + (bfhi(y0[q]) + bfhi(y1[q]));
                s += v[i][2 * q] + v[i][2 * q + 1];
            }
        }
        s = wave_sum(s);
        const float mu = s * (1.0f / D);
        float q2 = 0.f;
#pragma unroll
        for (int i = 0; i < 2; ++i)
#pragma unroll
            for (int k = 0; k < 8; ++k) { const float d = v[i][k] - mu; q2 += d * d; }
        q2 = wave_sum(q2);
        const float rstd = rsqrtf(q2 * (1.0f / D) + LN_EPS);
#pragma unroll
        for (int i = 0; i < 2; ++i) {
            const int col = i * 512 + lane * 8;
            const f32x4 g0 = lgv[i][0], g1 = lgv[i][1], b0 = lbv[i][0], b1 = lbv[i][1];
            f32x4 o0, o1;
#pragma unroll
            for (int k = 0; k < 4; ++k) { o0[k] = (v[i][k] - mu) * rstd * g0[k] + b0[k]; o1[k] = (v[i][4 + k] - mu) * rstd * g1[k] + b1[k]; }
            if (layer == DEPTH - 1) {
                *(f32x4*)(p.out + (size_t)t * D + col) = o0;
                *(f32x4*)(p.out + (size_t)t * D + col + 4) = o1;
            } else {
                u32x4 w; w.x = cvtpk(o0[0], o0[1]); w.y = cvtpk(o0[2], o0[3]); w.z = cvtpk(o1[0], o1[1]); w.w = cvtpk(o1[2], o1[3]);
                *(u32x4*)(xb + (size_t)t * D + col) = w;
            }
        }
    }
}

#define XB_TMO      128
#define XB_XCNT(j)  (256  + 64 * (j))
#define XB_XSUB(j)  (1280 + 64 * (j))
#define XB_XGEN(j)  (2304 + 64 * (j))
#define XB_TOP      3328
#define XB_TOPGEN   3392
#define XCD_BAR_WORDS 3456
#define XB_SPIN_CAP (1u << 20)
DI unsigned xb_ld(unsigned* p_) { return __hip_atomic_load(p_, __ATOMIC_RELAXED, __HIP_MEMORY_SCOPE_AGENT); }
DI unsigned xb_add(unsigned* p_, unsigned v) { return __hip_atomic_fetch_add(p_, v, __ATOMIC_RELAXED, __HIP_MEMORY_SCOPE_AGENT); }
DI unsigned xb_xcc_id() { return (unsigned)__builtin_amdgcn_s_getreg((3 << 11) | 20) & 0xFu; }
#define XB_SPIN(cond, bar) do { unsigned _sp = 0; while (cond) { __builtin_amdgcn_s_sleep(1); \
    if ((++_sp & 255u) == 0u) { if (xb_ld(&(bar)[XB_TMO])) break; if (_sp > XB_SPIN_CAP) { atomicAdd(&(bar)[XB_TMO], 1u); break; } } } } while (0)
struct XcdBarrier { unsigned* bar; unsigned x; volatile LAS unsigned* st; };
DI XcdBarrier xcd_barrier_post(unsigned* bar, volatile LAS unsigned* st) {
    XcdBarrier b; b.bar = bar; b.x = xb_xcc_id(); b.st = st;
    if (threadIdx.x == 0) (void)xb_add(&bar[XB_XCNT(b.x)], 1u);
    return b;
}
DI void xcd_barrier_complete(unsigned* bar, unsigned x, unsigned& nloc, unsigned& nx) {
    const unsigned G = gridDim.x * gridDim.y * gridDim.z;
    unsigned sum, cnt, mine, sp = 0u;
    for (;;) {
        sum = 0u; cnt = 0u; mine = 0u;
#pragma unroll
        for (unsigned j = 0; j < 16; ++j) { const unsigned c = xb_ld(&bar[XB_XCNT(j)]); sum += c; cnt += (c > 0u) ? 1u : 0u; mine = (j == x) ? c : mine; }
        if (sum == G) break;
        __builtin_amdgcn_s_sleep(1);
        if ((++sp & 255u) == 0u) { if (xb_ld(&bar[XB_TMO])) break; if (sp > XB_SPIN_CAP) { atomicAdd(&bar[XB_TMO], 1u); break; } }
    }
    nloc = mine > 0u ? mine : 1u; nx = cnt > 0u ? cnt : 1u;
}
DI void xcd_barrier(const XcdBarrier& b) {
    asm volatile("s_waitcnt vmcnt(0)" ::: "memory");
    __syncthreads();
    if (tid_opaque() == 0) {
        unsigned* bar = b.bar;
        __builtin_amdgcn_s_waitcnt(0);
        unsigned nloc = b.st[0], nx = b.st[1];
        if (nloc == 0u) { xcd_barrier_complete(bar, b.x, nloc, nx); b.st[0] = nloc; b.st[1] = nx; }
        const unsigned old = xb_add(&bar[XB_XSUB(b.x)], 1u);
        const unsigned gen = old / nloc;
        if (old + 1u == (gen + 1u) * nloc) {
            __builtin_amdgcn_fence(__ATOMIC_RELEASE, "agent");
            asm volatile("s_waitcnt vmcnt(0)" ::: "memory");
            const unsigned og = xb_add(&bar[XB_TOP], 1u);
            const unsigned tg = og / nx;
            if (og + 1u == (tg + 1u) * nx) xb_add(&bar[XB_TOPGEN], 1u);
            else XB_SPIN(xb_ld(&bar[XB_TOPGEN]) == tg, bar);
            __builtin_amdgcn_fence(__ATOMIC_ACQUIRE, "agent");
            xb_add(&bar[XB_XGEN(b.x)], 1u);
            asm volatile("s_waitcnt vmcnt(0)" ::: "memory");
        } else {
            XB_SPIN(xb_ld(&bar[XB_XGEN(b.x)]) == gen, bar);
            __builtin_amdgcn_fence(__ATOMIC_ACQUIRE, "agent");
            asm volatile("s_waitcnt vmcnt(0)" ::: "memory");
        }
    }
    __syncthreads();
}

enum { PH_INPROJ = 0, PH_MIX1, PH_MIX2, PH_MIX3, PH_OUTPROJ, PH_LN1, PH_MOEUP, PH_MOEDOWN, PH_LN2, PH_PER_LAYER, PH_PREP = 100, PH_KV = 101 };

DI void run_phase(const P& p, int ph, int layer, int bid, int nb, char* smem) {
    const bool conv = (layer & 1) == 0;
    if (ph == PH_PREP) phase_prep(p, bid, nb, smem);
    if (ph == PH_KV) phase_kv(p, bid, nb, smem);
    if (ph == PH_INPROJ) phase_inproj(p, layer, bid, nb, smem);
    if (ph == PH_MIX1) phase_ml_local(p, bid, nb, smem);
    if (ph == PH_MIX2) phase_ml_scan(p, bid, nb);
    if (ph == PH_MIX3) {
        if (conv) phase_convmix(p, layer, bid, nb);
        else phase_ml_out(p, layer, bid, nb, smem);
    }
    if (ph == PH_MIX1 || (ph == PH_MIX3 && conv)) phase_xattn(p, layer, bid, nb, smem);
    if (ph == PH_OUTPROJ) phase_outproj(p, layer, bid, nb, smem);
    if (ph == PH_LN1) { phase_ln1_route(p, layer, bid, nb, smem); if (layer > 0) moe_steal(p, 1 << 20, (layer + 1) * MOE_TILES_PER_LAYER, smem); }
    if (ph == PH_MOEUP) phase_moe_up(p, layer, bid, nb, smem);
    if (ph == PH_MOEDOWN) phase_moe_down(p, layer, bid, nb, smem);
    if (ph == PH_LN2) phase_ln2(p, layer, bid, nb);
}

__global__ void __launch_bounds__(NTHREADS, 2) mega(P p) {
    __shared__ __attribute__((aligned(16))) char smem[SMEM_BYTES];
    const int bid = blockIdx.x, nb = gridDim.x;
    volatile LAS unsigned* st = (volatile LAS unsigned*)(smem + SMEM_BYTES - 16);
    if (threadIdx.x == 0) { st[0] = 0u; st[1] = 0u; }
    __syncthreads();
    XcdBarrier xb = xcd_barrier_post((unsigned*)(p.ws + WS_CTL), st);
#pragma unroll 1
    for (int s = -2; s < DEPTH * PH_PER_LAYER; ++s) {
        int ph = (s == -2) ? (int)PH_PREP : (s == -1) ? (int)PH_KV : s % PH_PER_LAYER;
        int layer = (s < 0) ? 0 : s / PH_PER_LAYER;
        if ((layer & 1) == 0 && (ph == PH_MIX1 || ph == PH_MIX2)) continue;
        int b_ = bid, n_ = nb;
        asm volatile("" : "+s"(ph), "+s"(layer), "+s"(b_), "+s"(n_));
        P q = p;
        asm volatile("" : "+s"(q.ws));
        run_phase(q, ph, layer, b_, n_, smem);
#ifdef PROBE_MASK
        if (ph < 31 && ((PROBE_MASK >> ph) & 1)) { __syncthreads(); run_phase(q, ph, layer, b_, n_, smem); }
#endif
        if (ph != PH_KV) xcd_barrier(xb);
    }
}

extern "C" void kernel_launch(void* const* d_in, const int* in_sizes, int n_in, void* d_out, int out_size, void* d_ws, size_t ws_size,
                              hipStream_t stream) {
    if (ws_size < WS_TOTAL) { fprintf(stderr, "kernel_launch: workspace too small: %zu < %zu\n", ws_size, (size_t)WS_TOTAL); return; }
    static int grid_blocks = 0;
    if (!grid_blocks) {
        int dev = 0, cus = 0, per_cu = 0;
        (void)hipGetDevice(&dev);
        (void)hipDeviceGetAttribute(&cus, hipDeviceAttributeMultiprocessorCount, dev);
        if (hipOccupancyMaxActiveBlocksPerMultiprocessor(&per_cu, (const void*)mega, NTHREADS, 0) != hipSuccess) per_cu = 0;
        if (per_cu < 1 || cus < 1) { fprintf(stderr, "kernel_launch: occupancy query failed (per_cu=%d cus=%d)\n", per_cu, cus); return; }
        grid_blocks = cus;
    }
    P p{};
    p.x = (const float*)d_in[0]; p.mem = (const float*)d_in[1]; p.conv_w_in = (const float*)d_in[2]; p.conv_w = (const float*)d_in[3];
    p.ml_w_in = (const float*)d_in[4]; p.ml_gate_b = (const float*)d_in[5]; p.ml_norm_g = (const float*)d_in[6]; p.w_kv = (const float*)d_in[7];
    p.w_out = (const float*)d_in[8]; p.ln1_g = (const float*)d_in[9]; p.ln1_b = (const float*)d_in[10]; p.ln2_g = (const float*)d_in[11];
    p.ln2_b = (const float*)d_in[12]; p.router_w = (const float*)d_in[13]; p.router_b = (const float*)d_in[14]; p.w_gate = (const float*)d_in[15];
    p.w_up = (const float*)d_in[16]; p.w_down = (const float*)d_in[17];
    p.out = (float*)d_out; p.ws = (char*)d_ws;
    (void)hipMemsetAsync((char*)d_ws + WS_CTL, 0, CTL_BYTES, stream);
    void* args[] = {&p};
    hipError_t e = hipLaunchCooperativeKernel((const void*)mega, dim3(grid_blocks), dim3(NTHREADS), args, 0, stream);
    if (e != hipSuccess) fprintf(stderr, "kernel_launch: cooperative launch failed: %s (grid %d)\n", hipGetErrorString(e), grid_blocks);
}
```

```cpp
#include <hip/hip_runtime.h>
#include <stdint.h>
#include <stdio.h>

typedef unsigned short bf16_t;
typedef __attribute__((ext_vector_type(8))) short bf16x8;
typedef __attribute__((ext_vector_type(4))) float f32x4;
typedef __attribute__((ext_vector_type(4))) unsigned u32x4;
typedef __attribute__((ext_vector_type(2))) unsigned u32x2;

#define DI __device__ __forceinline__
#define LAS __attribute__((address_space(3)))

constexpr int D = 1024;
constexpr int NBATCH = 8;
constexpr int SEQ = 2048;
constexpr int T = NBATCH * SEQ;
constexpr int DEPTH = 4;
constexpr int MIXW = 768;
constexpr int XH = 4, XDH = 64, XW = 256, MEML = 256;
constexpr int MLH = 6, MLDH = 128, CHUNK = 128, NCH = SEQ / CHUNK;
constexpr int DIN_CONV = 2560, DIN_ML = 3340, LDP_ML = 3328, NV_ML = 3584;
constexpr int NE = 32, DFF = 512;
constexpr float ALPHA = 1.681792830507429f;
constexpr float LN_EPS = 1e-5f;

constexpr int NTHREADS = 512;
constexpr int NWAVES = 8;
constexpr int STAGE_BYTES = 131072;
constexpr int META_OFF = STAGE_BYTES;
constexpr int SMEM_BYTES = STAGE_BYTES + 4096;

constexpr size_t al256(size_t x) { return (x + 255) & ~(size_t)255; }
constexpr size_t WS_CTL   = 0;
constexpr size_t CTL_BYTES = 128 * 1024;
constexpr size_t CTL_CNT  = 32 * 1024;
constexpr int CNT_STRIDE = 64;
constexpr size_t CTL_READY = 64 * 1024;
constexpr size_t CTL_TMO  = 15 * 1024;
constexpr size_t CTL_TQ   = 16 * 1024;
constexpr size_t WS_XB    = WS_CTL + CTL_BYTES;
constexpr size_t WS_MEMB  = WS_XB + (size_t)T * D * 2;
constexpr size_t WS_KBUF  = WS_MEMB + (size_t)NBATCH * MEML * D * 2;
constexpr size_t WS_VT    = WS_KBUF + (size_t)DEPTH * NBATCH * MEML * XW * 2;
constexpr size_t WS_PROJ  = WS_VT + (size_t)DEPTH * NBATCH * MEML * XW * 2;
constexpr size_t WS_Z     = WS_PROJ;
constexpr size_t WS_LOGI  = WS_PROJ + (size_t)T * LDP_ML * 2;
constexpr size_t WS_LOGF  = WS_LOGI + (size_t)NBATCH * MLH * SEQ * 4;
constexpr size_t WS_CT    = WS_LOGF + (size_t)NBATCH * MLH * SEQ * 4;
constexpr size_t WS_CPB   = WS_CT + (size_t)48 * NCH * 128 * 128 * 4;
constexpr size_t WS_NLOC  = WS_CPB + (size_t)48 * NCH * 128 * 128 * 2;
constexpr size_t WS_NPREV = WS_NLOC + (size_t)48 * NCH * 128 * 4;
constexpr size_t WS_MLOC  = WS_NPREV + (size_t)48 * NCH * 128 * 4;
constexpr size_t WS_GSUM  = WS_MLOC + al256(48 * NCH * 4);
constexpr size_t WS_MPREV = WS_GSUM + al256(48 * NCH * 4);
constexpr size_t WS_HCAT  = WS_MPREV + al256(48 * NCH * 4);
constexpr size_t WS_X1B   = WS_HCAT + (size_t)T * D * 2;
constexpr size_t WS_GATE  = WS_X1B + (size_t)T * D * 2;
constexpr size_t WS_LIST  = WS_GATE + (size_t)T * 2 * 4;
constexpr size_t WS_HBUF  = WS_LIST + (size_t)NE * T * 4;
constexpr size_t WS_YASG  = WS_HBUF + (size_t)T * 2 * DFF * 2;
constexpr size_t WS_WIN   = WS_YASG + (size_t)T * 2 * D * 2;
constexpr size_t WS_WKV   = WS_WIN + ((size_t)2 * DIN_CONV + (size_t)2 * NV_ML) * D * 2;
constexpr size_t WS_WOUT  = WS_WKV + (size_t)DEPTH * 512 * D * 2;
constexpr size_t WS_WGU   = WS_WOUT + (size_t)DEPTH * D * D * 2;
constexpr size_t WS_WD    = WS_WGU + (size_t)DEPTH * NE * 1024 * D * 2;
constexpr size_t WS_RWT   = WS_WD + (size_t)DEPTH * NE * D * DFF * 2;
constexpr size_t WS_TOTAL = WS_RWT + (size_t)2 * NE * D * 2;

struct P {
    const float *x, *mem, *conv_w_in, *conv_w, *ml_w_in, *ml_gate_b, *ml_norm_g, *w_kv, *w_out;
    const float *ln1_g, *ln1_b, *ln2_g, *ln2_b, *router_w, *router_b, *w_gate, *w_up, *w_down;
    float* out;
    char* ws;
};

DI unsigned cvtpk(float lo, float hi) { unsigned r; asm("v_cvt_pk_bf16_f32 %0, %1, %2" : "=v"(r) : "v"(lo), "v"(hi)); return r; }
DI float bf2f(bf16_t v) { return __uint_as_float(((unsigned)v) << 16); }
DI float bflo(unsigned v) { return __uint_as_float(v << 16); }
DI float bfhi(unsigned v) { return __uint_as_float(v & 0xffff0000u); }
DI bf16_t f2bf(float f) { return (bf16_t)(cvtpk(f, f) & 0xffffu); }
DI float sigmoidf_(float x) { return 1.0f / (1.0f + __expf(-x)); }
DI float logsigmoidf_(float x) { return fminf(x, 0.0f) - log1pf(__expf(-fabsf(x))); }
DI float xor_add(float v, int m) { return v + __shfl_xor(v, m, 64); }
DI float xor_max(float v, int m) { return fmaxf(v, __shfl_xor(v, m, 64)); }
DI float wave_sum(float v) { v = xor_add(v, 32); v = xor_add(v, 16); v = xor_add(v, 8); v = xor_add(v, 4); v = xor_add(v, 2); v = xor_add(v, 1); return v; }
DI int tid_opaque() { int t = threadIdx.x; asm volatile("" : "+v"(t)); return t; }
DI f32x4 mfma16(bf16x8 a, bf16x8 b, f32x4 c) { return __builtin_amdgcn_mfma_f32_16x16x32_bf16(a, b, c, 0, 0, 0); }

namespace g8 {
constexpr int BM = 256, BK = 64, HALF = 128, HTB = HALF * BK * 2, NXCD = 8, WGM = 8;
DI int lds_byte(int r, int c) { const int st = (r >> 4) * 2 + (c >> 5), rr = r & 15, cc = c & 31, ob = rr * 64 + cc * 2; return st * 1024 + (ob ^ (((ob >> 9) & 1) << 5)); }
DI void stage_rc(int b, int& R, int& C) { const int st = b / 1024, sb = b % 1024, swz = sb ^ (((sb >> 9) & 1) << 5); R = (st >> 1) * 16 + swz / 64; C = (st & 1) * 32 + (swz % 64) / 2; }
DI int perm32(int rho) { const int n = rho >> 4, i = rho & 15; return 8 * (i >> 2) + 4 * n + (i & 3); }
DI int xcd_remap(int L, int n) { const int q = n / NXCD, r = n % NXCD, xcd = L % NXCD, off = L / NXCD; return (xcd < r ? xcd * (q + 1) : r * (q + 1) + (xcd - r) * q) + off; }

struct Unit { int pm, pn, e, valid, rbase, rti; };
DI const char* uni(const char* p_) {
    const unsigned long long v = (unsigned long long)p_;
    const unsigned lo = (unsigned)__builtin_amdgcn_readfirstlane((int)(unsigned)v), hi = (unsigned)__builtin_amdgcn_readfirstlane((int)(unsigned)(v >> 32));
    return (const char*)(((unsigned long long)hi << 32) | lo);
}

template <bool GATHER, class Epi, class Sched>
DI void gemm_phase(LAS unsigned char* lds, const int K, const Sched& S, const Epi& E) {
    const int tid = tid_opaque(), wid = __builtin_amdgcn_readfirstlane(tid >> 6), lane = tid & 63, wr = wid >> 2, wc = wid & 3, fr = lane & 15, fq = lane >> 4;
    const int nt = K / BK;
    const size_t kstep = (size_t)(BK * 2);
    const size_t hstep = (size_t)HALF * K * 2;
    unsigned vB0, vB1;
    {
        int R0, C0, R1, C1;
        stage_rc(tid * 16, R0, C0); stage_rc(tid * 16 + 8192, R1, C1);
        const int Rb0 = Epi::PERM ? ((R0 & ~31) + perm32(R0 & 31)) : R0, Rb1 = Epi::PERM ? ((R1 & ~31) + perm32(R1 & 31)) : R1;
        vB0 = (unsigned)(Rb0 * K + C0) * 2u; vB1 = (unsigned)(Rb1 * K + C1) * 2u;
    }
    const unsigned ldsw = (unsigned)wid * 1024u;
    const int aoff = lds_byte(wr * 64 + fr, fq * 8), boff = lds_byte(wc * 32 + fr, fq * 8);
#define G8_SA(b, h) (((b) * 2 + (h)) * HTB)
#define G8_SB(b, h) ((4 + (b) * 2 + (h)) * HTB)
#define G8_STAGE(bufoff, gbase, v0, v1) do { unsigned _o0 = (v0), _o1 = (v1); asm volatile("" : "+v"(_o0), "+v"(_o1));     \
        __builtin_amdgcn_global_load_lds((const unsigned*)((const char*)(gbase) + _o0), (LAS unsigned*)(lds + (bufoff) + ldsw), 16, 0, 0); \
        __builtin_amdgcn_global_load_lds((const unsigned*)((const char*)(gbase) + _o1), (LAS unsigned*)(lds + (bufoff) + ldsw + 8192), 16, 0, 0); } while (0)
#define G8_LDA(dst, b, h) do { _Pragma("unroll") for (int m = 0; m < 4; ++m) _Pragma("unroll") for (int k = 0; k < 2; ++k) dst[m][k] = *(const LAS bf16x8*)(lds + G8_SA(b, h) + aoff + m * 2048 + k * 1024); } while (0)
#define G8_LDB(dst, b, h) do { _Pragma("unroll") for (int n = 0; n < 2; ++n) _Pragma("unroll") for (int k = 0; k < 2; ++k) dst[n][k] = *(const LAS bf16x8*)(lds + G8_SB(b, h) + boff + n * 2048 + k * 1024); } while (0)
#define G8_MMA(ai, bj, At, Bt) do { __builtin_amdgcn_s_setprio(1); _Pragma("unroll") for (int m = 0; m < 4; ++m) _Pragma("unroll") for (int n = 0; n < 2; ++n) _Pragma("unroll") for (int k = 0; k < 2; ++k) \
        acc[ai][bj][m][n] = __builtin_amdgcn_mfma_f32_16x16x32_bf16(Bt[n][k], At[m][k], acc[ai][bj][m][n], 0, 0, 0); __builtin_amdgcn_s_setprio(0); } while (0)
#define G8_WAIT_V(n) asm volatile("s_waitcnt vmcnt(" #n ")" ::: "memory")
#define G8_WAIT_L(n) asm volatile("s_waitcnt lgkmcnt(" #n ")" ::: "memory")
#define G8_BAR __builtin_amdgcn_s_barrier()
#define G8_SCHED __builtin_amdgcn_sched_barrier(0)
    Unit cur, nxt;
    int ui = 0;
    if (!S.next(0, cur)) return;
    f32x4 acc[2][2][4][2];
#pragma unroll
    for (int a = 0; a < 2; ++a)
#pragma unroll
        for (int b = 0; b < 2; ++b)
#pragma unroll
            for (int m = 0; m < 4; ++m)
#pragma unroll
                for (int n = 0; n < 2; ++n) acc[a][b][m][n] = (f32x4){0.f, 0.f, 0.f, 0.f};
    bf16x8 At[4][2], B0[2][2], B1[2][2];
    S.a_ready(cur);
    const char* cA = S.a_base(cur);
    const char* cB = S.b_base(cur);
    unsigned cv00, cv01, cv10, cv11, nv00, nv01, nv10, nv11;
    {
        int R0, C0, R1, C1;
        stage_rc(tid * 16, R0, C0); stage_rc(tid * 16 + 8192, R1, C1);
        int rows[2][2];
        S.a_rows(cur, R0, R1, rows);
        cv00 = (unsigned)(rows[0][0] * K + C0) * 2u; cv01 = (unsigned)(rows[0][1] * K + C1) * 2u;
        cv10 = (unsigned)(rows[1][0] * K + C0) * 2u; cv11 = (unsigned)(rows[1][1] * K + C1) * 2u;
        nv00 = cv00; nv01 = cv01; nv10 = cv10; nv11 = cv11;
    }
    G8_STAGE(G8_SB(0, 0), uni(cB), vB0, vB1); G8_STAGE(G8_SA(0, 0), uni(cA), cv00, cv01); G8_STAGE(G8_SB(0, 1), uni(cB + hstep), vB0, vB1); G8_STAGE(G8_SA(0, 1), uni(cA), cv10, cv11);
    if (wr == 1) G8_BAR;
    G8_WAIT_V(4); G8_BAR;
    G8_STAGE(G8_SB(1, 0), uni(cB + kstep), vB0, vB1); G8_STAGE(G8_SA(1, 0), uni(cA + kstep), cv00, cv01); G8_STAGE(G8_SB(1, 1), uni(cB + hstep + kstep), vB0, vB1);
    G8_WAIT_V(6); G8_BAR;
    for (;;) {
        const bool has_next = S.next(ui + 1, nxt);
        const char* nA = has_next ? S.a_base(nxt) : cA;
        const char* nB = has_next ? S.b_base(nxt) : cB;
        if (GATHER) {
            if (has_next) {
                const int tid2 = tid_opaque();
                int R0, C0, R1, C1;
                stage_rc(tid2 * 16, R0, C0); stage_rc(tid2 * 16 + 8192, R1, C1);
                int rows[2][2];
                S.a_rows(nxt, R0, R1, rows);
                nv00 = (unsigned)(rows[0][0] * K + C0) * 2u; nv01 = (unsigned)(rows[0][1] * K + C1) * 2u;
                nv10 = (unsigned)(rows[1][0] * K + C0) * 2u; nv11 = (unsigned)(rows[1][1] * K + C1) * 2u;
            } else { nv00 = cv00; nv01 = cv01; nv10 = cv10; nv11 = cv11; }
        }
        for (int t = 0; t < nt; t += 2) {
            const bool last = (t == nt - 2);
            if (last && has_next) S.a_ready(nxt);
            const char* a1 = uni(cA + (size_t)(t + 1) * kstep);
            const char* a2 = uni(last ? nA : cA + (size_t)(t + 2) * kstep);
            const char* b2 = uni(last ? nB : cB + (size_t)(t + 2) * kstep);
            const char* a3 = uni(a2 + kstep);
            const char* b3 = uni(b2 + kstep);
            const char* b2h = uni(b2 + hstep);
            const char* b3h = uni(b3 + hstep);
            unsigned x00 = cv00, x01 = cv01, x10 = cv10, x11 = cv11;
            if (GATHER) { x00 = last ? nv00 : cv00; x01 = last ? nv01 : cv01; x10 = last ? nv10 : cv10; x11 = last ? nv11 : cv11; }
            G8_LDB(B0, 0, 0); G8_SCHED; G8_LDA(At, 0, 0); G8_STAGE(G8_SA(1, 1), a1, cv10, cv11);
            G8_WAIT_L(8); G8_BAR; G8_WAIT_L(0); G8_MMA(0, 0, At, B0); G8_BAR; G8_SCHED;
            G8_LDB(B1, 0, 1); G8_STAGE(G8_SB(0, 0), b2, vB0, vB1);
            G8_BAR; G8_WAIT_L(0); G8_MMA(0, 1, At, B1); G8_BAR;
            G8_LDA(At, 0, 1); G8_STAGE(G8_SA(0, 0), a2, x00, x01);
            G8_BAR; G8_WAIT_L(0); G8_MMA(1, 0, At, B0); G8_BAR; G8_SCHED;
            G8_STAGE(G8_SB(0, 1), b2h, vB0, vB1);
            G8_WAIT_V(6);
            G8_BAR; G8_MMA(1, 1, At, B1); G8_BAR;
            G8_LDB(B0, 1, 0); G8_SCHED; G8_LDA(At, 1, 0); G8_STAGE(G8_SA(0, 1), a2, x10, x11);
            G8_WAIT_L(8); G8_BAR; G8_WAIT_L(0); G8_MMA(0, 0, At, B0); G8_BAR; G8_SCHED;
            G8_LDB(B1, 1, 1); G8_STAGE(G8_SB(1, 0), b3, vB0, vB1);
            G8_BAR; G8_WAIT_L(0); G8_MMA(0, 1, At, B1); G8_BAR;
            G8_LDA(At, 1, 1); G8_STAGE(G8_SA(1, 0), a3, x00, x01);
            G8_BAR; G8_WAIT_L(0); G8_MMA(1, 0, At, B0); G8_BAR; G8_SCHED;
            G8_STAGE(G8_SB(1, 1), b3h, vB0, vB1);
            G8_WAIT_V(6); G8_BAR; G8_MMA(1, 1, At, B1); G8_BAR;
        }
        E(acc, cur, wr, wc, fr, fq);
        if (!has_next) break;
#pragma unroll
        for (int a = 0; a < 2; ++a)
#pragma unroll
            for (int b = 0; b < 2; ++b)
#pragma unroll
                for (int m = 0; m < 4; ++m)
#pragma unroll
                    for (int n = 0; n < 2; ++n) acc[a][b][m][n] = (f32x4){0.f, 0.f, 0.f, 0.f};
        cur = nxt; cA = nA; cB = nB; ++ui;
        if (GATHER) { cv00 = nv00; cv01 = nv01; cv10 = nv10; cv11 = nv11; }
    }
    G8_WAIT_V(0);
    if (wr == 0) G8_BAR;
    G8_BAR;
#undef G8_SA
#undef G8_SB
#undef G8_STAGE
#undef G8_LDA
#undef G8_LDB
#undef G8_MMA
#undef G8_WAIT_V
#undef G8_WAIT_L
#undef G8_BAR
#undef G8_SCHED
}

struct DenseSched {
    const char* A; const char* Bt; int K, nM, nN, nwg, G, c;
    DI void init(const void* A_, const void* Bt_, int M, int N, int K_, int G_, int c_) { A = (const char*)A_; Bt = (const char*)Bt_; K = K_; nM = M / BM; nN = N / BM; nwg = nM * nN; G = G_; c = c_; }
    DI bool next(int i, Unit& u) const {
        const int L = i * G + c;
        if (L >= nwg) return false;
        const int wgid = xcd_remap(L, nwg);
        const int nig = WGM * nN, gid = wgid / nig, fm = gid * WGM, gsz = (nM - fm) < WGM ? (nM - fm) : WGM;
        u.pm = fm + ((wgid % nig) % gsz); u.pn = (wgid % nig) / gsz; u.e = 0; u.valid = 256; u.rbase = 0; u.rti = 0;
        return true;
    }
    DI const char* a_base(const Unit& u) const { return A + (size_t)u.pm * 256 * K * 2; }
    DI const char* b_base(const Unit& u) const { return Bt + (size_t)u.pn * 256 * K * 2; }
    DI void a_rows(const Unit&, int R0, int R1, int (&rows)[2][2]) const { rows[0][0] = R0; rows[0][1] = R1; rows[1][0] = 128 + R0; rows[1][1] = 128 + R1; }
    DI void a_ready(const Unit&) const {}
};
}

struct TJ { const float* s[4]; float sc[4]; bf16_t* d[2]; };

template <class ColPtr>
DI void tj_make(TJ& j, ColPtr colptr, int ld, int k0, int v0, bf16_t* dst, int K, int tid) {
#pragma unroll
    for (int i = 0; i < 4; ++i) {
        const int idx = tid + NTHREADS * i, kr = idx >> 5, c4 = idx & 31;
        float sc;
        const float* src = colptr(v0 + 4 * c4, sc);
        j.s[i] = src + (size_t)(k0 + kr) * ld; j.sc[i] = sc;
    }
#pragma unroll
    for (int i = 0; i < 2; ++i) {
        const int ch = tid + NTHREADS * i, vr = ch >> 3, kc = ch & 7;
        j.d[i] = dst + (size_t)(v0 + vr) * K + k0 + kc * 8;
    }
}
DI void tj_load(const TJ& j, f32x4 (&v)[4]) {
#pragma unroll
    for (int i = 0; i < 4; ++i) v[i] = *(const f32x4*)j.s[i];
}
DI void tj_finish(const TJ& j, const f32x4 (&v)[4], float* tile, int tid) {
    constexpr int TS = 129;
    __syncthreads();
#pragma unroll
    for (int i = 0; i < 4; ++i) {
        const int idx = tid + NTHREADS * i, kr = idx >> 5, c4 = idx & 31;
        float* tp = tile + kr * TS + 4 * c4;
        tp[0] = v[i][0] * j.sc[i]; tp[1] = v[i][1] * j.sc[i]; tp[2] = v[i][2] * j.sc[i]; tp[3] = v[i][3] * j.sc[i];
    }
    __syncthreads();
#pragma unroll
    for (int i = 0; i < 2; ++i) {
        const int ch = tid + NTHREADS * i, vr = ch >> 3, kc = ch & 7;
        const float* tp = tile + (kc * 8) * TS + vr;
        u32x4 w;
        w.x = cvtpk(tp[0], tp[TS]); w.y = cvtpk(tp[2 * TS], tp[3 * TS]); w.z = cvtpk(tp[4 * TS], tp[5 * TS]); w.w = cvtpk(tp[6 * TS], tp[7 * TS]);
        *(u32x4*)j.d[i] = w;
    }
}

constexpr int MOE_TILES_PER_LAYER = NE * (16 * 8 + 8 * 8);
DI void moe_tile_job(const P& p, int q, int tid, TJ& j) {
    const int layer = q / MOE_TILES_PER_LAYER, r = q % MOE_TILES_PER_LAYER;
    if (r < NE * 128) {
        const int le = layer * NE + (r >> 7), qq = r & 127, kt = qq >> 3, vt = qq & 7;
        const float* Wg = p.w_gate + (size_t)le * D * DFF;
        const float* Wu = p.w_up + (size_t)le * D * DFF;
        tj_make(j, [&](int v4, float& sc) { sc = 1.0f; const int grp = v4 >> 7; return ((grp & 1) ? Wu : Wg) + (grp >> 1) * 128 + (v4 & 127); },
                DFF, kt * 64, vt * 128, (bf16_t*)(p.ws + WS_WGU) + (size_t)le * 1024 * D, D, tid);
    } else {
        const int r2 = r - NE * 128, le = layer * NE + (r2 >> 6), qq = r2 & 63, kt = qq >> 3, vt = qq & 7;
        const float* W = p.w_down + (size_t)le * DFF * D;
        tj_make(j, [&](int v4, float& sc) { sc = 1.0f; return W + v4; }, D, kt * 64, vt * 128, (bf16_t*)(p.ws + WS_WD) + (size_t)le * D * DFF, DFF, tid);
    }
}

constexpr int PT_CONV = 16 * 20, PT_ML = 16 * 28, PT_KV = 16 * 4, PT_OUT = 16 * 8;
constexpr int PN0 = 2 * PT_CONV, PN1 = PN0 + 2 * PT_ML, PN2 = PN1 + 4 * PT_KV, PN3 = PN2 + 4 * PT_OUT, PN5 = PN3 + MOE_TILES_PER_LAYER;
DI void prep_tile_job(const P& p, int it, int tid, TJ& j) {
    if (it < PN0) {
        const int jj = it / PT_CONV, q = it % PT_CONV, kt = q / 20, vt = q % 20;
        const float* W = p.conv_w_in + (size_t)jj * D * DIN_CONV;
        tj_make(j, [&](int v4, float& sc) { sc = 1.0f; return W + v4; }, DIN_CONV, kt * 64, vt * 128, (bf16_t*)(p.ws + WS_WIN) + (size_t)jj * DIN_CONV * D, D, tid);
    } else if (it < PN1) {
        const int r = it - PN0, jj = r / PT_ML, q = r % PT_ML, kt = q / 28, vt = q % 28;
        const float* W = p.ml_w_in + (size_t)jj * D * DIN_ML;
        tj_make(j, [&](int v4, float& sc) -> const float* {
                    sc = (v4 >= MIXW && v4 < 2 * MIXW) ? 0.08838834764831845f : 1.0f;
                    if (v4 < 3072) return W + v4;
                    if (v4 < 3328) return W + 3084 + (v4 - 3072);
                    if (v4 < 3340) return W + 3072 + (v4 - 3328);
                    sc = 0.0f; return W; },
                DIN_ML, kt * 64, vt * 128, (bf16_t*)(p.ws + WS_WIN) + ((size_t)2 * DIN_CONV + (size_t)jj * NV_ML) * D, D, tid);
    } else if (it < PN2) {
        const int r = it - PN1, l = r / PT_KV, q = r % PT_KV, kt = q / 4, vt = q % 4;
        const float* W = p.w_kv + (size_t)l * D * 512;
        tj_make(j, [&](int v4, float& sc) { sc = 1.0f; return W + v4; }, 512, kt * 64, vt * 128, (bf16_t*)(p.ws + WS_WKV) + (size_t)l * 512 * D, D, tid);
    } else if (it < PN3) {
        const int r = it - PN2, l = r / PT_OUT, q = r % PT_OUT, kt = q / 8, vt = q % 8;
        const float* W = p.w_out + (size_t)l * D * D;
        tj_make(j, [&](int v4, float& sc) { sc = 1.0f; return W + v4; }, D, kt * 64, vt * 128, (bf16_t*)(p.ws + WS_WOUT) + (size_t)l * D * D, D, tid);
    } else {
        moe_tile_job(p, it - PN3, tid, j);
    }
}

DI void phase_prep(const P& p, int bid, int nb, char* smem) {
    const int tid = tid_opaque();
    bf16_t* xb = (bf16_t*)(p.ws + WS_XB);
    bf16_t* memb = (bf16_t*)(p.ws + WS_MEMB);
    {
        const size_t nx = (size_t)T * D / 4, nm = (size_t)NBATCH * MEML * D / 4;
        for (size_t i = (size_t)bid * NTHREADS + tid; i < nx + nm; i += (size_t)nb * NTHREADS) {
            if (i < nx) { f32x4 v = ((const f32x4*)p.x)[i]; u32x2 w; w.x = cvtpk(v[0], v[1]); w.y = cvtpk(v[2], v[3]); ((u32x2*)xb)[i] = w; }
            else { size_t j = i - nx; f32x4 v = ((const f32x4*)p.mem)[j]; u32x2 w; w.x = cvtpk(v[0], v[1]); w.y = cvtpk(v[2], v[3]); ((u32x2*)memb)[j] = w; }
        }
    }
    {
        bf16_t* rwt = (bf16_t*)(p.ws + WS_RWT);
        for (int i = bid * NTHREADS + tid; i < NE * D; i += nb * NTHREADS) {
            const int e = i >> 10, d = i & 1023;
            const float w = p.router_w[(size_t)d * NE + e];
            const bf16_t hi = f2bf(w);
            rwt[i] = hi; rwt[NE * D + i] = f2bf(w - bf2f(hi));
        }
    }
    float* tile = (float*)smem;
    if (bid < PN5) {
        TJ cur; f32x4 cv[4];
        prep_tile_job(p, bid, tid, cur); tj_load(cur, cv);
        for (int it = bid; it < PN5; it += nb) {
            TJ nxt; f32x4 nv[4];
            const bool hn = it + nb < PN5;
            if (hn) { prep_tile_job(p, it + nb, tid, nxt); tj_load(nxt, nv); }
            tj_finish(cur, cv, tile, tid);
            if (hn) { cur = nxt;
#pragma unroll
                for (int i = 0; i < 4; ++i) cv[i] = nv[i]; }
        }
    }
}

DI void moe_steal(const P& p, int budget, int limit, char* smem) {
    volatile int* qslot = (volatile int*)(smem + META_OFF + 2048);
    unsigned* tq = (unsigned*)(p.ws + WS_CTL + CTL_TQ);
    const int tid = tid_opaque();
    if (budget <= 0) return;
    __syncthreads();
    if (tid == 0) qslot[0] = (int)__hip_atomic_fetch_add(tq, 1u, __ATOMIC_RELAXED, __HIP_MEMORY_SCOPE_AGENT);
    __syncthreads();
    int q = qslot[0] + MOE_TILES_PER_LAYER;
    if (q >= DEPTH * MOE_TILES_PER_LAYER) return;
    TJ cur; f32x4 cv[4];
    moe_tile_job(p, q, tid, cur); tj_load(cur, cv);
    for (int n = 1;; ++n) {
        const bool want = (n < budget) && (q < limit);
        int qn = DEPTH * MOE_TILES_PER_LAYER;
        if (want) {
            if (tid == 0) qslot[1] = (int)__hip_atomic_fetch_add(tq, 1u, __ATOMIC_RELAXED, __HIP_MEMORY_SCOPE_AGENT);
            __syncthreads();
            qn = qslot[1] + MOE_TILES_PER_LAYER;
        }
        const bool hn = qn < DEPTH * MOE_TILES_PER_LAYER;
        TJ nxt; f32x4 nv[4];
        if (hn) { moe_tile_job(p, qn, tid, nxt); tj_load(nxt, nv); }
        tj_finish(cur, cv, (float*)smem, tid);
        if (!hn) break;
        cur = nxt; q = qn;
#pragma unroll
        for (int i = 0; i < 4; ++i) cv[i] = nv[i];
    }
}

DI void store8_bf16(bf16_t* p8, const f32x4& v0, const f32x4& v1) {
    u32x4 w; w.x = cvtpk(v0[0], v0[1]); w.y = cvtpk(v0[2], v0[3]); w.z = cvtpk(v1[0], v1[1]); w.w = cvtpk(v1[2], v1[3]);
    *(u32x4*)p8 = w;
}

struct EpiTileBf16 {
    static constexpr bool PERM = true;
    bf16_t* O; int ldc; size_t pm_stride, pn_stride;
    DI void operator()(const f32x4 (&acc)[2][2][4][2], const g8::Unit& u, int wr, int wc, int fr, int fq) const {
        bf16_t* base = O + (size_t)u.pm * pm_stride + (size_t)u.pn * pn_stride + (size_t)(wr * 64 + fr) * ldc + wc * 32 + 8 * fq;
#pragma unroll
        for (int ai = 0; ai < 2; ++ai)
#pragma unroll
            for (int m = 0; m < 4; ++m)
                {
#pragma unroll
                    for (int bj = 0; bj < 2; ++bj) store8_bf16(base + (size_t)(ai * 128 + m * 16) * ldc + bj * 128, acc[ai][bj][m][0], acc[ai][bj][m][1]); __builtin_amdgcn_sched_barrier(0); }
    }
};

DI int slack_budget(int nunits, int G, int c, int per_unit) {
    const int mine = (c < nunits) ? (nunits - 1 - c) / G + 1 : 0, most = (nunits + G - 1) / G;
    return (most - mine) * per_unit;
}
constexpr int STEAL_K1024 = 9, STEAL_K512 = 4;

struct KSched {
    const char* memb; const char* wkv; int G, c;
    DI bool next(int i, g8::Unit& u) const { const int L = i * G + c; if (L >= 32) return false; u.pm = L & 7; u.pn = L >> 3; u.e = 0; u.valid = 256; u.rbase = 0; u.rti = 0; return true; }
    DI const char* a_base(const g8::Unit& u) const { return memb + (size_t)u.pm * 256 * D * 2; }
    DI const char* b_base(const g8::Unit& u) const { return wkv + (size_t)u.pn * 512 * D * 2; }
    DI void a_rows(const g8::Unit&, int R0, int R1, int (&rows)[2][2]) const { rows[0][0] = R0; rows[0][1] = R1; rows[1][0] = 128 + R0; rows[1][1] = 128 + R1; }
    DI void a_ready(const g8::Unit&) const {}
};
struct VSched {
    const char* memb; const char* wkv; int G, c;
    DI bool next(int i, g8::Unit& u) const { const int L = i * G + c - 32; if (L < 0 || L >= 32) return false; u.pm = L >> 3; u.pn = L & 7; u.e = 0; u.valid = 256; u.rbase = 0; u.rti = 0; return true; }
    DI const char* a_base(const g8::Unit& u) const { return wkv + ((size_t)u.pm * 512 + 256) * D * 2; }
    DI const char* b_base(const g8::Unit& u) const { return memb + (size_t)u.pn * 256 * D * 2; }
    DI void a_rows(const g8::Unit&, int R0, int R1, int (&rows)[2][2]) const { rows[0][0] = R0; rows[0][1] = R1; rows[1][0] = 128 + R0; rows[1][1] = 128 + R1; }
    DI void a_ready(const g8::Unit&) const {}
};
DI void phase_kv(const P& p, int bid, int nb, char* smem) {
    const char* memb = p.ws + WS_MEMB;
    const char* wkv = p.ws + WS_WKV;
    {
        KSched S{memb, wkv, nb, bid};
        EpiTileBf16 E{(bf16_t*)(p.ws + WS_KBUF), 256, (size_t)256 * 256, (size_t)2048 * 256};
        g8::gemm_phase<false>((LAS unsigned char*)smem, D, S, E);
    }
    {
        VSched S{memb, wkv, nb, bid};
        EpiTileBf16 E{(bf16_t*)(p.ws + WS_VT), 256, (size_t)8 * 256 * 256, (size_t)256 * 256};
        g8::gemm_phase<false>((LAS unsigned char*)smem, D, S, E);
    }
    if (bid >= 64) moe_steal(p, STEAL_K1024, DEPTH * MOE_TILES_PER_LAYER, smem);
}

struct EpiInproj {
    static constexpr bool PERM = true;
    bf16_t* projb; int ldp; int gate_pn; const float* gate_b; float* logi; float* logf;
    DI void operator()(const f32x4 (&acc)[2][2][4][2], const g8::Unit& u, int wr, int wc, int fr, int fq) const {
        if (u.pn != gate_pn) {
            bf16_t* base = projb + (size_t)(u.pm * 256 + wr * 64 + fr) * ldp + u.pn * 256 + wc * 32 + 8 * fq;
#pragma unroll
            for (int ai = 0; ai < 2; ++ai)
#pragma unroll
                for (int m = 0; m < 4; ++m)
                    {
#pragma unroll
                        for (int bj = 0; bj < 2; ++bj) store8_bf16(base + (size_t)(ai * 128 + m * 16) * ldp + bj * 128, acc[ai][bj][m][0], acc[ai][bj][m][1]); __builtin_amdgcn_sched_barrier(0); }
        } else if (wc == 0 && fq < 2) {
#pragma unroll
            for (int ai = 0; ai < 2; ++ai)
#pragma unroll
                for (int m = 0; m < 4; ++m) {
                    const int t = u.pm * 256 + ai * 128 + wr * 64 + m * 16 + fr;
                    const int b = t >> 11, s = t & 2047;
#pragma unroll
                    for (int n = 0; n < 2; ++n)
#pragma unroll
                        for (int i = 0; i < 4; ++i) {
                            const int col = 8 * fq + 4 * n + i;
                            if (col < 12) {
                                const float val = acc[ai][0][m][n][i] + gate_b[col];
                                if (col < 6) logi[(size_t)(b * 6 + col) * SEQ + s] = val;
                                else logf[(size_t)(b * 6 + col - 6) * SEQ + s] = logsigmoidf_(val);
                            }
                        }
                    __builtin_amdgcn_sched_barrier(0);
                }
        }
    }
};
DI void phase_inproj(const P& p, int layer, int bid, int nb, char* smem) {
    const bool conv = (layer & 1) == 0;
    const int j = layer >> 1;
    const bf16_t* W = (const bf16_t*)(p.ws + WS_WIN) + (conv ? (size_t)j * DIN_CONV * D : ((size_t)2 * DIN_CONV + (size_t)j * NV_ML) * D);
    g8::DenseSched S; S.init(p.ws + WS_XB, W, T, conv ? DIN_CONV : NV_ML, D, nb, bid);
    EpiInproj E{(bf16_t*)(p.ws + WS_PROJ), conv ? DIN_CONV : LDP_ML, conv ? -1 : 13, p.ml_gate_b + j * 12, (float*)(p.ws + WS_LOGI), (float*)(p.ws + WS_LOGF)};
    g8::gemm_phase<false>((LAS unsigned char*)smem, D, S, E);
    moe_steal(p, slack_budget(S.nwg, nb, bid, STEAL_K1024), DEPTH * MOE_TILES_PER_LAYER, smem);
}

struct EpiOutproj {
    static constexpr bool PERM = true;
    const bf16_t* xres; bf16_t* z;
    DI void operator()(const f32x4 (&acc)[2][2][4][2], const g8::Unit& u, int wr, int wc, int fr, int fq) const {
        const size_t off0 = (size_t)(u.pm * 256 + wr * 64 + fr) * D + u.pn * 256 + wc * 32 + 8 * fq;
#pragma unroll
        for (int ai = 0; ai < 2; ++ai)
#pragma unroll
            for (int m = 0; m < 4; ++m) {
#pragma unroll
                for (int bj = 0; bj < 2; ++bj) {
                    const size_t off = off0 + (size_t)(ai * 128 + m * 16) * D + bj * 128;
                    const u32x4 xr = *(const u32x4*)(xres + off);
                    f32x4 v0 = acc[ai][bj][m][0], v1 = acc[ai][bj][m][1];
                    v0[0] += ALPHA * bflo(xr.x); v0[1] += ALPHA * bfhi(xr.x); v0[2] += ALPHA * bflo(xr.y); v0[3] += ALPHA * bfhi(xr.y);
                    v1[0] += ALPHA * bflo(xr.z); v1[1] += ALPHA * bfhi(xr.z); v1[2] += ALPHA * bflo(xr.w); v1[3] += ALPHA * bfhi(xr.w);
                    store8_bf16(z + off, v0, v1);
                }
                __builtin_amdgcn_sched_barrier(0);
            }
    }
};
DI void phase_outproj(const P& p, int layer, int bid, int nb, char* smem) {
    g8::DenseSched S; S.init(p.ws + WS_HCAT, (const bf16_t*)(p.ws + WS_WOUT) + (size_t)layer * D * D, T, D, D, nb, bid);
    EpiOutproj E{(const bf16_t*)(p.ws + WS_XB), (bf16_t*)(p.ws + WS_Z)};
    g8::gemm_phase<false>((LAS unsigned char*)smem, D, S, E);
}

DI void moe_meta(const int* cnt, int* meta) {
    __syncthreads();
    const int t = tid_opaque();
    if (t < NE) meta[65 + t] = __hip_atomic_load(cnt + t * CNT_STRIDE, __ATOMIC_RELAXED, __HIP_MEMORY_SCOPE_AGENT);
    __syncthreads();
    if (t == 0) {
        int base = 0, blk = 0;
#pragma unroll 1
        for (int e = 0; e < NE; ++e) {
            const int c = meta[65 + e];
            meta[e] = base; meta[32 + e] = blk;
            base += c; blk += (c + 255) >> 8;
        }
        meta[64] = blk;
    }
    __syncthreads();
    if (t < 160) {
        int e = 0;
#pragma unroll 1
        for (int q = 1; q < NE; ++q) e += (meta[32 + q] <= t) ? 1 : 0;
        meta[128 + t] = e;
    }
    __syncthreads();
}
struct MoeSched {
    const int* meta; const int* list; const char* A; const char* Bt; size_t b_estride; int K, G, c, nunits;
    DI bool next(int i, g8::Unit& u) const {
        const int L = i * G + c;
        if (L >= nunits) return false;
        const int w = g8::xcd_remap(L, nunits);
        const int rti = w >> 2;
        const int e = __builtin_amdgcn_readfirstlane(meta[128 + rti]);
        u.e = e; u.pm = rti - __builtin_amdgcn_readfirstlane(meta[32 + e]); u.pn = w & 3; u.rti = rti;
        const int left = __builtin_amdgcn_readfirstlane(meta[65 + e]) - u.pm * 256;
        u.valid = left < 256 ? left : 256;
        u.rbase = __builtin_amdgcn_readfirstlane(meta[e]);
        return true;
    }
    DI const char* b_base(const g8::Unit& u) const { return Bt + (size_t)u.e * b_estride + (size_t)u.pn * 256 * K * 2; }
};
struct MoeUpSched : MoeSched {
    DI const char* a_base(const g8::Unit&) const { return A; }
    DI void a_rows(const g8::Unit& u, int R0, int R1, int (&rows)[2][2]) const {
        const int* lst = list + (size_t)u.e * T + u.pm * 256;
        const int vm = u.valid - 1;
        rows[0][0] = lst[min(R0, vm)] >> 1; rows[0][1] = lst[min(R1, vm)] >> 1;
        rows[1][0] = lst[min(128 + R0, vm)] >> 1; rows[1][1] = lst[min(128 + R1, vm)] >> 1;
    }
    DI void a_ready(const g8::Unit&) const {}
};
struct MoeDownSched : MoeSched {
    unsigned* ready; unsigned* tmo;
    DI const char* a_base(const g8::Unit& u) const { return A + ((size_t)u.rbase + (size_t)u.pm * 256) * K * 2; }
    DI void a_rows(const g8::Unit&, int R0, int R1, int (&rows)[2][2]) const { rows[0][0] = R0; rows[0][1] = R1; rows[1][0] = 128 + R0; rows[1][1] = 128 + R1; }
    DI void a_ready(const g8::Unit& u) const {
        if (tid_opaque() < 64) {
            unsigned* w = ready + u.rti * 16;
            unsigned spins = 0;
            while ((unsigned)__builtin_amdgcn_readfirstlane((int)__hip_atomic_load(w, __ATOMIC_RELAXED, __HIP_MEMORY_SCOPE_AGENT)) < 32u) {
                __builtin_amdgcn_s_sleep(2);
                if ((++spins & 255u) == 0u) {
                    if (__builtin_amdgcn_readfirstlane((int)__hip_atomic_load(tmo, __ATOMIC_RELAXED, __HIP_MEMORY_SCOPE_AGENT)) != 0) break;
                    if (spins > (1u << 22)) { __hip_atomic_store(tmo, 1u, __ATOMIC_RELAXED, __HIP_MEMORY_SCOPE_AGENT); break; }
                }
            }
            __builtin_amdgcn_fence(__ATOMIC_ACQUIRE, "agent");
            asm volatile("s_waitcnt vmcnt(0)" ::: "memory");
        }
        asm volatile("" ::: "memory"); __builtin_amdgcn_s_barrier(); asm volatile("" ::: "memory");
    }
};

struct EpiMoeUp {
    static constexpr bool PERM = true;
    __amdgpu_buffer_rsrc_t hrs; unsigned* ready;
    DI void operator()(const f32x4 (&acc)[2][2][4][2], const g8::Unit& u, int wr, int wc, int fr, int fq) const {
        const unsigned hrow0 = (unsigned)u.rbase + (unsigned)u.pm * 256u;
#pragma unroll
        for (int ai = 0; ai < 2; ++ai)
#pragma unroll
            for (int m = 0; m < 4; ++m) {
                const int row = ai * 128 + wr * 64 + m * 16 + fr;
                if (row < u.valid) {
                    f32x4 h0, h1;
#pragma unroll
                    for (int i = 0; i < 4; ++i) {
                        const float g0 = acc[ai][0][m][0][i], g1 = acc[ai][0][m][1][i];
                        h0[i] = g0 * sigmoidf_(g0) * acc[ai][1][m][0][i];
                        h1[i] = g1 * sigmoidf_(g1) * acc[ai][1][m][1][i];
                    }
                    u32x4 w; w.x = cvtpk(h0[0], h0[1]); w.y = cvtpk(h0[2], h0[3]); w.z = cvtpk(h1[0], h1[1]); w.w = cvtpk(h1[2], h1[3]);
                    __builtin_amdgcn_raw_buffer_store_b128(w, hrs, ((hrow0 + (unsigned)row) * DFF + u.pn * 128 + wc * 32 + 8 * fq) * 2u, 0,   16);
                }
                __builtin_amdgcn_sched_barrier(0);
            }
        asm volatile("s_waitcnt vmcnt(0)" ::: "memory");
        if (fr == 0 && fq == 0) __hip_atomic_fetch_add(ready + u.rti * 16, 1u, __ATOMIC_RELAXED, __HIP_MEMORY_SCOPE_AGENT);
    }
};
struct EpiMoeDown {
    static constexpr bool PERM = true;
    const int* list; const float* gate; bf16_t* yasg;
    DI void operator()(const f32x4 (&acc)[2][2][4][2], const g8::Unit& u, int wr, int wc, int fr, int fq) const {
        const int* lst = list + (size_t)u.e * T + u.pm * 256;
#pragma unroll
        for (int ai = 0; ai < 2; ++ai)
#pragma unroll
            for (int m = 0; m < 4; ++m) {
                const int row = ai * 128 + wr * 64 + m * 16 + fr;
                if (row < u.valid) {
                    const int a = lst[row];
                    const float gt = gate[a];
                    bf16_t* dst = yasg + (size_t)a * D + u.pn * 256 + wc * 32 + 8 * fq;
#pragma unroll
                    for (int bj = 0; bj < 2; ++bj) store8_bf16(dst + bj * 128, acc[ai][bj][m][0] * gt, acc[ai][bj][m][1] * gt);
                }
                __builtin_amdgcn_sched_barrier(0);
            }
    }
};
DI void phase_moe(const P& p, int layer, int bid, int nb, char* smem) {
    int* meta = (int*)(smem + META_OFF);
    moe_meta((const int*)(p.ws + WS_CTL + CTL_CNT) + layer * 32 * CNT_STRIDE, meta);
    unsigned* ready = (unsigned*)(p.ws + WS_CTL + CTL_READY) + layer * 160 * 16;
    const int nunits = meta[64] * 4;
    {
        MoeUpSched S;
        S.meta = meta; S.list = (const int*)(p.ws + WS_LIST); S.A = p.ws + WS_X1B; S.Bt = p.ws + WS_WGU + (size_t)layer * NE * 1024 * D * 2;
        S.b_estride = (size_t)1024 * D * 2; S.K = D; S.G = nb; S.c = bid; S.nunits = nunits;
        EpiMoeUp E{__builtin_amdgcn_make_buffer_rsrc((void*)(p.ws + WS_HBUF), (short)0, (int)((size_t)T * 2 * DFF * 2), 0x00020000), ready};
        g8::gemm_phase<true>((LAS unsigned char*)smem, D, S, E);
    }
    {
        MoeDownSched S;
        S.meta = meta; S.list = (const int*)(p.ws + WS_LIST); S.A = p.ws + WS_HBUF; S.Bt = p.ws + WS_WD + (size_t)layer * NE * D * DFF * 2;
        S.b_estride = (size_t)D * DFF * 2; S.K = DFF; S.G = nb; S.c = nb - 1 - bid; S.nunits = nunits;
        S.ready = ready; S.tmo = (unsigned*)(p.ws + WS_CTL + CTL_TMO);
        EpiMoeDown E{(const int*)(p.ws + WS_LIST), (const float*)(p.ws + WS_GATE), (bf16_t*)(p.ws + WS_YASG)};
        g8::gemm_phase<false>((LAS unsigned char*)smem, DFF, S, E);
    }
    {
        const int up_mine = (bid < nunits) ? (nunits - 1 - bid) / nb + 1 : 0, c2 = nb - 1 - bid, dn_mine = (c2 < nunits) ? (nunits - 1 - c2) / nb + 1 : 0;
        const int most = (nunits + nb - 1) / nb;
        const int spare = (most - up_mine) * STEAL_K1024 - (dn_mine - (most - 1) > 0 ? (dn_mine - (most - 1)) * STEAL_K512 : 0);
        moe_steal(p, spare, DEPTH * MOE_TILES_PER_LAYER, smem);
    }
}

DI void phase_convmix(const P& p, int layer, int bid, int nb) {
    const int j = layer >> 1;
    const int tid = tid_opaque();
    const bf16_t* projb = (const bf16_t*)(p.ws + WS_PROJ);
    bf16_t* hcat = (bf16_t*)(p.ws + WS_HCAT);
    const float* cw = p.conv_w + (size_t)j * 3 * MIXW;
    const int nitem = T * (MIXW / 8);
    for (int it = bid * NTHREADS + tid; it < nitem; it += nb * NTHREADS) {
        const int t = it / 96, c8 = (it % 96) * 8;
        const int s = t & 2047;
        const bf16_t* row = projb + (size_t)t * DIN_CONV;
        const u32x4 bg = *(const u32x4*)(row + c8);
        float u[3][8];
#pragma unroll
        for (int d = 0; d < 3; ++d) {
            const int back = 2 - d;
            if (s - back >= 0) {
                const bf16_t* rw = row - (size_t)back * DIN_CONV;
                const u32x4 cg = *(const u32x4*)(rw + MIXW + c8);
                const u32x4 xi = *(const u32x4*)(rw + 2 * MIXW + c8);
#pragma unroll
                for (int q = 0; q < 4; ++q) { u[d][2 * q] = bflo(cg[q]) * bflo(xi[q]); u[d][2 * q + 1] = bfhi(cg[q]) * bfhi(xi[q]); }
            } else {
#pragma unroll
                for (int q = 0; q < 8; ++q) u[d][q] = 0.f;
            }
        }
        float o[8];
#pragma unroll
        for (int q = 0; q < 8; ++q) {
            const float c = cw[c8 + q] * u[0][q] + cw[MIXW + c8 + q] * u[1][q] + cw[2 * MIXW + c8 + q] * u[2][q];
            const float b = (q & 1) ? bfhi(bg[q >> 1]) : bflo(bg[q >> 1]);
            o[q] = b * c;
        }
        u32x4 w; w.x = cvtpk(o[0], o[1]); w.y = cvtpk(o[2], o[3]); w.z = cvtpk(o[4], o[5]); w.w = cvtpk(o[6], o[7]);
        *(u32x4*)(hcat + (size_t)t * D + c8) = w;
    }
}

DI void phase_xattn(const P& p, int layer, int bid, int nb, char* smem) {
    const bool conv = (layer & 1) == 0;
    const int ldp = conv ? DIN_CONV : LDP_ML;
    const int qoff = conv ? 3 * MIXW : 3072;
    const bf16_t* projb = (const bf16_t*)(p.ws + WS_PROJ);
    const bf16_t* kbuf = (const bf16_t*)(p.ws + WS_KBUF) + (size_t)layer * 2048 * 256;
    const bf16_t* vT = (const bf16_t*)(p.ws + WS_VT) + (size_t)layer * 8 * 256 * 256;
    bf16_t* hcat = (bf16_t*)(p.ws + WS_HCAT);
    constexpr int LK = 72, LV = 264;
    bf16_t* Ks = (bf16_t*)smem;
    bf16_t* Vs = Ks + 256 * LK;
    for (int task = bid; task < NBATCH * XH * 16; task += nb) {
        const int tid = tid_opaque(), lane = tid & 63, wid = tid >> 6, r = lane & 15, g = lane >> 4;
        const int b = task >> 6, h = (task >> 4) & 3, qt = task & 15;
        __syncthreads();
#pragma unroll
        for (int i = 0; i < 4; ++i) {
            const int key = (tid >> 3) + 64 * i, kc = tid & 7;
            *(u32x4*)&Ks[key * LK + kc * 8] = *(const u32x4*)(kbuf + ((size_t)b * 256 + key) * 256 + h * 64 + kc * 8);
            const int dv = (tid >> 5) + 16 * i, mc = tid & 31;
            *(u32x4*)&Vs[dv * LV + mc * 8] = *(const u32x4*)(vT + (((size_t)b * 4 + h) * 64 + dv) * 256 + mc * 8);
        }
        __syncthreads();
        const int tq = b * SEQ + qt * 128 + wid * 16;
        const bf16_t* qrow = projb + (size_t)(tq + r) * ldp + qoff + h * 64;
        bf16x8 qf[2];
        qf[0] = *(const bf16x8*)(qrow + 8 * g);
        qf[1] = *(const bf16x8*)(qrow + 32 + 8 * g);
        f32x4 sacc[16];
#pragma unroll
        for (int kt = 0; kt < 16; ++kt) {
            f32x4 a = (f32x4){0.f, 0.f, 0.f, 0.f};
#pragma unroll
            for (int ks = 0; ks < 2; ++ks) {
                const bf16x8 kf = *(const bf16x8*)&Ks[(kt * 16 + r) * LK + ks * 32 + 8 * g];
                a = mfma16(kf, qf[ks], a);
            }
            sacc[kt] = a;
            if (kt & 1) __builtin_amdgcn_sched_barrier(0);
        }
        float mx = -3.0e38f;
#pragma unroll
        for (int kt = 0; kt < 16; ++kt)
#pragma unroll
            for (int i = 0; i < 4; ++i) { sacc[kt][i] *= 0.125f; mx = fmaxf(mx, sacc[kt][i]); }
        mx = xor_max(mx, 16); mx = xor_max(mx, 32);
        float sum = 0.f;
#pragma unroll
        for (int kt = 0; kt < 16; ++kt)
#pragma unroll
            for (int i = 0; i < 4; ++i) { const float e = __expf(sacc[kt][i] - mx); sacc[kt][i] = e; sum += e; }
        sum = xor_add(sum, 16); sum = xor_add(sum, 32);
        const float inv = 1.0f / sum;
        f32x4 oacc[4];
#pragma unroll
        for (int dt = 0; dt < 4; ++dt) oacc[dt] = (f32x4){0.f, 0.f, 0.f, 0.f};
#pragma unroll
        for (int s2 = 0; s2 < 8; ++s2) {
            u32x4 pw;
            pw.x = cvtpk(sacc[2 * s2][0], sacc[2 * s2][1]); pw.y = cvtpk(sacc[2 * s2][2], sacc[2 * s2][3]);
            pw.z = cvtpk(sacc[2 * s2 + 1][0], sacc[2 * s2 + 1][1]); pw.w = cvtpk(sacc[2 * s2 + 1][2], sacc[2 * s2 + 1][3]);
            const bf16x8 pf = __builtin_bit_cast(bf16x8, pw);
#pragma unroll
            for (int dt = 0; dt < 4; ++dt) {
                const bf16_t* vp = &Vs[(dt * 16 + r) * LV + s2 * 32 + 4 * g];
                const u32x2 v0 = *(const u32x2*)vp;
                const u32x2 v1 = *(const u32x2*)(vp + 16);
                u32x4 vw; vw.x = v0.x; vw.y = v0.y; vw.z = v1.x; vw.w = v1.y;
                oacc[dt] = mfma16(__builtin_bit_cast(bf16x8, vw), pf, oacc[dt]);
            }
            __builtin_amdgcn_sched_barrier(0);
        }
        bf16_t* orow = hcat + (size_t)(tq + r) * D + MIXW + h * 64;
#pragma unroll
        for (int dt = 0; dt < 4; ++dt) {
            u32x2 w; w.x = cvtpk(oacc[dt][0] * inv, oacc[dt][1] * inv); w.y = cvtpk(oacc[dt][2] * inv, oacc[dt][3] * inv);
            *(u32x2*)(orow + dt * 16 + 4 * g) = w;
        }
    }
}

DI void phase_ml_local(const P& p, int bid, int nb, char* smem) {
    const bf16_t* projb = (const bf16_t*)(p.ws + WS_PROJ);
    const float* logi = (const float*)(p.ws + WS_LOGI);
    const float* logf = (const float*)(p.ws + WS_LOGF);
    float* CT = (float*)(p.ws + WS_CT);
    float* nloc = (float*)(p.ws + WS_NLOC);
    float* mloc = (float*)(p.ws + WS_MLOC);
    float* gsum = (float*)(p.ws + WS_GSUM);
    constexpr int LS = 136;
    bf16_t* kwT = (bf16_t*)smem;
    bf16_t* vTs = kwT + 128 * LS;
    float* fb = (float*)(vTs + 128 * LS);
    float* fw = fb + 128;
    float* fr = fw + 128;
    for (int task = bid; task < 48 * NCH; task += nb) {
        const int tid = tid_opaque(), lane = tid & 63, wid = tid >> 6, r = lane & 15, g = lane >> 4;
        const int bh = task >> 4, c = task & 15, b = bh / 6, h = bh % 6;
        const int t0 = b * SEQ + c * CHUNK;
        __syncthreads();
        if (wid == 0) {
            const float* lfp = logf + (size_t)bh * SEQ + c * CHUNK + 2 * lane;
            const float* lip = logi + (size_t)bh * SEQ + c * CHUNK + 2 * lane;
            const float f0 = lfp[0], f1 = lfp[1], i0 = lip[0], i1 = lip[1];
            float ps = f0 + f1;
#pragma unroll
            for (int off = 1; off < 64; off <<= 1) { const float y = __shfl_up(ps, off, 64); if (lane >= off) ps += y; }
            const float gtot = __shfl(ps, 63, 64);
            const float b0 = ps - f1, b1 = ps;
            const float a0 = gtot - b0 + i0, a1 = gtot - b1 + i1;
            float mx = fmaxf(a0, a1);
            mx = xor_max(mx, 32); mx = xor_max(mx, 16); mx = xor_max(mx, 8); mx = xor_max(mx, 4); mx = xor_max(mx, 2); mx = xor_max(mx, 1);
            fw[2 * lane] = __expf(a0 - mx); fw[2 * lane + 1] = __expf(a1 - mx);
            if (lane == 0) { fr[0] = mx; fr[1] = gtot; }
        }
        __syncthreads();
        const float ml = fr[0], gtot = fr[1];
        {
            const int s = tid & 127, quarter = tid >> 7;
            const float w = fw[s];
            const bf16_t* krow = projb + (size_t)(t0 + s) * LDP_ML + MIXW + h * 128;
            const bf16_t* vrow = projb + (size_t)(t0 + s) * LDP_ML + 2 * MIXW + h * 128;
#pragma unroll
            for (int i = 0; i < 4; ++i) {
                const int dc = quarter * 4 + i;
                const u32x4 kk = *(const u32x4*)(krow + dc * 8);
                const u32x4 vv = *(const u32x4*)(vrow + dc * 8);
#pragma unroll
                for (int q = 0; q < 4; ++q) {
                    kwT[(dc * 8 + 2 * q) * LS + s] = f2bf(bflo(kk[q]) * w);
                    kwT[(dc * 8 + 2 * q + 1) * LS + s] = f2bf(bfhi(kk[q]) * w);
                    vTs[(dc * 8 + 2 * q) * LS + s] = (bf16_t)(vv[q] & 0xffffu);
                    vTs[(dc * 8 + 2 * q + 1) * LS + s] = (bf16_t)(vv[q] >> 16);
                }
            }
        }
        __syncthreads();
        float* ct = CT + (size_t)task * 128 * 128;
        {
            f32x4 acc[8];
#pragma unroll
            for (int dt = 0; dt < 8; ++dt) acc[dt] = (f32x4){0.f, 0.f, 0.f, 0.f};
#pragma unroll
            for (int ks = 0; ks < 4; ++ks) {
                const bf16x8 vf = *(const bf16x8*)&vTs[(wid * 16 + r) * LS + ks * 32 + 8 * g];
#pragma unroll
                for (int dt = 0; dt < 8; ++dt) {
                    const bf16x8 kf = *(const bf16x8*)&kwT[(dt * 16 + r) * LS + ks * 32 + 8 * g];
                    acc[dt] = mfma16(vf, kf, acc[dt]);
                }
                __builtin_amdgcn_sched_barrier(0);
            }
#pragma unroll
            for (int dt = 0; dt < 8; ++dt)
#pragma unroll
                for (int i = 0; i < 4; ++i) ct[(wid * 16 + 4 * g + i) * 128 + dt * 16 + r] = acc[dt][i];
        }
        {
            const bf16x8 ones = (bf16x8){0x3F80, 0x3F80, 0x3F80, 0x3F80, 0x3F80, 0x3F80, 0x3F80, 0x3F80};
            f32x4 an = (f32x4){0.f, 0.f, 0.f, 0.f};
#pragma unroll
            for (int ks = 0; ks < 4; ++ks) {
                const bf16x8 kf = *(const bf16x8*)&kwT[(wid * 16 + r) * LS + ks * 32 + 8 * g];
                an = mfma16(ones, kf, an);
            }
            if (g == 0) nloc[(size_t)task * 128 + wid * 16 + r] = an[0];
        }
        if (tid == 0) { mloc[task] = ml; gsum[task] = gtot; }
    }
}

DI void phase_ml_scan(const P& p, int bid, int nb) {
    const float* CT = (const float*)(p.ws + WS_CT);
    bf16_t* CPB = (bf16_t*)(p.ws + WS_CPB);
    const float* nloc = (const float*)(p.ws + WS_NLOC);
    float* nprev = (float*)(p.ws + WS_NPREV);
    const float* mloc = (const float*)(p.ws + WS_MLOC);
    const float* gsum = (const float*)(p.ws + WS_GSUM);
    float* mprev = (float*)(p.ws + WS_MPREV);
    const int tid = tid_opaque();
    for (int task = bid; task < 48 * 8; task += nb) {
        const int bh = task >> 3, sl = task & 7;
        const int idx = sl * 2048 + tid * 4;
        float m = 0.f;
        f32x4 st = (f32x4){0.f, 0.f, 0.f, 0.f};
        float nst = 0.f;
        const bool don = (sl == 0 && tid < 128);
        f32x4 loc = *(const f32x4*)(CT + (size_t)(bh * NCH) * 16384 + idx);
        for (int c = 0; c < NCH; ++c) {
            const int ch = bh * NCH + c;
            const float gg = gsum[ch], ml = mloc[ch];
            const float mnew = fmaxf(gg + m, ml);
            const float decay = __expf(gg + m - mnew), sc = __expf(ml - mnew);
            const f32x4 cur = loc;
            if (c + 1 < NCH) loc = *(const f32x4*)(CT + (size_t)(ch + 1) * 16384 + idx);
            u32x2 w; w.x = cvtpk(st[0], st[1]); w.y = cvtpk(st[2], st[3]);
            *(u32x2*)(CPB + (size_t)ch * 16384 + idx) = w;
            st = st * decay + cur * sc;
            if (don) {
                const float nl = nloc[(size_t)ch * 128 + tid];
                nprev[(size_t)ch * 128 + tid] = nst;
                nst = nst * decay + nl * sc;
            }
            if (sl == 0 && tid == 0) mprev[ch] = m;
            m = mnew;
        }
    }
}

DI void phase_ml_out(const P& p, int layer, int bid, int nb, char* smem) {
    const int j = layer >> 1;
    const bf16_t* projb = (const bf16_t*)(p.ws + WS_PROJ);
    const float* logi = (const float*)(p.ws + WS_LOGI);
    const float* logf = (const float*)(p.ws + WS_LOGF);
    const bf16_t* CPB = (const bf16_t*)(p.ws + WS_CPB);
    const float* nprev = (const float*)(p.ws + WS_NPREV);
    const float* mprev = (const float*)(p.ws + WS_MPREV);
    bf16_t* hcat = (bf16_t*)(p.ws + WS_HCAT);
    const float* ng_ = p.ml_norm_g + (size_t)j * MIXW;
    constexpr int LS = 136;
    bf16_t* kS = (bf16_t*)smem;
    bf16_t* vTs = kS + 128 * LS;
    float* fb = (float*)(vTs + 128 * LS);
    float* fB = fb + 128;
    float* fA = fB + 128;
    float* fW = fA + 128;
    float* fE = fW + 128;
    float* fN = fE + 128;
    for (int task = bid; task < 48 * NCH; task += nb) {
        const int tid = tid_opaque();
        const int lane = tid & 63, wid = __builtin_amdgcn_readfirstlane(tid >> 6), r = lane & 15, g = lane >> 4;
        const int bh = task >> 4, c = task & 15, b = bh / 6, h = bh % 6;
        const int t0 = b * SEQ + c * CHUNK;
        __syncthreads();
        if (wid == 0) {
            const float* lfp = logf + (size_t)bh * SEQ + c * CHUNK + 2 * lane;
            const float* lip = logi + (size_t)bh * SEQ + c * CHUNK + 2 * lane;
            const float f0 = lfp[0], f1 = lfp[1], i0 = lip[0], i1 = lip[1];
            const float mp = mprev[task];
            float ps = f0 + f1;
#pragma unroll
            for (int off = 1; off < 64; off <<= 1) { const float y = __shfl_up(ps, off, 64); if (lane >= off) ps += y; }
            const float b0 = ps - f1, b1 = ps;
            const float B0 = i0 - b0, B1 = i1 - b1;
            float pm = fmaxf(B0, B1);
#pragma unroll
            for (int off = 1; off < 64; off <<= 1) { const float y = __shfl_up(pm, off, 64); if (lane >= off) pm = fmaxf(pm, y); }
            float pmx = __shfl_up(pm, 1, 64);
            if (lane == 0) pmx = -3.0e38f;
            const float pm0 = fmaxf(pmx, B0), pm1 = pm;
            const float in0 = b0 + mp, in1 = b1 + mp;
            const float m0 = fmaxf(b0 + pm0, in0), m1 = fmaxf(b1 + pm1, in1);
            fB[2 * lane] = B0; fB[2 * lane + 1] = B1;
            fA[2 * lane] = b0 - m0; fA[2 * lane + 1] = b1 - m1;
            fW[2 * lane] = __expf(in0 - m0); fW[2 * lane + 1] = __expf(in1 - m1);
            fE[2 * lane] = __expf(-m0); fE[2 * lane + 1] = __expf(-m1);
        } else if (wid == 1) {
            fN[2 * lane] = nprev[(size_t)task * 128 + 2 * lane]; fN[2 * lane + 1] = nprev[(size_t)task * 128 + 2 * lane + 1];
        }
        {
#pragma unroll
            for (int i = 0; i < 4; ++i) {
                const int s = (tid >> 4) + 32 * i, dc = tid & 15;
                *(u32x4*)&kS[s * LS + dc * 8] = *(const u32x4*)(projb + (size_t)(t0 + s) * LDP_ML + MIXW + h * 128 + dc * 8);
            }
            const int s = tid & 127, quarter = tid >> 7;
            const bf16_t* vrow = projb + (size_t)(t0 + s) * LDP_ML + 2 * MIXW + h * 128;
#pragma unroll
            for (int i = 0; i < 4; ++i) {
                const int dc = quarter * 4 + i;
                const u32x4 vv = *(const u32x4*)(vrow + dc * 8);
#pragma unroll
                for (int q = 0; q < 4; ++q) {
                    vTs[(dc * 8 + 2 * q) * LS + s] = (bf16_t)(vv[q] & 0xffffu);
                    vTs[(dc * 8 + 2 * q + 1) * LS + s] = (bf16_t)(vv[q] >> 16);
                }
            }
        }
        __syncthreads();
        const bf16_t* cp = CPB + (size_t)task * 16384;
        {
            const int l = wid * 16 + r;
            bf16x8 qf[4];
            float qn;
            {
                const bf16_t* qrow = projb + (size_t)(t0 + l) * LDP_ML + h * 128;
                float part = 0.f;
#pragma unroll
                for (int ks = 0; ks < 4; ++ks) {
                    const u32x4 qq = *(const u32x4*)(qrow + ks * 32 + 8 * g);
                    qf[ks] = __builtin_bit_cast(bf16x8, qq);
#pragma unroll
                    for (int q = 0; q < 4; ++q) part += bflo(qq[q]) * fN[ks * 32 + 8 * g + 2 * q] + bfhi(qq[q]) * fN[ks * 32 + 8 * g + 2 * q + 1];
                }
                part = xor_add(part, 16); part = xor_add(part, 32);
                qn = part;
            }
            __builtin_amdgcn_sched_barrier(0);
            f32x4 nacc[8];
#pragma unroll
            for (int et = 0; et < 8; ++et) {
                f32x4 a = (f32x4){0.f, 0.f, 0.f, 0.f};
#pragma unroll
                for (int ks = 0; ks < 4; ++ks) {
                    const bf16x8 cf = *(const bf16x8*)(cp + (et * 16 + r) * 128 + ks * 32 + 8 * g);
                    a = mfma16(cf, qf[ks], a);
                }
                nacc[et] = a;
                if (et & 1) __builtin_amdgcn_sched_barrier(0);
            }
            const float Al = fA[l], wint = fW[l], eml = fE[l];
#pragma unroll
            for (int et = 0; et < 8; ++et) nacc[et] *= wint;
            const int stmax = wid;
            float den = 0.f;
#pragma unroll
            for (int s2 = 0; s2 < 4; ++s2) {
                if (2 * s2 <= stmax) {
                    f32x4 sa = (f32x4){0.f, 0.f, 0.f, 0.f}, sb = (f32x4){0.f, 0.f, 0.f, 0.f};
#pragma unroll
                    for (int ks = 0; ks < 4; ++ks) {
                        const bf16x8 kf = *(const bf16x8*)&kS[(s2 * 32 + r) * LS + ks * 32 + 8 * g];
                        sa = mfma16(kf, qf[ks], sa);
                    }
                    if (2 * s2 + 1 <= stmax) {
#pragma unroll
                        for (int ks = 0; ks < 4; ++ks) {
                            const bf16x8 kf = *(const bf16x8*)&kS[(s2 * 32 + 16 + r) * LS + ks * 32 + 8 * g];
                            sb = mfma16(kf, qf[ks], sb);
                        }
                    }
#pragma unroll
                    for (int i = 0; i < 4; ++i) {
                        const int s = s2 * 32 + 4 * g + i;
                        const float va = (s <= l) ? sa[i] * __expf(Al + fB[s]) : 0.f;
                        const float vb = (s + 16 <= l) ? sb[i] * __expf(Al + fB[s + 16]) : 0.f;
                        sa[i] = va; sb[i] = vb; den += va + vb;
                    }
                    u32x4 pw;
                    pw.x = cvtpk(sa[0], sa[1]); pw.y = cvtpk(sa[2], sa[3]);
                    pw.z = cvtpk(sb[0], sb[1]); pw.w = cvtpk(sb[2], sb[3]);
                    const bf16x8 pf = __builtin_bit_cast(bf16x8, pw);
#pragma unroll
                    for (int et = 0; et < 8; ++et) {
                        const bf16_t* vp = &vTs[(et * 16 + r) * LS + s2 * 32 + 4 * g];
                        const u32x2 v0 = *(const u32x2*)vp;
                        const u32x2 v1 = *(const u32x2*)(vp + 16);
                        u32x4 vw; vw.x = v0.x; vw.y = v0.y; vw.z = v1.x; vw.w = v1.y;
                        nacc[et] = mfma16(__builtin_bit_cast(bf16x8, vw), pf, nacc[et]);
                    }
                }
                __builtin_amdgcn_sched_barrier(0);
            }
            den = xor_add(den, 16); den = xor_add(den, 32);
            const float dd = fmaxf(fabsf(den + wint * qn), eml);
            const float invd = 1.0f / dd;
            float sm = 0.f;
#pragma unroll
            for (int et = 0; et < 8; ++et)
#pragma unroll
                for (int i = 0; i < 4; ++i) { nacc[et][i] *= invd; sm += nacc[et][i]; }
            sm = xor_add(sm, 16); sm = xor_add(sm, 32);
            const float mu = sm * (1.0f / 128.0f);
            float sq = 0.f;
#pragma unroll
            for (int et = 0; et < 8; ++et)
#pragma unroll
                for (int i = 0; i < 4; ++i) { const float dlt = nacc[et][i] - mu; sq += dlt * dlt; }
            sq = xor_add(sq, 16); sq = xor_add(sq, 32);
            const float rstd = rsqrtf(sq * (1.0f / 128.0f) + LN_EPS);
            const size_t trow = (size_t)(t0 + l);
            const bf16_t* og = projb + trow * LDP_ML + 3 * MIXW + h * 128;
            bf16_t* orow = hcat + trow * D + h * 128;
#pragma unroll
            for (int et = 0; et < 8; ++et) {
                const int e = et * 16 + 4 * g;
                const u32x2 ov = *(const u32x2*)(og + e);
                const f32x4 gv = *(const f32x4*)(ng_ + h * 128 + e);
                const float o0 = (nacc[et][0] - mu) * rstd * gv[0] * sigmoidf_(bflo(ov.x));
                const float o1 = (nacc[et][1] - mu) * rstd * gv[1] * sigmoidf_(bfhi(ov.x));
                const float o2 = (nacc[et][2] - mu) * rstd * gv[2] * sigmoidf_(bflo(ov.y));
                const float o3 = (nacc[et][3] - mu) * rstd * gv[3] * sigmoidf_(bfhi(ov.y));
                u32x2 w; w.x = cvtpk(o0, o1); w.y = cvtpk(o2, o3);
                *(u32x2*)(orow + e) = w;
                if (et & 1) __builtin_amdgcn_sched_barrier(0);
            }
        }
    }
}

constexpr int LN1_MAXT = 8;
DI void phase_ln1_route(const P& p, int layer, int bid, int nb, char* smem) {
    const bf16_t* z = (const bf16_t*)(p.ws + WS_Z);
    bf16_t* x1b = (bf16_t*)(p.ws + WS_X1B);
    float* gate = (float*)(p.ws + WS_GATE);
    int* list = (int*)(p.ws + WS_LIST);
    int* cnt = (int*)(p.ws + WS_CTL + CTL_CNT) + layer * 32 * CNT_STRIDE;
    const bf16_t* rwh = (const bf16_t*)(p.ws + WS_RWT);
    const bf16_t* rwl = rwh + NE * D;
    const float* lg = p.ln1_g + (size_t)layer * D;
    const float* lb = p.ln1_b + (size_t)layer * D;
    constexpr int XS = 1028;
    float* xs = (float*)smem;
    float* red = xs + 16 * XS;
    float* scs = red + 8 * 16 * 32;
    int* lcnt = (int*)(scs + 16 * 32);
    int* gbase = lcnt + 32;
    int* sel = gbase + 32;
    const int tid = tid_opaque(), lane = tid & 63, wid = tid >> 6, r = lane & 15, g = lane >> 4;
    __syncthreads();
    if (tid < 32) lcnt[tid] = 0;
    const float rb_e = p.router_b[tid & 31];
    bf16x8 wh[4][2], wl[4][2];
#pragma unroll
    for (int ks = 0; ks < 4; ++ks)
#pragma unroll
        for (int nt = 0; nt < 2; ++nt) {
            const size_t o = (size_t)(nt * 16 + r) * D + wid * 128 + ks * 32 + 8 * g;
            wh[ks][nt] = *(const bf16x8*)(rwh + o); wl[ks][nt] = *(const bf16x8*)(rwl + o);
        }
    f32x4 lgv[2][2], lbv[2][2];
#pragma unroll
    for (int i = 0; i < 2; ++i) { const int col = i * 512 + lane * 8; lgv[i][0] = *(const f32x4*)(lg + col); lgv[i][1] = *(const f32x4*)(lg + col + 4); lbv[i][0] = *(const f32x4*)(lb + col); lbv[i][1] = *(const f32x4*)(lb + col + 4); }
    u32x4 zn[2][2];
    if (bid < T / 16) {
#pragma unroll
        for (int rr = 0; rr < 2; ++rr)
#pragma unroll
            for (int i = 0; i < 2; ++i) zn[rr][i] = *(const u32x4*)(z + (size_t)(bid * 16 + wid * 2 + rr) * D + i * 512 + lane * 8);
    }
    int ti = 0;
    for (int task = bid; task < T / 16; task += nb, ++ti) {
        const int row0 = task * 16;
        u32x4 zc[2][2];
#pragma unroll
        for (int rr = 0; rr < 2; ++rr)
#pragma unroll
            for (int i = 0; i < 2; ++i) zc[rr][i] = zn[rr][i];
        if (task + nb < T / 16) {
#pragma unroll
            for (int rr = 0; rr < 2; ++rr)
#pragma unroll
                for (int i = 0; i < 2; ++i) zn[rr][i] = *(const u32x4*)(z + (size_t)((task + nb) * 16 + wid * 2 + rr) * D + i * 512 + lane * 8);
        }
        __syncthreads();
#pragma unroll
        for (int rr = 0; rr < 2; ++rr) {
            const int lr = wid * 2 + rr;
            const size_t t = (size_t)(row0 + lr);
            float v[2][8];
            float s = 0.f;
#pragma unroll
            for (int i = 0; i < 2; ++i) {
#pragma unroll
                for (int q = 0; q < 4; ++q) { v[i][2 * q] = bflo(zc[rr][i][q]); v[i][2 * q + 1] = bfhi(zc[rr][i][q]); s += v[i][2 * q] + v[i][2 * q + 1]; }
            }
            s = wave_sum(s);
            const float mu = s * (1.0f / D);
            float q2 = 0.f;
#pragma unroll
            for (int i = 0; i < 2; ++i)
#pragma unroll
                for (int k = 0; k < 8; ++k) { const float d = v[i][k] - mu; q2 += d * d; }
            q2 = wave_sum(q2);
            const float rstd = rsqrtf(q2 * (1.0f / D) + LN_EPS);
#pragma unroll
            for (int i = 0; i < 2; ++i) {
                const int col = i * 512 + lane * 8;
                const f32x4 g0 = lgv[i][0], g1 = lgv[i][1], b0 = lbv[i][0], b1 = lbv[i][1];
                f32x4 o0, o1;
#pragma unroll
                for (int k = 0; k < 4; ++k) { o0[k] = (v[i][k] - mu) * rstd * g0[k] + b0[k]; o1[k] = (v[i][4 + k] - mu) * rstd * g1[k] + b1[k]; }
                u32x4 w; w.x = cvtpk(o0[0], o0[1]); w.y = cvtpk(o0[2], o0[3]); w.z = cvtpk(o1[0], o1[1]); w.w = cvtpk(o1[2], o1[3]);
                *(u32x4*)(x1b + t * D + col) = w;
                *(f32x4*)(xs + lr * XS + col) = o0;
                *(f32x4*)(xs + lr * XS + col + 4) = o1;
            }
        }
        __syncthreads();
        {
            f32x4 acc0 = (f32x4){0.f, 0.f, 0.f, 0.f}, acc1 = (f32x4){0.f, 0.f, 0.f, 0.f};
#pragma unroll
            for (int ks = 0; ks < 4; ++ks) {
                const int k = wid * 128 + ks * 32 + 8 * g;
                const f32x4 xa0 = *(const f32x4*)(xs + r * XS + k), xa1 = *(const f32x4*)(xs + r * XS + k + 4);
                u32x4 hw, lw;
                hw.x = cvtpk(xa0[0], xa0[1]); hw.y = cvtpk(xa0[2], xa0[3]); hw.z = cvtpk(xa1[0], xa1[1]); hw.w = cvtpk(xa1[2], xa1[3]);
                lw.x = cvtpk(xa0[0] - bflo(hw.x), xa0[1] - bfhi(hw.x)); lw.y = cvtpk(xa0[2] - bflo(hw.y), xa0[3] - bfhi(hw.y));
                lw.z = cvtpk(xa1[0] - bflo(hw.z), xa1[1] - bfhi(hw.z)); lw.w = cvtpk(xa1[2] - bflo(hw.w), xa1[3] - bfhi(hw.w));
                const bf16x8 xh = __builtin_bit_cast(bf16x8, hw), xl = __builtin_bit_cast(bf16x8, lw);
                acc0 = mfma16(wh[ks][0], xh, acc0); acc0 = mfma16(wh[ks][0], xl, acc0); acc0 = mfma16(wl[ks][0], xh, acc0);
                acc1 = mfma16(wh[ks][1], xh, acc1); acc1 = mfma16(wh[ks][1], xl, acc1); acc1 = mfma16(wl[ks][1], xh, acc1);
            }
            *(f32x4*)(red + (wid * 16 + r) * 32 + 4 * g) = acc0;
            *(f32x4*)(red + (wid * 16 + r) * 32 + 16 + 4 * g) = acc1;
        }
        __syncthreads();
        {
            const int e = tid & 31, i = tid >> 5;
            float s = 0.f;
#pragma unroll
            for (int w = 0; w < 8; ++w) s += red[(w * 16 + i) * 32 + e];
            const float sc = sigmoidf_(s), sv = sc + rb_e;
            const float a1 = __shfl_xor(sv, 1, 64), a2 = __shfl_xor(sv, 2, 64), a3 = __shfl_xor(sv, 3, 64);
            const float c1 = __shfl_xor(sc, 1, 64), c2 = __shfl_xor(sc, 2, 64), c3 = __shfl_xor(sc, 3, 64);
            const float lo1 = fminf(sv, a1), hi1 = fmaxf(sv, a1), lo2 = fminf(a2, a3), hi2 = fmaxf(a2, a3);
            float bv = fmaxf(hi1, hi2) + fmaxf(fminf(hi1, hi2), fmaxf(lo1, lo2));
            int bg = e >> 2;
#pragma unroll
            for (int m = 4; m <= 16; m <<= 1) {
                const float ov = __shfl_xor(bv, m, 64); const int og = __shfl_xor(bg, m, 64);
                if (ov > bv || (ov == bv && og < bg)) { bv = ov; bg = og; }
            }
            if (e == bg * 4) {
                const float vv[4] = {sv, a1, a2, a3}, cc[4] = {sc, c1, c2, c3};
                int i1 = 0; float v1 = vv[0];
#pragma unroll
                for (int k = 1; k < 4; ++k) if (vv[k] > v1) { v1 = vv[k]; i1 = k; }
                int i2 = -1; float v2 = -3.0e38f, s1 = cc[0], s2 = 0.f;
#pragma unroll
                for (int k = 0; k < 4; ++k) { if (k == i1) s1 = cc[k]; }
#pragma unroll
                for (int k = 0; k < 4; ++k) if (k != i1 && vv[k] > v2) { v2 = vv[k]; i2 = k; s2 = cc[k]; }
                const int e1 = bg * 4 + i1, e2 = bg * 4 + i2;
                const float inv = 1.0f / (s1 + s2);
                const int t = row0 + i;
                gate[t * 2] = s1 * inv; gate[t * 2 + 1] = s2 * inv;
                const int lp1 = atomicAdd(&lcnt[e1], 1);
                const int lp2 = atomicAdd(&lcnt[e2], 1);
                if (ti < LN1_MAXT) { sel[(ti * 16 + i) * 2] = e1 | (lp1 << 8); sel[(ti * 16 + i) * 2 + 1] = e2 | (lp2 << 8); }
            }
        }
    }
    __syncthreads();
    const int tz = tid_opaque();
    if (tz < 32) { const int c = lcnt[tz]; gbase[tz] = c ? atomicAdd(&cnt[tz * CNT_STRIDE], c) : 0; }
    __syncthreads();
    if (tz < ti * 32) {
        const int tl = tz >> 5, rw = (tz >> 1) & 15, k = tz & 1;
        const int sv = sel[tz];
        const int e = sv & 255, lp = sv >> 8;
        list[(size_t)e * T + gbase[e] + lp] = ((bid + tl * nb) * 16 + rw) * 2 + k;
    }
}

DI void phase_ln2(const P& p, int layer, int bid, int nb) {
    const bf16_t* x1b = (const bf16_t*)(p.ws + WS_X1B);
    const bf16_t* yasg = (const bf16_t*)(p.ws + WS_YASG);
    bf16_t* xb = (bf16_t*)(p.ws + WS_XB);
    const float* lg = p.ln2_g + (size_t)layer * D;
    const float* lb = p.ln2_b + (size_t)layer * D;
    const int tid = tid_opaque(), lane = tid & 63, wid = tid >> 6;
    f32x4 lgv[2][2], lbv[2][2];
#pragma unroll
    for (int i = 0; i < 2; ++i) { const int col = i * 512 + lane * 8; lgv[i][0] = *(const f32x4*)(lg + col); lgv[i][1] = *(const f32x4*)(lg + col + 4); lbv[i][0] = *(const f32x4*)(lb + col); lbv[i][1] = *(const f32x4*)(lb + col + 4); }
    for (int t = bid * NWAVES + wid; t < T; t += nb * NWAVES) {
        float v[2][8];
        float s = 0.f;
#pragma unroll
        for (int i = 0; i < 2; ++i) {
            const int col = i * 512 + lane * 8;
            const u32x4 xv = *(const u32x4*)(x1b + (size_t)t * D + col);
            const u32x4 y0 = *(const u32x4*)(yasg + (size_t)(2 * t) * D + col);
            const u32x4 y1 = *(const u32x4*)(yasg + (size_t)(2 * t + 1) * D + col);
#pragma unroll
            for (int q = 0; q < 4; ++q) {
                v[i][2 * q] = bflo(xv[q]) * ALPHA + (bflo(y0[q]) + bflo(y1[q]));
                v[i][2 * q + 1] = bfhi(xv[q]) * ALPHA + (bfhi(y0[q]) + bfhi(y1[q]));
                s += v[i][2 * q] + v[i][2 * q + 1];
            }
        }
        s = wave_sum(s);
        const float mu = s * (1.0f / D);
        float q2 = 0.f;
#pragma unroll
        for (int i = 0; i < 2; ++i)
#pragma unroll
            for (int k = 0; k < 8; ++k) { const float d = v[i][k] - mu; q2 += d * d; }
        q2 = wave_sum(q2);
        const float rstd = rsqrtf(q2 * (1.0f / D) + LN_EPS);
#pragma unroll
        for (int i = 0; i < 2; ++i) {
            const int col = i * 512 + lane * 8;
            const f32x4 g0 = lgv[i][0], g1 = lgv[i][1], b0 = lbv[i][0], b1 = lbv[i][1];
            f32x4 o0, o1;
#pragma unroll
            for (int k = 0; k < 4; ++k) { o0[k] = (v[i][k] - mu) * rstd * g0[k] + b0[k]; o1[k] = (v[i][4 + k] - mu) * rstd * g1[k] + b1[k]; }
            if (layer == DEPTH - 1) {
                *(f32x4*)(p.out + (size_t)t * D + col) = o0;
                *(f32x4*)(p.out + (size_t)t * D + col + 4) = o1;
            } else {
                u32x4 w; w.x = cvtpk(o0[0], o0[1]); w.y = cvtpk(o0[2], o0[3]); w.z = cvtpk(o1[0], o1[1]); w.w = cvtpk(o1[2], o1[3]);
                *(u32x4*)(xb + (size_t)t * D + col) = w;
            }
        }
    }
}

#define XB_TMO      128
#define XB_XCNT(j)  (256  + 64 * (j))
#define XB_XSUB(j)  (1280 + 64 * (j))
#define XB_XGEN(j)  (2304 + 64 * (j))
#define XB_TOP      3328
#define XB_TOPGEN   3392
#define XCD_BAR_WORDS 3456
#define XB_SPIN_CAP (1u << 20)
DI unsigned xb_ld(unsigned* p_) { return __hip_atomic_load(p_, __ATOMIC_RELAXED, __HIP_MEMORY_SCOPE_AGENT); }
DI unsigned xb_add(unsigned* p_, unsigned v) { return __hip_atomic_fetch_add(p_, v, __ATOMIC_RELAXED, __HIP_MEMORY_SCOPE_AGENT); }
DI unsigned xb_xcc_id() { return (unsigned)__builtin_amdgcn_s_getreg((3 << 11) | 20) & 0xFu; }
#define XB_SPIN(cond, bar) do { unsigned _sp = 0; while (cond) { __builtin_amdgcn_s_sleep(1); \
    if ((++_sp & 255u) == 0u) { if (xb_ld(&(bar)[XB_TMO])) break; if (_sp > XB_SPIN_CAP) { atomicAdd(&(bar)[XB_TMO], 1u); break; } } } } while (0)
struct XcdBarrier { unsigned* bar; unsigned x; volatile LAS unsigned* st; };
DI XcdBarrier xcd_barrier_post(unsigned* bar, volatile LAS unsigned* st) {
    XcdBarrier b; b.bar = bar; b.x = xb_xcc_id(); b.st = st;
    if (threadIdx.x == 0) (void)xb_add(&bar[XB_XCNT(b.x)], 1u);
    return b;
}
DI void xcd_barrier_complete(unsigned* bar, unsigned x, unsigned& nloc, unsigned& nx) {
    const unsigned G = gridDim.x * gridDim.y * gridDim.z;
    unsigned sum, cnt, mine, sp = 0u;
    for (;;) {
        sum = 0u; cnt = 0u; mine = 0u;
#pragma unroll
        for (unsigned j = 0; j < 16; ++j) { const unsigned c = xb_ld(&bar[XB_XCNT(j)]); sum += c; cnt += (c > 0u) ? 1u : 0u; mine = (j == x) ? c : mine; }
        if (sum == G) break;
        __builtin_amdgcn_s_sleep(1);
        if ((++sp & 255u) == 0u) { if (xb_ld(&bar[XB_TMO])) break; if (sp > XB_SPIN_CAP) { atomicAdd(&bar[XB_TMO], 1u); break; } }
    }
    nloc = mine > 0u ? mine : 1u; nx = cnt > 0u ? cnt : 1u;
}
DI void xcd_barrier(const XcdBarrier& b) {
    asm volatile("s_waitcnt vmcnt(0)" ::: "memory");
    __syncthreads();
    if (tid_opaque() == 0) {
        unsigned* bar = b.bar;
        __builtin_amdgcn_s_waitcnt(0);
        unsigned nloc = b.st[0], nx = b.st[1];
        if (nloc == 0u) { xcd_barrier_complete(bar, b.x, nloc, nx); b.st[0] = nloc; b.st[1] = nx; }
        const unsigned old = xb_add(&bar[XB_XSUB(b.x)], 1u);
        const unsigned gen = old / nloc;
        if (old + 1u == (gen + 1u) * nloc) {
            __builtin_amdgcn_fence(__ATOMIC_RELEASE, "agent");
            asm volatile("s_waitcnt vmcnt(0)" ::: "memory");
            const unsigned og = xb_add(&bar[XB_TOP], 1u);
            const unsigned tg = og / nx;
            if (og + 1u == (tg + 1u) * nx) xb_add(&bar[XB_TOPGEN], 1u);
            else XB_SPIN(xb_ld(&bar[XB_TOPGEN]) == tg, bar);
            __builtin_amdgcn_fence(__ATOMIC_ACQUIRE, "agent");
            xb_add(&bar[XB_XGEN(b.x)], 1u);
            asm volatile("s_waitcnt vmcnt(0)" ::: "memory");
        } else {
            XB_SPIN(xb_ld(&bar[XB_XGEN(b.x)]) == gen, bar);
            __builtin_amdgcn_fence(__ATOMIC_ACQUIRE, "agent");
            asm volatile("s_waitcnt vmcnt(0)" ::: "memory");
        }
    }
    __syncthreads();
}

enum { PH_INPROJ = 0, PH_MIX1, PH_MIX2, PH_MIX3, PH_OUTPROJ, PH_LN1, PH_MOE, PH_LN2, PH_PER_LAYER, PH_PREP = 100, PH_KV = 101 };

DI void run_phase(const P& p, int ph, int layer, int bid, int nb, char* smem) {
    const bool conv = (layer & 1) == 0;
    if (ph == PH_PREP) phase_prep(p, bid, nb, smem);
    if (ph == PH_KV) phase_kv(p, bid, nb, smem);
    if (ph == PH_INPROJ) phase_inproj(p, layer, bid, nb, smem);
    if (ph == PH_MIX1) phase_ml_local(p, bid, nb, smem);
    if (ph == PH_MIX2) phase_ml_scan(p, bid, nb);
    if (ph == PH_MIX3) {
        if (conv) phase_convmix(p, layer, bid, nb);
        else phase_ml_out(p, layer, bid, nb, smem);
    }
    if (ph == PH_MIX1 || (ph == PH_MIX3 && conv)) phase_xattn(p, layer, bid, nb, smem);
    if (ph == PH_OUTPROJ) phase_outproj(p, layer, bid, nb, smem);
    if (ph == PH_LN1) { phase_ln1_route(p, layer, bid, nb, smem); if (layer > 0) moe_steal(p, 1 << 20, (layer + 1) * MOE_TILES_PER_LAYER, smem); }
    if (ph == PH_MOE) phase_moe(p, layer, bid, nb, smem);
    if (ph == PH_LN2) phase_ln2(p, layer, bid, nb);
}

__global__ void __launch_bounds__(NTHREADS, 2) mega(P p) {
    __shared__ __attribute__((aligned(16))) char smem[SMEM_BYTES];
    const int bid = blockIdx.x, nb = gridDim.x;
    volatile LAS unsigned* st = (volatile LAS unsigned*)(smem + SMEM_BYTES - 16);
    if (threadIdx.x == 0) { st[0] = 0u; st[1] = 0u; }
    __syncthreads();
    XcdBarrier xb = xcd_barrier_post((unsigned*)(p.ws + WS_CTL), st);
#pragma unroll 1
    for (int s = -2; s < DEPTH * PH_PER_LAYER; ++s) {
        int ph = (s == -2) ? (int)PH_PREP : (s == -1) ? (int)PH_KV : s % PH_PER_LAYER;
        int layer = (s < 0) ? 0 : s / PH_PER_LAYER;
        if ((layer & 1) == 0 && (ph == PH_MIX1 || ph == PH_MIX2)) continue;
        int b_ = bid, n_ = nb;
        asm volatile("" : "+s"(ph), "+s"(layer), "+s"(b_), "+s"(n_));
        P q = p;
        asm volatile("" : "+s"(q.ws));
        run_phase(q, ph, layer, b_, n_, smem);
#ifdef PROBE_MASK
        if (ph < 31 && ((PROBE_MASK >> ph) & 1)) { __syncthreads(); run_phase(q, ph, layer, b_, n_, smem); }
#endif
        if (ph != PH_KV) xcd_barrier(xb);
    }
}

extern "C" void kernel_launch(void* const* d_in, const int* in_sizes, int n_in, void* d_out, int out_size, void* d_ws, size_t ws_size,
                              hipStream_t stream) {
    if (ws_size < WS_TOTAL) { fprintf(stderr, "kernel_launch: workspace too small: %zu < %zu\n", ws_size, (size_t)WS_TOTAL); return; }
    static int grid_blocks = 0;
    if (!grid_blocks) {
        int dev = 0, cus = 0, per_cu = 0;
        (void)hipGetDevice(&dev);
        (void)hipDeviceGetAttribute(&cus, hipDeviceAttributeMultiprocessorCount, dev);
        if (hipOccupancyMaxActiveBlocksPerMultiprocessor(&per_cu, (const void*)mega, NTHREADS, 0) != hipSuccess) per_cu = 0;
        if (per_cu < 1 || cus < 1) { fprintf(stderr, "kernel_launch: occupancy query failed (per_cu=%d cus=%d)\n", per_cu, cus); return; }
        grid_blocks = cus;
    }
    P p{};
    p.x = (const float*)d_in[0]; p.mem = (const float*)d_in[1]; p.conv_w_in = (const float*)d_in[2]; p.conv_w = (const float*)d_in[3];
    p.ml_w_in = (const float*)d_in[4]; p.ml_gate_b = (const float*)d_in[5]; p.ml_norm_g = (const float*)d_in[6]; p.w_kv = (const float*)d_in[7];
    p.w_out = (const float*)d_in[8]; p.ln1_g = (const float*)d_in[9]; p.ln1_b = (const float*)d_in[10]; p.ln2_g = (const float*)d_in[11];
    p.ln2_b = (const float*)d_in[12]; p.router_w = (const float*)d_in[13]; p.router_b = (const float*)d_in[14]; p.w_gate = (const float*)d_in[15];
    p.w_up = (const float*)d_in[16]; p.w_down = (const float*)d_in[17];
    p.out = (float*)d_out; p.ws = (char*)d_ws;
    (void)hipMemsetAsync((char*)d_ws + WS_CTL, 0, CTL_BYTES, stream);
    void* args[] = {&p};
    hipError_t e = hipLaunchCooperativeKernel((const void*)mega, dim3(grid_blocks), dim3(NTHREADS), args, 0, stream);
    if (e != hipSuccess) fprintf(stderr, "kernel_launch: cooperative launch failed: %s (grid %d)\n", hipGetErrorString(e), grid_blocks);
}
```

```cpp
#include <hip/hip_runtime.h>
#include <stdint.h>
#include <stdio.h>

typedef unsigned short bf16_t;
typedef __attribute__((ext_vector_type(8))) short bf16x8;
typedef __attribute__((ext_vector_type(4))) float f32x4;
typedef __attribute__((ext_vector_type(4))) unsigned u32x4;
typedef __attribute__((ext_vector_type(2))) unsigned u32x2;

#define DI __device__ __forceinline__
#define LAS __attribute__((address_space(3)))

constexpr int D = 1024;
constexpr int NBATCH = 8;
constexpr int SEQ = 2048;
constexpr int T = NBATCH * SEQ;
constexpr int DEPTH = 4;
constexpr int MIXW = 768;
constexpr int XH = 4, XDH = 64, XW = 256, MEML = 256;
constexpr int MLH = 6, MLDH = 128, CHUNK = 128, NCH = SEQ / CHUNK;
constexpr int DIN_CONV = 2560, DIN_ML = 3340, LDP_ML = 3328, NV_ML = 3584;
constexpr int NE = 32, DFF = 512;
constexpr float ALPHA = 1.681792830507429f;
constexpr float LN_EPS = 1e-5f;

constexpr int NTHREADS = 512;
constexpr int NWAVES = 8;
constexpr int STAGE_BYTES = 131072;
constexpr int META_OFF = STAGE_BYTES;
constexpr int SMEM_BYTES = STAGE_BYTES + 4096;

constexpr size_t al256(size_t x) { return (x + 255) & ~(size_t)255; }
constexpr size_t WS_CTL   = 0;
constexpr size_t CTL_BYTES = 128 * 1024;
constexpr size_t CTL_CNT  = 32 * 1024;
constexpr int CNT_STRIDE = 64;
constexpr size_t CTL_READY = 64 * 1024;
constexpr size_t CTL_STOP = 14 * 1024;
constexpr size_t CTL_TMO  = 15 * 1024;
constexpr size_t CTL_TQ   = 16 * 1024;
constexpr size_t WS_XB    = WS_CTL + CTL_BYTES;
constexpr size_t WS_MEMB  = WS_XB + (size_t)T * D * 2;
constexpr size_t WS_KBUF  = WS_MEMB + (size_t)NBATCH * MEML * D * 2;
constexpr size_t WS_VT    = WS_KBUF + (size_t)DEPTH * NBATCH * MEML * XW * 2;
constexpr size_t WS_PROJ  = WS_VT + (size_t)DEPTH * NBATCH * MEML * XW * 2;
constexpr size_t WS_Z     = WS_PROJ;
constexpr size_t WS_LOGI  = WS_PROJ + (size_t)T * LDP_ML * 2;
constexpr size_t WS_CT    = WS_LOGI + (size_t)T * 16 * 4;
constexpr size_t WS_CPB   = WS_CT + (size_t)48 * NCH * 128 * 128 * 4;
constexpr size_t WS_NLOC  = WS_CPB + (size_t)48 * NCH * 128 * 128 * 2;
constexpr size_t WS_NPREV = WS_NLOC + (size_t)48 * NCH * 128 * 4;
constexpr size_t WS_MLOC  = WS_NPREV + (size_t)48 * NCH * 128 * 4;
constexpr size_t WS_GSUM  = WS_MLOC + al256(48 * NCH * 4);
constexpr size_t WS_MPREV = WS_GSUM + al256(48 * NCH * 4);
constexpr size_t WS_HCAT  = WS_MPREV + al256(48 * NCH * 4);
constexpr size_t WS_X1B   = WS_HCAT + (size_t)T * D * 2;
constexpr size_t WS_GATE  = WS_X1B + (size_t)T * D * 2;
constexpr size_t WS_LIST  = WS_GATE + (size_t)T * 2 * 4;
constexpr size_t WS_HBUF  = WS_LIST + (size_t)NE * T * 4;
constexpr size_t WS_YASG  = WS_HBUF + (size_t)T * 2 * DFF * 2;
constexpr size_t WS_WIN   = WS_YASG + (size_t)T * 2 * D * 2;
constexpr size_t WS_WKV   = WS_WIN + ((size_t)2 * DIN_CONV + (size_t)2 * NV_ML) * D * 2;
constexpr size_t WS_WOUT  = WS_WKV + (size_t)DEPTH * 512 * D * 2;
constexpr size_t WS_WGU   = WS_WOUT + (size_t)DEPTH * D * D * 2;
constexpr size_t WS_WD    = WS_WGU + (size_t)DEPTH * NE * 1024 * D * 2;
constexpr size_t WS_RWT   = WS_WD + (size_t)DEPTH * NE * D * DFF * 2;
constexpr size_t WS_TOTAL = WS_RWT + (size_t)2 * NE * D * 2;

struct P {
    const float *x, *mem, *conv_w_in, *conv_w, *ml_w_in, *ml_gate_b, *ml_norm_g, *w_kv, *w_out;
    const float *ln1_g, *ln1_b, *ln2_g, *ln2_b, *router_w, *router_b, *w_gate, *w_up, *w_down;
    float* out;
    char* ws;
};

DI unsigned cvtpk(float lo, float hi) { unsigned r; asm("v_cvt_pk_bf16_f32 %0, %1, %2" : "=v"(r) : "v"(lo), "v"(hi)); return r; }
DI float bf2f(bf16_t v) { return __uint_as_float(((unsigned)v) << 16); }
DI float bflo(unsigned v) { return __uint_as_float(v << 16); }
DI float bfhi(unsigned v) { return __uint_as_float(v & 0xffff0000u); }
DI bf16_t f2bf(float f) { return (bf16_t)(cvtpk(f, f) & 0xffffu); }
DI float sigmoidf_(float x) { return 1.0f / (1.0f + __expf(-x)); }
DI float logsigmoidf_(float x) { return fminf(x, 0.0f) - log1pf(__expf(-fabsf(x))); }
DI float xor_add(float v, int m) { return v + __shfl_xor(v, m, 64); }
DI float xor_max(float v, int m) { return fmaxf(v, __shfl_xor(v, m, 64)); }
DI float wave_sum(float v) { v = xor_add(v, 32); v = xor_add(v, 16); v = xor_add(v, 8); v = xor_add(v, 4); v = xor_add(v, 2); v = xor_add(v, 1); return v; }
DI int tid_opaque() { int t = threadIdx.x; asm volatile("" : "+v"(t)); return t; }
DI f32x4 mfma16(bf16x8 a, bf16x8 b, f32x4 c) { return __builtin_amdgcn_mfma_f32_16x16x32_bf16(a, b, c, 0, 0, 0); }

namespace g8 {
constexpr int BM = 256, BK = 64, HALF = 128, HTB = HALF * BK * 2, NXCD = 8, WGM = 8;
DI int lds_byte(int r, int c) { const int st = (r >> 4) * 2 + (c >> 5), rr = r & 15, cc = c & 31, ob = rr * 64 + cc * 2; return st * 1024 + (ob ^ (((ob >> 9) & 1) << 5)); }
DI void stage_rc(int b, int& R, int& C) { const int st = b / 1024, sb = b % 1024, swz = sb ^ (((sb >> 9) & 1) << 5); R = (st >> 1) * 16 + swz / 64; C = (st & 1) * 32 + (swz % 64) / 2; }
DI int perm32(int rho) { const int n = rho >> 4, i = rho & 15; return 8 * (i >> 2) + 4 * n + (i & 3); }
DI int xcd_remap(int L, int n) { const int q = n / NXCD, r = n % NXCD, xcd = L % NXCD, off = L / NXCD; return (xcd < r ? xcd * (q + 1) : r * (q + 1) + (xcd - r) * q) + off; }

struct Unit { int pm, pn, e, valid, rbase, rti; };
DI const char* uni(const char* p_) {
    const unsigned long long v = (unsigned long long)p_;
    const unsigned lo = (unsigned)__builtin_amdgcn_readfirstlane((int)(unsigned)v), hi = (unsigned)__builtin_amdgcn_readfirstlane((int)(unsigned)(v >> 32));
    return (const char*)(((unsigned long long)hi << 32) | lo);
}

template <bool GATHER, class Epi, class Sched>
DI void gemm_phase(LAS unsigned char* lds, const int K, const Sched& S, const Epi& E) {
    const int tid = tid_opaque(), wid = __builtin_amdgcn_readfirstlane(tid >> 6), lane = tid & 63, wr = wid >> 2, wc = wid & 3, fr = lane & 15, fq = lane >> 4;
    const int nt = K / BK;
    const size_t kstep = (size_t)(BK * 2);
    const size_t hstep = (size_t)HALF * K * 2;
    unsigned vB0, vB1;
    {
        int R0, C0, R1, C1;
        stage_rc(tid * 16, R0, C0); stage_rc(tid * 16 + 8192, R1, C1);
        const int Rb0 = Epi::PERM ? ((R0 & ~31) + perm32(R0 & 31)) : R0, Rb1 = Epi::PERM ? ((R1 & ~31) + perm32(R1 & 31)) : R1;
        vB0 = (unsigned)(Rb0 * K + C0) * 2u; vB1 = (unsigned)(Rb1 * K + C1) * 2u;
    }
    const unsigned ldsw = (unsigned)wid * 1024u;
    const int aoff = lds_byte(wr * 64 + fr, fq * 8), boff = lds_byte(wc * 32 + fr, fq * 8);
#define G8_SA(b, h) (((b) * 2 + (h)) * HTB)
#define G8_SB(b, h) ((4 + (b) * 2 + (h)) * HTB)
#define G8_STAGE(bufoff, gbase, v0, v1) do { unsigned _o0 = (v0), _o1 = (v1); asm volatile("" : "+v"(_o0), "+v"(_o1));     \
        __builtin_amdgcn_global_load_lds((const unsigned*)((const char*)(gbase) + _o0), (LAS unsigned*)(lds + (bufoff) + ldsw), 16, 0, 0); \
        __builtin_amdgcn_global_load_lds((const unsigned*)((const char*)(gbase) + _o1), (LAS unsigned*)(lds + (bufoff) + ldsw + 8192), 16, 0, 0); } while (0)
#define G8_LDA(dst, b, h) do { _Pragma("unroll") for (int m = 0; m < 4; ++m) _Pragma("unroll") for (int k = 0; k < 2; ++k) dst[m][k] = *(const LAS bf16x8*)(lds + G8_SA(b, h) + aoff + m * 2048 + k * 1024); } while (0)
#define G8_LDB(dst, b, h) do { _Pragma("unroll") for (int n = 0; n < 2; ++n) _Pragma("unroll") for (int k = 0; k < 2; ++k) dst[n][k] = *(const LAS bf16x8*)(lds + G8_SB(b, h) + boff + n * 2048 + k * 1024); } while (0)
#define G8_MMA(ai, bj, At, Bt) do { __builtin_amdgcn_s_setprio(1); _Pragma("unroll") for (int m = 0; m < 4; ++m) _Pragma("unroll") for (int n = 0; n < 2; ++n) _Pragma("unroll") for (int k = 0; k < 2; ++k) \
        acc[ai][bj][m][n] = __builtin_amdgcn_mfma_f32_16x16x32_bf16(Bt[n][k], At[m][k], acc[ai][bj][m][n], 0, 0, 0); __builtin_amdgcn_s_setprio(0); } while (0)
#define G8_WAIT_V(n) asm volatile("s_waitcnt vmcnt(" #n ")" ::: "memory")
#define G8_WAIT_L(n) asm volatile("s_waitcnt lgkmcnt(" #n ")" ::: "memory")
#define G8_BAR __builtin_amdgcn_s_barrier()
#define G8_SCHED __builtin_amdgcn_sched_barrier(0)
    Unit cur, nxt;
    int ui = 0;
    if (!S.next(0, cur)) return;
    f32x4 acc[2][2][4][2];
#pragma unroll
    for (int a = 0; a < 2; ++a)
#pragma unroll
        for (int b = 0; b < 2; ++b)
#pragma unroll
            for (int m = 0; m < 4; ++m)
#pragma unroll
                for (int n = 0; n < 2; ++n) acc[a][b][m][n] = (f32x4){0.f, 0.f, 0.f, 0.f};
    bf16x8 At[4][2], B0[2][2], B1[2][2];
    S.a_ready(cur);
    const char* cA = S.a_base(cur);
    const char* cB = S.b_base(cur);
    unsigned cv00, cv01, cv10, cv11, nv00, nv01, nv10, nv11;
    {
        int R0, C0, R1, C1;
        stage_rc(tid * 16, R0, C0); stage_rc(tid * 16 + 8192, R1, C1);
        int rows[2][2];
        S.a_rows(cur, R0, R1, rows);
        cv00 = (unsigned)(rows[0][0] * K + C0) * 2u; cv01 = (unsigned)(rows[0][1] * K + C1) * 2u;
        cv10 = (unsigned)(rows[1][0] * K + C0) * 2u; cv11 = (unsigned)(rows[1][1] * K + C1) * 2u;
        nv00 = cv00; nv01 = cv01; nv10 = cv10; nv11 = cv11;
    }
    G8_STAGE(G8_SB(0, 0), uni(cB), vB0, vB1); G8_STAGE(G8_SA(0, 0), uni(cA), cv00, cv01); G8_STAGE(G8_SB(0, 1), uni(cB + hstep), vB0, vB1); G8_STAGE(G8_SA(0, 1), uni(cA), cv10, cv11);
    if (wr == 1) G8_BAR;
    G8_WAIT_V(4); G8_BAR;
    G8_STAGE(G8_SB(1, 0), uni(cB + kstep), vB0, vB1); G8_STAGE(G8_SA(1, 0), uni(cA + kstep), cv00, cv01); G8_STAGE(G8_SB(1, 1), uni(cB + hstep + kstep), vB0, vB1);
    G8_WAIT_V(6); G8_BAR;
    for (;;) {
        const bool has_next = S.next(ui + 1, nxt);
        const char* nA = has_next ? S.a_base(nxt) : cA;
        const char* nB = has_next ? S.b_base(nxt) : cB;
        if (GATHER) {
            if (has_next) {
                const int tid2 = tid_opaque();
                int R0, C0, R1, C1;
                stage_rc(tid2 * 16, R0, C0); stage_rc(tid2 * 16 + 8192, R1, C1);
                int rows[2][2];
                S.a_rows(nxt, R0, R1, rows);
                nv00 = (unsigned)(rows[0][0] * K + C0) * 2u; nv01 = (unsigned)(rows[0][1] * K + C1) * 2u;
                nv10 = (unsigned)(rows[1][0] * K + C0) * 2u; nv11 = (unsigned)(rows[1][1] * K + C1) * 2u;
            } else { nv00 = cv00; nv01 = cv01; nv10 = cv10; nv11 = cv11; }
        }
        for (int t = 0; t < nt; t += 2) {
            const bool last = (t == nt - 2);
            if (last && has_next) S.a_ready(nxt);
            const char* a1 = uni(cA + (size_t)(t + 1) * kstep);
            const char* a2 = uni(last ? nA : cA + (size_t)(t + 2) * kstep);
            const char* b2 = uni(last ? nB : cB + (size_t)(t + 2) * kstep);
            const char* a3 = uni(a2 + kstep);
            const char* b3 = uni(b2 + kstep);
            const char* b2h = uni(b2 + hstep);
            const char* b3h = uni(b3 + hstep);
            unsigned x00 = cv00, x01 = cv01, x10 = cv10, x11 = cv11;
            if (GATHER) { x00 = last ? nv00 : cv00; x01 = last ? nv01 : cv01; x10 = last ? nv10 : cv10; x11 = last ? nv11 : cv11; }
            G8_LDB(B0, 0, 0); G8_SCHED; G8_LDA(At, 0, 0); G8_STAGE(G8_SA(1, 1), a1, cv10, cv11);
            G8_WAIT_L(8); G8_BAR; G8_WAIT_L(0); G8_MMA(0, 0, At, B0); G8_BAR; G8_SCHED;
            G8_LDB(B1, 0, 1); G8_STAGE(G8_SB(0, 0), b2, vB0, vB1);
            G8_BAR; G8_WAIT_L(0); G8_MMA(0, 1, At, B1); G8_BAR;
            G8_LDA(At, 0, 1); G8_STAGE(G8_SA(0, 0), a2, x00, x01);
            G8_BAR; G8_WAIT_L(0); G8_MMA(1, 0, At, B0); G8_BAR; G8_SCHED;
            G8_STAGE(G8_SB(0, 1), b2h, vB0, vB1);
            G8_WAIT_V(6);
            G8_BAR; G8_MMA(1, 1, At, B1); G8_BAR;
            G8_LDB(B0, 1, 0); G8_SCHED; G8_LDA(At, 1, 0); G8_STAGE(G8_SA(0, 1), a2, x10, x11);
            G8_WAIT_L(8); G8_BAR; G8_WAIT_L(0); G8_MMA(0, 0, At, B0); G8_BAR; G8_SCHED;
            G8_LDB(B1, 1, 1); G8_STAGE(G8_SB(1, 0), b3, vB0, vB1);
            G8_BAR; G8_WAIT_L(0); G8_MMA(0, 1, At, B1); G8_BAR;
            G8_LDA(At, 1, 1); G8_STAGE(G8_SA(1, 0), a3, x00, x01);
            G8_BAR; G8_WAIT_L(0); G8_MMA(1, 0, At, B0); G8_BAR; G8_SCHED;
            G8_STAGE(G8_SB(1, 1), b3h, vB0, vB1);
            G8_WAIT_V(6); G8_BAR; G8_MMA(1, 1, At, B1); G8_BAR;
        }
        E(acc, cur, wr, wc, fr, fq);
        if (!has_next) break;
#pragma unroll
        for (int a = 0; a < 2; ++a)
#pragma unroll
            for (int b = 0; b < 2; ++b)
#pragma unroll
                for (int m = 0; m < 4; ++m)
#pragma unroll
                    for (int n = 0; n < 2; ++n) acc[a][b][m][n] = (f32x4){0.f, 0.f, 0.f, 0.f};
        cur = nxt; cA = nA; cB = nB; ++ui;
        if (GATHER) { cv00 = nv00; cv01 = nv01; cv10 = nv10; cv11 = nv11; }
    }
    G8_WAIT_V(0);
    if (wr == 0) G8_BAR;
    G8_BAR;
#undef G8_SA
#undef G8_SB
#undef G8_STAGE
#undef G8_LDA
#undef G8_LDB
#undef G8_MMA
#undef G8_WAIT_V
#undef G8_WAIT_L
#undef G8_BAR
#undef G8_SCHED
}

struct DenseSched {
    const char* A; const char* Bt; int K, nM, nN, nwg, G, c;
    DI void init(const void* A_, const void* Bt_, int M, int N, int K_, int G_, int c_) { A = (const char*)A_; Bt = (const char*)Bt_; K = K_; nM = M / BM; nN = N / BM; nwg = nM * nN; G = G_; c = c_; }
    DI bool next(int i, Unit& u) const {
        const int L = i * G + c;
        if (L >= nwg) return false;
        const int wgid = xcd_remap(L, nwg);
        const int nig = WGM * nN, gid = wgid / nig, fm = gid * WGM, gsz = (nM - fm) < WGM ? (nM - fm) : WGM;
        u.pm = fm + ((wgid % nig) % gsz); u.pn = (wgid % nig) / gsz; u.e = 0; u.valid = 256; u.rbase = 0; u.rti = 0;
        return true;
    }
    DI const char* a_base(const Unit& u) const { return A + (size_t)u.pm * 256 * K * 2; }
    DI const char* b_base(const Unit& u) const { return Bt + (size_t)u.pn * 256 * K * 2; }
    DI void a_rows(const Unit&, int R0, int R1, int (&rows)[2][2]) const { rows[0][0] = R0; rows[0][1] = R1; rows[1][0] = 128 + R0; rows[1][1] = 128 + R1; }
    DI void a_ready(const Unit&) const {}
};
}

struct TJ { const float* s[4]; float sc[4]; bf16_t* d[2]; };

template <class ColPtr>
DI void tj_make(TJ& j, ColPtr colptr, int ld, int k0, int v0, bf16_t* dst, int K, int tid) {
#pragma unroll
    for (int i = 0; i < 4; ++i) {
        const int idx = tid + NTHREADS * i, kr = idx >> 5, c4 = idx & 31;
        float sc;
        const float* src = colptr(v0 + 4 * c4, sc);
        j.s[i] = src + (size_t)(k0 + kr) * ld; j.sc[i] = sc;
    }
#pragma unroll
    for (int i = 0; i < 2; ++i) {
        const int ch = tid + NTHREADS * i, vr = ch >> 3, kc = ch & 7;
        j.d[i] = dst + (size_t)(v0 + vr) * K + k0 + kc * 8;
    }
}
DI void tj_load(const TJ& j, f32x4 (&v)[4]) {
#pragma unroll
    for (int i = 0; i < 4; ++i) v[i] = __builtin_nontemporal_load((const f32x4*)j.s[i]);
}
DI void tj_finish(const TJ& j, const f32x4 (&v)[4], float* tile, int tid) {
    constexpr int TS = 129;
    __syncthreads();
#pragma unroll
    for (int i = 0; i < 4; ++i) {
        const int idx = tid + NTHREADS * i, kr = idx >> 5, c4 = idx & 31;
        float* tp = tile + kr * TS + 4 * c4;
        tp[0] = v[i][0] * j.sc[i]; tp[1] = v[i][1] * j.sc[i]; tp[2] = v[i][2] * j.sc[i]; tp[3] = v[i][3] * j.sc[i];
    }
    __syncthreads();
#pragma unroll
    for (int i = 0; i < 2; ++i) {
        const int ch = tid + NTHREADS * i, vr = ch >> 3, kc = ch & 7;
        const float* tp = tile + (kc * 8) * TS + vr;
        u32x4 w;
        w.x = cvtpk(tp[0], tp[TS]); w.y = cvtpk(tp[2 * TS], tp[3 * TS]); w.z = cvtpk(tp[4 * TS], tp[5 * TS]); w.w = cvtpk(tp[6 * TS], tp[7 * TS]);
        __builtin_nontemporal_store(w, (u32x4*)j.d[i]);
    }
}

constexpr int MOE_TILES_PER_LAYER = NE * (16 * 8 + 8 * 8);
DI void moe_tile_job(const P& p, int q, int tid, TJ& j) {
    const int layer = q / MOE_TILES_PER_LAYER, r = q % MOE_TILES_PER_LAYER;
    if (r < NE * 128) {
        const int le = layer * NE + (r >> 7), qq = r & 127, kt = qq >> 3, vt = qq & 7;
        const float* Wg = p.w_gate + (size_t)le * D * DFF;
        const float* Wu = p.w_up + (size_t)le * D * DFF;
        tj_make(j, [&](int v4, float& sc) { sc = 1.0f; const int grp = v4 >> 7; return ((grp & 1) ? Wu : Wg) + (grp >> 1) * 128 + (v4 & 127); },
                DFF, kt * 64, vt * 128, (bf16_t*)(p.ws + WS_WGU) + (size_t)le * 1024 * D, D, tid);
    } else {
        const int r2 = r - NE * 128, le = layer * NE + (r2 >> 6), qq = r2 & 63, kt = qq >> 3, vt = qq & 7;
        const float* W = p.w_down + (size_t)le * DFF * D;
        tj_make(j, [&](int v4, float& sc) { sc = 1.0f; return W + v4; }, D, kt * 64, vt * 128, (bf16_t*)(p.ws + WS_WD) + (size_t)le * D * DFF, DFF, tid);
    }
}

constexpr int PT_CONV = 16 * 20, PT_ML = 16 * 28, PT_KV = 16 * 4, PT_OUT = 16 * 8;
constexpr int PN0 = 2 * PT_CONV, PN1 = PN0 + 2 * PT_ML, PN2 = PN1 + 4 * PT_KV, PN3 = PN2 + 4 * PT_OUT, PN5 = PN3 + MOE_TILES_PER_LAYER;
DI void prep_tile_job(const P& p, int it, int tid, TJ& j) {
    if (it < PN0) {
        const int jj = it / PT_CONV, q = it % PT_CONV, kt = q / 20, vt = q % 20;
        const float* W = p.conv_w_in + (size_t)jj * D * DIN_CONV;
        tj_make(j, [&](int v4, float& sc) { sc = 1.0f; return W + v4; }, DIN_CONV, kt * 64, vt * 128, (bf16_t*)(p.ws + WS_WIN) + (size_t)jj * DIN_CONV * D, D, tid);
    } else if (it < PN1) {
        const int r = it - PN0, jj = r / PT_ML, q = r % PT_ML, kt = q / 28, vt = q % 28;
        const float* W = p.ml_w_in + (size_t)jj * D * DIN_ML;
        tj_make(j, [&](int v4, float& sc) -> const float* {
                    sc = (v4 >= MIXW && v4 < 2 * MIXW) ? 0.08838834764831845f : 1.0f;
                    if (v4 < 3072) return W + v4;
                    if (v4 < 3328) return W + 3084 + (v4 - 3072);
                    if (v4 < 3340) return W + 3072 + (v4 - 3328);
                    sc = 0.0f; return W; },
                DIN_ML, kt * 64, vt * 128, (bf16_t*)(p.ws + WS_WIN) + ((size_t)2 * DIN_CONV + (size_t)jj * NV_ML) * D, D, tid);
    } else if (it < PN2) {
        const int r = it - PN1, l = r / PT_KV, q = r % PT_KV, kt = q / 4, vt = q % 4;
        const float* W = p.w_kv + (size_t)l * D * 512;
        tj_make(j, [&](int v4, float& sc) { sc = 1.0f; return W + v4; }, 512, kt * 64, vt * 128, (bf16_t*)(p.ws + WS_WKV) + (size_t)l * 512 * D, D, tid);
    } else if (it < PN3) {
        const int r = it - PN2, l = r / PT_OUT, q = r % PT_OUT, kt = q / 8, vt = q % 8;
        const float* W = p.w_out + (size_t)l * D * D;
        tj_make(j, [&](int v4, float& sc) { sc = 1.0f; return W + v4; }, D, kt * 64, vt * 128, (bf16_t*)(p.ws + WS_WOUT) + (size_t)l * D * D, D, tid);
    } else {
        moe_tile_job(p, it - PN3, tid, j);
    }
}

DI void phase_prep(const P& p, int bid, int nb, char* smem) {
    const int tid = tid_opaque();
    bf16_t* xb = (bf16_t*)(p.ws + WS_XB);
    bf16_t* memb = (bf16_t*)(p.ws + WS_MEMB);
    {
        const size_t nx = (size_t)T * D / 4, nm = (size_t)NBATCH * MEML * D / 4;
        for (size_t i = (size_t)bid * NTHREADS + tid; i < nx + nm; i += (size_t)nb * NTHREADS) {
            if (i < nx) { f32x4 v = ((const f32x4*)p.x)[i]; u32x2 w; w.x = cvtpk(v[0], v[1]); w.y = cvtpk(v[2], v[3]); ((u32x2*)xb)[i] = w; }
            else { size_t j = i - nx; f32x4 v = ((const f32x4*)p.mem)[j]; u32x2 w; w.x = cvtpk(v[0], v[1]); w.y = cvtpk(v[2], v[3]); ((u32x2*)memb)[j] = w; }
        }
    }
    {
        bf16_t* rwt = (bf16_t*)(p.ws + WS_RWT);
        for (int i = bid * NTHREADS + tid; i < NE * D; i += nb * NTHREADS) {
            const int e = i >> 10, d = i & 1023;
            const float w = p.router_w[(size_t)d * NE + e];
            const bf16_t hi = f2bf(w);
            rwt[i] = hi; rwt[NE * D + i] = f2bf(w - bf2f(hi));
        }
    }
    float* tile = (float*)smem;
    if (bid < PN5) {
        TJ cur; f32x4 cv[4];
        prep_tile_job(p, bid, tid, cur); tj_load(cur, cv);
        for (int it = bid; it < PN5; it += nb) {
            TJ nxt; f32x4 nv[4];
            const bool hn = it + nb < PN5;
            if (hn) { prep_tile_job(p, it + nb, tid, nxt); tj_load(nxt, nv); }
            tj_finish(cur, cv, tile, tid);
            if (hn) { cur = nxt;
#pragma unroll
                for (int i = 0; i < 4; ++i) cv[i] = nv[i]; }
        }
    }
}

DI void moe_steal(const P& p, int budget, int limit, const unsigned* stop, unsigned stop_at, char* smem) {
    volatile int* qslot = (volatile int*)(smem + META_OFF + 2048);
    unsigned* tq = (unsigned*)(p.ws + WS_CTL + CTL_TQ);
    const int tid = tid_opaque();
    constexpr int QEND = DEPTH * MOE_TILES_PER_LAYER;
    if (budget <= 0) return;
    __syncthreads();
    if (tid == 0) {
        const bool halt = stop && __hip_atomic_load(stop, __ATOMIC_RELAXED, __HIP_MEMORY_SCOPE_AGENT) >= stop_at;
        qslot[0] = halt ? QEND : (int)__hip_atomic_fetch_add(tq, 1u, __ATOMIC_RELAXED, __HIP_MEMORY_SCOPE_AGENT) + MOE_TILES_PER_LAYER;
    }
    __syncthreads();
    int q = qslot[0];
    if (q >= QEND) return;
    TJ cur; f32x4 cv[4];
    moe_tile_job(p, q, tid, cur); tj_load(cur, cv);
    for (int n = 1;; ++n) {
        const bool want = (n < budget) && (q < limit);
        int qn = QEND;
        if (want) {
            if (tid == 0) {
                const bool halt = stop && __hip_atomic_load(stop, __ATOMIC_RELAXED, __HIP_MEMORY_SCOPE_AGENT) >= stop_at;
                qslot[1] = halt ? QEND : (int)__hip_atomic_fetch_add(tq, 1u, __ATOMIC_RELAXED, __HIP_MEMORY_SCOPE_AGENT) + MOE_TILES_PER_LAYER;
            }
            __syncthreads();
            qn = qslot[1];
        }
        const bool hn = qn < QEND;
        TJ nxt; f32x4 nv[4];
        if (hn) { moe_tile_job(p, qn, tid, nxt); tj_load(nxt, nv); }
        tj_finish(cur, cv, (float*)smem, tid);
        if (!hn) break;
        cur = nxt; q = qn;
#pragma unroll
        for (int i = 0; i < 4; ++i) cv[i] = nv[i];
    }
}
DI void steal_in_slack(const P& p, int slot, bool longest, int nlong, char* smem) {
    unsigned* stop = (unsigned*)(p.ws + WS_CTL + CTL_STOP) + slot;
    if (longest) { if (tid_opaque() == 0) __hip_atomic_fetch_add(stop, 1u, __ATOMIC_RELAXED, __HIP_MEMORY_SCOPE_AGENT); }
    else moe_steal(p, 64, DEPTH * MOE_TILES_PER_LAYER, stop, (unsigned)((nlong * 3 + 3) / 4), smem);
}

DI void store8_bf16(bf16_t* p8, const f32x4& v0, const f32x4& v1) {
    u32x4 w; w.x = cvtpk(v0[0], v0[1]); w.y = cvtpk(v0[2], v0[3]); w.z = cvtpk(v1[0], v1[1]); w.w = cvtpk(v1[2], v1[3]);
    *(u32x4*)p8 = w;
}

struct EpiTileBf16 {
    static constexpr bool PERM = true;
    bf16_t* O; int ldc; size_t pm_stride, pn_stride;
    DI void operator()(const f32x4 (&acc)[2][2][4][2], const g8::Unit& u, int wr, int wc, int fr, int fq) const {
        bf16_t* base = O + (size_t)u.pm * pm_stride + (size_t)u.pn * pn_stride + (size_t)(wr * 64 + fr) * ldc + wc * 32 + 8 * fq;
#pragma unroll
        for (int ai = 0; ai < 2; ++ai)
#pragma unroll
            for (int m = 0; m < 4; ++m)
                {
#pragma unroll
                    for (int bj = 0; bj < 2; ++bj) store8_bf16(base + (size_t)(ai * 128 + m * 16) * ldc + bj * 128, acc[ai][bj][m][0], acc[ai][bj][m][1]); __builtin_amdgcn_sched_barrier(0); }
    }
};

DI int units_of(int nunits, int G, int c) { return (c < nunits) ? (nunits - 1 - c) / G + 1 : 0; }

struct KSched {
    const char* memb; const char* wkv; int G, c;
    DI bool next(int i, g8::Unit& u) const { const int L = i * G + c; if (L >= 32) return false; u.pm = L & 7; u.pn = L >> 3; u.e = 0; u.valid = 256; u.rbase = 0; u.rti = 0; return true; }
    DI const char* a_base(const g8::Unit& u) const { return memb + (size_t)u.pm * 256 * D * 2; }
    DI const char* b_base(const g8::Unit& u) const { return wkv + (size_t)u.pn * 512 * D * 2; }
    DI void a_rows(const g8::Unit&, int R0, int R1, int (&rows)[2][2]) const { rows[0][0] = R0; rows[0][1] = R1; rows[1][0] = 128 + R0; rows[1][1] = 128 + R1; }
    DI void a_ready(const g8::Unit&) const {}
};
struct VSched {
    const char* memb; const char* wkv; int G, c;
    DI bool next(int i, g8::Unit& u) const { const int L = i * G + c - 32; if (L < 0 || L >= 32) return false; u.pm = L >> 3; u.pn = L & 7; u.e = 0; u.valid = 256; u.rbase = 0; u.rti = 0; return true; }
    DI const char* a_base(const g8::Unit& u) const { return wkv + ((size_t)u.pm * 512 + 256) * D * 2; }
    DI const char* b_base(const g8::Unit& u) const { return memb + (size_t)u.pn * 256 * D * 2; }
    DI void a_rows(const g8::Unit&, int R0, int R1, int (&rows)[2][2]) const { rows[0][0] = R0; rows[0][1] = R1; rows[1][0] = 128 + R0; rows[1][1] = 128 + R1; }
    DI void a_ready(const g8::Unit&) const {}
};
DI void phase_kv(const P& p, int bid, int nb, char* smem) {
    const char* memb = p.ws + WS_MEMB;
    const char* wkv = p.ws + WS_WKV;
    {
        KSched S{memb, wkv, nb, bid};
        EpiTileBf16 E{(bf16_t*)(p.ws + WS_KBUF), 256, (size_t)256 * 256, (size_t)2048 * 256};
        g8::gemm_phase<false>((LAS unsigned char*)smem, D, S, E);
    }
    {
        VSched S{memb, wkv, nb, bid};
        EpiTileBf16 E{(bf16_t*)(p.ws + WS_VT), 256, (size_t)8 * 256 * 256, (size_t)256 * 256};
        g8::gemm_phase<false>((LAS unsigned char*)smem, D, S, E);
    }
    steal_in_slack(p, 31, bid < 64, 64, smem);
}

struct EpiInproj {
    static constexpr bool PERM = true;
    bf16_t* projb; int ldp; int gate_pn; float* graw;
    DI void operator()(const f32x4 (&acc)[2][2][4][2], const g8::Unit& u, int wr, int wc, int fr, int fq) const {
        if (u.pn != gate_pn) {
            bf16_t* base = projb + (size_t)(u.pm * 256 + wr * 64 + fr) * ldp + u.pn * 256 + wc * 32 + 8 * fq;
#pragma unroll
            for (int ai = 0; ai < 2; ++ai)
#pragma unroll
                for (int m = 0; m < 4; ++m)
                    {
#pragma unroll
                        for (int bj = 0; bj < 2; ++bj) store8_bf16(base + (size_t)(ai * 128 + m * 16) * ldp + bj * 128, acc[ai][bj][m][0], acc[ai][bj][m][1]); __builtin_amdgcn_sched_barrier(0); }
        } else if (wc == 0 && fq < 2) {
#pragma unroll
            for (int ai = 0; ai < 2; ++ai)
#pragma unroll
                for (int m = 0; m < 4; ++m) {
                    float* dst = graw + (size_t)(u.pm * 256 + ai * 128 + wr * 64 + m * 16 + fr) * 16 + 8 * fq;
                    *(f32x4*)dst = acc[ai][0][m][0];
                    *(f32x4*)(dst + 4) = acc[ai][0][m][1];
                }
        }
    }
};
DI void phase_inproj(const P& p, int layer, int bid, int nb, char* smem) {
    const bool conv = (layer & 1) == 0;
    const int j = layer >> 1;
    const bf16_t* W = (const bf16_t*)(p.ws + WS_WIN) + (conv ? (size_t)j * DIN_CONV * D : ((size_t)2 * DIN_CONV + (size_t)j * NV_ML) * D);
    g8::DenseSched S; S.init(p.ws + WS_XB, W, T, conv ? DIN_CONV : NV_ML, D, nb, bid);
    EpiInproj E{(bf16_t*)(p.ws + WS_PROJ), conv ? DIN_CONV : LDP_ML, conv ? -1 : 13, (float*)(p.ws + WS_LOGI)};
    g8::gemm_phase<false>((LAS unsigned char*)smem, D, S, E);
    { const int most = (S.nwg + nb - 1) / nb, nlong = S.nwg - (most - 1) * nb; steal_in_slack(p, layer * 2, units_of(S.nwg, nb, bid) == most, nlong, smem); }
}

struct EpiOutproj {
    static constexpr bool PERM = true;
    const bf16_t* xres; bf16_t* z;
    DI void operator()(const f32x4 (&acc)[2][2][4][2], const g8::Unit& u, int wr, int wc, int fr, int fq) const {
        const size_t off0 = (size_t)(u.pm * 256 + wr * 64 + fr) * D + u.pn * 256 + wc * 32 + 8 * fq;
        u32x4 xr[2][4][2];
#pragma unroll
        for (int ai = 0; ai < 2; ++ai)
#pragma unroll
            for (int m = 0; m < 4; ++m)
#pragma unroll
                for (int bj = 0; bj < 2; ++bj) xr[ai][m][bj] = *(const u32x4*)(xres + off0 + (size_t)(ai * 128 + m * 16) * D + bj * 128);
#pragma unroll
        for (int ai = 0; ai < 2; ++ai)
#pragma unroll
            for (int m = 0; m < 4; ++m)
#pragma unroll
                for (int bj = 0; bj < 2; ++bj) {
                    const size_t off = off0 + (size_t)(ai * 128 + m * 16) * D + bj * 128;
                    const u32x4 r4 = xr[ai][m][bj];
                    f32x4 v0 = acc[ai][bj][m][0], v1 = acc[ai][bj][m][1];
                    v0[0] += ALPHA * bflo(r4.x); v0[1] += ALPHA * bfhi(r4.x); v0[2] += ALPHA * bflo(r4.y); v0[3] += ALPHA * bfhi(r4.y);
                    v1[0] += ALPHA * bflo(r4.z); v1[1] += ALPHA * bfhi(r4.z); v1[2] += ALPHA * bflo(r4.w); v1[3] += ALPHA * bfhi(r4.w);
                    store8_bf16(z + off, v0, v1);
                }
    }
};
DI void phase_outproj(const P& p, int layer, int bid, int nb, char* smem) {
    g8::DenseSched S; S.init(p.ws + WS_HCAT, (const bf16_t*)(p.ws + WS_WOUT) + (size_t)layer * D * D, T, D, D, nb, bid);
    EpiOutproj E{(const bf16_t*)(p.ws + WS_XB), (bf16_t*)(p.ws + WS_Z)};
    g8::gemm_phase<false>((LAS unsigned char*)smem, D, S, E);
}

DI void moe_meta(const int* cnt, int* meta) {
    __syncthreads();
    const int t = tid_opaque();
    if (t < NE) meta[65 + t] = __hip_atomic_load(cnt + t * CNT_STRIDE, __ATOMIC_RELAXED, __HIP_MEMORY_SCOPE_AGENT);
    __syncthreads();
    if (t == 0) {
        int base = 0, blk = 0;
#pragma unroll 1
        for (int e = 0; e < NE; ++e) {
            const int c = meta[65 + e];
            meta[e] = base; meta[32 + e] = blk;
            base += c; blk += (c + 255) >> 8;
        }
        meta[64] = blk;
    }
    __syncthreads();
    if (t < 160) {
        int e = 0;
#pragma unroll 1
        for (int q = 1; q < NE; ++q) e += (meta[32 + q] <= t) ? 1 : 0;
        meta[128 + t] = e;
    }
    __syncthreads();
}
struct MoeSched {
    const int* meta; const int* list; const char* A; const char* Bt; size_t b_estride; int K, G, c, nunits;
    DI bool next(int i, g8::Unit& u) const {
        const int L = i * G + c;
        if (L >= nunits) return false;
        const int w = g8::xcd_remap(L, nunits);
        const int rti = w >> 2;
        const int e = __builtin_amdgcn_readfirstlane(meta[128 + rti]);
        u.e = e; u.pm = rti - __builtin_amdgcn_readfirstlane(meta[32 + e]); u.pn = w & 3; u.rti = rti;
        const int left = __builtin_amdgcn_readfirstlane(meta[65 + e]) - u.pm * 256;
        u.valid = left < 256 ? left : 256;
        u.rbase = __builtin_amdgcn_readfirstlane(meta[e]);
        return true;
    }
    DI const char* b_base(const g8::Unit& u) const { return Bt + (size_t)u.e * b_estride + (size_t)u.pn * 256 * K * 2; }
};
struct MoeUpSched : MoeSched {
    DI const char* a_base(const g8::Unit&) const { return A; }
    DI void a_rows(const g8::Unit& u, int R0, int R1, int (&rows)[2][2]) const {
        const int* lst = list + (size_t)u.e * T + u.pm * 256;
        const int vm = u.valid - 1;
        rows[0][0] = lst[min(R0, vm)] >> 1; rows[0][1] = lst[min(R1, vm)] >> 1;
        rows[1][0] = lst[min(128 + R0, vm)] >> 1; rows[1][1] = lst[min(128 + R1, vm)] >> 1;
    }
    DI void a_ready(const g8::Unit&) const {}
};
struct MoeDownSched : MoeSched {
    unsigned* ready; unsigned* tmo;
    DI const char* a_base(const g8::Unit& u) const { return A + ((size_t)u.rbase + (size_t)u.pm * 256) * K * 2; }
    DI void a_rows(const g8::Unit&, int R0, int R1, int (&rows)[2][2]) const { rows[0][0] = R0; rows[0][1] = R1; rows[1][0] = 128 + R0; rows[1][1] = 128 + R1; }
    DI void a_ready(const g8::Unit& u) const {
        if (tid_opaque() < 64) {
            unsigned* w = ready + u.rti * 16;
            unsigned spins = 0;
            while ((unsigned)__builtin_amdgcn_readfirstlane((int)__hip_atomic_load(w, __ATOMIC_RELAXED, __HIP_MEMORY_SCOPE_AGENT)) < 32u) {
                __builtin_amdgcn_s_sleep(2);
                if ((++spins & 255u) == 0u) {
                    if (__builtin_amdgcn_readfirstlane((int)__hip_atomic_load(tmo, __ATOMIC_RELAXED, __HIP_MEMORY_SCOPE_AGENT)) != 0) break;
                    if (spins > (1u << 22)) { __hip_atomic_store(tmo, 1u, __ATOMIC_RELAXED, __HIP_MEMORY_SCOPE_AGENT); break; }
                }
            }
            __builtin_amdgcn_fence(__ATOMIC_ACQUIRE, "agent");
            asm volatile("s_waitcnt vmcnt(0)" ::: "memory");
        }
        asm volatile("" ::: "memory"); __builtin_amdgcn_s_barrier(); asm volatile("" ::: "memory");
    }
};

struct EpiMoeUp {
    static constexpr bool PERM = true;
    __amdgpu_buffer_rsrc_t hrs; unsigned* ready;
    DI void operator()(const f32x4 (&acc)[2][2][4][2], const g8::Unit& u, int wr, int wc, int fr, int fq) const {
        const unsigned hrow0 = (unsigned)u.rbase + (unsigned)u.pm * 256u;
#pragma unroll
        for (int ai = 0; ai < 2; ++ai)
#pragma unroll
            for (int m = 0; m < 4; ++m) {
                const int row = ai * 128 + wr * 64 + m * 16 + fr;
                if (row < u.valid) {
                    f32x4 h0, h1;
#pragma unroll
                    for (int i = 0; i < 4; ++i) {
                        const float g0 = acc[ai][0][m][0][i], g1 = acc[ai][0][m][1][i];
                        h0[i] = g0 * sigmoidf_(g0) * acc[ai][1][m][0][i];
                        h1[i] = g1 * sigmoidf_(g1) * acc[ai][1][m][1][i];
                    }
                    u32x4 w; w.x = cvtpk(h0[0], h0[1]); w.y = cvtpk(h0[2], h0[3]); w.z = cvtpk(h1[0], h1[1]); w.w = cvtpk(h1[2], h1[3]);
                    __builtin_amdgcn_raw_buffer_store_b128(w, hrs, ((hrow0 + (unsigned)row) * DFF + u.pn * 128 + wc * 32 + 8 * fq) * 2u, 0,   16);
                }
                __builtin_amdgcn_sched_barrier(0);
            }
        asm volatile("s_waitcnt vmcnt(0)" ::: "memory");
        if (fr == 0 && fq == 0) __hip_atomic_fetch_add(ready + u.rti * 16, 1u, __ATOMIC_RELAXED, __HIP_MEMORY_SCOPE_AGENT);
    }
};
struct EpiMoeDown {
    static constexpr bool PERM = true;
    const int* list; const float* gate; bf16_t* yasg;
    DI void operator()(const f32x4 (&acc)[2][2][4][2], const g8::Unit& u, int wr, int wc, int fr, int fq) const {
        const int* lst = list + (size_t)u.e * T + u.pm * 256;
        int aid[2][4]; float gt[2][4];
#pragma unroll
        for (int ai = 0; ai < 2; ++ai)
#pragma unroll
            for (int m = 0; m < 4; ++m) { const int row = ai * 128 + wr * 64 + m * 16 + fr; aid[ai][m] = lst[min(row, u.valid - 1)]; }
#pragma unroll
        for (int ai = 0; ai < 2; ++ai)
#pragma unroll
            for (int m = 0; m < 4; ++m) gt[ai][m] = gate[aid[ai][m]];
#pragma unroll
        for (int ai = 0; ai < 2; ++ai)
#pragma unroll
            for (int m = 0; m < 4; ++m) {
                const int row = ai * 128 + wr * 64 + m * 16 + fr;
                if (row < u.valid) {
                    bf16_t* dst = yasg + (size_t)aid[ai][m] * D + u.pn * 256 + wc * 32 + 8 * fq;
                    const float g_ = gt[ai][m];
#pragma unroll
                    for (int bj = 0; bj < 2; ++bj) store8_bf16(dst + bj * 128, acc[ai][bj][m][0] * g_, acc[ai][bj][m][1] * g_);
                }
                __builtin_amdgcn_sched_barrier(0);
            }
    }
};
DI void phase_moe(const P& p, int layer, int bid, int nb, char* smem) {
    int* meta = (int*)(smem + META_OFF);
    moe_meta((const int*)(p.ws + WS_CTL + CTL_CNT) + layer * 32 * CNT_STRIDE, meta);
    unsigned* ready = (unsigned*)(p.ws + WS_CTL + CTL_READY) + layer * 160 * 16;
    const int nunits = meta[64] * 4;
    {
        MoeUpSched S;
        S.meta = meta; S.list = (const int*)(p.ws + WS_LIST); S.A = p.ws + WS_X1B; S.Bt = p.ws + WS_WGU + (size_t)layer * NE * 1024 * D * 2;
        S.b_estride = (size_t)1024 * D * 2; S.K = D; S.G = nb; S.c = bid; S.nunits = nunits;
        EpiMoeUp E{__builtin_amdgcn_make_buffer_rsrc((void*)(p.ws + WS_HBUF), (short)0, (int)((size_t)T * 2 * DFF * 2), 0x00020000), ready};
        g8::gemm_phase<true>((LAS unsigned char*)smem, D, S, E);
    }
    {
        MoeDownSched S;
        S.meta = meta; S.list = (const int*)(p.ws + WS_LIST); S.A = p.ws + WS_HBUF; S.Bt = p.ws + WS_WD + (size_t)layer * NE * D * DFF * 2;
        S.b_estride = (size_t)D * DFF * 2; S.K = DFF; S.G = nb; S.c = nb - 1 - bid; S.nunits = nunits;
        S.ready = ready; S.tmo = (unsigned*)(p.ws + WS_CTL + CTL_TMO);
        EpiMoeDown E{(const int*)(p.ws + WS_LIST), (const float*)(p.ws + WS_GATE), (bf16_t*)(p.ws + WS_YASG)};
        g8::gemm_phase<false>((LAS unsigned char*)smem, DFF, S, E);
    }
    { const int most = (nunits + nb - 1) / nb, nlong = nunits - (most - 1) * nb; steal_in_slack(p, layer * 2 + 1, units_of(nunits, nb, bid) == most, nlong, smem); }
}

DI void phase_convmix(const P& p, int layer, int bid, int nb) {
    const int j = layer >> 1;
    const int tid = tid_opaque();
    const bf16_t* projb = (const bf16_t*)(p.ws + WS_PROJ);
    bf16_t* hcat = (bf16_t*)(p.ws + WS_HCAT);
    const float* cw = p.conv_w + (size_t)j * 3 * MIXW;
    const int nitem = T * (MIXW / 8);
    for (int it = bid * NTHREADS + tid; it < nitem; it += nb * NTHREADS) {
        const int t = it / 96, c8 = (it % 96) * 8;
        const int s = t & 2047;
        const bf16_t* row = projb + (size_t)t * DIN_CONV;
        const u32x4 bg = *(const u32x4*)(row + c8);
        float u[3][8];
#pragma unroll
        for (int d = 0; d < 3; ++d) {
            const int back = 2 - d;
            if (s - back >= 0) {
                const bf16_t* rw = row - (size_t)back * DIN_CONV;
                const u32x4 cg = *(const u32x4*)(rw + MIXW + c8);
                const u32x4 xi = *(const u32x4*)(rw + 2 * MIXW + c8);
#pragma unroll
                for (int q = 0; q < 4; ++q) { u[d][2 * q] = bflo(cg[q]) * bflo(xi[q]); u[d][2 * q + 1] = bfhi(cg[q]) * bfhi(xi[q]); }
            } else {
#pragma unroll
                for (int q = 0; q < 8; ++q) u[d][q] = 0.f;
            }
        }
        float o[8];
#pragma unroll
        for (int q = 0; q < 8; ++q) {
            const float c = cw[c8 + q] * u[0][q] + cw[MIXW + c8 + q] * u[1][q] + cw[2 * MIXW + c8 + q] * u[2][q];
            const float b = (q & 1) ? bfhi(bg[q >> 1]) : bflo(bg[q >> 1]);
            o[q] = b * c;
        }
        u32x4 w; w.x = cvtpk(o[0], o[1]); w.y = cvtpk(o[2], o[3]); w.z = cvtpk(o[4], o[5]); w.w = cvtpk(o[6], o[7]);
        *(u32x4*)(hcat + (size_t)t * D + c8) = w;
    }
}

DI void phase_xattn(const P& p, int layer, int bid, int nb, char* smem) {
    const bool conv = (layer & 1) == 0;
    const int ldp = conv ? DIN_CONV : LDP_ML;
    const int qoff = conv ? 3 * MIXW : 3072;
    const bf16_t* projb = (const bf16_t*)(p.ws + WS_PROJ);
    const bf16_t* kbuf = (const bf16_t*)(p.ws + WS_KBUF) + (size_t)layer * 2048 * 256;
    const bf16_t* vT = (const bf16_t*)(p.ws + WS_VT) + (size_t)layer * 8 * 256 * 256;
    bf16_t* hcat = (bf16_t*)(p.ws + WS_HCAT);
    constexpr int LK = 72, LV = 264;
    bf16_t* Ks = (bf16_t*)smem;
    bf16_t* Vs = Ks + 256 * LK;
    for (int task = bid; task < NBATCH * XH * 16; task += nb) {
        const int tid = tid_opaque(), lane = tid & 63, wid = tid >> 6, r = lane & 15, g = lane >> 4;
        const int b = task >> 6, h = (task >> 4) & 3, qt = task & 15;
        __syncthreads();
#pragma unroll
        for (int i = 0; i < 4; ++i) {
            const int key = (tid >> 3) + 64 * i, kc = tid & 7;
            *(u32x4*)&Ks[key * LK + kc * 8] = *(const u32x4*)(kbuf + ((size_t)b * 256 + key) * 256 + h * 64 + kc * 8);
            const int dv = (tid >> 5) + 16 * i, mc = tid & 31;
            *(u32x4*)&Vs[dv * LV + mc * 8] = *(const u32x4*)(vT + (((size_t)b * 4 + h) * 64 + dv) * 256 + mc * 8);
        }
        __syncthreads();
        const int tq = b * SEQ + qt * 128 + wid * 16;
        const bf16_t* qrow = projb + (size_t)(tq + r) * ldp + qoff + h * 64;
        bf16x8 qf[2];
        qf[0] = *(const bf16x8*)(qrow + 8 * g);
        qf[1] = *(const bf16x8*)(qrow + 32 + 8 * g);
        f32x4 sacc[16];
#pragma unroll
        for (int kt = 0; kt < 16; ++kt) {
            f32x4 a = (f32x4){0.f, 0.f, 0.f, 0.f};
#pragma unroll
            for (int ks = 0; ks < 2; ++ks) {
                const bf16x8 kf = *(const bf16x8*)&Ks[(kt * 16 + r) * LK + ks * 32 + 8 * g];
                a = mfma16(kf, qf[ks], a);
            }
            sacc[kt] = a;
            if (kt & 1) __builtin_amdgcn_sched_barrier(0);
        }
        float mx = -3.0e38f;
#pragma unroll
        for (int kt = 0; kt < 16; ++kt)
#pragma unroll
            for (int i = 0; i < 4; ++i) { sacc[kt][i] *= 0.125f; mx = fmaxf(mx, sacc[kt][i]); }
        mx = xor_max(mx, 16); mx = xor_max(mx, 32);
        float sum = 0.f;
#pragma unroll
        for (int kt = 0; kt < 16; ++kt)
#pragma unroll
            for (int i = 0; i < 4; ++i) { const float e = __expf(sacc[kt][i] - mx); sacc[kt][i] = e; sum += e; }
        sum = xor_add(sum, 16); sum = xor_add(sum, 32);
        const float inv = 1.0f / sum;
        f32x4 oacc[4];
#pragma unroll
        for (int dt = 0; dt < 4; ++dt) oacc[dt] = (f32x4){0.f, 0.f, 0.f, 0.f};
#pragma unroll
        for (int s2 = 0; s2 < 8; ++s2) {
            u32x4 pw;
            pw.x = cvtpk(sacc[2 * s2][0], sacc[2 * s2][1]); pw.y = cvtpk(sacc[2 * s2][2], sacc[2 * s2][3]);
            pw.z = cvtpk(sacc[2 * s2 + 1][0], sacc[2 * s2 + 1][1]); pw.w = cvtpk(sacc[2 * s2 + 1][2], sacc[2 * s2 + 1][3]);
            const bf16x8 pf = __builtin_bit_cast(bf16x8, pw);
#pragma unroll
            for (int dt = 0; dt < 4; ++dt) {
                const bf16_t* vp = &Vs[(dt * 16 + r) * LV + s2 * 32 + 4 * g];
                const u32x2 v0 = *(const u32x2*)vp;
                const u32x2 v1 = *(const u32x2*)(vp + 16);
                u32x4 vw; vw.x = v0.x; vw.y = v0.y; vw.z = v1.x; vw.w = v1.y;
                oacc[dt] = mfma16(__builtin_bit_cast(bf16x8, vw), pf, oacc[dt]);
            }
            __builtin_amdgcn_sched_barrier(0);
        }
        bf16_t* orow = hcat + (size_t)(tq + r) * D + MIXW + h * 64;
#pragma unroll
        for (int dt = 0; dt < 4; ++dt) {
            u32x2 w; w.x = cvtpk(oacc[dt][0] * inv, oacc[dt][1] * inv); w.y = cvtpk(oacc[dt][2] * inv, oacc[dt][3] * inv);
            *(u32x2*)(orow + dt * 16 + 4 * g) = w;
        }
    }
}

DI void phase_ml_local(const P& p, int layer, int bid, int nb, char* smem) {
    const float* gate_b = p.ml_gate_b + (layer >> 1) * 12;
    const bf16_t* projb = (const bf16_t*)(p.ws + WS_PROJ);
    const float* graw = (const float*)(p.ws + WS_LOGI);
    float* CT = (float*)(p.ws + WS_CT);
    float* nloc = (float*)(p.ws + WS_NLOC);
    float* mloc = (float*)(p.ws + WS_MLOC);
    float* gsum = (float*)(p.ws + WS_GSUM);
    constexpr int LS = 136;
    bf16_t* kwT = (bf16_t*)smem;
    bf16_t* vTs = kwT + 128 * LS;
    float* fb = (float*)(vTs + 128 * LS);
    float* fw = fb + 128;
    float* fr = fw + 128;
    for (int task = bid; task < 48 * NCH; task += nb) {
        const int tid = tid_opaque(), lane = tid & 63, wid = tid >> 6, r = lane & 15, g = lane >> 4;
        const int bh = task >> 4, c = task & 15, b = bh / 6, h = bh % 6;
        const int t0 = b * SEQ + c * CHUNK;
        const float gbi = gate_b[h], gbf = gate_b[6 + h];
        __syncthreads();
        if (wid == 0) {
            const float* gp = graw + (size_t)(t0 + 2 * lane) * 16 + h;
            const float i0 = gp[0] + gbi, i1 = gp[16] + gbi;
            const float f0 = logsigmoidf_(gp[6] + gbf), f1 = logsigmoidf_(gp[22] + gbf);
            float ps = f0 + f1;
#pragma unroll
            for (int off = 1; off < 64; off <<= 1) { const float y = __shfl_up(ps, off, 64); if (lane >= off) ps += y; }
            const float gtot = __shfl(ps, 63, 64);
            const float b0 = ps - f1, b1 = ps;
            const float a0 = gtot - b0 + i0, a1 = gtot - b1 + i1;
            float mx = fmaxf(a0, a1);
            mx = xor_max(mx, 32); mx = xor_max(mx, 16); mx = xor_max(mx, 8); mx = xor_max(mx, 4); mx = xor_max(mx, 2); mx = xor_max(mx, 1);
            fw[2 * lane] = __expf(a0 - mx); fw[2 * lane + 1] = __expf(a1 - mx);
            if (lane == 0) { fr[0] = mx; fr[1] = gtot; }
        }
        __syncthreads();
        const float ml = fr[0], gtot = fr[1];
        {
            const int s = tid & 127, quarter = tid >> 7;
            const float w = fw[s];
            const bf16_t* krow = projb + (size_t)(t0 + s) * LDP_ML + MIXW + h * 128;
            const bf16_t* vrow = projb + (size_t)(t0 + s) * LDP_ML + 2 * MIXW + h * 128;
#pragma unroll
            for (int i = 0; i < 4; ++i) {
                const int dc = quarter * 4 + i;
                const u32x4 kk = *(const u32x4*)(krow + dc * 8);
                const u32x4 vv = *(const u32x4*)(vrow + dc * 8);
#pragma unroll
                for (int q = 0; q < 4; ++q) {
                    kwT[(dc * 8 + 2 * q) * LS + s] = f2bf(bflo(kk[q]) * w);
                    kwT[(dc * 8 + 2 * q + 1) * LS + s] = f2bf(bfhi(kk[q]) * w);
                    vTs[(dc * 8 + 2 * q) * LS + s] = (bf16_t)(vv[q] & 0xffffu);
                    vTs[(dc * 8 + 2 * q + 1) * LS + s] = (bf16_t)(vv[q] >> 16);
                }
            }
        }
        __syncthreads();
        float* ct = CT + (size_t)task * 128 * 128;
        {
            f32x4 acc[8];
#pragma unroll
            for (int dt = 0; dt < 8; ++dt) acc[dt] = (f32x4){0.f, 0.f, 0.f, 0.f};
#pragma unroll
            for (int ks = 0; ks < 4; ++ks) {
                const bf16x8 vf = *(const bf16x8*)&vTs[(wid * 16 + r) * LS + ks * 32 + 8 * g];
#pragma unroll
                for (int dt = 0; dt < 8; ++dt) {
                    const bf16x8 kf = *(const bf16x8*)&kwT[(dt * 16 + r) * LS + ks * 32 + 8 * g];
                    acc[dt] = mfma16(vf, kf, acc[dt]);
                }
                __builtin_amdgcn_sched_barrier(0);
            }
#pragma unroll
            for (int dt = 0; dt < 8; ++dt)
#pragma unroll
                for (int i = 0; i < 4; ++i) ct[(wid * 16 + 4 * g + i) * 128 + dt * 16 + r] = acc[dt][i];
        }
        {
            const bf16x8 ones = (bf16x8){0x3F80, 0x3F80, 0x3F80, 0x3F80, 0x3F80, 0x3F80, 0x3F80, 0x3F80};
            f32x4 an = (f32x4){0.f, 0.f, 0.f, 0.f};
#pragma unroll
            for (int ks = 0; ks < 4; ++ks) {
                const bf16x8 kf = *(const bf16x8*)&kwT[(wid * 16 + r) * LS + ks * 32 + 8 * g];
                an = mfma16(ones, kf, an);
            }
            if (g == 0) nloc[(size_t)task * 128 + wid * 16 + r] = an[0];
        }
        if (tid == 0) { mloc[task] = ml; gsum[task] = gtot; }
    }
}

DI void phase_ml_scan(const P& p, int bid, int nb) {
    const float* CT = (const float*)(p.ws + WS_CT);
    bf16_t* CPB = (bf16_t*)(p.ws + WS_CPB);
    const float* nloc = (const float*)(p.ws + WS_NLOC);
    float* nprev = (float*)(p.ws + WS_NPREV);
    const float* mloc = (const float*)(p.ws + WS_MLOC);
    const float* gsum = (const float*)(p.ws + WS_GSUM);
    float* mprev = (float*)(p.ws + WS_MPREV);
    const int tid = tid_opaque();
    for (int task = bid; task < 48 * 8; task += nb) {
        const int bh = task >> 3, sl = task & 7;
        const int idx = sl * 2048 + tid * 4;
        float m = 0.f;
        f32x4 st = (f32x4){0.f, 0.f, 0.f, 0.f};
        float nst = 0.f;
        const bool don = (sl == 0 && tid < 128);
        f32x4 loc = *(const f32x4*)(CT + (size_t)(bh * NCH) * 16384 + idx);
        for (int c = 0; c < NCH; ++c) {
            const int ch = bh * NCH + c;
            const float gg = gsum[ch], ml = mloc[ch];
            const float mnew = fmaxf(gg + m, ml);
            const float decay = __expf(gg + m - mnew), sc = __expf(ml - mnew);
            const f32x4 cur = loc;
            if (c + 1 < NCH) loc = *(const f32x4*)(CT + (size_t)(ch + 1) * 16384 + idx);
            u32x2 w; w.x = cvtpk(st[0], st[1]); w.y = cvtpk(st[2], st[3]);
            *(u32x2*)(CPB + (size_t)ch * 16384 + idx) = w;
            st = st * decay + cur * sc;
            if (don) {
                const float nl = nloc[(size_t)ch * 128 + tid];
                nprev[(size_t)ch * 128 + tid] = nst;
                nst = nst * decay + nl * sc;
            }
            if (sl == 0 && tid == 0) mprev[ch] = m;
            m = mnew;
        }
    }
}

DI void phase_ml_out(const P& p, int layer, int bid, int nb, char* smem) {
    const int j = layer >> 1;
    const float* gate_b = p.ml_gate_b + j * 12;
    const bf16_t* projb = (const bf16_t*)(p.ws + WS_PROJ);
    const float* graw = (const float*)(p.ws + WS_LOGI);
    const bf16_t* CPB = (const bf16_t*)(p.ws + WS_CPB);
    const float* nprev = (const float*)(p.ws + WS_NPREV);
    const float* mprev = (const float*)(p.ws + WS_MPREV);
    bf16_t* hcat = (bf16_t*)(p.ws + WS_HCAT);
    const float* ng_ = p.ml_norm_g + (size_t)j * MIXW;
    constexpr int LS = 136;
    bf16_t* kS = (bf16_t*)smem;
    bf16_t* vTs = kS + 128 * LS;
    float* fb = (float*)(vTs + 128 * LS);
    float* fB = fb + 128;
    float* fA = fB + 128;
    float* fW = fA + 128;
    float* fE = fW + 128;
    float* fN = fE + 128;
    for (int task = bid; task < 48 * NCH; task += nb) {
        const int tid = tid_opaque();
        const int lane = tid & 63, wid = __builtin_amdgcn_readfirstlane(tid >> 6), r = lane & 15, g = lane >> 4;
        const int bh = task >> 4, c = task & 15, b = bh / 6, h = bh % 6;
        const int t0 = b * SEQ + c * CHUNK;
        const float gbi = gate_b[h], gbf = gate_b[6 + h];
        __syncthreads();
        if (wid == 0) {
            const float* gp = graw + (size_t)(t0 + 2 * lane) * 16 + h;
            const float i0 = gp[0] + gbi, i1 = gp[16] + gbi;
            const float f0 = logsigmoidf_(gp[6] + gbf), f1 = logsigmoidf_(gp[22] + gbf);
            const float mp = mprev[task];
            float ps = f0 + f1;
#pragma unroll
            for (int off = 1; off < 64; off <<= 1) { const float y = __shfl_up(ps, off, 64); if (lane >= off) ps += y; }
            const float b0 = ps - f1, b1 = ps;
            const float B0 = i0 - b0, B1 = i1 - b1;
            float pm = fmaxf(B0, B1);
#pragma unroll
            for (int off = 1; off < 64; off <<= 1) { const float y = __shfl_up(pm, off, 64); if (lane >= off) pm = fmaxf(pm, y); }
            float pmx = __shfl_up(pm, 1, 64);
            if (lane == 0) pmx = -3.0e38f;
            const float pm0 = fmaxf(pmx, B0), pm1 = pm;
            const float in0 = b0 + mp, in1 = b1 + mp;
            const float m0 = fmaxf(b0 + pm0, in0), m1 = fmaxf(b1 + pm1, in1);
            fB[2 * lane] = B0; fB[2 * lane + 1] = B1;
            fA[2 * lane] = b0 - m0; fA[2 * lane + 1] = b1 - m1;
            fW[2 * lane] = __expf(in0 - m0); fW[2 * lane + 1] = __expf(in1 - m1);
            fE[2 * lane] = __expf(-m0); fE[2 * lane + 1] = __expf(-m1);
        } else if (wid == 1) {
            fN[2 * lane] = nprev[(size_t)task * 128 + 2 * lane]; fN[2 * lane + 1] = nprev[(size_t)task * 128 + 2 * lane + 1];
        }
        {
#pragma unroll
            for (int i = 0; i < 4; ++i) {
                const int s = (tid >> 4) + 32 * i, dc = tid & 15;
                *(u32x4*)&kS[s * LS + dc * 8] = *(const u32x4*)(projb + (size_t)(t0 + s) * LDP_ML + MIXW + h * 128 + dc * 8);
            }
            const int s = tid & 127, quarter = tid >> 7;
            const bf16_t* vrow = projb + (size_t)(t0 + s) * LDP_ML + 2 * MIXW + h * 128;
#pragma unroll
            for (int i = 0; i < 4; ++i) {
                const int dc = quarter * 4 + i;
                const u32x4 vv = *(const u32x4*)(vrow + dc * 8);
#pragma unroll
                for (int q = 0; q < 4; ++q) {
                    vTs[(dc * 8 + 2 * q) * LS + s] = (bf16_t)(vv[q] & 0xffffu);
                    vTs[(dc * 8 + 2 * q + 1) * LS + s] = (bf16_t)(vv[q] >> 16);
                }
            }
        }
        __syncthreads();
        const bf16_t* cp = CPB + (size_t)task * 16384;
        {
            const int l = wid * 16 + r;
            bf16x8 qf[4];
            float qn;
            {
                const bf16_t* qrow = projb + (size_t)(t0 + l) * LDP_ML + h * 128;
                float part = 0.f;
#pragma unroll
                for (int ks = 0; ks < 4; ++ks) {
                    const u32x4 qq = *(const u32x4*)(qrow + ks * 32 + 8 * g);
                    qf[ks] = __builtin_bit_cast(bf16x8, qq);
#pragma unroll
                    for (int q = 0; q < 4; ++q) part += bflo(qq[q]) * fN[ks * 32 + 8 * g + 2 * q] + bfhi(qq[q]) * fN[ks * 32 + 8 * g + 2 * q + 1];
                }
                part = xor_add(part, 16); part = xor_add(part, 32);
                qn = part;
            }
            __builtin_amdgcn_sched_barrier(0);
            f32x4 nacc[8];
#pragma unroll
            for (int et = 0; et < 8; ++et) {
                f32x4 a = (f32x4){0.f, 0.f, 0.f, 0.f};
#pragma unroll
                for (int ks = 0; ks < 4; ++ks) {
                    const bf16x8 cf = *(const bf16x8*)(cp + (et * 16 + r) * 128 + ks * 32 + 8 * g);
                    a = mfma16(cf, qf[ks], a);
                }
                nacc[et] = a;
                if (et & 1) __builtin_amdgcn_sched_barrier(0);
            }
            const float Al = fA[l], wint = fW[l], eml = fE[l];
#pragma unroll
            for (int et = 0; et < 8; ++et) nacc[et] *= wint;
            const int stmax = wid;
            float den = 0.f;
#pragma unroll
            for (int s2 = 0; s2 < 4; ++s2) {
                if (2 * s2 <= stmax) {
                    f32x4 sa = (f32x4){0.f, 0.f, 0.f, 0.f}, sb = (f32x4){0.f, 0.f, 0.f, 0.f};
#pragma unroll
                    for (int ks = 0; ks < 4; ++ks) {
                        const bf16x8 kf = *(const bf16x8*)&kS[(s2 * 32 + r) * LS + ks * 32 + 8 * g];
                        sa = mfma16(kf, qf[ks], sa);
                    }
                    if (2 * s2 + 1 <= stmax) {
#pragma unroll
                        for (int ks = 0; ks < 4; ++ks) {
                            const bf16x8 kf = *(const bf16x8*)&kS[(s2 * 32 + 16 + r) * LS + ks * 32 + 8 * g];
                            sb = mfma16(kf, qf[ks], sb);
                        }
                    }
#pragma unroll
                    for (int i = 0; i < 4; ++i) {
                        const int s = s2 * 32 + 4 * g + i;
                        const float va = (s <= l) ? sa[i] * __expf(Al + fB[s]) : 0.f;
                        const float vb = (s + 16 <= l) ? sb[i] * __expf(Al + fB[s + 16]) : 0.f;
                        sa[i] = va; sb[i] = vb; den += va + vb;
                    }
                    u32x4 pw;
                    pw.x = cvtpk(sa[0], sa[1]); pw.y = cvtpk(sa[2], sa[3]);
                    pw.z = cvtpk(sb[0], sb[1]); pw.w = cvtpk(sb[2], sb[3]);
                    const bf16x8 pf = __builtin_bit_cast(bf16x8, pw);
#pragma unroll
                    for (int et = 0; et < 8; ++et) {
                        const bf16_t* vp = &vTs[(et * 16 + r) * LS + s2 * 32 + 4 * g];
                        const u32x2 v0 = *(const u32x2*)vp;
                        const u32x2 v1 = *(const u32x2*)(vp + 16);
                        u32x4 vw; vw.x = v0.x; vw.y = v0.y; vw.z = v1.x; vw.w = v1.y;
                        nacc[et] = mfma16(__builtin_bit_cast(bf16x8, vw), pf, nacc[et]);
                    }
                }
                __builtin_amdgcn_sched_barrier(0);
            }
            den = xor_add(den, 16); den = xor_add(den, 32);
            const float dd = fmaxf(fabsf(den + wint * qn), eml);
            const float invd = 1.0f / dd;
            float sm = 0.f;
#pragma unroll
            for (int et = 0; et < 8; ++et)
#pragma unroll
                for (int i = 0; i < 4; ++i) { nacc[et][i] *= invd; sm += nacc[et][i]; }
            sm = xor_add(sm, 16); sm = xor_add(sm, 32);
            const float mu = sm * (1.0f / 128.0f);
            float sq = 0.f;
#pragma unroll
            for (int et = 0; et < 8; ++et)
#pragma unroll
                for (int i = 0; i < 4; ++i) { const float dlt = nacc[et][i] - mu; sq += dlt * dlt; }
            sq = xor_add(sq, 16); sq = xor_add(sq, 32);
            const float rstd = rsqrtf(sq * (1.0f / 128.0f) + LN_EPS);
            const size_t trow = (size_t)(t0 + l);
            const bf16_t* og = projb + trow * LDP_ML + 3 * MIXW + h * 128;
            bf16_t* orow = hcat + trow * D + h * 128;
#pragma unroll
            for (int et = 0; et < 8; ++et) {
                const int e = et * 16 + 4 * g;
                const u32x2 ov = *(const u32x2*)(og + e);
                const f32x4 gv = *(const f32x4*)(ng_ + h * 128 + e);
                const float o0 = (nacc[et][0] - mu) * rstd * gv[0] * sigmoidf_(bflo(ov.x));
                const float o1 = (nacc[et][1] - mu) * rstd * gv[1] * sigmoidf_(bfhi(ov.x));
                const float o2 = (nacc[et][2] - mu) * rstd * gv[2] * sigmoidf_(bflo(ov.y));
                const float o3 = (nacc[et][3] - mu) * rstd * gv[3] * sigmoidf_(bfhi(ov.y));
                u32x2 w; w.x = cvtpk(o0, o1); w.y = cvtpk(o2, o3);
                *(u32x2*)(orow + e) = w;
                if (et & 1) __builtin_amdgcn_sched_barrier(0);
            }
        }
    }
}

constexpr int LN1_MAXT = 8;
DI void phase_ln1_route(const P& p, int layer, int bid, int nb, char* smem) {
    const bf16_t* z = (const bf16_t*)(p.ws + WS_Z);
    bf16_t* x1b = (bf16_t*)(p.ws + WS_X1B);
    float* gate = (float*)(p.ws + WS_GATE);
    int* list = (int*)(p.ws + WS_LIST);
    int* cnt = (int*)(p.ws + WS_CTL + CTL_CNT) + layer * 32 * CNT_STRIDE;
    const bf16_t* rwh = (const bf16_t*)(p.ws + WS_RWT);
    const bf16_t* rwl = rwh + NE * D;
    const float* lg = p.ln1_g + (size_t)layer * D;
    const float* lb = p.ln1_b + (size_t)layer * D;
    constexpr int XS = 1028;
    float* xs = (float*)smem;
    float* red = xs + 16 * XS;
    float* scs = red + 8 * 16 * 32;
    int* lcnt = (int*)(scs + 16 * 32);
    int* gbase = lcnt + 32;
    int* sel = gbase + 32;
    const int tid = tid_opaque(), lane = tid & 63, wid = tid >> 6, r = lane & 15, g = lane >> 4;
    __syncthreads();
    if (tid < 32) lcnt[tid] = 0;
    const float rb_e = p.router_b[tid & 31];
    bf16x8 wh[4][2], wl[4][2];
#pragma unroll
    for (int ks = 0; ks < 4; ++ks)
#pragma unroll
        for (int nt = 0; nt < 2; ++nt) {
            const size_t o = (size_t)(nt * 16 + r) * D + wid * 128 + ks * 32 + 8 * g;
            wh[ks][nt] = *(const bf16x8*)(rwh + o); wl[ks][nt] = *(const bf16x8*)(rwl + o);
        }
    f32x4 lgv[2][2], lbv[2][2];
#pragma unroll
    for (int i = 0; i < 2; ++i) { const int col = i * 512 + lane * 8; lgv[i][0] = *(const f32x4*)(lg + col); lgv[i][1] = *(const f32x4*)(lg + col + 4); lbv[i][0] = *(const f32x4*)(lb + col); lbv[i][1] = *(const f32x4*)(lb + col + 4); }
    u32x4 zn[2][2];
    if (bid < T / 16) {
#pragma unroll
        for (int rr = 0; rr < 2; ++rr)
#pragma unroll
            for (int i = 0; i < 2; ++i) zn[rr][i] = *(const u32x4*)(z + (size_t)(bid * 16 + wid * 2 + rr) * D + i * 512 + lane * 8);
    }
    int ti = 0;
    for (int task = bid; task < T / 16; task += nb, ++ti) {
        const int row0 = task * 16;
        u32x4 zc[2][2];
#pragma unroll
        for (int rr = 0; rr < 2; ++rr)
#pragma unroll
            for (int i = 0; i < 2; ++i) zc[rr][i] = zn[rr][i];
        if (task + nb < T / 16) {
#pragma unroll
            for (int rr = 0; rr < 2; ++rr)
#pragma unroll
                for (int i = 0; i < 2; ++i) zn[rr][i] = *(const u32x4*)(z + (size_t)((task + nb) * 16 + wid * 2 + rr) * D + i * 512 + lane * 8);
        }
        __syncthreads();
#pragma unroll
        for (int rr = 0; rr < 2; ++rr) {
            const int lr = wid * 2 + rr;
            const size_t t = (size_t)(row0 + lr);
            float v[2][8];
            float s = 0.f;
#pragma unroll
            for (int i = 0; i < 2; ++i) {
#pragma unroll
                for (int q = 0; q < 4; ++q) { v[i][2 * q] = bflo(zc[rr][i][q]); v[i][2 * q + 1] = bfhi(zc[rr][i][q]); s += v[i][2 * q] + v[i][2 * q + 1]; }
            }
            s = wave_sum(s);
            const float mu = s * (1.0f / D);
            float q2 = 0.f;
#pragma unroll
            for (int i = 0; i < 2; ++i)
#pragma unroll
                for (int k = 0; k < 8; ++k) { const float d = v[i][k] - mu; q2 += d * d; }
            q2 = wave_sum(q2);
            const float rstd = rsqrtf(q2 * (1.0f / D) + LN_EPS);
#pragma unroll
            for (int i = 0; i < 2; ++i) {
                const int col = i * 512 + lane * 8;
                const f32x4 g0 = lgv[i][0], g1 = lgv[i][1], b0 = lbv[i][0], b1 = lbv[i][1];
                f32x4 o0, o1;
#pragma unroll
                for (int k = 0; k < 4; ++k) { o0[k] = (v[i][k] - mu) * rstd * g0[k] + b0[k]; o1[k] = (v[i][4 + k] - mu) * rstd * g1[k] + b1[k]; }
                u32x4 w; w.x = cvtpk(o0[0], o0[1]); w.y = cvtpk(o0[2], o0[3]); w.z = cvtpk(o1[0], o1[1]); w.w = cvtpk(o1[2], o1[3]);
                *(u32x4*)(x1b + t * D + col) = w;
                *(f32x4*)(xs + lr * XS + col) = o0;
                *(f32x4*)(xs + lr * XS + col + 4) = o1;
            }
        }
        __syncthreads();
        {
            f32x4 acc0 = (f32x4){0.f, 0.f, 0.f, 0.f}, acc1 = (f32x4){0.f, 0.f, 0.f, 0.f};
#pragma unroll
            for (int ks = 0; ks < 4; ++ks) {
                const int k = wid * 128 + ks * 32 + 8 * g;
                const f32x4 xa0 = *(const f32x4*)(xs + r * XS + k), xa1 = *(const f32x4*)(xs + r * XS + k + 4);
                u32x4 hw, lw;
                hw.x = cvtpk(xa0[0], xa0[1]); hw.y = cvtpk(xa0[2], xa0[3]); hw.z = cvtpk(xa1[0], xa1[1]); hw.w = cvtpk(xa1[2], xa1[3]);
                lw.x = cvtpk(xa0[0] - bflo(hw.x), xa0[1] - bfhi(hw.x)); lw.y = cvtpk(xa0[2] - bflo(hw.y), xa0[3] - bfhi(hw.y));
                lw.z = cvtpk(xa1[0] - bflo(hw.z), xa1[1] - bfhi(hw.z)); lw.w = cvtpk(xa1[2] - bflo(hw.w), xa1[3] - bfhi(hw.w));
                const bf16x8 xh = __builtin_bit_cast(bf16x8, hw), xl = __builtin_bit_cast(bf16x8, lw);
                acc0 = mfma16(wh[ks][0], xh, acc0); acc0 = mfma16(wh[ks][0], xl, acc0); acc0 = mfma16(wl[ks][0], xh, acc0);
                acc1 = mfma16(wh[ks][1], xh, acc1); acc1 = mfma16(wh[ks][1], xl, acc1); acc1 = mfma16(wl[ks][1], xh, acc1);
            }
            *(f32x4*)(red + (wid * 16 + r) * 32 + 4 * g) = acc0;
            *(f32x4*)(red + (wid * 16 + r) * 32 + 16 + 4 * g) = acc1;
        }
        __syncthreads();
        {
            const int e = tid & 31, i = tid >> 5;
            float s = 0.f;
#pragma unroll
            for (int w = 0; w < 8; ++w) s += red[(w * 16 + i) * 32 + e];
            const float sc = sigmoidf_(s), sv = sc + rb_e;
            const float a1 = __shfl_xor(sv, 1, 64), a2 = __shfl_xor(sv, 2, 64), a3 = __shfl_xor(sv, 3, 64);
            const float c1 = __shfl_xor(sc, 1, 64), c2 = __shfl_xor(sc, 2, 64), c3 = __shfl_xor(sc, 3, 64);
            const float lo1 = fminf(sv, a1), hi1 = fmaxf(sv, a1), lo2 = fminf(a2, a3), hi2 = fmaxf(a2, a3);
            float bv = fmaxf(hi1, hi2) + fmaxf(fminf(hi1, hi2), fmaxf(lo1, lo2));
            int bg = e >> 2;
#pragma unroll
            for (int m = 4; m <= 16; m <<= 1) {
                const float ov = __shfl_xor(bv, m, 64); const int og = __shfl_xor(bg, m, 64);
                if (ov > bv || (ov == bv && og < bg)) { bv = ov; bg = og; }
            }
            if (e == bg * 4) {
                const float vv[4] = {sv, a1, a2, a3}, cc[4] = {sc, c1, c2, c3};
                int i1 = 0; float v1 = vv[0];
#pragma unroll
                for (int k = 1; k < 4; ++k) if (vv[k] > v1) { v1 = vv[k]; i1 = k; }
                int i2 = -1; float v2 = -3.0e38f, s1 = cc[0], s2 = 0.f;
#pragma unroll
                for (int k = 0; k < 4; ++k) { if (k == i1) s1 = cc[k]; }
#pragma unroll
                for (int k = 0; k < 4; ++k) if (k != i1 && vv[k] > v2) { v2 = vv[k]; i2 = k; s2 = cc[k]; }
                const int e1 = bg * 4 + i1, e2 = bg * 4 + i2;
                const float inv = 1.0f / (s1 + s2);
                const int t = row0 + i;
                gate[t * 2] = s1 * inv; gate[t * 2 + 1] = s2 * inv;
                const int lp1 = atomicAdd(&lcnt[e1], 1);
                const int lp2 = atomicAdd(&lcnt[e2], 1);
                if (ti < LN1_MAXT) { sel[(ti * 16 + i) * 2] = e1 | (lp1 << 8); sel[(ti * 16 + i) * 2 + 1] = e2 | (lp2 << 8); }
            }
        }
    }
    __syncthreads();
    const int tz = tid_opaque();
    if (tz < 32) { const int c = lcnt[tz]; gbase[tz] = c ? atomicAdd(&cnt[tz * CNT_STRIDE], c) : 0; }
    __syncthreads();
    if (tz < ti * 32) {
        const int tl = tz >> 5, rw = (tz >> 1) & 15, k = tz & 1;
        const int sv = sel[tz];
        const int e = sv & 255, lp = sv >> 8;
        list[(size_t)e * T + gbase[e] + lp] = ((bid + tl * nb) * 16 + rw) * 2 + k;
    }
}

DI void phase_ln2(const P& p, int layer, int bid, int nb) {
    const bf16_t* x1b = (const bf16_t*)(p.ws + WS_X1B);
    const bf16_t* yasg = (const bf16_t*)(p.ws + WS_YASG);
    bf16_t* xb = (bf16_t*)(p.ws + WS_XB);
    const float* lg = p.ln2_g + (size_t)layer * D;
    const float* lb = p.ln2_b + (size_t)layer * D;
    const int tid = tid_opaque(), lane = tid & 63, wid = tid >> 6;
    f32x4 lgv[2][2], lbv[2][2];
#pragma unroll
    for (int i = 0; i < 2; ++i) { const int col = i * 512 + lane * 8; lgv[i][0] = *(const f32x4*)(lg + col); lgv[i][1] = *(const f32x4*)(lg + col + 4); lbv[i][0] = *(const f32x4*)(lb + col); lbv[i][1] = *(const f32x4*)(lb + col + 4); }
    for (int t = bid * NWAVES + wid; t < T; t += nb * NWAVES) {
        float v[2][8];
        float s = 0.f;
#pragma unroll
        for (int i = 0; i < 2; ++i) {
            const int col = i * 512 + lane * 8;
            const u32x4 xv = *(const u32x4*)(x1b + (size_t)t * D + col);
            const u32x4 y0 = *(const u32x4*)(yasg + (size_t)(2 * t) * D + col);
            const u32x4 y1 = *(const u32x4*)(yasg + (size_t)(2 * t + 1) * D + col);
#pragma unroll
            for (int q = 0; q < 4; ++q) {
                v[i][2 * q] = bflo(xv[q]) * ALPHA + (bflo(y0[q]) + bflo(y1[q]));
                v[i][2 * q + 1] = bfhi(xv[q]) * ALPHA + (bfhi(y0[q]) + bfhi(y1[q]));
                s += v[i][2 * q] + v[i][2 * q + 1];
            }
        }
        s = wave_sum(s);
        const float mu = s * (1.0f / D);
        float q2 = 0.f;
#pragma unroll
        for (int i = 0; i < 2; ++i)
#pragma unroll
            for (int k = 0; k < 8; ++k) { const float d = v[i][k] - mu; q2 += d * d; }
        q2 = wave_sum(q2);
        const float rstd = rsqrtf(q2 * (1.0f / D) + LN_EPS);
#pragma unroll
        for (int i = 0; i < 2; ++i) {
            const int col = i * 512 + lane * 8;
            const f32x4 g0 = lgv[i][0], g1 = lgv[i][1], b0 = lbv[i][0], b1 = lbv[i][1];
            f32x4 o0, o1;
#pragma unroll
            for (int k = 0; k < 4; ++k) { o0[k] = (v[i][k] - mu) * rstd * g0[k] + b0[k]; o1[k] = (v[i][4 + k] - mu) * rstd * g1[k] + b1[k]; }
            if (layer == DEPTH - 1) {
                *(f32x4*)(p.out + (size_t)t * D + col) = o0;
                *(f32x4*)(p.out + (size_t)t * D + col + 4) = o1;
            } else {
                u32x4 w; w.x = cvtpk(o0[0], o0[1]); w.y = cvtpk(o0[2], o0[3]); w.z = cvtpk(o1[0], o1[1]); w.w = cvtpk(o1[2], o1[3]);
                *(u32x4*)(xb + (size_t)t * D + col) = w;
            }
        }
    }
}

#define XB_TMO      128
#define XB_XCNT(j)  (256  + 64 * (j))
#define XB_XSUB(j)  (1280 + 64 * (j))
#define XB_XGEN(j)  (2304 + 64 * (j))
#define XB_TOP      3328
#define XB_TOPGEN   3392
#define XCD_BAR_WORDS 3456
#define XB_SPIN_CAP (1u << 20)
DI unsigned xb_ld(unsigned* p_) { return __hip_atomic_load(p_, __ATOMIC_RELAXED, __HIP_MEMORY_SCOPE_AGENT); }
DI unsigned xb_add(unsigned* p_, unsigned v) { return __hip_atomic_fetch_add(p_, v, __ATOMIC_RELAXED, __HIP_MEMORY_SCOPE_AGENT); }
DI unsigned xb_xcc_id() { return (unsigned)__builtin_amdgcn_s_getreg((3 << 11) | 20) & 0xFu; }
#define XB_SPIN(cond, bar) do { unsigned _sp = 0; while (cond) { __builtin_amdgcn_s_sleep(1); \
    if ((++_sp & 255u) == 0u) { if (xb_ld(&(bar)[XB_TMO])) break; if (_sp > XB_SPIN_CAP) { atomicAdd(&(bar)[XB_TMO], 1u); break; } } } } while (0)
struct XcdBarrier { unsigned* bar; unsigned x; volatile LAS unsigned* st; };
DI XcdBarrier xcd_barrier_post(unsigned* bar, volatile LAS unsigned* st) {
    XcdBarrier b; b.bar = bar; b.x = xb_xcc_id(); b.st = st;
    if (threadIdx.x == 0) (void)xb_add(&bar[XB_XCNT(b.x)], 1u);
    return b;
}
DI void xcd_barrier_complete(unsigned* bar, unsigned x, unsigned& nloc, unsigned& nx) {
    const unsigned G = gridDim.x * gridDim.y * gridDim.z;
    unsigned sum, cnt, mine, sp = 0u;
    for (;;) {
        sum = 0u; cnt = 0u; mine = 0u;
#pragma unroll
        for (unsigned j = 0; j < 16; ++j) { const unsigned c = xb_ld(&bar[XB_XCNT(j)]); sum += c; cnt += (c > 0u) ? 1u : 0u; mine = (j == x) ? c : mine; }
        if (sum == G) break;
        __builtin_amdgcn_s_sleep(1);
        if ((++sp & 255u) == 0u) { if (xb_ld(&bar[XB_TMO])) break; if (sp > XB_SPIN_CAP) { atomicAdd(&bar[XB_TMO], 1u); break; } }
    }
    nloc = mine > 0u ? mine : 1u; nx = cnt > 0u ? cnt : 1u;
}
DI void xcd_barrier(const XcdBarrier& b) {
    asm volatile("s_waitcnt vmcnt(0)" ::: "memory");
    __syncthreads();
    if (tid_opaque() == 0) {
        unsigned* bar = b.bar;
        __builtin_amdgcn_s_waitcnt(0);
        unsigned nloc = b.st[0], nx = b.st[1];
        if (nloc == 0u) { xcd_barrier_complete(bar, b.x, nloc, nx); b.st[0] = nloc; b.st[1] = nx; }
        const unsigned old = xb_add(&bar[XB_XSUB(b.x)], 1u);
        const unsigned gen = old / nloc;
        if (old + 1u == (gen + 1u) * nloc) {
            __builtin_amdgcn_fence(__ATOMIC_RELEASE, "agent");
            asm volatile("s_waitcnt vmcnt(0)" ::: "memory");
            const unsigned og = xb_add(&bar[XB_TOP], 1u);
            const unsigned tg = og / nx;
            if (og + 1u == (tg + 1u) * nx) xb_add(&bar[XB_TOPGEN], 1u);
            else XB_SPIN(xb_ld(&bar[XB_TOPGEN]) == tg, bar);
            __builtin_amdgcn_fence(__ATOMIC_ACQUIRE, "agent");
            xb_add(&bar[XB_XGEN(b.x)], 1u);
            asm volatile("s_waitcnt vmcnt(0)" ::: "memory");
        } else {
            XB_SPIN(xb_ld(&bar[XB_XGEN(b.x)]) == gen, bar);
            __builtin_amdgcn_fence(__ATOMIC_ACQUIRE, "agent");
            asm volatile("s_waitcnt vmcnt(0)" ::: "memory");
        }
    }
    __syncthreads();
}

enum { PH_INPROJ = 0, PH_MIX1, PH_MIX2, PH_MIX3, PH_OUTPROJ, PH_LN1, PH_MOE, PH_LN2, PH_PER_LAYER, PH_PREP = 100, PH_KV = 101 };

DI void run_phase(const P& p, int ph, int layer, int bid, int nb, char* smem) {
    const bool conv = (layer & 1) == 0;
    if (ph == PH_PREP) phase_prep(p, bid, nb, smem);
    if (ph == PH_KV) phase_kv(p, bid, nb, smem);
    if (ph == PH_INPROJ) phase_inproj(p, layer, bid, nb, smem);
    if (ph == PH_MIX1) phase_ml_local(p, layer, bid, nb, smem);
    if (ph == PH_MIX2) phase_ml_scan(p, bid, nb);
    if (ph == PH_MIX3) {
        if (conv) phase_convmix(p, layer, bid, nb);
        else phase_ml_out(p, layer, bid, nb, smem);
    }
    if (ph == PH_MIX1 || (ph == PH_MIX3 && conv)) phase_xattn(p, layer, bid, nb, smem);
    if (ph == PH_OUTPROJ) phase_outproj(p, layer, bid, nb, smem);
    if (ph == PH_LN1) { phase_ln1_route(p, layer, bid, nb, smem); if (layer > 0) moe_steal(p, 1 << 20, (layer + 1) * MOE_TILES_PER_LAYER, nullptr, 0u, smem); }
    if (ph == PH_MOE) phase_moe(p, layer, bid, nb, smem);
    if (ph == PH_LN2) phase_ln2(p, layer, bid, nb);
}

__global__ void __launch_bounds__(NTHREADS, 2) mega(P p) {
    __shared__ __attribute__((aligned(16))) char smem[SMEM_BYTES];
    const int bid = blockIdx.x, nb = gridDim.x;
    volatile LAS unsigned* st = (volatile LAS unsigned*)(smem + SMEM_BYTES - 16);
    if (threadIdx.x == 0) { st[0] = 0u; st[1] = 0u; }
    __syncthreads();
    XcdBarrier xb = xcd_barrier_post((unsigned*)(p.ws + WS_CTL), st);
#pragma unroll 1
    for (int s = -2; s < DEPTH * PH_PER_LAYER; ++s) {
        int ph = (s == -2) ? (int)PH_PREP : (s == -1) ? (int)PH_KV : s % PH_PER_LAYER;
        int layer = (s < 0) ? 0 : s / PH_PER_LAYER;
        if ((layer & 1) == 0 && (ph == PH_MIX1 || ph == PH_MIX2)) continue;
        int b_ = bid, n_ = nb;
        asm volatile("" : "+s"(ph), "+s"(layer), "+s"(b_), "+s"(n_));
        P q = p;
        asm volatile("" : "+s"(q.ws));
        run_phase(q, ph, layer, b_, n_, smem);
#ifdef PROBE_MASK
        if (ph < 31 && ((PROBE_MASK >> ph) & 1)) { __syncthreads(); run_phase(q, ph, layer, b_, n_, smem); }
#endif
        if (ph != PH_KV) xcd_barrier(xb);
    }
}

extern "C" void kernel_launch(void* const* d_in, const int* in_sizes, int n_in, void* d_out, int out_size, void* d_ws, size_t ws_size,
                              hipStream_t stream) {
    if (ws_size < WS_TOTAL) { fprintf(stderr, "kernel_launch: workspace too small: %zu < %zu\n", ws_size, (size_t)WS_TOTAL); return; }
    static int grid_blocks = 0;
    if (!grid_blocks) {
        int dev = 0, cus = 0, per_cu = 0;
        (void)hipGetDevice(&dev);
        (void)hipDeviceGetAttribute(&cus, hipDeviceAttributeMultiprocessorCount, dev);
        if (hipOccupancyMaxActiveBlocksPerMultiprocessor(&per_cu, (const void*)mega, NTHREADS, 0) != hipSuccess) per_cu = 0;
        if (per_cu < 1 || cus < 1) { fprintf(stderr, "kernel_launch: occupancy query failed (per_cu=%d cus=%d)\n", per_cu, cus); return; }
        grid_blocks = cus;
    }
    P p{};
    p.x = (const float*)d_in[0]; p.mem = (const float*)d_in[1]; p.conv_w_in = (const float*)d_in[2]; p.conv_w = (const float*)d_in[3];
    p.ml_w_in = (const float*)d_in[4]; p.ml_gate_b = (const float*)d_in[5]; p.ml_norm_g = (const float*)d_in[6]; p.w_kv = (const float*)d_in[7];
    p.w_out = (const float*)d_in[8]; p.ln1_g = (const float*)d_in[9]; p.ln1_b = (const float*)d_in[10]; p.ln2_g = (const float*)d_in[11];
    p.ln2_b = (const float*)d_in[12]; p.router_w = (const float*)d_in[13]; p.router_b = (const float*)d_in[14]; p.w_gate = (const float*)d_in[15];
    p.w_up = (const float*)d_in[16]; p.w_down = (const float*)d_in[17];
    p.out = (float*)d_out; p.ws = (char*)d_ws;
    (void)hipMemsetAsync((char*)d_ws + WS_CTL, 0, CTL_BYTES, stream);
    void* args[] = {&p};
    hipError_t e = hipLaunchCooperativeKernel((const void*)mega, dim3(grid_blocks), dim3(NTHREADS), args, 0, stream);
    if (e != hipSuccess) fprintf(stderr, "kernel_launch: cooperative launch failed: %s (grid %d)\n", hipGetErrorString(e), grid_blocks);
}
```

```cpp
#include <hip/hip_runtime.h>
#include <stdint.h>
#include <stdio.h>

typedef unsigned short bf16_t;
typedef __attribute__((ext_vector_type(8))) short bf16x8;
typedef __attribute__((ext_vector_type(4))) float f32x4;
typedef __attribute__((ext_vector_type(4))) unsigned u32x4;
typedef __attribute__((ext_vector_type(2))) unsigned u32x2;

#define DI __device__ __forceinline__
#define LAS __attribute__((address_space(3)))

constexpr int D = 1024;
constexpr int NBATCH = 8;
constexpr int SEQ = 2048;
constexpr int T = NBATCH * SEQ;
constexpr int DEPTH = 4;
constexpr int MIXW = 768;
constexpr int XH = 4, XDH = 64, XW = 256, MEML = 256;
constexpr int MLH = 6, MLDH = 128, CHUNK = 128, NCH = SEQ / CHUNK;
constexpr int DIN_CONV = 2560, DIN_ML = 3340, LDP_ML = 3328, NV_ML = 3584;
constexpr int NE = 32, DFF = 512;
constexpr float ALPHA = 1.681792830507429f;
constexpr float LN_EPS = 1e-5f;

constexpr int NTHREADS = 512;
constexpr int NWAVES = 8;
constexpr int STAGE_BYTES = 131072;
constexpr int META_OFF = STAGE_BYTES;
constexpr int SMEM_BYTES = STAGE_BYTES + 4096;

constexpr size_t al256(size_t x) { return (x + 255) & ~(size_t)255; }
constexpr size_t WS_CTL   = 0;
constexpr size_t CTL_BYTES = 128 * 1024;
constexpr size_t CTL_CNT  = 32 * 1024;
constexpr int CNT_STRIDE = 64;
constexpr size_t CTL_READY = 64 * 1024;
constexpr size_t CTL_STOP = 14 * 1024;
constexpr size_t CTL_TMO  = 15 * 1024;
constexpr size_t CTL_TQ   = 16 * 1024;
constexpr size_t WS_XB    = WS_CTL + CTL_BYTES;
constexpr size_t WS_MEMB  = WS_XB + (size_t)T * D * 2;
constexpr size_t WS_KBUF  = WS_MEMB + (size_t)NBATCH * MEML * D * 2;
constexpr size_t WS_VT    = WS_KBUF + (size_t)DEPTH * NBATCH * MEML * XW * 2;
constexpr size_t WS_PROJ  = WS_VT + (size_t)DEPTH * NBATCH * MEML * XW * 2;
constexpr size_t WS_Z     = WS_PROJ;
constexpr size_t WS_LOGI  = WS_PROJ + (size_t)T * LDP_ML * 2;
constexpr size_t WS_CT    = WS_LOGI + (size_t)T * 16 * 4;
constexpr size_t WS_CPB   = WS_CT + (size_t)48 * NCH * 128 * 128 * 4;
constexpr size_t WS_NLOC  = WS_CPB + (size_t)48 * NCH * 128 * 128 * 2;
constexpr size_t WS_NPREV = WS_NLOC + (size_t)48 * NCH * 128 * 4;
constexpr size_t WS_MLOC  = WS_NPREV + (size_t)48 * NCH * 128 * 4;
constexpr size_t WS_GSUM  = WS_MLOC + al256(48 * NCH * 4);
constexpr size_t WS_MPREV = WS_GSUM + al256(48 * NCH * 4);
constexpr size_t WS_HCAT  = WS_MPREV + al256(48 * NCH * 4);
constexpr size_t WS_X1B   = WS_HCAT + (size_t)T * D * 2;
constexpr size_t WS_GATE  = WS_X1B + (size_t)T * D * 2;
constexpr size_t WS_LIST  = WS_GATE + (size_t)T * 2 * 4;
constexpr size_t WS_HBUF  = WS_LIST + (size_t)NE * T * 4;
constexpr size_t WS_YASG  = WS_HBUF + (size_t)T * 2 * DFF * 2;
constexpr size_t WS_WIN   = WS_YASG + (size_t)T * 2 * D * 2;
constexpr size_t WS_WKV   = WS_WIN + ((size_t)2 * DIN_CONV + (size_t)2 * NV_ML) * D * 2;
constexpr size_t WS_WOUT  = WS_WKV + (size_t)DEPTH * 512 * D * 2;
constexpr size_t WS_WGU   = WS_WOUT + (size_t)DEPTH * D * D * 2;
constexpr size_t WS_WD    = WS_WGU + (size_t)DEPTH * NE * 1024 * D * 2;
constexpr size_t WS_RWT   = WS_WD + (size_t)DEPTH * NE * D * DFF * 2;
constexpr size_t WS_TOTAL = WS_RWT + (size_t)2 * NE * D * 2;

struct P {
    const float *x, *mem, *conv_w_in, *conv_w, *ml_w_in, *ml_gate_b, *ml_norm_g, *w_kv, *w_out;
    const float *ln1_g, *ln1_b, *ln2_g, *ln2_b, *router_w, *router_b, *w_gate, *w_up, *w_down;
    float* out;
    char* ws;
};

DI unsigned cvtpk(float lo, float hi) { unsigned r; asm("v_cvt_pk_bf16_f32 %0, %1, %2" : "=v"(r) : "v"(lo), "v"(hi)); return r; }
DI float bf2f(bf16_t v) { return __uint_as_float(((unsigned)v) << 16); }
DI float bflo(unsigned v) { return __uint_as_float(v << 16); }
DI float bfhi(unsigned v) { return __uint_as_float(v & 0xffff0000u); }
DI bf16_t f2bf(float f) { return (bf16_t)(cvtpk(f, f) & 0xffffu); }
DI float sigmoidf_(float x) { return 1.0f / (1.0f + __expf(-x)); }
DI float logsigmoidf_(float x) { return fminf(x, 0.0f) - log1pf(__expf(-fabsf(x))); }
DI float xor_add(float v, int m) { return v + __shfl_xor(v, m, 64); }
DI float xor_max(float v, int m) { return fmaxf(v, __shfl_xor(v, m, 64)); }
DI float wave_sum(float v) { v = xor_add(v, 32); v = xor_add(v, 16); v = xor_add(v, 8); v = xor_add(v, 4); v = xor_add(v, 2); v = xor_add(v, 1); return v; }
DI int tid_opaque() { int t = threadIdx.x; asm volatile("" : "+v"(t)); return t; }
DI f32x4 mfma16(bf16x8 a, bf16x8 b, f32x4 c) { return __builtin_amdgcn_mfma_f32_16x16x32_bf16(a, b, c, 0, 0, 0); }

namespace g8 {
constexpr int BM = 256, BK = 64, HALF = 128, HTB = HALF * BK * 2, NXCD = 8, WGM = 8;
DI int lds_byte(int r, int c) { const int st = (r >> 4) * 2 + (c >> 5), rr = r & 15, cc = c & 31, ob = rr * 64 + cc * 2; return st * 1024 + (ob ^ (((ob >> 9) & 1) << 5)); }
DI void stage_rc(int b, int& R, int& C) { const int st = b / 1024, sb = b % 1024, swz = sb ^ (((sb >> 9) & 1) << 5); R = (st >> 1) * 16 + swz / 64; C = (st & 1) * 32 + (swz % 64) / 2; }
DI int perm32(int rho) { const int n = rho >> 4, i = rho & 15; return 8 * (i >> 2) + 4 * n + (i & 3); }
DI int xcd_remap(int L, int n) { const int q = n / NXCD, r = n % NXCD, xcd = L % NXCD, off = L / NXCD; return (xcd < r ? xcd * (q + 1) : r * (q + 1) + (xcd - r) * q) + off; }

struct Unit { int pm, pn, e, valid, rbase, rti; };
DI const char* uni(const char* p_) {
    const unsigned long long v = (unsigned long long)p_;
    const unsigned lo = (unsigned)__builtin_amdgcn_readfirstlane((int)(unsigned)v), hi = (unsigned)__builtin_amdgcn_readfirstlane((int)(unsigned)(v >> 32));
    return (const char*)(((unsigned long long)hi << 32) | lo);
}

template <bool GATHER, class Epi, class Sched>
DI void gemm_phase(LAS unsigned char* lds, const int K, const Sched& S, const Epi& E) {
    const int tid = tid_opaque(), wid = __builtin_amdgcn_readfirstlane(tid >> 6), lane = tid & 63, wr = wid >> 2, wc = wid & 3, fr = lane & 15, fq = lane >> 4;
    const int nt = K / BK;
    const size_t kstep = (size_t)(BK * 2);
    const size_t hstep = (size_t)HALF * K * 2;
    unsigned vB0, vB1;
    {
        int R0, C0, R1, C1;
        stage_rc(tid * 16, R0, C0); stage_rc(tid * 16 + 8192, R1, C1);
        const int Rb0 = Epi::PERM ? ((R0 & ~31) + perm32(R0 & 31)) : R0, Rb1 = Epi::PERM ? ((R1 & ~31) + perm32(R1 & 31)) : R1;
        vB0 = (unsigned)(Rb0 * K + C0) * 2u; vB1 = (unsigned)(Rb1 * K + C1) * 2u;
    }
    const unsigned ldsw = (unsigned)wid * 1024u;
    const int aoff = lds_byte(wr * 64 + fr, fq * 8), boff = lds_byte(wc * 32 + fr, fq * 8);
#define G8_SA(b, h) (((b) * 2 + (h)) * HTB)
#define G8_SB(b, h) ((4 + (b) * 2 + (h)) * HTB)
#define G8_STAGE(bufoff, gbase, v0, v1) do { unsigned _o0 = (v0), _o1 = (v1); asm volatile("" : "+v"(_o0), "+v"(_o1));     \
        __builtin_amdgcn_global_load_lds((const unsigned*)((const char*)(gbase) + _o0), (LAS unsigned*)(lds + (bufoff) + ldsw), 16, 0, 0); \
        __builtin_amdgcn_global_load_lds((const unsigned*)((const char*)(gbase) + _o1), (LAS unsigned*)(lds + (bufoff) + ldsw + 8192), 16, 0, 0); } while (0)
#define G8_LDA(dst, b, h) do { _Pragma("unroll") for (int m = 0; m < 4; ++m) _Pragma("unroll") for (int k = 0; k < 2; ++k) dst[m][k] = *(const LAS bf16x8*)(lds + G8_SA(b, h) + aoff + m * 2048 + k * 1024); } while (0)
#define G8_LDB(dst, b, h) do { _Pragma("unroll") for (int n = 0; n < 2; ++n) _Pragma("unroll") for (int k = 0; k < 2; ++k) dst[n][k] = *(const LAS bf16x8*)(lds + G8_SB(b, h) + boff + n * 2048 + k * 1024); } while (0)
#define G8_MMA(ai, bj, At, Bt) do { __builtin_amdgcn_s_setprio(1); _Pragma("unroll") for (int m = 0; m < 4; ++m) _Pragma("unroll") for (int n = 0; n < 2; ++n) _Pragma("unroll") for (int k = 0; k < 2; ++k) \
        acc[ai][bj][m][n] = __builtin_amdgcn_mfma_f32_16x16x32_bf16(Bt[n][k], At[m][k], acc[ai][bj][m][n], 0, 0, 0); __builtin_amdgcn_s_setprio(0); } while (0)
#define G8_WAIT_V(n) asm volatile("s_waitcnt vmcnt(" #n ")" ::: "memory")
#define G8_WAIT_L(n) asm volatile("s_waitcnt lgkmcnt(" #n ")" ::: "memory")
#define G8_BAR __builtin_amdgcn_s_barrier()
#define G8_SCHED __builtin_amdgcn_sched_barrier(0)
    Unit cur, nxt;
    int ui = 0;
    if (!S.next(0, cur)) return;
    f32x4 acc[2][2][4][2];
#pragma unroll
    for (int a = 0; a < 2; ++a)
#pragma unroll
        for (int b = 0; b < 2; ++b)
#pragma unroll
            for (int m = 0; m < 4; ++m)
#pragma unroll
                for (int n = 0; n < 2; ++n) acc[a][b][m][n] = (f32x4){0.f, 0.f, 0.f, 0.f};
    bf16x8 At[4][2], B0[2][2], B1[2][2];
    S.a_ready(cur);
    const char* cA = S.a_base(cur);
    const char* cB = S.b_base(cur);
    unsigned cv00, cv01, cv10, cv11, nv00, nv01, nv10, nv11;
    {
        int R0, C0, R1, C1;
        stage_rc(tid * 16, R0, C0); stage_rc(tid * 16 + 8192, R1, C1);
        int rows[2][2];
        S.a_rows(cur, R0, R1, rows);
        cv00 = (unsigned)(rows[0][0] * K + C0) * 2u; cv01 = (unsigned)(rows[0][1] * K + C1) * 2u;
        cv10 = (unsigned)(rows[1][0] * K + C0) * 2u; cv11 = (unsigned)(rows[1][1] * K + C1) * 2u;
        nv00 = cv00; nv01 = cv01; nv10 = cv10; nv11 = cv11;
    }
    G8_STAGE(G8_SB(0, 0), uni(cB), vB0, vB1); G8_STAGE(G8_SA(0, 0), uni(cA), cv00, cv01); G8_STAGE(G8_SB(0, 1), uni(cB + hstep), vB0, vB1); G8_STAGE(G8_SA(0, 1), uni(cA), cv10, cv11);
    if (wr == 1) G8_BAR;
    G8_WAIT_V(4); G8_BAR;
    G8_STAGE(G8_SB(1, 0), uni(cB + kstep), vB0, vB1); G8_STAGE(G8_SA(1, 0), uni(cA + kstep), cv00, cv01); G8_STAGE(G8_SB(1, 1), uni(cB + hstep + kstep), vB0, vB1);
    G8_WAIT_V(6); G8_BAR;
    for (;;) {
        const bool has_next = S.next(ui + 1, nxt);
        const char* nA = has_next ? S.a_base(nxt) : cA;
        const char* nB = has_next ? S.b_base(nxt) : cB;
        if (GATHER) {
            if (has_next) {
                const int tid2 = tid_opaque();
                int R0, C0, R1, C1;
                stage_rc(tid2 * 16, R0, C0); stage_rc(tid2 * 16 + 8192, R1, C1);
                int rows[2][2];
                S.a_rows(nxt, R0, R1, rows);
                nv00 = (unsigned)(rows[0][0] * K + C0) * 2u; nv01 = (unsigned)(rows[0][1] * K + C1) * 2u;
                nv10 = (unsigned)(rows[1][0] * K + C0) * 2u; nv11 = (unsigned)(rows[1][1] * K + C1) * 2u;
            } else { nv00 = cv00; nv01 = cv01; nv10 = cv10; nv11 = cv11; }
        }
        for (int t = 0; t < nt; t += 2) {
            const bool last = (t == nt - 2);
            if (last && has_next) S.a_ready(nxt);
            const char* a1 = uni(cA + (size_t)(t + 1) * kstep);
            const char* a2 = uni(last ? nA : cA + (size_t)(t + 2) * kstep);
            const char* b2 = uni(last ? nB : cB + (size_t)(t + 2) * kstep);
            const char* a3 = uni(a2 + kstep);
            const char* b3 = uni(b2 + kstep);
            const char* b2h = uni(b2 + hstep);
            const char* b3h = uni(b3 + hstep);
            unsigned x00 = cv00, x01 = cv01, x10 = cv10, x11 = cv11;
            if (GATHER) { x00 = last ? nv00 : cv00; x01 = last ? nv01 : cv01; x10 = last ? nv10 : cv10; x11 = last ? nv11 : cv11; }
            G8_LDB(B0, 0, 0); G8_SCHED; G8_LDA(At, 0, 0); G8_STAGE(G8_SA(1, 1), a1, cv10, cv11);
            G8_WAIT_L(8); G8_BAR; G8_WAIT_L(0); G8_MMA(0, 0, At, B0); G8_BAR; G8_SCHED;
            G8_LDB(B1, 0, 1); G8_STAGE(G8_SB(0, 0), b2, vB0, vB1);
            G8_BAR; G8_WAIT_L(0); G8_MMA(0, 1, At, B1); G8_BAR;
            G8_LDA(At, 0, 1); G8_STAGE(G8_SA(0, 0), a2, x00, x01);
            G8_BAR; G8_WAIT_L(0); G8_MMA(1, 0, At, B0); G8_BAR; G8_SCHED;
            G8_STAGE(G8_SB(0, 1), b2h, vB0, vB1);
            G8_WAIT_V(6);
            G8_BAR; G8_MMA(1, 1, At, B1); G8_BAR;
            G8_LDB(B0, 1, 0); G8_SCHED; G8_LDA(At, 1, 0); G8_STAGE(G8_SA(0, 1), a2, x10, x11);
            G8_WAIT_L(8); G8_BAR; G8_WAIT_L(0); G8_MMA(0, 0, At, B0); G8_BAR; G8_SCHED;
            G8_LDB(B1, 1, 1); G8_STAGE(G8_SB(1, 0), b3, vB0, vB1);
            G8_BAR; G8_WAIT_L(0); G8_MMA(0, 1, At, B1); G8_BAR;
            G8_LDA(At, 1, 1); G8_STAGE(G8_SA(1, 0), a3, x00, x01);
            G8_BAR; G8_WAIT_L(0); G8_MMA(1, 0, At, B0); G8_BAR; G8_SCHED;
            G8_STAGE(G8_SB(1, 1), b3h, vB0, vB1);
            G8_WAIT_V(6); G8_BAR; G8_MMA(1, 1, At, B1); G8_BAR;
        }
        E(acc, cur, wr, wc, fr, fq);
        if (!has_next) break;
#pragma unroll
        for (int a = 0; a < 2; ++a)
#pragma unroll
            for (int b = 0; b < 2; ++b)
#pragma unroll
                for (int m = 0; m < 4; ++m)
#pragma unroll
                    for (int n = 0; n < 2; ++n) acc[a][b][m][n] = (f32x4){0.f, 0.f, 0.f, 0.f};
        cur = nxt; cA = nA; cB = nB; ++ui;
        if (GATHER) { cv00 = nv00; cv01 = nv01; cv10 = nv10; cv11 = nv11; }
    }
    G8_WAIT_V(0);
    if (wr == 0) G8_BAR;
    G8_BAR;
#undef G8_SA
#undef G8_SB
#undef G8_STAGE
#undef G8_LDA
#undef G8_LDB
#undef G8_MMA
#undef G8_WAIT_V
#undef G8_WAIT_L
#undef G8_BAR
#undef G8_SCHED
}

struct DenseSched {
    const char* A; const char* Bt; int K, nM, nN, nwg, G, c;
    DI void init(const void* A_, const void* Bt_, int M, int N, int K_, int G_, int c_) { A = (const char*)A_; Bt = (const char*)Bt_; K = K_; nM = M / BM; nN = N / BM; nwg = nM * nN; G = G_; c = c_; }
    DI bool next(int i, Unit& u) const {
        const int L = i * G + c;
        if (L >= nwg) return false;
        const int wgid = xcd_remap(L, nwg);
        const int nig = WGM * nN, gid = wgid / nig, fm = gid * WGM, gsz = (nM - fm) < WGM ? (nM - fm) : WGM;
        u.pm = fm + ((wgid % nig) % gsz); u.pn = (wgid % nig) / gsz; u.e = 0; u.valid = 256; u.rbase = 0; u.rti = 0;
        return true;
    }
    DI const char* a_base(const Unit& u) const { return A + (size_t)u.pm * 256 * K * 2; }
    DI const char* b_base(const Unit& u) const { return Bt + (size_t)u.pn * 256 * K * 2; }
    DI void a_rows(const Unit&, int R0, int R1, int (&rows)[2][2]) const { rows[0][0] = R0; rows[0][1] = R1; rows[1][0] = 128 + R0; rows[1][1] = 128 + R1; }
    DI void a_ready(const Unit&) const {}
};
}


struct TJ { const float* s[4]; float sc[4]; bf16_t* d[2]; };

template <class ColPtr>
DI void tj_make(TJ& j, ColPtr colptr, int ld, int k0, int v0, bf16_t* dst, int K, int tid) {
#pragma unroll
    for (int i = 0; i < 4; ++i) {
        const int idx = tid + NTHREADS * i, kr = idx >> 5, c4 = idx & 31;
        float sc;
        const float* src = colptr(v0 + 4 * c4, sc);
        j.s[i] = src + (size_t)(k0 + kr) * ld; j.sc[i] = sc;
    }
#pragma unroll
    for (int i = 0; i < 2; ++i) {
        const int ch = tid + NTHREADS * i, vr = ch >> 3, kc = ch & 7;
        j.d[i] = dst + (size_t)(v0 + vr) * K + k0 + kc * 8;
    }
}
DI void tj_load(const TJ& j, f32x4 (&v)[4]) {
#pragma unroll
    for (int i = 0; i < 4; ++i) v[i] = __builtin_nontemporal_load((const f32x4*)j.s[i]);
}
DI void tj_finish(const TJ& j, const f32x4 (&v)[4], float* tile, int tid) {
    constexpr int TS = 129;
    __syncthreads();
#pragma unroll
    for (int i = 0; i < 4; ++i) {
        const int idx = tid + NTHREADS * i, kr = idx >> 5, c4 = idx & 31;
        float* tp = tile + kr * TS + 4 * c4;
        tp[0] = v[i][0] * j.sc[i]; tp[1] = v[i][1] * j.sc[i]; tp[2] = v[i][2] * j.sc[i]; tp[3] = v[i][3] * j.sc[i];
    }
    __syncthreads();
#pragma unroll
    for (int i = 0; i < 2; ++i) {
        const int ch = tid + NTHREADS * i, vr = ch >> 3, kc = ch & 7;
        const float* tp = tile + (kc * 8) * TS + vr;
        u32x4 w;
        w.x = cvtpk(tp[0], tp[TS]); w.y = cvtpk(tp[2 * TS], tp[3 * TS]); w.z = cvtpk(tp[4 * TS], tp[5 * TS]); w.w = cvtpk(tp[6 * TS], tp[7 * TS]);
        __builtin_nontemporal_store(w, (u32x4*)j.d[i]);
    }
}

constexpr int MOE_TILES_PER_LAYER = NE * (16 * 8 + 8 * 8);
DI void moe_tile_job(const P& p, int q, int tid, TJ& j) {
    const int layer = q / MOE_TILES_PER_LAYER, r = q % MOE_TILES_PER_LAYER;
    if (r < NE * 128) {
        const int le = layer * NE + (r >> 7), qq = r & 127, kt = qq >> 3, vt = qq & 7;
        const float* Wg = p.w_gate + (size_t)le * D * DFF;
        const float* Wu = p.w_up + (size_t)le * D * DFF;
        tj_make(j, [&](int v4, float& sc) { sc = 1.0f; const int grp = v4 >> 7; return ((grp & 1) ? Wu : Wg) + (grp >> 1) * 128 + (v4 & 127); },
                DFF, kt * 64, vt * 128, (bf16_t*)(p.ws + WS_WGU) + (size_t)le * 1024 * D, D, tid);
    } else {
        const int r2 = r - NE * 128, le = layer * NE + (r2 >> 6), qq = r2 & 63, kt = qq >> 3, vt = qq & 7;
        const float* W = p.w_down + (size_t)le * DFF * D;
        tj_make(j, [&](int v4, float& sc) { sc = 1.0f; return W + v4; }, D, kt * 64, vt * 128, (bf16_t*)(p.ws + WS_WD) + (size_t)le * D * DFF, DFF, tid);
    }
}

constexpr int PT_CONV = 16 * 20, PT_ML = 16 * 28, PT_KV = 16 * 4, PT_OUT = 16 * 8;
constexpr int PN0 = 2 * PT_CONV, PN1 = PN0 + 2 * PT_ML, PN2 = PN1 + 4 * PT_KV, PN3 = PN2 + 4 * PT_OUT, PN5 = PN3 + MOE_TILES_PER_LAYER;
DI void prep_tile_job(const P& p, int it, int tid, TJ& j) {
    if (it < PN0) {
        const int jj = it / PT_CONV, q = it % PT_CONV, kt = q / 20, vt = q % 20;
        const float* W = p.conv_w_in + (size_t)jj * D * DIN_CONV;
        tj_make(j, [&](int v4, float& sc) { sc = 1.0f; return W + v4; }, DIN_CONV, kt * 64, vt * 128, (bf16_t*)(p.ws + WS_WIN) + (size_t)jj * DIN_CONV * D, D, tid);
    } else if (it < PN1) {
        const int r = it - PN0, jj = r / PT_ML, q = r % PT_ML, kt = q / 28, vt = q % 28;
        const float* W = p.ml_w_in + (size_t)jj * D * DIN_ML;
        tj_make(j, [&](int v4, float& sc) -> const float* {
                    sc = (v4 >= MIXW && v4 < 2 * MIXW) ? 0.08838834764831845f : 1.0f;
                    if (v4 < 3072) return W + v4;
                    if (v4 < 3328) return W + 3084 + (v4 - 3072);
                    if (v4 < 3340) return W + 3072 + (v4 - 3328);
                    sc = 0.0f; return W; },
                DIN_ML, kt * 64, vt * 128, (bf16_t*)(p.ws + WS_WIN) + ((size_t)2 * DIN_CONV + (size_t)jj * NV_ML) * D, D, tid);
    } else if (it < PN2) {
        const int r = it - PN1, l = r / PT_KV, q = r % PT_KV, kt = q / 4, vt = q % 4;
        const float* W = p.w_kv + (size_t)l * D * 512;
        tj_make(j, [&](int v4, float& sc) { sc = 1.0f; return W + v4; }, 512, kt * 64, vt * 128, (bf16_t*)(p.ws + WS_WKV) + (size_t)l * 512 * D, D, tid);
    } else if (it < PN3) {
        const int r = it - PN2, l = r / PT_OUT, q = r % PT_OUT, kt = q / 8, vt = q % 8;
        const float* W = p.w_out + (size_t)l * D * D;
        tj_make(j, [&](int v4, float& sc) { sc = 1.0f; return W + v4; }, D, kt * 64, vt * 128, (bf16_t*)(p.ws + WS_WOUT) + (size_t)l * D * D, D, tid);
    } else {
        moe_tile_job(p, it - PN3, tid, j);
    }
}

DI void phase_prep(const P& p, int bid, int nb, char* smem) {
    const int tid = tid_opaque();
    bf16_t* xb = (bf16_t*)(p.ws + WS_XB);
    bf16_t* memb = (bf16_t*)(p.ws + WS_MEMB);
    {
        const size_t nx = (size_t)T * D / 4, nm = (size_t)NBATCH * MEML * D / 4;
        for (size_t i = (size_t)bid * NTHREADS + tid; i < nx + nm; i += (size_t)nb * NTHREADS) {
            if (i < nx) { f32x4 v = ((const f32x4*)p.x)[i]; u32x2 w; w.x = cvtpk(v[0], v[1]); w.y = cvtpk(v[2], v[3]); ((u32x2*)xb)[i] = w; }
            else { size_t j = i - nx; f32x4 v = ((const f32x4*)p.mem)[j]; u32x2 w; w.x = cvtpk(v[0], v[1]); w.y = cvtpk(v[2], v[3]); ((u32x2*)memb)[j] = w; }
        }
    }
    {
        bf16_t* rwt = (bf16_t*)(p.ws + WS_RWT);
        for (int i = bid * NTHREADS + tid; i < NE * D; i += nb * NTHREADS) {
            const int e = i >> 10, d = i & 1023;
            const float w = p.router_w[(size_t)d * NE + e];
            const bf16_t hi = f2bf(w);
            rwt[i] = hi; rwt[NE * D + i] = f2bf(w - bf2f(hi));
        }
    }
    float* tile = (float*)smem;
    if (bid < PN5) {
        TJ j0, j1, j2; f32x4 v0[4], v1[4], v2[4];
        prep_tile_job(p, bid, tid, j0); tj_load(j0, v0);
        if (bid + nb < PN5) { prep_tile_job(p, bid + nb, tid, j1); tj_load(j1, v1); }
        for (int it = bid; it < PN5; it += nb) {
            const bool h2 = it + 2 * nb < PN5;
            if (h2) { prep_tile_job(p, it + 2 * nb, tid, j2); tj_load(j2, v2); }
            tj_finish(j0, v0, tile, tid);
            j0 = j1; j1 = j2;
#pragma unroll
            for (int i = 0; i < 4; ++i) { v0[i] = v1[i]; v1[i] = v2[i]; }
        }
    }
}

DI void moe_steal(const P& p, int budget, int limit, const unsigned* stop, unsigned stop_at, char* smem) {
    volatile int* qslot = (volatile int*)(smem + META_OFF + 2048);
    unsigned* tq = (unsigned*)(p.ws + WS_CTL + CTL_TQ);
    const int tid = tid_opaque();
    constexpr int QEND = DEPTH * MOE_TILES_PER_LAYER;
    if (budget <= 0) return;
    int nclaimed = 0, qlast = 0;
    auto claim = [&](int k) {
        if (tid == 0) {
            const bool halt = (nclaimed >= budget) || (qlast >= limit) || (stop && __hip_atomic_load(stop, __ATOMIC_RELAXED, __HIP_MEMORY_SCOPE_AGENT) >= stop_at);
            qslot[k] = halt ? QEND : (int)__hip_atomic_fetch_add(tq, 1u, __ATOMIC_RELAXED, __HIP_MEMORY_SCOPE_AGENT) + MOE_TILES_PER_LAYER;
        }
    };
    __syncthreads();
    claim(0);
    __syncthreads();
    int q0 = qslot[0];
    if (q0 >= QEND) return;
    nclaimed = 1; qlast = q0;
    TJ j0, j1, j2; f32x4 v0[4], v1[4], v2[4];
    moe_tile_job(p, q0, tid, j0); tj_load(j0, v0);
    claim(1);
    __syncthreads();
    int q1 = qslot[1];
    if (q1 < QEND) { nclaimed = 2; qlast = q1; moe_tile_job(p, q1, tid, j1); tj_load(j1, v1); }
    for (;;) {
        int q2 = QEND;
        if (q1 < QEND) {
            claim(2);
            __syncthreads();
            q2 = qslot[2];
            if (q2 < QEND) { ++nclaimed; qlast = q2; moe_tile_job(p, q2, tid, j2); tj_load(j2, v2); }
        }
        tj_finish(j0, v0, (float*)smem, tid);
        if (q1 >= QEND) break;
        j0 = j1; j1 = j2; q0 = q1; q1 = q2;
#pragma unroll
        for (int i = 0; i < 4; ++i) { v0[i] = v1[i]; v1[i] = v2[i]; }
    }
}
DI void steal_in_slack(const P& p, int slot, bool longest, int nlong, char* smem) {
    unsigned* stop = (unsigned*)(p.ws + WS_CTL + CTL_STOP) + slot;
    if (longest) { if (tid_opaque() == 0) __hip_atomic_fetch_add(stop, 1u, __ATOMIC_RELAXED, __HIP_MEMORY_SCOPE_AGENT); }
    else moe_steal(p, 64, DEPTH * MOE_TILES_PER_LAYER, stop, (unsigned)((nlong * 3 + 3) / 4), smem);
}

DI void store8_bf16(bf16_t* p8, const f32x4& v0, const f32x4& v1) {
    u32x4 w; w.x = cvtpk(v0[0], v0[1]); w.y = cvtpk(v0[2], v0[3]); w.z = cvtpk(v1[0], v1[1]); w.w = cvtpk(v1[2], v1[3]);
    *(u32x4*)p8 = w;
}

struct EpiTileBf16 {
    static constexpr bool PERM = true;
    bf16_t* O; int ldc; size_t pm_stride, pn_stride;
    DI void operator()(const f32x4 (&acc)[2][2][4][2], const g8::Unit& u, int wr, int wc, int fr, int fq) const {
        bf16_t* base = O + (size_t)u.pm * pm_stride + (size_t)u.pn * pn_stride + (size_t)(wr * 64 + fr) * ldc + wc * 32 + 8 * fq;
#pragma unroll
        for (int ai = 0; ai < 2; ++ai)
#pragma unroll
            for (int m = 0; m < 4; ++m)
                {
#pragma unroll
                    for (int bj = 0; bj < 2; ++bj) store8_bf16(base + (size_t)(ai * 128 + m * 16) * ldc + bj * 128, acc[ai][bj][m][0], acc[ai][bj][m][1]); __builtin_amdgcn_sched_barrier(0); }
    }
};

DI int units_of(int nunits, int G, int c) { return (c < nunits) ? (nunits - 1 - c) / G + 1 : 0; }

struct KSched {
    const char* memb; const char* wkv; int G, c;
    DI bool next(int i, g8::Unit& u) const { const int L = i * G + c; if (L >= 32) return false; u.pm = L & 7; u.pn = L >> 3; u.e = 0; u.valid = 256; u.rbase = 0; u.rti = 0; return true; }
    DI const char* a_base(const g8::Unit& u) const { return memb + (size_t)u.pm * 256 * D * 2; }
    DI const char* b_base(const g8::Unit& u) const { return wkv + (size_t)u.pn * 512 * D * 2; }
    DI void a_rows(const g8::Unit&, int R0, int R1, int (&rows)[2][2]) const { rows[0][0] = R0; rows[0][1] = R1; rows[1][0] = 128 + R0; rows[1][1] = 128 + R1; }
    DI void a_ready(const g8::Unit&) const {}
};
struct VSched {
    const char* memb; const char* wkv; int G, c;
    DI bool next(int i, g8::Unit& u) const { const int L = i * G + c - 32; if (L < 0 || L >= 32) return false; u.pm = L >> 3; u.pn = L & 7; u.e = 0; u.valid = 256; u.rbase = 0; u.rti = 0; return true; }
    DI const char* a_base(const g8::Unit& u) const { return wkv + ((size_t)u.pm * 512 + 256) * D * 2; }
    DI const char* b_base(const g8::Unit& u) const { return memb + (size_t)u.pn * 256 * D * 2; }
    DI void a_rows(const g8::Unit&, int R0, int R1, int (&rows)[2][2]) const { rows[0][0] = R0; rows[0][1] = R1; rows[1][0] = 128 + R0; rows[1][1] = 128 + R1; }
    DI void a_ready(const g8::Unit&) const {}
};
DI void phase_kv(const P& p, int bid, int nb, char* smem) {
    const char* memb = p.ws + WS_MEMB;
    const char* wkv = p.ws + WS_WKV;
    {
        KSched S{memb, wkv, nb, bid};
        EpiTileBf16 E{(bf16_t*)(p.ws + WS_KBUF), 256, (size_t)256 * 256, (size_t)2048 * 256};
        g8::gemm_phase<false>((LAS unsigned char*)smem, D, S, E);
    }
    {
        VSched S{memb, wkv, nb, bid};
        EpiTileBf16 E{(bf16_t*)(p.ws + WS_VT), 256, (size_t)8 * 256 * 256, (size_t)256 * 256};
        g8::gemm_phase<false>((LAS unsigned char*)smem, D, S, E);
    }
    steal_in_slack(p, 31, bid < 64, 64, smem);
}

struct EpiInproj {
    static constexpr bool PERM = true;
    bf16_t* projb; int ldp; int gate_pn; float* graw;
    DI void operator()(const f32x4 (&acc)[2][2][4][2], const g8::Unit& u, int wr, int wc, int fr, int fq) const {
        if (u.pn != gate_pn) {
            bf16_t* base = projb + (size_t)(u.pm * 256 + wr * 64 + fr) * ldp + u.pn * 256 + wc * 32 + 8 * fq;
#pragma unroll
            for (int ai = 0; ai < 2; ++ai)
#pragma unroll
                for (int m = 0; m < 4; ++m)
                    {
#pragma unroll
                        for (int bj = 0; bj < 2; ++bj) store8_bf16(base + (size_t)(ai * 128 + m * 16) * ldp + bj * 128, acc[ai][bj][m][0], acc[ai][bj][m][1]); __builtin_amdgcn_sched_barrier(0); }
        } else if (wc == 0 && fq < 2) {
#pragma unroll
            for (int ai = 0; ai < 2; ++ai)
#pragma unroll
                for (int m = 0; m < 4; ++m) {
                    float* dst = graw + (size_t)(u.pm * 256 + ai * 128 + wr * 64 + m * 16 + fr) * 16 + 8 * fq;
                    *(f32x4*)dst = acc[ai][0][m][0];
                    *(f32x4*)(dst + 4) = acc[ai][0][m][1];
                }
        }
    }
};
DI void phase_inproj(const P& p, int layer, int bid, int nb, char* smem) {
    const bool conv = (layer & 1) == 0;
    const int j = layer >> 1;
    const bf16_t* W = (const bf16_t*)(p.ws + WS_WIN) + (conv ? (size_t)j * DIN_CONV * D : ((size_t)2 * DIN_CONV + (size_t)j * NV_ML) * D);
    g8::DenseSched S; S.init(p.ws + WS_XB, W, T, conv ? DIN_CONV : NV_ML, D, nb, bid);
    EpiInproj E{(bf16_t*)(p.ws + WS_PROJ), conv ? DIN_CONV : LDP_ML, conv ? -1 : 13, (float*)(p.ws + WS_LOGI)};
    g8::gemm_phase<false>((LAS unsigned char*)smem, D, S, E);
    { const int most = (S.nwg + nb - 1) / nb, nlong = S.nwg - (most - 1) * nb; steal_in_slack(p, layer * 2, units_of(S.nwg, nb, bid) == most, nlong, smem); }
}

struct EpiOutproj {
    static constexpr bool PERM = true;
    const bf16_t* xres; bf16_t* z;
    DI void operator()(const f32x4 (&acc)[2][2][4][2], const g8::Unit& u, int wr, int wc, int fr, int fq) const {
        const size_t off0 = (size_t)(u.pm * 256 + wr * 64 + fr) * D + u.pn * 256 + wc * 32 + 8 * fq;
        u32x4 xr[2][4][2];
#pragma unroll
        for (int ai = 0; ai < 2; ++ai)
#pragma unroll
            for (int m = 0; m < 4; ++m)
#pragma unroll
                for (int bj = 0; bj < 2; ++bj) xr[ai][m][bj] = *(const u32x4*)(xres + off0 + (size_t)(ai * 128 + m * 16) * D + bj * 128);
#pragma unroll
        for (int ai = 0; ai < 2; ++ai)
#pragma unroll
            for (int m = 0; m < 4; ++m)
#pragma unroll
                for (int bj = 0; bj < 2; ++bj) {
                    const size_t off = off0 + (size_t)(ai * 128 + m * 16) * D + bj * 128;
                    const u32x4 r4 = xr[ai][m][bj];
                    f32x4 v0 = acc[ai][bj][m][0], v1 = acc[ai][bj][m][1];
                    v0[0] += ALPHA * bflo(r4.x); v0[1] += ALPHA * bfhi(r4.x); v0[2] += ALPHA * bflo(r4.y); v0[3] += ALPHA * bfhi(r4.y);
                    v1[0] += ALPHA * bflo(r4.z); v1[1] += ALPHA * bfhi(r4.z); v1[2] += ALPHA * bflo(r4.w); v1[3] += ALPHA * bfhi(r4.w);
                    store8_bf16(z + off, v0, v1);
                }
    }
};
DI void phase_outproj(const P& p, int layer, int bid, int nb, char* smem) {
    g8::DenseSched S; S.init(p.ws + WS_HCAT, (const bf16_t*)(p.ws + WS_WOUT) + (size_t)layer * D * D, T, D, D, nb, bid);
    EpiOutproj E{(const bf16_t*)(p.ws + WS_XB), (bf16_t*)(p.ws + WS_Z)};
    g8::gemm_phase<false>((LAS unsigned char*)smem, D, S, E);
}

DI void moe_meta(const int* cnt, int* meta) {
    __syncthreads();
    const int t = tid_opaque();
    if (t < NE) meta[65 + t] = __hip_atomic_load(cnt + t * CNT_STRIDE, __ATOMIC_RELAXED, __HIP_MEMORY_SCOPE_AGENT);
    __syncthreads();
    if (t == 0) {
        int base = 0, blk = 0;
#pragma unroll 1
        for (int e = 0; e < NE; ++e) {
            const int c = meta[65 + e];
            meta[e] = base; meta[32 + e] = blk;
            base += c; blk += (c + 255) >> 8;
        }
        meta[64] = blk;
    }
    __syncthreads();
    if (t < 160) {
        int e = 0;
#pragma unroll 1
        for (int q = 1; q < NE; ++q) e += (meta[32 + q] <= t) ? 1 : 0;
        meta[128 + t] = e;
    }
    __syncthreads();
}
struct MoeSched {
    const int* meta; const int* list; const char* A; const char* Bt; size_t b_estride; int K, G, c, nunits;
    DI bool next(int i, g8::Unit& u) const {
        const int L = i * G + c;
        if (L >= nunits) return false;
        const int w = g8::xcd_remap(L, nunits);
        const int rti = w >> 2;
        const int e = __builtin_amdgcn_readfirstlane(meta[128 + rti]);
        u.e = e; u.pm = rti - __builtin_amdgcn_readfirstlane(meta[32 + e]); u.pn = w & 3; u.rti = rti;
        const int left = __builtin_amdgcn_readfirstlane(meta[65 + e]) - u.pm * 256;
        u.valid = left < 256 ? left : 256;
        u.rbase = __builtin_amdgcn_readfirstlane(meta[e]);
        return true;
    }
    DI const char* b_base(const g8::Unit& u) const { return Bt + (size_t)u.e * b_estride + (size_t)u.pn * 256 * K * 2; }
};
struct MoeUpSched : MoeSched {
    DI const char* a_base(const g8::Unit&) const { return A; }
    DI void a_rows(const g8::Unit& u, int R0, int R1, int (&rows)[2][2]) const {
        const int* lst = list + (size_t)u.e * T + u.pm * 256;
        const int vm = u.valid - 1;
        rows[0][0] = lst[min(R0, vm)] >> 1; rows[0][1] = lst[min(R1, vm)] >> 1;
        rows[1][0] = lst[min(128 + R0, vm)] >> 1; rows[1][1] = lst[min(128 + R1, vm)] >> 1;
    }
    DI void a_ready(const g8::Unit&) const {}
};
struct MoeDownSched : MoeSched {
    unsigned* ready; unsigned* tmo;
    DI const char* a_base(const g8::Unit& u) const { return A + ((size_t)u.rbase + (size_t)u.pm * 256) * K * 2; }
    DI void a_rows(const g8::Unit&, int R0, int R1, int (&rows)[2][2]) const { rows[0][0] = R0; rows[0][1] = R1; rows[1][0] = 128 + R0; rows[1][1] = 128 + R1; }
    DI void a_ready(const g8::Unit& u) const {
        if (tid_opaque() < 64) {
            unsigned* w = ready + u.rti * 16;
            unsigned spins = 0;
            while ((unsigned)__builtin_amdgcn_readfirstlane((int)__hip_atomic_load(w, __ATOMIC_RELAXED, __HIP_MEMORY_SCOPE_AGENT)) < 32u) {
                __builtin_amdgcn_s_sleep(2);
                if ((++spins & 255u) == 0u) {
                    if (__builtin_amdgcn_readfirstlane((int)__hip_atomic_load(tmo, __ATOMIC_RELAXED, __HIP_MEMORY_SCOPE_AGENT)) != 0) break;
                    if (spins > (1u << 22)) { __hip_atomic_store(tmo, 1u, __ATOMIC_RELAXED, __HIP_MEMORY_SCOPE_AGENT); break; }
                }
            }
            __builtin_amdgcn_fence(__ATOMIC_ACQUIRE, "agent");
            asm volatile("s_waitcnt vmcnt(0)" ::: "memory");
        }
        asm volatile("" ::: "memory"); __builtin_amdgcn_s_barrier(); asm volatile("" ::: "memory");
    }
};

struct EpiMoeUp {
    static constexpr bool PERM = true;
    __amdgpu_buffer_rsrc_t hrs; unsigned* ready;
    DI void operator()(const f32x4 (&acc)[2][2][4][2], const g8::Unit& u, int wr, int wc, int fr, int fq) const {
        const unsigned hrow0 = (unsigned)u.rbase + (unsigned)u.pm * 256u;
#pragma unroll
        for (int ai = 0; ai < 2; ++ai)
#pragma unroll
            for (int m = 0; m < 4; ++m) {
                const int row = ai * 128 + wr * 64 + m * 16 + fr;
                if (row < u.valid) {
                    f32x4 h0, h1;
#pragma unroll
                    for (int i = 0; i < 4; ++i) {
                        const float g0 = acc[ai][0][m][0][i], g1 = acc[ai][0][m][1][i];
                        h0[i] = g0 * sigmoidf_(g0) * acc[ai][1][m][0][i];
                        h1[i] = g1 * sigmoidf_(g1) * acc[ai][1][m][1][i];
                    }
                    u32x4 w; w.x = cvtpk(h0[0], h0[1]); w.y = cvtpk(h0[2], h0[3]); w.z = cvtpk(h1[0], h1[1]); w.w = cvtpk(h1[2], h1[3]);
                    __builtin_amdgcn_raw_buffer_store_b128(w, hrs, ((hrow0 + (unsigned)row) * DFF + u.pn * 128 + wc * 32 + 8 * fq) * 2u, 0,   16);
                }
                __builtin_amdgcn_sched_barrier(0);
            }
        asm volatile("s_waitcnt vmcnt(0)" ::: "memory");
        if (fr == 0 && fq == 0) __hip_atomic_fetch_add(ready + u.rti * 16, 1u, __ATOMIC_RELAXED, __HIP_MEMORY_SCOPE_AGENT);
    }
};
struct EpiMoeDown {
    static constexpr bool PERM = true;
    const int* list; const float* gate; bf16_t* yasg;
    DI void operator()(const f32x4 (&acc)[2][2][4][2], const g8::Unit& u, int wr, int wc, int fr, int fq) const {
        const int* lst = list + (size_t)u.e * T + u.pm * 256;
        int aid[2][4]; float gt[2][4];
#pragma unroll
        for (int ai = 0; ai < 2; ++ai)
#pragma unroll
            for (int m = 0; m < 4; ++m) { const int row = ai * 128 + wr * 64 + m * 16 + fr; aid[ai][m] = lst[min(row, u.valid - 1)]; }
#pragma unroll
        for (int ai = 0; ai < 2; ++ai)
#pragma unroll
            for (int m = 0; m < 4; ++m) gt[ai][m] = gate[aid[ai][m]];
#pragma unroll
        for (int ai = 0; ai < 2; ++ai)
#pragma unroll
            for (int m = 0; m < 4; ++m) {
                const int row = ai * 128 + wr * 64 + m * 16 + fr;
                if (row < u.valid) {
                    bf16_t* dst = yasg + (size_t)aid[ai][m] * D + u.pn * 256 + wc * 32 + 8 * fq;
                    const float g_ = gt[ai][m];
#pragma unroll
                    for (int bj = 0; bj < 2; ++bj) store8_bf16(dst + bj * 128, acc[ai][bj][m][0] * g_, acc[ai][bj][m][1] * g_);
                }
                __builtin_amdgcn_sched_barrier(0);
            }
    }
};
DI void phase_moe(const P& p, int layer, int bid, int nb, char* smem) {
    int* meta = (int*)(smem + META_OFF);
    moe_meta((const int*)(p.ws + WS_CTL + CTL_CNT) + layer * 32 * CNT_STRIDE, meta);
    unsigned* ready = (unsigned*)(p.ws + WS_CTL + CTL_READY) + layer * 160 * 16;
    const int nunits = meta[64] * 4;
    {
        MoeUpSched S;
        S.meta = meta; S.list = (const int*)(p.ws + WS_LIST); S.A = p.ws + WS_X1B; S.Bt = p.ws + WS_WGU + (size_t)layer * NE * 1024 * D * 2;
        S.b_estride = (size_t)1024 * D * 2; S.K = D; S.G = nb; S.c = bid; S.nunits = nunits;
        EpiMoeUp E{__builtin_amdgcn_make_buffer_rsrc((void*)(p.ws + WS_HBUF), (short)0, (int)((size_t)T * 2 * DFF * 2), 0x00020000), ready};
        g8::gemm_phase<true>((LAS unsigned char*)smem, D, S, E);
    }
    {
        MoeDownSched S;
        S.meta = meta; S.list = (const int*)(p.ws + WS_LIST); S.A = p.ws + WS_HBUF; S.Bt = p.ws + WS_WD + (size_t)layer * NE * D * DFF * 2;
        S.b_estride = (size_t)D * DFF * 2; S.K = DFF; S.G = nb; S.c = nb - 1 - bid; S.nunits = nunits;
        S.ready = ready; S.tmo = (unsigned*)(p.ws + WS_CTL + CTL_TMO);
        EpiMoeDown E{(const int*)(p.ws + WS_LIST), (const float*)(p.ws + WS_GATE), (bf16_t*)(p.ws + WS_YASG)};
        g8::gemm_phase<false>((LAS unsigned char*)smem, DFF, S, E);
    }
    { const int most = (nunits + nb - 1) / nb, nlong = nunits - (most - 1) * nb; steal_in_slack(p, layer * 2 + 1, units_of(nunits, nb, bid) == most, nlong, smem); }
}

DI void phase_convmix(const P& p, int layer, int bid, int nb) {
    const int j = layer >> 1;
    const int tid = tid_opaque();
    const bf16_t* projb = (const bf16_t*)(p.ws + WS_PROJ);
    bf16_t* hcat = (bf16_t*)(p.ws + WS_HCAT);
    const float* cw = p.conv_w + (size_t)j * 3 * MIXW;
    const int nitem = T * (MIXW / 8);
    for (int it = bid * NTHREADS + tid; it < nitem; it += nb * NTHREADS) {
        const int t = it / 96, c8 = (it % 96) * 8;
        const int s = t & 2047;
        const bf16_t* row = projb + (size_t)t * DIN_CONV;
        const u32x4 bg = *(const u32x4*)(row + c8);
        float u[3][8];
#pragma unroll
        for (int d = 0; d < 3; ++d) {
            const int back = 2 - d;
            if (s - back >= 0) {
                const bf16_t* rw = row - (size_t)back * DIN_CONV;
                const u32x4 cg = *(const u32x4*)(rw + MIXW + c8);
                const u32x4 xi = *(const u32x4*)(rw + 2 * MIXW + c8);
#pragma unroll
                for (int q = 0; q < 4; ++q) { u[d][2 * q] = bflo(cg[q]) * bflo(xi[q]); u[d][2 * q + 1] = bfhi(cg[q]) * bfhi(xi[q]); }
            } else {
#pragma unroll
                for (int q = 0; q < 8; ++q) u[d][q] = 0.f;
            }
        }
        float o[8];
#pragma unroll
        for (int q = 0; q < 8; ++q) {
            const float c = cw[c8 + q] * u[0][q] + cw[MIXW + c8 + q] * u[1][q] + cw[2 * MIXW + c8 + q] * u[2][q];
            const float b = (q & 1) ? bfhi(bg[q >> 1]) : bflo(bg[q >> 1]);
            o[q] = b * c;
        }
        u32x4 w; w.x = cvtpk(o[0], o[1]); w.y = cvtpk(o[2], o[3]); w.z = cvtpk(o[4], o[5]); w.w = cvtpk(o[6], o[7]);
        *(u32x4*)(hcat + (size_t)t * D + c8) = w;
    }
}

DI void phase_xattn(const P& p, int layer, int bid, int nb, char* smem) {
    const bool conv = (layer & 1) == 0;
    const int ldp = conv ? DIN_CONV : LDP_ML;
    const int qoff = conv ? 3 * MIXW : 3072;
    const bf16_t* projb = (const bf16_t*)(p.ws + WS_PROJ);
    const bf16_t* kbuf = (const bf16_t*)(p.ws + WS_KBUF) + (size_t)layer * 2048 * 256;
    const bf16_t* vT = (const bf16_t*)(p.ws + WS_VT) + (size_t)layer * 8 * 256 * 256;
    bf16_t* hcat = (bf16_t*)(p.ws + WS_HCAT);
    constexpr int LK = 72, LV = 264;
    bf16_t* Ks = (bf16_t*)smem;
    bf16_t* Vs = Ks + 256 * LK;
    for (int task = bid; task < NBATCH * XH * 16; task += nb) {
        const int tid = tid_opaque(), lane = tid & 63, wid = tid >> 6, r = lane & 15, g = lane >> 4;
        const int b = task >> 6, h = (task >> 4) & 3, qt = task & 15;
        __syncthreads();
#pragma unroll
        for (int i = 0; i < 4; ++i) {
            const int key = (tid >> 3) + 64 * i, kc = tid & 7;
            *(u32x4*)&Ks[key * LK + kc * 8] = *(const u32x4*)(kbuf + ((size_t)b * 256 + key) * 256 + h * 64 + kc * 8);
            const int dv = (tid >> 5) + 16 * i, mc = tid & 31;
            *(u32x4*)&Vs[dv * LV + mc * 8] = *(const u32x4*)(vT + (((size_t)b * 4 + h) * 64 + dv) * 256 + mc * 8);
        }
        __syncthreads();
        const int tq = b * SEQ + qt * 128 + wid * 16;
        const bf16_t* qrow = projb + (size_t)(tq + r) * ldp + qoff + h * 64;
        bf16x8 qf[2];
        qf[0] = *(const bf16x8*)(qrow + 8 * g);
        qf[1] = *(const bf16x8*)(qrow + 32 + 8 * g);
        f32x4 sacc[16];
#pragma unroll
        for (int kt = 0; kt < 16; ++kt) {
            f32x4 a = (f32x4){0.f, 0.f, 0.f, 0.f};
#pragma unroll
            for (int ks = 0; ks < 2; ++ks) {
                const bf16x8 kf = *(const bf16x8*)&Ks[(kt * 16 + r) * LK + ks * 32 + 8 * g];
                a = mfma16(kf, qf[ks], a);
            }
            sacc[kt] = a;
            if (kt & 1) __builtin_amdgcn_sched_barrier(0);
        }
        float mx = -3.0e38f;
#pragma unroll
        for (int kt = 0; kt < 16; ++kt)
#pragma unroll
            for (int i = 0; i < 4; ++i) { sacc[kt][i] *= 0.125f; mx = fmaxf(mx, sacc[kt][i]); }
        mx = xor_max(mx, 16); mx = xor_max(mx, 32);
        float sum = 0.f;
#pragma unroll
        for (int kt = 0; kt < 16; ++kt)
#pragma unroll
            for (int i = 0; i < 4; ++i) { const float e = __expf(sacc[kt][i] - mx); sacc[kt][i] = e; sum += e; }
        sum = xor_add(sum, 16); sum = xor_add(sum, 32);
        const float inv = 1.0f / sum;
        f32x4 oacc[4];
#pragma unroll
        for (int dt = 0; dt < 4; ++dt) oacc[dt] = (f32x4){0.f, 0.f, 0.f, 0.f};
#pragma unroll
        for (int s2 = 0; s2 < 8; ++s2) {
            u32x4 pw;
            pw.x = cvtpk(sacc[2 * s2][0], sacc[2 * s2][1]); pw.y = cvtpk(sacc[2 * s2][2], sacc[2 * s2][3]);
            pw.z = cvtpk(sacc[2 * s2 + 1][0], sacc[2 * s2 + 1][1]); pw.w = cvtpk(sacc[2 * s2 + 1][2], sacc[2 * s2 + 1][3]);
            const bf16x8 pf = __builtin_bit_cast(bf16x8, pw);
#pragma unroll
            for (int dt = 0; dt < 4; ++dt) {
                const bf16_t* vp = &Vs[(dt * 16 + r) * LV + s2 * 32 + 4 * g];
                const u32x2 v0 = *(const u32x2*)vp;
                const u32x2 v1 = *(const u32x2*)(vp + 16);
                u32x4 vw; vw.x = v0.x; vw.y = v0.y; vw.z = v1.x; vw.w = v1.y;
                oacc[dt] = mfma16(__builtin_bit_cast(bf16x8, vw), pf, oacc[dt]);
            }
            __builtin_amdgcn_sched_barrier(0);
        }
        bf16_t* orow = hcat + (size_t)(tq + r) * D + MIXW + h * 64;
#pragma unroll
        for (int dt = 0; dt < 4; ++dt) {
            u32x2 w; w.x = cvtpk(oacc[dt][0] * inv, oacc[dt][1] * inv); w.y = cvtpk(oacc[dt][2] * inv, oacc[dt][3] * inv);
            *(u32x2*)(orow + dt * 16 + 4 * g) = w;
        }
    }
}

DI void phase_ml_local(const P& p, int layer, int bid, int nb, char* smem) {
    const float* gate_b = p.ml_gate_b + (layer >> 1) * 12;
    const bf16_t* projb = (const bf16_t*)(p.ws + WS_PROJ);
    const float* graw = (const float*)(p.ws + WS_LOGI);
    float* CT = (float*)(p.ws + WS_CT);
    float* nloc = (float*)(p.ws + WS_NLOC);
    float* mloc = (float*)(p.ws + WS_MLOC);
    float* gsum = (float*)(p.ws + WS_GSUM);
    constexpr int LS = 136;
    bf16_t* kwT = (bf16_t*)smem;
    bf16_t* vTs = kwT + 128 * LS;
    float* fb = (float*)(vTs + 128 * LS);
    float* fw = fb + 128;
    float* fr = fw + 128;
    for (int task = bid; task < 48 * NCH; task += nb) {
        const int tid = tid_opaque(), lane = tid & 63, wid = tid >> 6, r = lane & 15, g = lane >> 4;
        const int bh = task >> 4, c = task & 15, b = bh / 6, h = bh % 6;
        const int t0 = b * SEQ + c * CHUNK;
        const float gbi = gate_b[h], gbf = gate_b[6 + h];
        __syncthreads();
        if (wid == 0) {
            const float* gp = graw + (size_t)(t0 + 2 * lane) * 16 + h;
            const float i0 = gp[0] + gbi, i1 = gp[16] + gbi;
            const float f0 = logsigmoidf_(gp[6] + gbf), f1 = logsigmoidf_(gp[22] + gbf);
            float ps = f0 + f1;
#pragma unroll
            for (int off = 1; off < 64; off <<= 1) { const float y = __shfl_up(ps, off, 64); if (lane >= off) ps += y; }
            const float gtot = __shfl(ps, 63, 64);
            const float b0 = ps - f1, b1 = ps;
            const float a0 = gtot - b0 + i0, a1 = gtot - b1 + i1;
            float mx = fmaxf(a0, a1);
            mx = xor_max(mx, 32); mx = xor_max(mx, 16); mx = xor_max(mx, 8); mx = xor_max(mx, 4); mx = xor_max(mx, 2); mx = xor_max(mx, 1);
            fw[2 * lane] = __expf(a0 - mx); fw[2 * lane + 1] = __expf(a1 - mx);
            if (lane == 0) { fr[0] = mx; fr[1] = gtot; }
        }
        __syncthreads();
        const float ml = fr[0], gtot = fr[1];
        {
            const int s = tid & 127, quarter = tid >> 7;
            const float w = fw[s];
            const bf16_t* krow = projb + (size_t)(t0 + s) * LDP_ML + MIXW + h * 128;
            const bf16_t* vrow = projb + (size_t)(t0 + s) * LDP_ML + 2 * MIXW + h * 128;
#pragma unroll
            for (int i = 0; i < 4; ++i) {
                const int dc = quarter * 4 + i;
                const u32x4 kk = *(const u32x4*)(krow + dc * 8);
                const u32x4 vv = *(const u32x4*)(vrow + dc * 8);
#pragma unroll
                for (int q = 0; q < 4; ++q) {
                    kwT[(dc * 8 + 2 * q) * LS + s] = f2bf(bflo(kk[q]) * w);
                    kwT[(dc * 8 + 2 * q + 1) * LS + s] = f2bf(bfhi(kk[q]) * w);
                    vTs[(dc * 8 + 2 * q) * LS + s] = (bf16_t)(vv[q] & 0xffffu);
                    vTs[(dc * 8 + 2 * q + 1) * LS + s] = (bf16_t)(vv[q] >> 16);
                }
            }
        }
        __syncthreads();
        float* ct = CT + (size_t)task * 128 * 128;
        {
            f32x4 acc[8];
#pragma unroll
            for (int dt = 0; dt < 8; ++dt) acc[dt] = (f32x4){0.f, 0.f, 0.f, 0.f};
#pragma unroll
            for (int ks = 0; ks < 4; ++ks) {
                const bf16x8 vf = *(const bf16x8*)&vTs[(wid * 16 + r) * LS + ks * 32 + 8 * g];
#pragma unroll
                for (int dt = 0; dt < 8; ++dt) {
                    const bf16x8 kf = *(const bf16x8*)&kwT[(dt * 16 + r) * LS + ks * 32 + 8 * g];
                    acc[dt] = mfma16(vf, kf, acc[dt]);
                }
                __builtin_amdgcn_sched_barrier(0);
            }
#pragma unroll
            for (int dt = 0; dt < 8; ++dt)
#pragma unroll
                for (int i = 0; i < 4; ++i) ct[(wid * 16 + 4 * g + i) * 128 + dt * 16 + r] = acc[dt][i];
        }
        {
            const bf16x8 ones = (bf16x8){0x3F80, 0x3F80, 0x3F80, 0x3F80, 0x3F80, 0x3F80, 0x3F80, 0x3F80};
            f32x4 an = (f32x4){0.f, 0.f, 0.f, 0.f};
#pragma unroll
            for (int ks = 0; ks < 4; ++ks) {
                const bf16x8 kf = *(const bf16x8*)&kwT[(wid * 16 + r) * LS + ks * 32 + 8 * g];
                an = mfma16(ones, kf, an);
            }
            if (g == 0) nloc[(size_t)task * 128 + wid * 16 + r] = an[0];
        }
        if (tid == 0) { mloc[task] = ml; gsum[task] = gtot; }
    }
}

DI void phase_ml_scan(const P& p, int bid, int nb) {
    const float* CT = (const float*)(p.ws + WS_CT);
    bf16_t* CPB = (bf16_t*)(p.ws + WS_CPB);
    const float* nloc = (const float*)(p.ws + WS_NLOC);
    float* nprev = (float*)(p.ws + WS_NPREV);
    const float* mloc = (const float*)(p.ws + WS_MLOC);
    const float* gsum = (const float*)(p.ws + WS_GSUM);
    float* mprev = (float*)(p.ws + WS_MPREV);
    const int tid = tid_opaque();
    for (int task = bid; task < 48 * 8; task += nb) {
        const int bh = task >> 3, sl = task & 7;
        const int idx = sl * 2048 + tid * 4;
        float m = 0.f;
        f32x4 st = (f32x4){0.f, 0.f, 0.f, 0.f};
        float nst = 0.f;
        const bool don = (sl == 0 && tid < 128);
        f32x4 loc = *(const f32x4*)(CT + (size_t)(bh * NCH) * 16384 + idx);
        for (int c = 0; c < NCH; ++c) {
            const int ch = bh * NCH + c;
            const float gg = gsum[ch], ml = mloc[ch];
            const float mnew = fmaxf(gg + m, ml);
            const float decay = __expf(gg + m - mnew), sc = __expf(ml - mnew);
            const f32x4 cur = loc;
            if (c + 1 < NCH) loc = *(const f32x4*)(CT + (size_t)(ch + 1) * 16384 + idx);
            u32x2 w; w.x = cvtpk(st[0], st[1]); w.y = cvtpk(st[2], st[3]);
            *(u32x2*)(CPB + (size_t)ch * 16384 + idx) = w;
            st = st * decay + cur * sc;
            if (don) {
                const float nl = nloc[(size_t)ch * 128 + tid];
                nprev[(size_t)ch * 128 + tid] = nst;
                nst = nst * decay + nl * sc;
            }
            if (sl == 0 && tid == 0) mprev[ch] = m;
            m = mnew;
        }
    }
}

DI void phase_ml_out(const P& p, int layer, int bid, int nb, char* smem) {
    const int j = layer >> 1;
    const float* gate_b = p.ml_gate_b + j * 12;
    const bf16_t* projb = (const bf16_t*)(p.ws + WS_PROJ);
    const float* graw = (const float*)(p.ws + WS_LOGI);
    const bf16_t* CPB = (const bf16_t*)(p.ws + WS_CPB);
    const float* nprev = (const float*)(p.ws + WS_NPREV);
    const float* mprev = (const float*)(p.ws + WS_MPREV);
    bf16_t* hcat = (bf16_t*)(p.ws + WS_HCAT);
    const float* ng_ = p.ml_norm_g + (size_t)j * MIXW;
    constexpr int LS = 136;
    bf16_t* kS = (bf16_t*)smem;
    bf16_t* vTs = kS + 128 * LS;
    float* fb = (float*)(vTs + 128 * LS);
    float* fB = fb + 128;
    float* fA = fB + 128;
    float* fW = fA + 128;
    float* fE = fW + 128;
    float* fN = fE + 128;
    for (int task = bid; task < 48 * NCH; task += nb) {
        const int tid = tid_opaque();
        const int lane = tid & 63, wid = __builtin_amdgcn_readfirstlane(tid >> 6), r = lane & 15, g = lane >> 4;
        const int bh = task >> 4, c = task & 15, b = bh / 6, h = bh % 6;
        const int t0 = b * SEQ + c * CHUNK;
        const float gbi = gate_b[h], gbf = gate_b[6 + h];
        __syncthreads();
        if (wid == 0) {
            const float* gp = graw + (size_t)(t0 + 2 * lane) * 16 + h;
            const float i0 = gp[0] + gbi, i1 = gp[16] + gbi;
            const float f0 = logsigmoidf_(gp[6] + gbf), f1 = logsigmoidf_(gp[22] + gbf);
            const float mp = mprev[task];
            float ps = f0 + f1;
#pragma unroll
            for (int off = 1; off < 64; off <<= 1) { const float y = __shfl_up(ps, off, 64); if (lane >= off) ps += y; }
            const float b0 = ps - f1, b1 = ps;
            const float B0 = i0 - b0, B1 = i1 - b1;
            float pm = fmaxf(B0, B1);
#pragma unroll
            for (int off = 1; off < 64; off <<= 1) { const float y = __shfl_up(pm, off, 64); if (lane >= off) pm = fmaxf(pm, y); }
            float pmx = __shfl_up(pm, 1, 64);
            if (lane == 0) pmx = -3.0e38f;
            const float pm0 = fmaxf(pmx, B0), pm1 = pm;
            const float in0 = b0 + mp, in1 = b1 + mp;
            const float m0 = fmaxf(b0 + pm0, in0), m1 = fmaxf(b1 + pm1, in1);
            fB[2 * lane] = B0; fB[2 * lane + 1] = B1;
            fA[2 * lane] = b0 - m0; fA[2 * lane + 1] = b1 - m1;
            fW[2 * lane] = __expf(in0 - m0); fW[2 * lane + 1] = __expf(in1 - m1);
            fE[2 * lane] = __expf(-m0); fE[2 * lane + 1] = __expf(-m1);
        } else if (wid == 1) {
            fN[2 * lane] = nprev[(size_t)task * 128 + 2 * lane]; fN[2 * lane + 1] = nprev[(size_t)task * 128 + 2 * lane + 1];
        }
        {
#pragma unroll
            for (int i = 0; i < 4; ++i) {
                const int s = (tid >> 4) + 32 * i, dc = tid & 15;
                *(u32x4*)&kS[s * LS + dc * 8] = *(const u32x4*)(projb + (size_t)(t0 + s) * LDP_ML + MIXW + h * 128 + dc * 8);
            }
            const int s = tid & 127, quarter = tid >> 7;
            const bf16_t* vrow = projb + (size_t)(t0 + s) * LDP_ML + 2 * MIXW + h * 128;
#pragma unroll
            for (int i = 0; i < 4; ++i) {
                const int dc = quarter * 4 + i;
                const u32x4 vv = *(const u32x4*)(vrow + dc * 8);
#pragma unroll
                for (int q = 0; q < 4; ++q) {
                    vTs[(dc * 8 + 2 * q) * LS + s] = (bf16_t)(vv[q] & 0xffffu);
                    vTs[(dc * 8 + 2 * q + 1) * LS + s] = (bf16_t)(vv[q] >> 16);
                }
            }
        }
        __syncthreads();
        const bf16_t* cp = CPB + (size_t)task * 16384;
        {
            const int l = wid * 16 + r;
            bf16x8 qf[4];
            float qn;
            {
                const bf16_t* qrow = projb + (size_t)(t0 + l) * LDP_ML + h * 128;
                float part = 0.f;
#pragma unroll
                for (int ks = 0; ks < 4; ++ks) {
                    const u32x4 qq = *(const u32x4*)(qrow + ks * 32 + 8 * g);
                    qf[ks] = __builtin_bit_cast(bf16x8, qq);
#pragma unroll
                    for (int q = 0; q < 4; ++q) part += bflo(qq[q]) * fN[ks * 32 + 8 * g + 2 * q] + bfhi(qq[q]) * fN[ks * 32 + 8 * g + 2 * q + 1];
                }
                part = xor_add(part, 16); part = xor_add(part, 32);
                qn = part;
            }
            __builtin_amdgcn_sched_barrier(0);
            f32x4 nacc[8];
#pragma unroll
            for (int et = 0; et < 8; ++et) {
                f32x4 a = (f32x4){0.f, 0.f, 0.f, 0.f};
#pragma unroll
                for (int ks = 0; ks < 4; ++ks) {
                    const bf16x8 cf = *(const bf16x8*)(cp + (et * 16 + r) * 128 + ks * 32 + 8 * g);
                    a = mfma16(cf, qf[ks], a);
                }
                nacc[et] = a;
                if (et & 1) __builtin_amdgcn_sched_barrier(0);
            }
            const float Al = fA[l], wint = fW[l], eml = fE[l];
#pragma unroll
            for (int et = 0; et < 8; ++et) nacc[et] *= wint;
            const int stmax = wid;
            float den = 0.f;
#pragma unroll
            for (int s2 = 0; s2 < 4; ++s2) {
                if (2 * s2 <= stmax) {
                    f32x4 sa = (f32x4){0.f, 0.f, 0.f, 0.f}, sb = (f32x4){0.f, 0.f, 0.f, 0.f};
#pragma unroll
                    for (int ks = 0; ks < 4; ++ks) {
                        const bf16x8 kf = *(const bf16x8*)&kS[(s2 * 32 + r) * LS + ks * 32 + 8 * g];
                        sa = mfma16(kf, qf[ks], sa);
                    }
                    if (2 * s2 + 1 <= stmax) {
#pragma unroll
                        for (int ks = 0; ks < 4; ++ks) {
                            const bf16x8 kf = *(const bf16x8*)&kS[(s2 * 32 + 16 + r) * LS + ks * 32 + 8 * g];
                            sb = mfma16(kf, qf[ks], sb);
                        }
                    }
#pragma unroll
                    for (int i = 0; i < 4; ++i) {
                        const int s = s2 * 32 + 4 * g + i;
                        const float va = (s <= l) ? sa[i] * __expf(Al + fB[s]) : 0.f;
                        const float vb = (s + 16 <= l) ? sb[i] * __expf(Al + fB[s + 16]) : 0.f;
                        sa[i] = va; sb[i] = vb; den += va + vb;
                    }
                    u32x4 pw;
                    pw.x = cvtpk(sa[0], sa[1]); pw.y = cvtpk(sa[2], sa[3]);
                    pw.z = cvtpk(sb[0], sb[1]); pw.w = cvtpk(sb[2], sb[3]);
                    const bf16x8 pf = __builtin_bit_cast(bf16x8, pw);
#pragma unroll
                    for (int et = 0; et < 8; ++et) {
                        const bf16_t* vp = &vTs[(et * 16 + r) * LS + s2 * 32 + 4 * g];
                        const u32x2 v0 = *(const u32x2*)vp;
                        const u32x2 v1 = *(const u32x2*)(vp + 16);
                        u32x4 vw; vw.x = v0.x; vw.y = v0.y; vw.z = v1.x; vw.w = v1.y;
                        nacc[et] = mfma16(__builtin_bit_cast(bf16x8, vw), pf, nacc[et]);
                    }
                }
                __builtin_amdgcn_sched_barrier(0);
            }
            den = xor_add(den, 16); den = xor_add(den, 32);
            const float dd = fmaxf(fabsf(den + wint * qn), eml);
            const float invd = 1.0f / dd;
            float sm = 0.f;
#pragma unroll
            for (int et = 0; et < 8; ++et)
#pragma unroll
                for (int i = 0; i < 4; ++i) { nacc[et][i] *= invd; sm += nacc[et][i]; }
            sm = xor_add(sm, 16); sm = xor_add(sm, 32);
            const float mu = sm * (1.0f / 128.0f);
            float sq = 0.f;
#pragma unroll
            for (int et = 0; et < 8; ++et)
#pragma unroll
                for (int i = 0; i < 4; ++i) { const float dlt = nacc[et][i] - mu; sq += dlt * dlt; }
            sq = xor_add(sq, 16); sq = xor_add(sq, 32);
            const float rstd = rsqrtf(sq * (1.0f / 128.0f) + LN_EPS);
            const size_t trow = (size_t)(t0 + l);
            const bf16_t* og = projb + trow * LDP_ML + 3 * MIXW + h * 128;
            bf16_t* orow = hcat + trow * D + h * 128;
#pragma unroll
            for (int et = 0; et < 8; ++et) {
                const int e = et * 16 + 4 * g;
                const u32x2 ov = *(const u32x2*)(og + e);
                const f32x4 gv = *(const f32x4*)(ng_ + h * 128 + e);
                const float o0 = (nacc[et][0] - mu) * rstd * gv[0] * sigmoidf_(bflo(ov.x));
                const float o1 = (nacc[et][1] - mu) * rstd * gv[1] * sigmoidf_(bfhi(ov.x));
                const float o2 = (nacc[et][2] - mu) * rstd * gv[2] * sigmoidf_(bflo(ov.y));
                const float o3 = (nacc[et][3] - mu) * rstd * gv[3] * sigmoidf_(bfhi(ov.y));
                u32x2 w; w.x = cvtpk(o0, o1); w.y = cvtpk(o2, o3);
                *(u32x2*)(orow + e) = w;
                if (et & 1) __builtin_amdgcn_sched_barrier(0);
            }
        }
    }
}

constexpr int LN1_MAXT = 8;
DI void phase_ln1_route(const P& p, int layer, int bid, int nb, char* smem) {
    const bf16_t* z = (const bf16_t*)(p.ws + WS_Z);
    bf16_t* x1b = (bf16_t*)(p.ws + WS_X1B);
    float* gate = (float*)(p.ws + WS_GATE);
    int* list = (int*)(p.ws + WS_LIST);
    int* cnt = (int*)(p.ws + WS_CTL + CTL_CNT) + layer * 32 * CNT_STRIDE;
    const bf16_t* rwh = (const bf16_t*)(p.ws + WS_RWT);
    const bf16_t* rwl = rwh + NE * D;
    const float* lg = p.ln1_g + (size_t)layer * D;
    const float* lb = p.ln1_b + (size_t)layer * D;
    constexpr int XS = 1028;
    float* xs = (float*)smem;
    float* red = xs + 16 * XS;
    float* scs = red + 8 * 16 * 32;
    int* lcnt = (int*)(scs + 16 * 32);
    int* gbase = lcnt + 32;
    int* sel = gbase + 32;
    const int tid = tid_opaque(), lane = tid & 63, wid = tid >> 6, r = lane & 15, g = lane >> 4;
    __syncthreads();
    if (tid < 32) lcnt[tid] = 0;
    const float rb_e = p.router_b[tid & 31];
    bf16x8 wh[4][2], wl[4][2];
#pragma unroll
    for (int ks = 0; ks < 4; ++ks)
#pragma unroll
        for (int nt = 0; nt < 2; ++nt) {
            const size_t o = (size_t)(nt * 16 + r) * D + wid * 128 + ks * 32 + 8 * g;
            wh[ks][nt] = *(const bf16x8*)(rwh + o); wl[ks][nt] = *(const bf16x8*)(rwl + o);
        }
    f32x4 lgv[2][2], lbv[2][2];
#pragma unroll
    for (int i = 0; i < 2; ++i) { const int col = i * 512 + lane * 8; lgv[i][0] = *(const f32x4*)(lg + col); lgv[i][1] = *(const f32x4*)(lg + col + 4); lbv[i][0] = *(const f32x4*)(lb + col); lbv[i][1] = *(const f32x4*)(lb + col + 4); }
    u32x4 zn[2][2];
    if (bid < T / 16) {
#pragma unroll
        for (int rr = 0; rr < 2; ++rr)
#pragma unroll
            for (int i = 0; i < 2; ++i) zn[rr][i] = *(const u32x4*)(z + (size_t)(bid * 16 + wid * 2 + rr) * D + i * 512 + lane * 8);
    }
    int ti = 0;
    for (int task = bid; task < T / 16; task += nb, ++ti) {
        const int row0 = task * 16;
        u32x4 zc[2][2];
#pragma unroll
        for (int rr = 0; rr < 2; ++rr)
#pragma unroll
            for (int i = 0; i < 2; ++i) zc[rr][i] = zn[rr][i];
        if (task + nb < T / 16) {
#pragma unroll
            for (int rr = 0; rr < 2; ++rr)
#pragma unroll
                for (int i = 0; i < 2; ++i) zn[rr][i] = *(const u32x4*)(z + (size_t)((task + nb) * 16 + wid * 2 + rr) * D + i * 512 + lane * 8);
        }
        __syncthreads();
#pragma unroll
        for (int rr = 0; rr < 2; ++rr) {
            const int lr = wid * 2 + rr;
            const size_t t = (size_t)(row0 + lr);
            float v[2][8];
            float s = 0.f;
#pragma unroll
            for (int i = 0; i < 2; ++i) {
#pragma unroll
                for (int q = 0; q < 4; ++q) { v[i][2 * q] = bflo(zc[rr][i][q]); v[i][2 * q + 1] = bfhi(zc[rr][i][q]); s += v[i][2 * q] + v[i][2 * q + 1]; }
            }
            s = wave_sum(s);
            const float mu = s * (1.0f / D);
            float q2 = 0.f;
#pragma unroll
            for (int i = 0; i < 2; ++i)
#pragma unroll
                for (int k = 0; k < 8; ++k) { const float d = v[i][k] - mu; q2 += d * d; }
            q2 = wave_sum(q2);
            const float rstd = rsqrtf(q2 * (1.0f / D) + LN_EPS);
#pragma unroll
            for (int i = 0; i < 2; ++i) {
                const int col = i * 512 + lane * 8;
                const f32x4 g0 = lgv[i][0], g1 = lgv[i][1], b0 = lbv[i][0], b1 = lbv[i][1];
                f32x4 o0, o1;
#pragma unroll
                for (int k = 0; k < 4; ++k) { o0[k] = (v[i][k] - mu) * rstd * g0[k] + b0[k]; o1[k] = (v[i][4 + k] - mu) * rstd * g1[k] + b1[k]; }
                u32x4 w; w.x = cvtpk(o0[0], o0[1]); w.y = cvtpk(o0[2], o0[3]); w.z = cvtpk(o1[0], o1[1]); w.w = cvtpk(o1[2], o1[3]);
                *(u32x4*)(x1b + t * D + col) = w;
                *(f32x4*)(xs + lr * XS + col) = o0;
                *(f32x4*)(xs + lr * XS + col + 4) = o1;
            }
        }
        __syncthreads();
        {
            f32x4 acc0 = (f32x4){0.f, 0.f, 0.f, 0.f}, acc1 = (f32x4){0.f, 0.f, 0.f, 0.f};
#pragma unroll
            for (int ks = 0; ks < 4; ++ks) {
                const int k = wid * 128 + ks * 32 + 8 * g;
                const f32x4 xa0 = *(const f32x4*)(xs + r * XS + k), xa1 = *(const f32x4*)(xs + r * XS + k + 4);
                u32x4 hw, lw;
                hw.x = cvtpk(xa0[0], xa0[1]); hw.y = cvtpk(xa0[2], xa0[3]); hw.z = cvtpk(xa1[0], xa1[1]); hw.w = cvtpk(xa1[2], xa1[3]);
                lw.x = cvtpk(xa0[0] - bflo(hw.x), xa0[1] - bfhi(hw.x)); lw.y = cvtpk(xa0[2] - bflo(hw.y), xa0[3] - bfhi(hw.y));
                lw.z = cvtpk(xa1[0] - bflo(hw.z), xa1[1] - bfhi(hw.z)); lw.w = cvtpk(xa1[2] - bflo(hw.w), xa1[3] - bfhi(hw.w));
                const bf16x8 xh = __builtin_bit_cast(bf16x8, hw), xl = __builtin_bit_cast(bf16x8, lw);
                acc0 = mfma16(wh[ks][0], xh, acc0); acc0 = mfma16(wh[ks][0], xl, acc0); acc0 = mfma16(wl[ks][0], xh, acc0);
                acc1 = mfma16(wh[ks][1], xh, acc1); acc1 = mfma16(wh[ks][1], xl, acc1); acc1 = mfma16(wl[ks][1], xh, acc1);
            }
            *(f32x4*)(red + (wid * 16 + r) * 32 + 4 * g) = acc0;
            *(f32x4*)(red + (wid * 16 + r) * 32 + 16 + 4 * g) = acc1;
        }
        __syncthreads();
        {
            const int e = tid & 31, i = tid >> 5;
            float s = 0.f;
#pragma unroll
            for (int w = 0; w < 8; ++w) s += red[(w * 16 + i) * 32 + e];
            const float sc = sigmoidf_(s), sv = sc + rb_e;
            const float a1 = __shfl_xor(sv, 1, 64), a2 = __shfl_xor(sv, 2, 64), a3 = __shfl_xor(sv, 3, 64);
            const float c1 = __shfl_xor(sc, 1, 64), c2 = __shfl_xor(sc, 2, 64), c3 = __shfl_xor(sc, 3, 64);
            const float lo1 = fminf(sv, a1), hi1 = fmaxf(sv, a1), lo2 = fminf(a2, a3), hi2 = fmaxf(a2, a3);
            float bv = fmaxf(hi1, hi2) + fmaxf(fminf(hi1, hi2), fmaxf(lo1, lo2));
            int bg = e >> 2;
#pragma unroll
            for (int m = 4; m <= 16; m <<= 1) {
                const float ov = __shfl_xor(bv, m, 64); const int og = __shfl_xor(bg, m, 64);
                if (ov > bv || (ov == bv && og < bg)) { bv = ov; bg = og; }
            }
            if (e == bg * 4) {
                const float vv[4] = {sv, a1, a2, a3}, cc[4] = {sc, c1, c2, c3};
                int i1 = 0; float v1 = vv[0];
#pragma unroll
                for (int k = 1; k < 4; ++k) if (vv[k] > v1) { v1 = vv[k]; i1 = k; }
                int i2 = -1; float v2 = -3.0e38f, s1 = cc[0], s2 = 0.f;
#pragma unroll
                for (int k = 0; k < 4; ++k) { if (k == i1) s1 = cc[k]; }
#pragma unroll
                for (int k = 0; k < 4; ++k) if (k != i1 && vv[k] > v2) { v2 = vv[k]; i2 = k; s2 = cc[k]; }
                const int e1 = bg * 4 + i1, e2 = bg * 4 + i2;
                const float inv = 1.0f / (s1 + s2);
                const int t = row0 + i;
                gate[t * 2] = s1 * inv; gate[t * 2 + 1] = s2 * inv;
                const int lp1 = atomicAdd(&lcnt[e1], 1);
                const int lp2 = atomicAdd(&lcnt[e2], 1);
                if (ti < LN1_MAXT) { sel[(ti * 16 + i) * 2] = e1 | (lp1 << 8); sel[(ti * 16 + i) * 2 + 1] = e2 | (lp2 << 8); }
            }
        }
    }
    __syncthreads();
    const int tz = tid_opaque();
    if (tz < 32) { const int c = lcnt[tz]; gbase[tz] = c ? atomicAdd(&cnt[tz * CNT_STRIDE], c) : 0; }
    __syncthreads();
    if (tz < ti * 32) {
        const int tl = tz >> 5, rw = (tz >> 1) & 15, k = tz & 1;
        const int sv = sel[tz];
        const int e = sv & 255, lp = sv >> 8;
        list[(size_t)e * T + gbase[e] + lp] = ((bid + tl * nb) * 16 + rw) * 2 + k;
    }
}

DI void phase_ln2(const P& p, int layer, int bid, int nb) {
    const bf16_t* x1b = (const bf16_t*)(p.ws + WS_X1B);
    const bf16_t* yasg = (const bf16_t*)(p.ws + WS_YASG);
    bf16_t* xb = (bf16_t*)(p.ws + WS_XB);
    const float* lg = p.ln2_g + (size_t)layer * D;
    const float* lb = p.ln2_b + (size_t)layer * D;
    const int tid = tid_opaque(), lane = tid & 63, wid = tid >> 6;
    f32x4 lgv[2][2], lbv[2][2];
#pragma unroll
    for (int i = 0; i < 2; ++i) { const int col = i * 512 + lane * 8; lgv[i][0] = *(const f32x4*)(lg + col); lgv[i][1] = *(const f32x4*)(lg + col + 4); lbv[i][0] = *(const f32x4*)(lb + col); lbv[i][1] = *(const f32x4*)(lb + col + 4); }
    for (int t = bid * NWAVES + wid; t < T; t += nb * NWAVES) {
        float v[2][8];
        float s = 0.f;
#pragma unroll
        for (int i = 0; i < 2; ++i) {
            const int col = i * 512 + lane * 8;
            const u32x4 xv = *(const u32x4*)(x1b + (size_t)t * D + col);
            const u32x4 y0 = *(const u32x4*)(yasg + (size_t)(2 * t) * D + col);
            const u32x4 y1 = *(const u32x4*)(yasg + (size_t)(2 * t + 1) * D + col);
#pragma unroll
            for (int q = 0; q < 4; ++q) {
                v[i][2 * q] = bflo(xv[q]) * ALPHA + (bflo(y0[q]) + bflo(y1[q]));
                v[i][2 * q + 1] = bfhi(xv[q]) * ALPHA + (bfhi(y0[q]) + bfhi(y1[q]));
                s += v[i][2 * q] + v[i][2 * q + 1];
            }
        }
        s = wave_sum(s);
        const float mu = s * (1.0f / D);
        float q2 = 0.f;
#pragma unroll
        for (int i = 0; i < 2; ++i)
#pragma unroll
            for (int k = 0; k < 8; ++k) { const float d = v[i][k] - mu; q2 += d * d; }
        q2 = wave_sum(q2);
        const float rstd = rsqrtf(q2 * (1.0f / D) + LN_EPS);
#pragma unroll
        for (int i = 0; i < 2; ++i) {
            const int col = i * 512 + lane * 8;
            const f32x4 g0 = lgv[i][0], g1 = lgv[i][1], b0 = lbv[i][0], b1 = lbv[i][1];
            f32x4 o0, o1;
#pragma unroll
            for (int k = 0; k < 4; ++k) { o0[k] = (v[i][k] - mu) * rstd * g0[k] + b0[k]; o1[k] = (v[i][4 + k] - mu) * rstd * g1[k] + b1[k]; }
            if (layer == DEPTH - 1) {
                *(f32x4*)(p.out + (size_t)t * D + col) = o0;
                *(f32x4*)(p.out + (size_t)t * D + col + 4) = o1;
            } else {
                u32x4 w; w.x = cvtpk(o0[0], o0[1]); w.y = cvtpk(o0[2], o0[3]); w.z = cvtpk(o1[0], o1[1]); w.w = cvtpk(o1[2], o1[3]);
                *(u32x4*)(xb + (size_t)t * D + col) = w;
            }
        }
    }
}

#define XB_TMO      128
#define XB_XCNT(j)  (256  + 64 * (j))
#define XB_XSUB(j)  (1280 + 64 * (j))
#define XB_XGEN(j)  (2304 + 64 * (j))
#define XB_TOP      3328
#define XB_TOPGEN   3392
#define XCD_BAR_WORDS 3456
#define XB_SPIN_CAP (1u << 20)
DI unsigned xb_ld(unsigned* p_) { return __hip_atomic_load(p_, __ATOMIC_RELAXED, __HIP_MEMORY_SCOPE_AGENT); }
DI unsigned xb_add(unsigned* p_, unsigned v) { return __hip_atomic_fetch_add(p_, v, __ATOMIC_RELAXED, __HIP_MEMORY_SCOPE_AGENT); }
DI unsigned xb_xcc_id() { return (unsigned)__builtin_amdgcn_s_getreg((3 << 11) | 20) & 0xFu; }
#define XB_SPIN(cond, bar) do { unsigned _sp = 0; while (cond) { __builtin_amdgcn_s_sleep(1); \
    if ((++_sp & 255u) == 0u) { if (xb_ld(&(bar)[XB_TMO])) break; if (_sp > XB_SPIN_CAP) { atomicAdd(&(bar)[XB_TMO], 1u); break; } } } } while (0)
struct XcdBarrier { unsigned* bar; unsigned x; volatile LAS unsigned* st; };
DI XcdBarrier xcd_barrier_post(unsigned* bar, volatile LAS unsigned* st) {
    XcdBarrier b; b.bar = bar; b.x = xb_xcc_id(); b.st = st;
    if (threadIdx.x == 0) (void)xb_add(&bar[XB_XCNT(b.x)], 1u);
    return b;
}
DI void xcd_barrier_complete(unsigned* bar, unsigned x, unsigned& nloc, unsigned& nx) {
    const unsigned G = gridDim.x * gridDim.y * gridDim.z;
    unsigned sum, cnt, mine, sp = 0u;
    for (;;) {
        sum = 0u; cnt = 0u; mine = 0u;
#pragma unroll
        for (unsigned j = 0; j < 16; ++j) { const unsigned c = xb_ld(&bar[XB_XCNT(j)]); sum += c; cnt += (c > 0u) ? 1u : 0u; mine = (j == x) ? c : mine; }
        if (sum == G) break;
        __builtin_amdgcn_s_sleep(1);
        if ((++sp & 255u) == 0u) { if (xb_ld(&bar[XB_TMO])) break; if (sp > XB_SPIN_CAP) { atomicAdd(&bar[XB_TMO], 1u); break; } }
    }
    nloc = mine > 0u ? mine : 1u; nx = cnt > 0u ? cnt : 1u;
}
DI void xcd_barrier(const XcdBarrier& b) {
    asm volatile("s_waitcnt vmcnt(0)" ::: "memory");
    __syncthreads();
    if (tid_opaque() == 0) {
        unsigned* bar = b.bar;
        __builtin_amdgcn_s_waitcnt(0);
        unsigned nloc = b.st[0], nx = b.st[1];
        if (nloc == 0u) { xcd_barrier_complete(bar, b.x, nloc, nx); b.st[0] = nloc; b.st[1] = nx; }
        const unsigned old = xb_add(&bar[XB_XSUB(b.x)], 1u);
        const unsigned gen = old / nloc;
        if (old + 1u == (gen + 1u) * nloc) {
            __builtin_amdgcn_fence(__ATOMIC_RELEASE, "agent");
            asm volatile("s_waitcnt vmcnt(0)" ::: "memory");
            const unsigned og = xb_add(&bar[XB_TOP], 1u);
            const unsigned tg = og / nx;
            if (og + 1u == (tg + 1u) * nx) xb_add(&bar[XB_TOPGEN], 1u);
            else XB_SPIN(xb_ld(&bar[XB_TOPGEN]) == tg, bar);
            __builtin_amdgcn_fence(__ATOMIC_ACQUIRE, "agent");
            xb_add(&bar[XB_XGEN(b.x)], 1u);
            asm volatile("s_waitcnt vmcnt(0)" ::: "memory");
        } else {
            XB_SPIN(xb_ld(&bar[XB_XGEN(b.x)]) == gen, bar);
            __builtin_amdgcn_fence(__ATOMIC_ACQUIRE, "agent");
            asm volatile("s_waitcnt vmcnt(0)" ::: "memory");
        }
    }
    __syncthreads();
}

enum { PH_INPROJ = 0, PH_MIX1, PH_MIX2, PH_MIX3, PH_OUTPROJ, PH_LN1, PH_MOE, PH_LN2, PH_PER_LAYER, PH_PREP = 100, PH_KV = 101 };

DI void run_phase(const P& p, int ph, int layer, int bid, int nb, char* smem) {
    const bool conv = (layer & 1) == 0;
    if (ph == PH_PREP) phase_prep(p, bid, nb, smem);
    if (ph == PH_KV) phase_kv(p, bid, nb, smem);
    if (ph == PH_INPROJ) phase_inproj(p, layer, bid, nb, smem);
    if (ph == PH_MIX1) phase_ml_local(p, layer, bid, nb, smem);
    if (ph == PH_MIX2) phase_ml_scan(p, bid, nb);
    if (ph == PH_MIX3) {
        if (conv) phase_convmix(p, layer, bid, nb);
        else phase_ml_out(p, layer, bid, nb, smem);
    }
    if (ph == PH_MIX1 || (ph == PH_MIX3 && conv)) phase_xattn(p, layer, bid, nb, smem);
    if (ph == PH_OUTPROJ) phase_outproj(p, layer, bid, nb, smem);
    if (ph == PH_LN1) { phase_ln1_route(p, layer, bid, nb, smem); if (layer > 0) moe_steal(p, 1 << 20, (layer + 1) * MOE_TILES_PER_LAYER, nullptr, 0u, smem); }
    if (ph == PH_MOE) phase_moe(p, layer, bid, nb, smem);
    if (ph == PH_LN2) phase_ln2(p, layer, bid, nb);
}

__global__ void __launch_bounds__(NTHREADS, 2) mega(P p) {
    __shared__ __attribute__((aligned(16))) char smem[SMEM_BYTES];
    const int bid = blockIdx.x, nb = gridDim.x;
    volatile LAS unsigned* st = (volatile LAS unsigned*)(smem + SMEM_BYTES - 16);
    if (threadIdx.x == 0) { st[0] = 0u; st[1] = 0u; }
    __syncthreads();
    XcdBarrier xb = xcd_barrier_post((unsigned*)(p.ws + WS_CTL), st);
#pragma unroll 1
    for (int s = -2; s < DEPTH * PH_PER_LAYER; ++s) {
        int ph = (s == -2) ? (int)PH_PREP : (s == -1) ? (int)PH_KV : s % PH_PER_LAYER;
        int layer = (s < 0) ? 0 : s / PH_PER_LAYER;
        if ((layer & 1) == 0 && (ph == PH_MIX1 || ph == PH_MIX2)) continue;
        int b_ = bid, n_ = nb;
        asm volatile("" : "+s"(ph), "+s"(layer), "+s"(b_), "+s"(n_));
        P q = p;
        asm volatile("" : "+s"(q.ws));
        run_phase(q, ph, layer, b_, n_, smem);
#ifdef PROBE_MASK
        if (ph < 31 && ((PROBE_MASK >> ph) & 1)) { __syncthreads(); run_phase(q, ph, layer, b_, n_, smem); }
#endif
        if (ph != PH_KV) xcd_barrier(xb);
    }
}

extern "C" void kernel_launch(void* const* d_in, const int* in_sizes, int n_in, void* d_out, int out_size, void* d_ws, size_t ws_size,
                              hipStream_t stream) {
    if (ws_size < WS_TOTAL) { fprintf(stderr, "kernel_launch: workspace too small: %zu < %zu\n", ws_size, (size_t)WS_TOTAL); return; }
    static int grid_blocks = 0;
    if (!grid_blocks) {
        int dev = 0, cus = 0, per_cu = 0;
        (void)hipGetDevice(&dev);
        (void)hipDeviceGetAttribute(&cus, hipDeviceAttributeMultiprocessorCount, dev);
        if (hipOccupancyMaxActiveBlocksPerMultiprocessor(&per_cu, (const void*)mega, NTHREADS, 0) != hipSuccess) per_cu = 0;
        if (per_cu < 1 || cus < 1) { fprintf(stderr, "kernel_launch: occupancy query failed (per_cu=%d cus=%d)\n", per_cu, cus); return; }
        grid_blocks = cus;
    }
    P p{};
    p.x = (const float*)d_in[0]; p.mem = (const float*)d_in[1]; p.conv_w_in = (const float*)d_in[2]; p.conv_w = (const float*)d_in[3];
    p.ml_w_in = (const float*)d_in[4]; p.ml_gate_b = (const float*)d_in[5]; p.ml_norm_g = (const float*)d_in[6]; p.w_kv = (const float*)d_in[7];
    p.w_out = (const float*)d_in[8]; p.ln1_g = (const float*)d_in[9]; p.ln1_b = (const float*)d_in[10]; p.ln2_g = (const float*)d_in[11];
    p.ln2_b = (const float*)d_in[12]; p.router_w = (const float*)d_in[13]; p.router_b = (const float*)d_in[14]; p.w_gate = (const float*)d_in[15];
    p.w_up = (const float*)d_in[16]; p.w_down = (const float*)d_in[17];
    p.out = (float*)d_out; p.ws = (char*)d_ws;
    (void)hipMemsetAsync((char*)d_ws + WS_CTL, 0, CTL_BYTES, stream);
    void* args[] = {&p};
    hipError_t e = hipLaunchCooperativeKernel((const void*)mega, dim3(grid_blocks), dim3(NTHREADS), args, 0, stream);
    if (e != hipSuccess) fprintf(stderr, "kernel_launch: cooperative launch failed: %s (grid %d)\n", hipGetErrorString(e), grid_blocks);
}
```

```cpp
#include <hip/hip_runtime.h>
#include <stdint.h>
#include <stdio.h>

typedef unsigned short bf16_t;
typedef __attribute__((ext_vector_type(8))) short bf16x8;
typedef __attribute__((ext_vector_type(4))) float f32x4;
typedef __attribute__((ext_vector_type(4))) unsigned u32x4;
typedef __attribute__((ext_vector_type(2))) unsigned u32x2;

#define DI __device__ __forceinline__
#define LAS __attribute__((address_space(3)))

constexpr int D = 1024;
constexpr int NBATCH = 8;
constexpr int SEQ = 2048;
constexpr int T = NBATCH * SEQ;
constexpr int DEPTH = 4;
constexpr int MIXW = 768;
constexpr int XH = 4, XDH = 64, XW = 256, MEML = 256;
constexpr int MLH = 6, MLDH = 128, CHUNK = 128, NCH = SEQ / CHUNK;
constexpr int DIN_CONV = 2560, DIN_ML = 3340, LDP_ML = 3328, NV_ML = 3584;
constexpr int NE = 32, DFF = 512;
constexpr float ALPHA = 1.681792830507429f;
constexpr float LN_EPS = 1e-5f;

constexpr int NTHREADS = 512;
constexpr int NWAVES = 8;
constexpr int STAGE_BYTES = 131072;
constexpr int META_OFF = STAGE_BYTES;
constexpr int SMEM_BYTES = STAGE_BYTES + 4096;

constexpr size_t al256(size_t x) { return (x + 255) & ~(size_t)255; }
constexpr size_t WS_CTL   = 0;
constexpr size_t CTL_BYTES = 128 * 1024;
constexpr size_t CTL_CNT  = 32 * 1024;
constexpr int CNT_STRIDE = 64;
constexpr size_t CTL_READY = 64 * 1024;
constexpr size_t CTL_STOP = 14 * 1024;
constexpr size_t CTL_TMO  = 15 * 1024;
constexpr size_t CTL_TQ   = 16 * 1024;
constexpr size_t WS_XB    = WS_CTL + CTL_BYTES;
constexpr size_t WS_MEMB  = WS_XB + (size_t)T * D * 2;
constexpr size_t WS_KBUF  = WS_MEMB + (size_t)NBATCH * MEML * D * 2;
constexpr size_t WS_VT    = WS_KBUF + (size_t)DEPTH * NBATCH * MEML * XW * 2;
constexpr size_t WS_PROJ  = WS_VT + (size_t)DEPTH * NBATCH * MEML * XW * 2;
constexpr size_t WS_Z     = WS_PROJ;
constexpr size_t WS_LOGI  = WS_PROJ + (size_t)T * LDP_ML * 2;
constexpr size_t WS_CT    = WS_LOGI + (size_t)T * 16 * 4;
constexpr size_t WS_CPB   = WS_CT + (size_t)48 * NCH * 128 * 128 * 4;
constexpr size_t WS_NLOC  = WS_CPB + (size_t)48 * NCH * 128 * 128 * 2;
constexpr size_t WS_NPREV = WS_NLOC + (size_t)48 * NCH * 128 * 4;
constexpr size_t WS_MLOC  = WS_NPREV + (size_t)48 * NCH * 128 * 4;
constexpr size_t WS_GSUM  = WS_MLOC + al256(48 * NCH * 4);
constexpr size_t WS_MPREV = WS_GSUM + al256(48 * NCH * 4);
constexpr size_t WS_HCAT  = WS_MPREV + al256(48 * NCH * 4);
constexpr size_t WS_X1B   = WS_HCAT + (size_t)T * D * 2;
constexpr size_t WS_GATE  = WS_X1B + (size_t)T * D * 2;
constexpr size_t WS_LIST  = WS_GATE + (size_t)T * 2 * 4;
constexpr size_t WS_HBUF  = WS_LIST + (size_t)NE * T * 4;
constexpr size_t WS_YASG  = WS_HBUF + (size_t)T * 2 * DFF * 2;
constexpr size_t WS_WIN   = WS_YASG + (size_t)T * 2 * D * 2;
constexpr size_t WS_WKV   = WS_WIN + ((size_t)2 * DIN_CONV + (size_t)2 * NV_ML) * D * 2;
constexpr size_t WS_WOUT  = WS_WKV + (size_t)DEPTH * 512 * D * 2;
constexpr size_t WS_WGU   = WS_WOUT + (size_t)DEPTH * D * D * 2;
constexpr size_t WS_WD    = WS_WGU + (size_t)DEPTH * NE * 1024 * D * 2;
constexpr size_t WS_RWT   = WS_WD + (size_t)DEPTH * NE * D * DFF * 2;
constexpr size_t WS_TOTAL = WS_RWT + (size_t)2 * NE * D * 2;

struct P {
    const float *x, *mem, *conv_w_in, *conv_w, *ml_w_in, *ml_gate_b, *ml_norm_g, *w_kv, *w_out;
    const float *ln1_g, *ln1_b, *ln2_g, *ln2_b, *router_w, *router_b, *w_gate, *w_up, *w_down;
    float* out;
    char* ws;
};

DI unsigned cvtpk(float lo, float hi) { unsigned r; asm("v_cvt_pk_bf16_f32 %0, %1, %2" : "=v"(r) : "v"(lo), "v"(hi)); return r; }
DI float bf2f(bf16_t v) { return __uint_as_float(((unsigned)v) << 16); }
DI float bflo(unsigned v) { return __uint_as_float(v << 16); }
DI float bfhi(unsigned v) { return __uint_as_float(v & 0xffff0000u); }
DI bf16_t f2bf(float f) { return (bf16_t)(cvtpk(f, f) & 0xffffu); }
DI float sigmoidf_(float x) { return 1.0f / (1.0f + __expf(-x)); }
DI float logsigmoidf_(float x) { return fminf(x, 0.0f) - log1pf(__expf(-fabsf(x))); }
DI float xor_add(float v, int m) { return v + __shfl_xor(v, m, 64); }
DI float xor_max(float v, int m) { return fmaxf(v, __shfl_xor(v, m, 64)); }
DI float wave_sum(float v) { v = xor_add(v, 32); v = xor_add(v, 16); v = xor_add(v, 8); v = xor_add(v, 4); v = xor_add(v, 2); v = xor_add(v, 1); return v; }
DI int tid_opaque() { int t = threadIdx.x; asm volatile("" : "+v"(t)); return t; }
DI f32x4 mfma16(bf16x8 a, bf16x8 b, f32x4 c) { return __builtin_amdgcn_mfma_f32_16x16x32_bf16(a, b, c, 0, 0, 0); }

namespace g8 {
constexpr int BM = 256, BK = 64, HALF = 128, HTB = HALF * BK * 2, NXCD = 8, WGM = 8;
DI int lds_byte(int r, int c) { const int st = (r >> 4) * 2 + (c >> 5), rr = r & 15, cc = c & 31, ob = rr * 64 + cc * 2; return st * 1024 + (ob ^ (((ob >> 9) & 1) << 5)); }
DI void stage_rc(int b, int& R, int& C) { const int st = b / 1024, sb = b % 1024, swz = sb ^ (((sb >> 9) & 1) << 5); R = (st >> 1) * 16 + swz / 64; C = (st & 1) * 32 + (swz % 64) / 2; }
DI int perm32(int rho) { const int n = rho >> 4, i = rho & 15; return 8 * (i >> 2) + 4 * n + (i & 3); }
DI int xcd_remap(int L, int n) { const int q = n / NXCD, r = n % NXCD, xcd = L % NXCD, off = L / NXCD; return (xcd < r ? xcd * (q + 1) : r * (q + 1) + (xcd - r) * q) + off; }

struct Unit { int pm, pn, e, valid, rbase, rti; };
DI const char* uni(const char* p_) {
    const unsigned long long v = (unsigned long long)p_;
    const unsigned lo = (unsigned)__builtin_amdgcn_readfirstlane((int)(unsigned)v), hi = (unsigned)__builtin_amdgcn_readfirstlane((int)(unsigned)(v >> 32));
    return (const char*)(((unsigned long long)hi << 32) | lo);
}

template <bool GATHER, class Epi, class Sched>
DI void gemm_phase(LAS unsigned char* lds, const int K, const Sched& S, const Epi& E) {
    const int tid = tid_opaque(), wid = __builtin_amdgcn_readfirstlane(tid >> 6), lane = tid & 63, wr = wid >> 2, wc = wid & 3, fr = lane & 15, fq = lane >> 4;
    const int nt = K / BK;
    const size_t kstep = (size_t)(BK * 2);
    const size_t hstep = (size_t)HALF * K * 2;
    unsigned vB0, vB1;
    {
        int R0, C0, R1, C1;
        stage_rc(tid * 16, R0, C0); stage_rc(tid * 16 + 8192, R1, C1);
        const int Rb0 = Epi::PERM ? ((R0 & ~31) + perm32(R0 & 31)) : R0, Rb1 = Epi::PERM ? ((R1 & ~31) + perm32(R1 & 31)) : R1;
        vB0 = (unsigned)(Rb0 * K + C0) * 2u; vB1 = (unsigned)(Rb1 * K + C1) * 2u;
    }
    const unsigned ldsw = (unsigned)wid * 1024u;
    const int aoff = lds_byte(wr * 64 + fr, fq * 8), boff = lds_byte(wc * 32 + fr, fq * 8);
#define G8_SA(b, h) (((b) * 2 + (h)) * HTB)
#define G8_SB(b, h) ((4 + (b) * 2 + (h)) * HTB)
#define G8_STAGE(bufoff, gbase, v0, v1) do { unsigned _o0 = (v0), _o1 = (v1); asm volatile("" : "+v"(_o0), "+v"(_o1));     \
        __builtin_amdgcn_global_load_lds((const unsigned*)((const char*)(gbase) + _o0), (LAS unsigned*)(lds + (bufoff) + ldsw), 16, 0, 0); \
        __builtin_amdgcn_global_load_lds((const unsigned*)((const char*)(gbase) + _o1), (LAS unsigned*)(lds + (bufoff) + ldsw + 8192), 16, 0, 0); } while (0)
#define G8_LDA(dst, b, h) do { _Pragma("unroll") for (int m = 0; m < 4; ++m) _Pragma("unroll") for (int k = 0; k < 2; ++k) dst[m][k] = *(const LAS bf16x8*)(lds + G8_SA(b, h) + aoff + m * 2048 + k * 1024); } while (0)
#define G8_LDB(dst, b, h) do { _Pragma("unroll") for (int n = 0; n < 2; ++n) _Pragma("unroll") for (int k = 0; k < 2; ++k) dst[n][k] = *(const LAS bf16x8*)(lds + G8_SB(b, h) + boff + n * 2048 + k * 1024); } while (0)
#define G8_MMA(ai, bj, At, Bt) do { __builtin_amdgcn_s_setprio(1); _Pragma("unroll") for (int m = 0; m < 4; ++m) _Pragma("unroll") for (int n = 0; n < 2; ++n) _Pragma("unroll") for (int k = 0; k < 2; ++k) \
        acc[ai][bj][m][n] = __builtin_amdgcn_mfma_f32_16x16x32_bf16(Bt[n][k], At[m][k], acc[ai][bj][m][n], 0, 0, 0); __builtin_amdgcn_s_setprio(0); } while (0)
#define G8_WAIT_V(n) asm volatile("s_waitcnt vmcnt(" #n ")" ::: "memory")
#define G8_WAIT_L(n) asm volatile("s_waitcnt lgkmcnt(" #n ")" ::: "memory")
#define G8_BAR __builtin_amdgcn_s_barrier()
#define G8_SCHED __builtin_amdgcn_sched_barrier(0)
    Unit cur, nxt;
    int ui = 0;
    if (!S.next(0, cur)) return;
    f32x4 acc[2][2][4][2];
#pragma unroll
    for (int a = 0; a < 2; ++a)
#pragma unroll
        for (int b = 0; b < 2; ++b)
#pragma unroll
            for (int m = 0; m < 4; ++m)
#pragma unroll
                for (int n = 0; n < 2; ++n) acc[a][b][m][n] = (f32x4){0.f, 0.f, 0.f, 0.f};
    bf16x8 At[4][2], B0[2][2], B1[2][2];
    S.a_ready(cur);
    const char* cA = S.a_base(cur);
    const char* cB = S.b_base(cur);
    unsigned cv00, cv01, cv10, cv11, nv00, nv01, nv10, nv11;
    {
        int R0, C0, R1, C1;
        stage_rc(tid * 16, R0, C0); stage_rc(tid * 16 + 8192, R1, C1);
        int rows[2][2];
        S.a_rows(cur, R0, R1, rows);
        cv00 = (unsigned)(rows[0][0] * K + C0) * 2u; cv01 = (unsigned)(rows[0][1] * K + C1) * 2u;
        cv10 = (unsigned)(rows[1][0] * K + C0) * 2u; cv11 = (unsigned)(rows[1][1] * K + C1) * 2u;
        nv00 = cv00; nv01 = cv01; nv10 = cv10; nv11 = cv11;
    }
    G8_STAGE(G8_SB(0, 0), uni(cB), vB0, vB1); G8_STAGE(G8_SA(0, 0), uni(cA), cv00, cv01); G8_STAGE(G8_SB(0, 1), uni(cB + hstep), vB0, vB1); G8_STAGE(G8_SA(0, 1), uni(cA), cv10, cv11);
    if (wr == 1) G8_BAR;
    G8_WAIT_V(4); G8_BAR;
    G8_STAGE(G8_SB(1, 0), uni(cB + kstep), vB0, vB1); G8_STAGE(G8_SA(1, 0), uni(cA + kstep), cv00, cv01); G8_STAGE(G8_SB(1, 1), uni(cB + hstep + kstep), vB0, vB1);
    G8_WAIT_V(6); G8_BAR;
    for (;;) {
        const bool has_next = S.next(ui + 1, nxt);
        const char* nA = has_next ? S.a_base(nxt) : cA;
        const char* nB = has_next ? S.b_base(nxt) : cB;
        if (GATHER) {
            if (has_next) {
                const int tid2 = tid_opaque();
                int R0, C0, R1, C1;
                stage_rc(tid2 * 16, R0, C0); stage_rc(tid2 * 16 + 8192, R1, C1);
                int rows[2][2];
                S.a_rows(nxt, R0, R1, rows);
                nv00 = (unsigned)(rows[0][0] * K + C0) * 2u; nv01 = (unsigned)(rows[0][1] * K + C1) * 2u;
                nv10 = (unsigned)(rows[1][0] * K + C0) * 2u; nv11 = (unsigned)(rows[1][1] * K + C1) * 2u;
            } else { nv00 = cv00; nv01 = cv01; nv10 = cv10; nv11 = cv11; }
        }
        for (int t = 0; t < nt; t += 2) {
            const bool last = (t == nt - 2);
            if (last && has_next) S.a_ready(nxt);
            const char* a1 = uni(cA + (size_t)(t + 1) * kstep);
            const char* a2 = uni(last ? nA : cA + (size_t)(t + 2) * kstep);
            const char* b2 = uni(last ? nB : cB + (size_t)(t + 2) * kstep);
            const char* a3 = uni(a2 + kstep);
            const char* b3 = uni(b2 + kstep);
            const char* b2h = uni(b2 + hstep);
            const char* b3h = uni(b3 + hstep);
            unsigned x00 = cv00, x01 = cv01, x10 = cv10, x11 = cv11;
            if (GATHER) { x00 = last ? nv00 : cv00; x01 = last ? nv01 : cv01; x10 = last ? nv10 : cv10; x11 = last ? nv11 : cv11; }
            G8_LDB(B0, 0, 0); G8_SCHED; G8_LDA(At, 0, 0); G8_STAGE(G8_SA(1, 1), a1, cv10, cv11);
            G8_WAIT_L(8); G8_BAR; G8_WAIT_L(0); G8_MMA(0, 0, At, B0); G8_BAR; G8_SCHED;
            G8_LDB(B1, 0, 1); G8_STAGE(G8_SB(0, 0), b2, vB0, vB1);
            G8_BAR; G8_WAIT_L(0); G8_MMA(0, 1, At, B1); G8_BAR;
            G8_LDA(At, 0, 1); G8_STAGE(G8_SA(0, 0), a2, x00, x01);
            G8_BAR; G8_WAIT_L(0); G8_MMA(1, 0, At, B0); G8_BAR; G8_SCHED;
            G8_STAGE(G8_SB(0, 1), b2h, vB0, vB1);
            G8_WAIT_V(6);
            G8_BAR; G8_MMA(1, 1, At, B1); G8_BAR;
            G8_LDB(B0, 1, 0); G8_SCHED; G8_LDA(At, 1, 0); G8_STAGE(G8_SA(0, 1), a2, x10, x11);
            G8_WAIT_L(8); G8_BAR; G8_WAIT_L(0); G8_MMA(0, 0, At, B0); G8_BAR; G8_SCHED;
            G8_LDB(B1, 1, 1); G8_STAGE(G8_SB(1, 0), b3, vB0, vB1);
            G8_BAR; G8_WAIT_L(0); G8_MMA(0, 1, At, B1); G8_BAR;
            G8_LDA(At, 1, 1); G8_STAGE(G8_SA(1, 0), a3, x00, x01);
            G8_BAR; G8_WAIT_L(0); G8_MMA(1, 0, At, B0); G8_BAR; G8_SCHED;
            G8_STAGE(G8_SB(1, 1), b3h, vB0, vB1);
            G8_WAIT_V(6); G8_BAR; G8_MMA(1, 1, At, B1); G8_BAR;
        }
        E(acc, cur, wr, wc, fr, fq);
        if (!has_next) break;
#pragma unroll
        for (int a = 0; a < 2; ++a)
#pragma unroll
            for (int b = 0; b < 2; ++b)
#pragma unroll
                for (int m = 0; m < 4; ++m)
#pragma unroll
                    for (int n = 0; n < 2; ++n) acc[a][b][m][n] = (f32x4){0.f, 0.f, 0.f, 0.f};
        cur = nxt; cA = nA; cB = nB; ++ui;
        if (GATHER) { cv00 = nv00; cv01 = nv01; cv10 = nv10; cv11 = nv11; }
    }
    G8_WAIT_V(0);
    if (wr == 0) G8_BAR;
    G8_BAR;
#undef G8_SA
#undef G8_SB
#undef G8_STAGE
#undef G8_LDA
#undef G8_LDB
#undef G8_MMA
#undef G8_WAIT_V
#undef G8_WAIT_L
#undef G8_BAR
#undef G8_SCHED
}

struct DenseSched {
    const char* A; const char* Bt; int K, nM, nN, nwg, G, c;
    DI void init(const void* A_, const void* Bt_, int M, int N, int K_, int G_, int c_) { A = (const char*)A_; Bt = (const char*)Bt_; K = K_; nM = M / BM; nN = N / BM; nwg = nM * nN; G = G_; c = c_; }
    DI bool next(int i, Unit& u) const {
        const int L = i * G + c;
        if (L >= nwg) return false;
        const int wgid = xcd_remap(L, nwg);
        const int nig = WGM * nN, gid = wgid / nig, fm = gid * WGM, gsz = (nM - fm) < WGM ? (nM - fm) : WGM;
        u.pm = fm + ((wgid % nig) % gsz); u.pn = (wgid % nig) / gsz; u.e = 0; u.valid = 256; u.rbase = 0; u.rti = 0;
        return true;
    }
    DI const char* a_base(const Unit& u) const { return A + (size_t)u.pm * 256 * K * 2; }
    DI const char* b_base(const Unit& u) const { return Bt + (size_t)u.pn * 256 * K * 2; }
    DI void a_rows(const Unit&, int R0, int R1, int (&rows)[2][2]) const { rows[0][0] = R0; rows[0][1] = R1; rows[1][0] = 128 + R0; rows[1][1] = 128 + R1; }
    DI void a_ready(const Unit&) const {}
};
}


struct TJ { const float* s[4]; float sc[4]; bf16_t* d[2]; };

template <class ColPtr>
DI void tj_make(TJ& j, ColPtr colptr, int ld, int k0, int v0, bf16_t* dst, int K, int tid) {
#pragma unroll
    for (int i = 0; i < 4; ++i) {
        const int idx = tid + NTHREADS * i, kr = idx >> 5, c4 = idx & 31;
        float sc;
        const float* src = colptr(v0 + 4 * c4, sc);
        j.s[i] = src + (size_t)(k0 + kr) * ld; j.sc[i] = sc;
    }
#pragma unroll
    for (int i = 0; i < 2; ++i) {
        const int ch = tid + NTHREADS * i, vr = ch >> 3, kc = ch & 7;
        j.d[i] = dst + (size_t)(v0 + vr) * K + k0 + kc * 8;
    }
}
DI void tj_load(const TJ& j, f32x4 (&v)[4]) {
#pragma unroll
    for (int i = 0; i < 4; ++i) v[i] = __builtin_nontemporal_load((const f32x4*)j.s[i]);
}
DI void tj_finish(const TJ& j, const f32x4 (&v)[4], float* tile, int tid) {
    constexpr int TS = 129;
    __syncthreads();
#pragma unroll
    for (int i = 0; i < 4; ++i) {
        const int idx = tid + NTHREADS * i, kr = idx >> 5, c4 = idx & 31;
        float* tp = tile + kr * TS + 4 * c4;
        tp[0] = v[i][0] * j.sc[i]; tp[1] = v[i][1] * j.sc[i]; tp[2] = v[i][2] * j.sc[i]; tp[3] = v[i][3] * j.sc[i];
    }
    __syncthreads();
#pragma unroll
    for (int i = 0; i < 2; ++i) {
        const int ch = tid + NTHREADS * i, vr = ch >> 3, kc = ch & 7;
        const float* tp = tile + (kc * 8) * TS + vr;
        u32x4 w;
        w.x = cvtpk(tp[0], tp[TS]); w.y = cvtpk(tp[2 * TS], tp[3 * TS]); w.z = cvtpk(tp[4 * TS], tp[5 * TS]); w.w = cvtpk(tp[6 * TS], tp[7 * TS]);
        __builtin_nontemporal_store(w, (u32x4*)j.d[i]);
    }
}

constexpr int MOE_TILES_PER_LAYER = NE * (16 * 8 + 8 * 8);
DI void moe_tile_job(const P& p, int q, int tid, TJ& j) {
    const int layer = q / MOE_TILES_PER_LAYER, r = q % MOE_TILES_PER_LAYER;
    if (r < NE * 128) {
        const int le = layer * NE + (r >> 7), qq = r & 127, kt = qq >> 3, vt = qq & 7;
        const float* Wg = p.w_gate + (size_t)le * D * DFF;
        const float* Wu = p.w_up + (size_t)le * D * DFF;
        tj_make(j, [&](int v4, float& sc) { sc = 1.0f; const int grp = v4 >> 7; return ((grp & 1) ? Wu : Wg) + (grp >> 1) * 128 + (v4 & 127); },
                DFF, kt * 64, vt * 128, (bf16_t*)(p.ws + WS_WGU) + (size_t)le * 1024 * D, D, tid);
    } else {
        const int r2 = r - NE * 128, le = layer * NE + (r2 >> 6), qq = r2 & 63, kt = qq >> 3, vt = qq & 7;
        const float* W = p.w_down + (size_t)le * DFF * D;
        tj_make(j, [&](int v4, float& sc) { sc = 1.0f; return W + v4; }, D, kt * 64, vt * 128, (bf16_t*)(p.ws + WS_WD) + (size_t)le * D * DFF, DFF, tid);
    }
}

constexpr int PT_CONV = 16 * 20, PT_ML = 16 * 28, PT_KV = 16 * 4, PT_OUT = 16 * 8;
constexpr int PN0 = 2 * PT_CONV, PN1 = PN0 + 2 * PT_ML, PN2 = PN1 + 4 * PT_KV, PN3 = PN2 + 4 * PT_OUT, PN5 = PN3 + MOE_TILES_PER_LAYER;
DI void prep_tile_job(const P& p, int it, int tid, TJ& j) {
    if (it < PN0) {
        const int jj = it / PT_CONV, q = it % PT_CONV, kt = q / 20, vt = q % 20;
        const float* W = p.conv_w_in + (size_t)jj * D * DIN_CONV;
        tj_make(j, [&](int v4, float& sc) { sc = 1.0f; return W + v4; }, DIN_CONV, kt * 64, vt * 128, (bf16_t*)(p.ws + WS_WIN) + (size_t)jj * DIN_CONV * D, D, tid);
    } else if (it < PN1) {
        const int r = it - PN0, jj = r / PT_ML, q = r % PT_ML, kt = q / 28, vt = q % 28;
        const float* W = p.ml_w_in + (size_t)jj * D * DIN_ML;
        tj_make(j, [&](int v4, float& sc) -> const float* {
                    sc = (v4 >= MIXW && v4 < 2 * MIXW) ? 0.08838834764831845f : 1.0f;
                    if (v4 < 3072) return W + v4;
                    if (v4 < 3328) return W + 3084 + (v4 - 3072);
                    if (v4 < 3340) return W + 3072 + (v4 - 3328);
                    sc = 0.0f; return W; },
                DIN_ML, kt * 64, vt * 128, (bf16_t*)(p.ws + WS_WIN) + ((size_t)2 * DIN_CONV + (size_t)jj * NV_ML) * D, D, tid);
    } else if (it < PN2) {
        const int r = it - PN1, l = r / PT_KV, q = r % PT_KV, kt = q / 4, vt = q % 4;
        const float* W = p.w_kv + (size_t)l * D * 512;
        tj_make(j, [&](int v4, float& sc) { sc = 1.0f; return W + v4; }, 512, kt * 64, vt * 128, (bf16_t*)(p.ws + WS_WKV) + (size_t)l * 512 * D, D, tid);
    } else if (it < PN3) {
        const int r = it - PN2, l = r / PT_OUT, q = r % PT_OUT, kt = q / 8, vt = q % 8;
        const float* W = p.w_out + (size_t)l * D * D;
        tj_make(j, [&](int v4, float& sc) { sc = 1.0f; return W + v4; }, D, kt * 64, vt * 128, (bf16_t*)(p.ws + WS_WOUT) + (size_t)l * D * D, D, tid);
    } else {
        moe_tile_job(p, it - PN3, tid, j);
    }
}

DI void phase_prep(const P& p, int bid, int nb, char* smem) {
    const int tid = tid_opaque();
    bf16_t* xb = (bf16_t*)(p.ws + WS_XB);
    bf16_t* memb = (bf16_t*)(p.ws + WS_MEMB);
    {
        const size_t nx = (size_t)T * D / 4, nm = (size_t)NBATCH * MEML * D / 4, stride = (size_t)nb * NTHREADS;
        for (size_t i = (size_t)bid * NTHREADS + tid; i < nx; i += 4 * stride) {
            f32x4 v[4];
#pragma unroll
            for (int k = 0; k < 4; ++k) if (i + k * stride < nx) v[k] = __builtin_nontemporal_load((const f32x4*)p.x + i + k * stride);
#pragma unroll
            for (int k = 0; k < 4; ++k) if (i + k * stride < nx) { u32x2 w; w.x = cvtpk(v[k][0], v[k][1]); w.y = cvtpk(v[k][2], v[k][3]); ((u32x2*)xb)[i + k * stride] = w; }
        }
        for (size_t i = (size_t)bid * NTHREADS + tid; i < nm; i += stride) {
            const f32x4 v = ((const f32x4*)p.mem)[i]; u32x2 w; w.x = cvtpk(v[0], v[1]); w.y = cvtpk(v[2], v[3]); ((u32x2*)memb)[i] = w;
        }
    }
    {
        bf16_t* rwt = (bf16_t*)(p.ws + WS_RWT);
        for (int i = bid * NTHREADS + tid; i < NE * D; i += nb * NTHREADS) {
            const int e = i >> 10, d = i & 1023;
            const float w = p.router_w[(size_t)d * NE + e];
            const bf16_t hi = f2bf(w);
            rwt[i] = hi; rwt[NE * D + i] = f2bf(w - bf2f(hi));
        }
    }
    float* tile = (float*)smem;
    if (bid < PN5) {
        TJ j0, j1, j2; f32x4 v0[4], v1[4], v2[4];
        prep_tile_job(p, bid, tid, j0); tj_load(j0, v0);
        if (bid + nb < PN5) { prep_tile_job(p, bid + nb, tid, j1); tj_load(j1, v1); }
        for (int it = bid; it < PN5; it += nb) {
            const bool h2 = it + 2 * nb < PN5;
            if (h2) { prep_tile_job(p, it + 2 * nb, tid, j2); tj_load(j2, v2); }
            tj_finish(j0, v0, tile, tid);
            j0 = j1; j1 = j2;
#pragma unroll
            for (int i = 0; i < 4; ++i) { v0[i] = v1[i]; v1[i] = v2[i]; }
        }
    }
}

DI void moe_steal(const P& p, int budget, int limit, const unsigned* stop, unsigned stop_at, char* smem) {
    volatile int* qslot = (volatile int*)(smem + META_OFF + 2048);
    unsigned* tq = (unsigned*)(p.ws + WS_CTL + CTL_TQ);
    const int tid = tid_opaque();
    constexpr int QEND = DEPTH * MOE_TILES_PER_LAYER;
    if (budget <= 0) return;
    int nclaimed = 0, qlast = 0;
    auto claim = [&](int k) {
        if (tid == 0) {
            const bool halt = (nclaimed >= budget) || (qlast >= limit) || (stop && __hip_atomic_load(stop, __ATOMIC_RELAXED, __HIP_MEMORY_SCOPE_AGENT) >= stop_at);
            qslot[k] = halt ? QEND : (int)__hip_atomic_fetch_add(tq, 1u, __ATOMIC_RELAXED, __HIP_MEMORY_SCOPE_AGENT) + MOE_TILES_PER_LAYER;
        }
    };
    __syncthreads();
    claim(0);
    __syncthreads();
    int q0 = qslot[0];
    if (q0 >= QEND) return;
    nclaimed = 1; qlast = q0;
    TJ j0, j1, j2; f32x4 v0[4], v1[4], v2[4];
    moe_tile_job(p, q0, tid, j0); tj_load(j0, v0);
    claim(1);
    __syncthreads();
    int q1 = qslot[1];
    if (q1 < QEND) { nclaimed = 2; qlast = q1; moe_tile_job(p, q1, tid, j1); tj_load(j1, v1); }
    for (;;) {
        int q2 = QEND;
        if (q1 < QEND) {
            claim(2);
            __syncthreads();
            q2 = qslot[2];
            if (q2 < QEND) { ++nclaimed; qlast = q2; moe_tile_job(p, q2, tid, j2); tj_load(j2, v2); }
        }
        tj_finish(j0, v0, (float*)smem, tid);
        if (q1 >= QEND) break;
        j0 = j1; j1 = j2; q0 = q1; q1 = q2;
#pragma unroll
        for (int i = 0; i < 4; ++i) { v0[i] = v1[i]; v1[i] = v2[i]; }
    }
}
DI void steal_in_slack(const P& p, int slot, bool longest, int nlong, char* smem) {
    unsigned* stop = (unsigned*)(p.ws + WS_CTL + CTL_STOP) + slot;
    if (longest) { if (tid_opaque() == 0) __hip_atomic_fetch_add(stop, 1u, __ATOMIC_RELAXED, __HIP_MEMORY_SCOPE_AGENT); }
    else moe_steal(p, 64, DEPTH * MOE_TILES_PER_LAYER, stop, (unsigned)((nlong * 3 + 3) / 4), smem);
}

DI void store8_bf16(bf16_t* p8, const f32x4& v0, const f32x4& v1) {
    u32x4 w; w.x = cvtpk(v0[0], v0[1]); w.y = cvtpk(v0[2], v0[3]); w.z = cvtpk(v1[0], v1[1]); w.w = cvtpk(v1[2], v1[3]);
    *(u32x4*)p8 = w;
}

struct EpiTileBf16 {
    static constexpr bool PERM = true;
    bf16_t* O; int ldc; size_t pm_stride, pn_stride;
    DI void operator()(const f32x4 (&acc)[2][2][4][2], const g8::Unit& u, int wr, int wc, int fr, int fq) const {
        bf16_t* base = O + (size_t)u.pm * pm_stride + (size_t)u.pn * pn_stride + (size_t)(wr * 64 + fr) * ldc + wc * 32 + 8 * fq;
#pragma unroll
        for (int ai = 0; ai < 2; ++ai)
#pragma unroll
            for (int m = 0; m < 4; ++m)
                {
#pragma unroll
                    for (int bj = 0; bj < 2; ++bj) store8_bf16(base + (size_t)(ai * 128 + m * 16) * ldc + bj * 128, acc[ai][bj][m][0], acc[ai][bj][m][1]); __builtin_amdgcn_sched_barrier(0); }
    }
};

DI int units_of(int nunits, int G, int c) { return (c < nunits) ? (nunits - 1 - c) / G + 1 : 0; }

struct KSched {
    const char* memb; const char* wkv; int G, c;
    DI bool next(int i, g8::Unit& u) const { const int L = i * G + c; if (L >= 32) return false; u.pm = L & 7; u.pn = L >> 3; u.e = 0; u.valid = 256; u.rbase = 0; u.rti = 0; return true; }
    DI const char* a_base(const g8::Unit& u) const { return memb + (size_t)u.pm * 256 * D * 2; }
    DI const char* b_base(const g8::Unit& u) const { return wkv + (size_t)u.pn * 512 * D * 2; }
    DI void a_rows(const g8::Unit&, int R0, int R1, int (&rows)[2][2]) const { rows[0][0] = R0; rows[0][1] = R1; rows[1][0] = 128 + R0; rows[1][1] = 128 + R1; }
    DI void a_ready(const g8::Unit&) const {}
};
struct VSched {
    const char* memb; const char* wkv; int G, c;
    DI bool next(int i, g8::Unit& u) const { const int L = i * G + c - 32; if (L < 0 || L >= 32) return false; u.pm = L >> 3; u.pn = L & 7; u.e = 0; u.valid = 256; u.rbase = 0; u.rti = 0; return true; }
    DI const char* a_base(const g8::Unit& u) const { return wkv + ((size_t)u.pm * 512 + 256) * D * 2; }
    DI const char* b_base(const g8::Unit& u) const { return memb + (size_t)u.pn * 256 * D * 2; }
    DI void a_rows(const g8::Unit&, int R0, int R1, int (&rows)[2][2]) const { rows[0][0] = R0; rows[0][1] = R1; rows[1][0] = 128 + R0; rows[1][1] = 128 + R1; }
    DI void a_ready(const g8::Unit&) const {}
};
DI void phase_kv(const P& p, int bid, int nb, char* smem) {
    const char* memb = p.ws + WS_MEMB;
    const char* wkv = p.ws + WS_WKV;
    {
        KSched S{memb, wkv, nb, bid};
        EpiTileBf16 E{(bf16_t*)(p.ws + WS_KBUF), 256, (size_t)256 * 256, (size_t)2048 * 256};
        g8::gemm_phase<false>((LAS unsigned char*)smem, D, S, E);
    }
    {
        VSched S{memb, wkv, nb, bid};
        EpiTileBf16 E{(bf16_t*)(p.ws + WS_VT), 256, (size_t)8 * 256 * 256, (size_t)256 * 256};
        g8::gemm_phase<false>((LAS unsigned char*)smem, D, S, E);
    }
    steal_in_slack(p, 31, bid < 64, 64, smem);
}

struct EpiInproj {
    static constexpr bool PERM = true;
    bf16_t* projb; int ldp; int gate_pn; float* graw;
    DI void operator()(const f32x4 (&acc)[2][2][4][2], const g8::Unit& u, int wr, int wc, int fr, int fq) const {
        if (u.pn != gate_pn) {
            bf16_t* base = projb + (size_t)(u.pm * 256 + wr * 64 + fr) * ldp + u.pn * 256 + wc * 32 + 8 * fq;
#pragma unroll
            for (int ai = 0; ai < 2; ++ai)
#pragma unroll
                for (int m = 0; m < 4; ++m)
                    {
#pragma unroll
                        for (int bj = 0; bj < 2; ++bj) store8_bf16(base + (size_t)(ai * 128 + m * 16) * ldp + bj * 128, acc[ai][bj][m][0], acc[ai][bj][m][1]); __builtin_amdgcn_sched_barrier(0); }
        } else if (wc == 0 && fq < 2) {
#pragma unroll
            for (int ai = 0; ai < 2; ++ai)
#pragma unroll
                for (int m = 0; m < 4; ++m) {
                    float* dst = graw + (size_t)(u.pm * 256 + ai * 128 + wr * 64 + m * 16 + fr) * 16 + 8 * fq;
                    *(f32x4*)dst = acc[ai][0][m][0];
                    *(f32x4*)(dst + 4) = acc[ai][0][m][1];
                }
        }
    }
};
DI void phase_inproj(const P& p, int layer, int bid, int nb, char* smem) {
    const bool conv = (layer & 1) == 0;
    const int j = layer >> 1;
    const bf16_t* W = (const bf16_t*)(p.ws + WS_WIN) + (conv ? (size_t)j * DIN_CONV * D : ((size_t)2 * DIN_CONV + (size_t)j * NV_ML) * D);
    g8::DenseSched S; S.init(p.ws + WS_XB, W, T, conv ? DIN_CONV : NV_ML, D, nb, bid);
    EpiInproj E{(bf16_t*)(p.ws + WS_PROJ), conv ? DIN_CONV : LDP_ML, conv ? -1 : 13, (float*)(p.ws + WS_LOGI)};
    g8::gemm_phase<false>((LAS unsigned char*)smem, D, S, E);
    { const int most = (S.nwg + nb - 1) / nb, nlong = S.nwg - (most - 1) * nb; steal_in_slack(p, layer * 2, units_of(S.nwg, nb, bid) == most, nlong, smem); }
}

struct EpiOutproj {
    static constexpr bool PERM = true;
    const bf16_t* xres; bf16_t* z;
    DI void operator()(const f32x4 (&acc)[2][2][4][2], const g8::Unit& u, int wr, int wc, int fr, int fq) const {
        const size_t off0 = (size_t)(u.pm * 256 + wr * 64 + fr) * D + u.pn * 256 + wc * 32 + 8 * fq;
        u32x4 xr[2][4][2];
#pragma unroll
        for (int ai = 0; ai < 2; ++ai)
#pragma unroll
            for (int m = 0; m < 4; ++m)
#pragma unroll
                for (int bj = 0; bj < 2; ++bj) xr[ai][m][bj] = *(const u32x4*)(xres + off0 + (size_t)(ai * 128 + m * 16) * D + bj * 128);
#pragma unroll
        for (int ai = 0; ai < 2; ++ai)
#pragma unroll
            for (int m = 0; m < 4; ++m)
#pragma unroll
                for (int bj = 0; bj < 2; ++bj) {
                    const size_t off = off0 + (size_t)(ai * 128 + m * 16) * D + bj * 128;
                    const u32x4 r4 = xr[ai][m][bj];
                    f32x4 v0 = acc[ai][bj][m][0], v1 = acc[ai][bj][m][1];
                    v0[0] += ALPHA * bflo(r4.x); v0[1] += ALPHA * bfhi(r4.x); v0[2] += ALPHA * bflo(r4.y); v0[3] += ALPHA * bfhi(r4.y);
                    v1[0] += ALPHA * bflo(r4.z); v1[1] += ALPHA * bfhi(r4.z); v1[2] += ALPHA * bflo(r4.w); v1[3] += ALPHA * bfhi(r4.w);
                    store8_bf16(z + off, v0, v1);
                }
    }
};
DI void phase_outproj(const P& p, int layer, int bid, int nb, char* smem) {
    g8::DenseSched S; S.init(p.ws + WS_HCAT, (const bf16_t*)(p.ws + WS_WOUT) + (size_t)layer * D * D, T, D, D, nb, bid);
    EpiOutproj E{(const bf16_t*)(p.ws + WS_XB), (bf16_t*)(p.ws + WS_Z)};
    g8::gemm_phase<false>((LAS unsigned char*)smem, D, S, E);
}

DI void moe_meta(const int* cnt, int* meta) {
    __syncthreads();
    const int t = tid_opaque();
    if (t < NE) meta[65 + t] = __hip_atomic_load(cnt + t * CNT_STRIDE, __ATOMIC_RELAXED, __HIP_MEMORY_SCOPE_AGENT);
    __syncthreads();
    if (t == 0) {
        int base = 0, blk = 0;
#pragma unroll 1
        for (int e = 0; e < NE; ++e) {
            const int c = meta[65 + e];
            meta[e] = base; meta[32 + e] = blk;
            base += c; blk += (c + 255) >> 8;
        }
        meta[64] = blk;
    }
    __syncthreads();
    if (t < 160) {
        int e = 0;
#pragma unroll 1
        for (int q = 1; q < NE; ++q) e += (meta[32 + q] <= t) ? 1 : 0;
        meta[128 + t] = e;
    }
    __syncthreads();
}
struct MoeSched {
    const int* meta; const int* list; const char* A; const char* Bt; size_t b_estride; int K, G, c, nunits;
    DI bool next(int i, g8::Unit& u) const {
        const int L = i * G + c;
        if (L >= nunits) return false;
        const int w = g8::xcd_remap(L, nunits);
        const int rti = w >> 2;
        const int e = __builtin_amdgcn_readfirstlane(meta[128 + rti]);
        u.e = e; u.pm = rti - __builtin_amdgcn_readfirstlane(meta[32 + e]); u.pn = w & 3; u.rti = rti;
        const int left = __builtin_amdgcn_readfirstlane(meta[65 + e]) - u.pm * 256;
        u.valid = left < 256 ? left : 256;
        u.rbase = __builtin_amdgcn_readfirstlane(meta[e]);
        return true;
    }
    DI const char* b_base(const g8::Unit& u) const { return Bt + (size_t)u.e * b_estride + (size_t)u.pn * 256 * K * 2; }
};
struct MoeUpSched : MoeSched {
    DI const char* a_base(const g8::Unit&) const { return A; }
    DI void a_rows(const g8::Unit& u, int R0, int R1, int (&rows)[2][2]) const {
        const int* lst = list + (size_t)u.e * T + u.pm * 256;
        const int vm = u.valid - 1;
        rows[0][0] = lst[min(R0, vm)] >> 1; rows[0][1] = lst[min(R1, vm)] >> 1;
        rows[1][0] = lst[min(128 + R0, vm)] >> 1; rows[1][1] = lst[min(128 + R1, vm)] >> 1;
    }
    DI void a_ready(const g8::Unit&) const {}
};
struct MoeDownSched : MoeSched {
    unsigned* ready; unsigned* tmo;
    DI const char* a_base(const g8::Unit& u) const { return A + ((size_t)u.rbase + (size_t)u.pm * 256) * K * 2; }
    DI void a_rows(const g8::Unit&, int R0, int R1, int (&rows)[2][2]) const { rows[0][0] = R0; rows[0][1] = R1; rows[1][0] = 128 + R0; rows[1][1] = 128 + R1; }
    DI void a_ready(const g8::Unit& u) const {
        if (tid_opaque() < 64) {
            unsigned* w = ready + u.rti * 16;
            unsigned spins = 0;
            while ((unsigned)__builtin_amdgcn_readfirstlane((int)__hip_atomic_load(w, __ATOMIC_RELAXED, __HIP_MEMORY_SCOPE_AGENT)) < 32u) {
                __builtin_amdgcn_s_sleep(2);
                if ((++spins & 255u) == 0u) {
                    if (__builtin_amdgcn_readfirstlane((int)__hip_atomic_load(tmo, __ATOMIC_RELAXED, __HIP_MEMORY_SCOPE_AGENT)) != 0) break;
                    if (spins > (1u << 22)) { __hip_atomic_store(tmo, 1u, __ATOMIC_RELAXED, __HIP_MEMORY_SCOPE_AGENT); break; }
                }
            }
            __builtin_amdgcn_fence(__ATOMIC_ACQUIRE, "agent");
            asm volatile("s_waitcnt vmcnt(0)" ::: "memory");
        }
        asm volatile("" ::: "memory"); __builtin_amdgcn_s_barrier(); asm volatile("" ::: "memory");
    }
};

struct EpiMoeUp {
    static constexpr bool PERM = true;
    __amdgpu_buffer_rsrc_t hrs; unsigned* ready;
    DI void operator()(const f32x4 (&acc)[2][2][4][2], const g8::Unit& u, int wr, int wc, int fr, int fq) const {
        const unsigned hrow0 = (unsigned)u.rbase + (unsigned)u.pm * 256u;
#pragma unroll
        for (int ai = 0; ai < 2; ++ai)
#pragma unroll
            for (int m = 0; m < 4; ++m) {
                const int row = ai * 128 + wr * 64 + m * 16 + fr;
                if (row < u.valid) {
                    f32x4 h0, h1;
#pragma unroll
                    for (int i = 0; i < 4; ++i) {
                        const float g0 = acc[ai][0][m][0][i], g1 = acc[ai][0][m][1][i];
                        h0[i] = g0 * sigmoidf_(g0) * acc[ai][1][m][0][i];
                        h1[i] = g1 * sigmoidf_(g1) * acc[ai][1][m][1][i];
                    }
                    u32x4 w; w.x = cvtpk(h0[0], h0[1]); w.y = cvtpk(h0[2], h0[3]); w.z = cvtpk(h1[0], h1[1]); w.w = cvtpk(h1[2], h1[3]);
                    __builtin_amdgcn_raw_buffer_store_b128(w, hrs, ((hrow0 + (unsigned)row) * DFF + u.pn * 128 + wc * 32 + 8 * fq) * 2u, 0,   16);
                }
                __builtin_amdgcn_sched_barrier(0);
            }
        asm volatile("s_waitcnt vmcnt(0)" ::: "memory");
        if (fr == 0 && fq == 0) __hip_atomic_fetch_add(ready + u.rti * 16, 1u, __ATOMIC_RELAXED, __HIP_MEMORY_SCOPE_AGENT);
    }
};
struct EpiMoeDown {
    static constexpr bool PERM = true;
    const int* list; const float* gate; bf16_t* yasg;
    DI void operator()(const f32x4 (&acc)[2][2][4][2], const g8::Unit& u, int wr, int wc, int fr, int fq) const {
        const int* lst = list + (size_t)u.e * T + u.pm * 256;
        int aid[2][4]; float gt[2][4];
#pragma unroll
        for (int ai = 0; ai < 2; ++ai)
#pragma unroll
            for (int m = 0; m < 4; ++m) { const int row = ai * 128 + wr * 64 + m * 16 + fr; aid[ai][m] = lst[min(row, u.valid - 1)]; }
#pragma unroll
        for (int ai = 0; ai < 2; ++ai)
#pragma unroll
            for (int m = 0; m < 4; ++m) gt[ai][m] = gate[aid[ai][m]];
#pragma unroll
        for (int ai = 0; ai < 2; ++ai)
#pragma unroll
            for (int m = 0; m < 4; ++m) {
                const int row = ai * 128 + wr * 64 + m * 16 + fr;
                if (row < u.valid) {
                    bf16_t* dst = yasg + (size_t)aid[ai][m] * D + u.pn * 256 + wc * 32 + 8 * fq;
                    const float g_ = gt[ai][m];
#pragma unroll
                    for (int bj = 0; bj < 2; ++bj) store8_bf16(dst + bj * 128, acc[ai][bj][m][0] * g_, acc[ai][bj][m][1] * g_);
                }
                __builtin_amdgcn_sched_barrier(0);
            }
    }
};
DI void phase_moe(const P& p, int layer, int bid, int nb, char* smem) {
    int* meta = (int*)(smem + META_OFF);
    moe_meta((const int*)(p.ws + WS_CTL + CTL_CNT) + layer * 32 * CNT_STRIDE, meta);
    unsigned* ready = (unsigned*)(p.ws + WS_CTL + CTL_READY) + layer * 160 * 16;
    const int nunits = meta[64] * 4;
    {
        MoeUpSched S;
        S.meta = meta; S.list = (const int*)(p.ws + WS_LIST); S.A = p.ws + WS_X1B; S.Bt = p.ws + WS_WGU + (size_t)layer * NE * 1024 * D * 2;
        S.b_estride = (size_t)1024 * D * 2; S.K = D; S.G = nb; S.c = bid; S.nunits = nunits;
        EpiMoeUp E{__builtin_amdgcn_make_buffer_rsrc((void*)(p.ws + WS_HBUF), (short)0, (int)((size_t)T * 2 * DFF * 2), 0x00020000), ready};
        g8::gemm_phase<true>((LAS unsigned char*)smem, D, S, E);
    }
    {
        MoeDownSched S;
        S.meta = meta; S.list = (const int*)(p.ws + WS_LIST); S.A = p.ws + WS_HBUF; S.Bt = p.ws + WS_WD + (size_t)layer * NE * D * DFF * 2;
        S.b_estride = (size_t)D * DFF * 2; S.K = DFF; S.G = nb; S.c = nb - 1 - bid; S.nunits = nunits;
        S.ready = ready; S.tmo = (unsigned*)(p.ws + WS_CTL + CTL_TMO);
        EpiMoeDown E{(const int*)(p.ws + WS_LIST), (const float*)(p.ws + WS_GATE), (bf16_t*)(p.ws + WS_YASG)};
        g8::gemm_phase<false>((LAS unsigned char*)smem, DFF, S, E);
    }
    { const int most = (nunits + nb - 1) / nb, nlong = nunits - (most - 1) * nb; steal_in_slack(p, layer * 2 + 1, units_of(nunits, nb, bid) == most, nlong, smem); }
}

DI void phase_convmix(const P& p, int layer, int bid, int nb) {
    const int j = layer >> 1;
    const int tid = tid_opaque();
    const bf16_t* projb = (const bf16_t*)(p.ws + WS_PROJ);
    bf16_t* hcat = (bf16_t*)(p.ws + WS_HCAT);
    const float* cw = p.conv_w + (size_t)j * 3 * MIXW;
    const int nitem = T * (MIXW / 8);
#pragma unroll 2
    for (int it = bid * NTHREADS + tid; it < nitem; it += nb * NTHREADS) {
        const int t = it / 96, c8 = (it % 96) * 8;
        const int s = t & 2047;
        const bf16_t* row = projb + (size_t)t * DIN_CONV;
        const u32x4 bg = *(const u32x4*)(row + c8);
        float u[3][8];
#pragma unroll
        for (int d = 0; d < 3; ++d) {
            const int back = 2 - d;
            if (s - back >= 0) {
                const bf16_t* rw = row - (size_t)back * DIN_CONV;
                const u32x4 cg = *(const u32x4*)(rw + MIXW + c8);
                const u32x4 xi = *(const u32x4*)(rw + 2 * MIXW + c8);
#pragma unroll
                for (int q = 0; q < 4; ++q) { u[d][2 * q] = bflo(cg[q]) * bflo(xi[q]); u[d][2 * q + 1] = bfhi(cg[q]) * bfhi(xi[q]); }
            } else {
#pragma unroll
                for (int q = 0; q < 8; ++q) u[d][q] = 0.f;
            }
        }
        float o[8];
#pragma unroll
        for (int q = 0; q < 8; ++q) {
            const float c = cw[c8 + q] * u[0][q] + cw[MIXW + c8 + q] * u[1][q] + cw[2 * MIXW + c8 + q] * u[2][q];
            const float b = (q & 1) ? bfhi(bg[q >> 1]) : bflo(bg[q >> 1]);
            o[q] = b * c;
        }
        u32x4 w; w.x = cvtpk(o[0], o[1]); w.y = cvtpk(o[2], o[3]); w.z = cvtpk(o[4], o[5]); w.w = cvtpk(o[6], o[7]);
        *(u32x4*)(hcat + (size_t)t * D + c8) = w;
    }
}

DI void phase_xattn(const P& p, int layer, int bid, int nb, char* smem) {
    const bool conv = (layer & 1) == 0;
    const int ldp = conv ? DIN_CONV : LDP_ML;
    const int qoff = conv ? 3 * MIXW : 3072;
    const bf16_t* projb = (const bf16_t*)(p.ws + WS_PROJ);
    const bf16_t* kbuf = (const bf16_t*)(p.ws + WS_KBUF) + (size_t)layer * 2048 * 256;
    const bf16_t* vT = (const bf16_t*)(p.ws + WS_VT) + (size_t)layer * 8 * 256 * 256;
    bf16_t* hcat = (bf16_t*)(p.ws + WS_HCAT);
    constexpr int LK = 72, LV = 264;
    bf16_t* Ks = (bf16_t*)smem;
    bf16_t* Vs = Ks + 256 * LK;
    const int per = (NBATCH * XH * 16 + nb - 1) / nb;
    int staged = -1;
    for (int k = 0; k < per; ++k) {
        const int task = bid * per + k;
        if (task >= NBATCH * XH * 16) break;
        const int tid = tid_opaque(), lane = tid & 63, wid = tid >> 6, r = lane & 15, g = lane >> 4;
        const int b = task >> 6, h = (task >> 4) & 3, qt = task & 15;
        const bool restage = (task >> 4) != staged;
        staged = task >> 4;
        __syncthreads();
        if (restage) {
#pragma unroll
        for (int i = 0; i < 4; ++i) {
            const int key = (tid >> 3) + 64 * i, kc = tid & 7;
            *(u32x4*)&Ks[key * LK + kc * 8] = *(const u32x4*)(kbuf + ((size_t)b * 256 + key) * 256 + h * 64 + kc * 8);
            const int dv = (tid >> 5) + 16 * i, mc = tid & 31;
            *(u32x4*)&Vs[dv * LV + mc * 8] = *(const u32x4*)(vT + (((size_t)b * 4 + h) * 64 + dv) * 256 + mc * 8);
        }
        }
        __syncthreads();
        const int tq = b * SEQ + qt * 128 + wid * 16;
        const bf16_t* qrow = projb + (size_t)(tq + r) * ldp + qoff + h * 64;
        bf16x8 qf[2];
        qf[0] = *(const bf16x8*)(qrow + 8 * g);
        qf[1] = *(const bf16x8*)(qrow + 32 + 8 * g);
        f32x4 sacc[16];
#pragma unroll
        for (int kt = 0; kt < 16; ++kt) {
            f32x4 a = (f32x4){0.f, 0.f, 0.f, 0.f};
#pragma unroll
            for (int ks = 0; ks < 2; ++ks) {
                const bf16x8 kf = *(const bf16x8*)&Ks[(kt * 16 + r) * LK + ks * 32 + 8 * g];
                a = mfma16(kf, qf[ks], a);
            }
            sacc[kt] = a;
            if (kt & 1) __builtin_amdgcn_sched_barrier(0);
        }
        float mx = -3.0e38f;
#pragma unroll
        for (int kt = 0; kt < 16; ++kt)
#pragma unroll
            for (int i = 0; i < 4; ++i) { sacc[kt][i] *= 0.125f; mx = fmaxf(mx, sacc[kt][i]); }
        mx = xor_max(mx, 16); mx = xor_max(mx, 32);
        float sum = 0.f;
#pragma unroll
        for (int kt = 0; kt < 16; ++kt)
#pragma unroll
            for (int i = 0; i < 4; ++i) { const float e = __expf(sacc[kt][i] - mx); sacc[kt][i] = e; sum += e; }
        sum = xor_add(sum, 16); sum = xor_add(sum, 32);
        const float inv = 1.0f / sum;
        f32x4 oacc[4];
#pragma unroll
        for (int dt = 0; dt < 4; ++dt) oacc[dt] = (f32x4){0.f, 0.f, 0.f, 0.f};
#pragma unroll
        for (int s2 = 0; s2 < 8; ++s2) {
            u32x4 pw;
            pw.x = cvtpk(sacc[2 * s2][0], sacc[2 * s2][1]); pw.y = cvtpk(sacc[2 * s2][2], sacc[2 * s2][3]);
            pw.z = cvtpk(sacc[2 * s2 + 1][0], sacc[2 * s2 + 1][1]); pw.w = cvtpk(sacc[2 * s2 + 1][2], sacc[2 * s2 + 1][3]);
            const bf16x8 pf = __builtin_bit_cast(bf16x8, pw);
#pragma unroll
            for (int dt = 0; dt < 4; ++dt) {
                const bf16_t* vp = &Vs[(dt * 16 + r) * LV + s2 * 32 + 4 * g];
                const u32x2 v0 = *(const u32x2*)vp;
                const u32x2 v1 = *(const u32x2*)(vp + 16);
                u32x4 vw; vw.x = v0.x; vw.y = v0.y; vw.z = v1.x; vw.w = v1.y;
                oacc[dt] = mfma16(__builtin_bit_cast(bf16x8, vw), pf, oacc[dt]);
            }
            __builtin_amdgcn_sched_barrier(0);
        }
        bf16_t* orow = hcat + (size_t)(tq + r) * D + MIXW + h * 64;
#pragma unroll
        for (int dt = 0; dt < 4; ++dt) {
            u32x2 w; w.x = cvtpk(oacc[dt][0] * inv, oacc[dt][1] * inv); w.y = cvtpk(oacc[dt][2] * inv, oacc[dt][3] * inv);
            *(u32x2*)(orow + dt * 16 + 4 * g) = w;
        }
    }
}

DI void phase_ml_local(const P& p, int layer, int bid, int nb, char* smem) {
    const float* gate_b = p.ml_gate_b + (layer >> 1) * 12;
    const bf16_t* projb = (const bf16_t*)(p.ws + WS_PROJ);
    const float* graw = (const float*)(p.ws + WS_LOGI);
    float* CT = (float*)(p.ws + WS_CT);
    float* nloc = (float*)(p.ws + WS_NLOC);
    float* mloc = (float*)(p.ws + WS_MLOC);
    float* gsum = (float*)(p.ws + WS_GSUM);
    constexpr int LS = 136;
    bf16_t* kwT = (bf16_t*)smem;
    bf16_t* vTs = kwT + 128 * LS;
    float* fb = (float*)(vTs + 128 * LS);
    float* fw = fb + 128;
    float* fr = fw + 128;
    for (int task = bid; task < 48 * NCH; task += nb) {
        const int tid = tid_opaque(), lane = tid & 63, wid = tid >> 6, r = lane & 15, g = lane >> 4;
        const int bh = task >> 4, c = task & 15, b = bh / 6, h = bh % 6;
        const int t0 = b * SEQ + c * CHUNK;
        const float gbi = gate_b[h], gbf = gate_b[6 + h];
        __syncthreads();
        if (wid == 0) {
            const float* gp = graw + (size_t)(t0 + 2 * lane) * 16 + h;
            const float i0 = gp[0] + gbi, i1 = gp[16] + gbi;
            const float f0 = logsigmoidf_(gp[6] + gbf), f1 = logsigmoidf_(gp[22] + gbf);
            float ps = f0 + f1;
#pragma unroll
            for (int off = 1; off < 64; off <<= 1) { const float y = __shfl_up(ps, off, 64); if (lane >= off) ps += y; }
            const float gtot = __shfl(ps, 63, 64);
            const float b0 = ps - f1, b1 = ps;
            const float a0 = gtot - b0 + i0, a1 = gtot - b1 + i1;
            float mx = fmaxf(a0, a1);
            mx = xor_max(mx, 32); mx = xor_max(mx, 16); mx = xor_max(mx, 8); mx = xor_max(mx, 4); mx = xor_max(mx, 2); mx = xor_max(mx, 1);
            fw[2 * lane] = __expf(a0 - mx); fw[2 * lane + 1] = __expf(a1 - mx);
            if (lane == 0) { fr[0] = mx; fr[1] = gtot; }
        }
        __syncthreads();
        const float ml = fr[0], gtot = fr[1];
        {
            const int s = tid & 127, quarter = tid >> 7;
            const float w = fw[s];
            const bf16_t* krow = projb + (size_t)(t0 + s) * LDP_ML + MIXW + h * 128;
            const bf16_t* vrow = projb + (size_t)(t0 + s) * LDP_ML + 2 * MIXW + h * 128;
#pragma unroll
            for (int i = 0; i < 4; ++i) {
                const int dc = quarter * 4 + i;
                const u32x4 kk = *(const u32x4*)(krow + dc * 8);
                const u32x4 vv = *(const u32x4*)(vrow + dc * 8);
#pragma unroll
                for (int q = 0; q < 4; ++q) {
                    kwT[(dc * 8 + 2 * q) * LS + s] = f2bf(bflo(kk[q]) * w);
                    kwT[(dc * 8 + 2 * q + 1) * LS + s] = f2bf(bfhi(kk[q]) * w);
                    vTs[(dc * 8 + 2 * q) * LS + s] = (bf16_t)(vv[q] & 0xffffu);
                    vTs[(dc * 8 + 2 * q + 1) * LS + s] = (bf16_t)(vv[q] >> 16);
                }
            }
        }
        __syncthreads();
        float* ct = CT + (size_t)task * 128 * 128;
        {
            f32x4 acc[8];
#pragma unroll
            for (int dt = 0; dt < 8; ++dt) acc[dt] = (f32x4){0.f, 0.f, 0.f, 0.f};
#pragma unroll
            for (int ks = 0; ks < 4; ++ks) {
                const bf16x8 vf = *(const bf16x8*)&vTs[(wid * 16 + r) * LS + ks * 32 + 8 * g];
#pragma unroll
                for (int dt = 0; dt < 8; ++dt) {
                    const bf16x8 kf = *(const bf16x8*)&kwT[(dt * 16 + r) * LS + ks * 32 + 8 * g];
                    acc[dt] = mfma16(vf, kf, acc[dt]);
                }
                __builtin_amdgcn_sched_barrier(0);
            }
#pragma unroll
            for (int dt = 0; dt < 8; ++dt)
#pragma unroll
                for (int i = 0; i < 4; ++i) ct[(wid * 16 + 4 * g + i) * 128 + dt * 16 + r] = acc[dt][i];
        }
        {
            const bf16x8 ones = (bf16x8){0x3F80, 0x3F80, 0x3F80, 0x3F80, 0x3F80, 0x3F80, 0x3F80, 0x3F80};
            f32x4 an = (f32x4){0.f, 0.f, 0.f, 0.f};
#pragma unroll
            for (int ks = 0; ks < 4; ++ks) {
                const bf16x8 kf = *(const bf16x8*)&kwT[(wid * 16 + r) * LS + ks * 32 + 8 * g];
                an = mfma16(ones, kf, an);
            }
            if (g == 0) nloc[(size_t)task * 128 + wid * 16 + r] = an[0];
        }
        if (tid == 0) { mloc[task] = ml; gsum[task] = gtot; }
    }
}

DI void phase_ml_scan(const P& p, int bid, int nb) {
    const float* CT = (const float*)(p.ws + WS_CT);
    bf16_t* CPB = (bf16_t*)(p.ws + WS_CPB);
    const float* nloc = (const float*)(p.ws + WS_NLOC);
    float* nprev = (float*)(p.ws + WS_NPREV);
    const float* mloc = (const float*)(p.ws + WS_MLOC);
    const float* gsum = (const float*)(p.ws + WS_GSUM);
    float* mprev = (float*)(p.ws + WS_MPREV);
    const int tid = tid_opaque();
    for (int task = bid; task < 48 * 8; task += nb) {
        const int bh = task >> 3, sl = task & 7;
        const int idx = sl * 2048 + tid * 4;
        const bool don = (sl == 0 && tid < 128);
        f32x4 loc[NCH];
        float nl[NCH];
#pragma unroll
        for (int c = 0; c < NCH; ++c) loc[c] = *(const f32x4*)(CT + (size_t)(bh * NCH + c) * 16384 + idx);
#pragma unroll
        for (int c = 0; c < NCH; ++c) nl[c] = don ? nloc[(size_t)(bh * NCH + c) * 128 + tid] : 0.f;
        float m = 0.f;
        f32x4 st = (f32x4){0.f, 0.f, 0.f, 0.f};
        float nst = 0.f;
#pragma unroll
        for (int c = 0; c < NCH; ++c) {
            const int ch = bh * NCH + c;
            const float gg = gsum[ch], ml = mloc[ch];
            const float mnew = fmaxf(gg + m, ml);
            const float decay = __expf(gg + m - mnew), sc = __expf(ml - mnew);
            u32x2 w; w.x = cvtpk(st[0], st[1]); w.y = cvtpk(st[2], st[3]);
            *(u32x2*)(CPB + (size_t)ch * 16384 + idx) = w;
            st = st * decay + loc[c] * sc;
            if (don) { nprev[(size_t)ch * 128 + tid] = nst; nst = nst * decay + nl[c] * sc; }
            if (sl == 0 && tid == 0) mprev[ch] = m;
            m = mnew;
        }
    }
}

DI void phase_ml_out(const P& p, int layer, int bid, int nb, char* smem) {
    const int j = layer >> 1;
    const float* gate_b = p.ml_gate_b + j * 12;
    const bf16_t* projb = (const bf16_t*)(p.ws + WS_PROJ);
    const float* graw = (const float*)(p.ws + WS_LOGI);
    const bf16_t* CPB = (const bf16_t*)(p.ws + WS_CPB);
    const float* nprev = (const float*)(p.ws + WS_NPREV);
    const float* mprev = (const float*)(p.ws + WS_MPREV);
    bf16_t* hcat = (bf16_t*)(p.ws + WS_HCAT);
    const float* ng_ = p.ml_norm_g + (size_t)j * MIXW;
    constexpr int LS = 136;
    bf16_t* kS = (bf16_t*)smem;
    bf16_t* vTs = kS + 128 * LS;
    bf16_t* cS = vTs + 128 * LS;
    float* fb = (float*)(cS + 128 * LS);
    float* fB = fb + 128;
    float* fA = fB + 128;
    float* fW = fA + 128;
    float* fE = fW + 128;
    float* fN = fE + 128;
    for (int task = bid; task < 48 * NCH; task += nb) {
        const int tid = tid_opaque();
        const int lane = tid & 63, wid = __builtin_amdgcn_readfirstlane(tid >> 6), r = lane & 15, g = lane >> 4;
        const int bh = task >> 4, c = task & 15, b = bh / 6, h = bh % 6;
        const int t0 = b * SEQ + c * CHUNK;
        const float gbi = gate_b[h], gbf = gate_b[6 + h];
        __syncthreads();
        if (wid == 0) {
            const float* gp = graw + (size_t)(t0 + 2 * lane) * 16 + h;
            const float i0 = gp[0] + gbi, i1 = gp[16] + gbi;
            const float f0 = logsigmoidf_(gp[6] + gbf), f1 = logsigmoidf_(gp[22] + gbf);
            const float mp = mprev[task];
            float ps = f0 + f1;
#pragma unroll
            for (int off = 1; off < 64; off <<= 1) { const float y = __shfl_up(ps, off, 64); if (lane >= off) ps += y; }
            const float b0 = ps - f1, b1 = ps;
            const float B0 = i0 - b0, B1 = i1 - b1;
            float pm = fmaxf(B0, B1);
#pragma unroll
            for (int off = 1; off < 64; off <<= 1) { const float y = __shfl_up(pm, off, 64); if (lane >= off) pm = fmaxf(pm, y); }
            float pmx = __shfl_up(pm, 1, 64);
            if (lane == 0) pmx = -3.0e38f;
            const float pm0 = fmaxf(pmx, B0), pm1 = pm;
            const float in0 = b0 + mp, in1 = b1 + mp;
            const float m0 = fmaxf(b0 + pm0, in0), m1 = fmaxf(b1 + pm1, in1);
            fB[2 * lane] = B0; fB[2 * lane + 1] = B1;
            fA[2 * lane] = b0 - m0; fA[2 * lane + 1] = b1 - m1;
            fW[2 * lane] = __expf(in0 - m0); fW[2 * lane + 1] = __expf(in1 - m1);
            fE[2 * lane] = __expf(-m0); fE[2 * lane + 1] = __expf(-m1);
        } else if (wid == 1) {
            fN[2 * lane] = nprev[(size_t)task * 128 + 2 * lane]; fN[2 * lane + 1] = nprev[(size_t)task * 128 + 2 * lane + 1];
        }
        {
#pragma unroll
            for (int i = 0; i < 4; ++i) {
                const int s = (tid >> 4) + 32 * i, dc = tid & 15;
                *(u32x4*)&kS[s * LS + dc * 8] = *(const u32x4*)(projb + (size_t)(t0 + s) * LDP_ML + MIXW + h * 128 + dc * 8);
                *(u32x4*)&cS[s * LS + dc * 8] = *(const u32x4*)(CPB + (size_t)task * 16384 + s * 128 + dc * 8);
            }
            const int s = tid & 127, quarter = tid >> 7;
            const bf16_t* vrow = projb + (size_t)(t0 + s) * LDP_ML + 2 * MIXW + h * 128;
#pragma unroll
            for (int i = 0; i < 4; ++i) {
                const int dc = quarter * 4 + i;
                const u32x4 vv = *(const u32x4*)(vrow + dc * 8);
#pragma unroll
                for (int q = 0; q < 4; ++q) {
                    vTs[(dc * 8 + 2 * q) * LS + s] = (bf16_t)(vv[q] & 0xffffu);
                    vTs[(dc * 8 + 2 * q + 1) * LS + s] = (bf16_t)(vv[q] >> 16);
                }
            }
        }
        __syncthreads();
        {
            const int l = wid * 16 + r;
            bf16x8 qf[4];
            float qn;
            {
                const bf16_t* qrow = projb + (size_t)(t0 + l) * LDP_ML + h * 128;
                float part = 0.f;
#pragma unroll
                for (int ks = 0; ks < 4; ++ks) {
                    const u32x4 qq = *(const u32x4*)(qrow + ks * 32 + 8 * g);
                    qf[ks] = __builtin_bit_cast(bf16x8, qq);
#pragma unroll
                    for (int q = 0; q < 4; ++q) part += bflo(qq[q]) * fN[ks * 32 + 8 * g + 2 * q] + bfhi(qq[q]) * fN[ks * 32 + 8 * g + 2 * q + 1];
                }
                part = xor_add(part, 16); part = xor_add(part, 32);
                qn = part;
            }
            __builtin_amdgcn_sched_barrier(0);
            f32x4 nacc[8];
#pragma unroll
            for (int et = 0; et < 8; ++et) {
                f32x4 a = (f32x4){0.f, 0.f, 0.f, 0.f};
#pragma unroll
                for (int ks = 0; ks < 4; ++ks) {
                    const bf16x8 cf = *(const bf16x8*)&cS[(et * 16 + r) * LS + ks * 32 + 8 * g];
                    a = mfma16(cf, qf[ks], a);
                }
                nacc[et] = a;
                if (et & 1) __builtin_amdgcn_sched_barrier(0);
            }
            const float Al = fA[l], wint = fW[l], eml = fE[l];
#pragma unroll
            for (int et = 0; et < 8; ++et) nacc[et] *= wint;
            const int stmax = wid;
            float den = 0.f;
#pragma unroll
            for (int s2 = 0; s2 < 4; ++s2) {
                if (2 * s2 <= stmax) {
                    f32x4 sa = (f32x4){0.f, 0.f, 0.f, 0.f}, sb = (f32x4){0.f, 0.f, 0.f, 0.f};
#pragma unroll
                    for (int ks = 0; ks < 4; ++ks) {
                        const bf16x8 kf = *(const bf16x8*)&kS[(s2 * 32 + r) * LS + ks * 32 + 8 * g];
                        sa = mfma16(kf, qf[ks], sa);
                    }
                    if (2 * s2 + 1 <= stmax) {
#pragma unroll
                        for (int ks = 0; ks < 4; ++ks) {
                            const bf16x8 kf = *(const bf16x8*)&kS[(s2 * 32 + 16 + r) * LS + ks * 32 + 8 * g];
                            sb = mfma16(kf, qf[ks], sb);
                        }
                    }
#pragma unroll
                    for (int i = 0; i < 4; ++i) {
                        const int s = s2 * 32 + 4 * g + i;
                        const float va = (s <= l) ? sa[i] * __expf(Al + fB[s]) : 0.f;
                        const float vb = (s + 16 <= l) ? sb[i] * __expf(Al + fB[s + 16]) : 0.f;
                        sa[i] = va; sb[i] = vb; den += va + vb;
                    }
                    u32x4 pw;
                    pw.x = cvtpk(sa[0], sa[1]); pw.y = cvtpk(sa[2], sa[3]);
                    pw.z = cvtpk(sb[0], sb[1]); pw.w = cvtpk(sb[2], sb[3]);
                    const bf16x8 pf = __builtin_bit_cast(bf16x8, pw);
#pragma unroll
                    for (int et = 0; et < 8; ++et) {
                        const bf16_t* vp = &vTs[(et * 16 + r) * LS + s2 * 32 + 4 * g];
                        const u32x2 v0 = *(const u32x2*)vp;
                        const u32x2 v1 = *(const u32x2*)(vp + 16);
                        u32x4 vw; vw.x = v0.x; vw.y = v0.y; vw.z = v1.x; vw.w = v1.y;
                        nacc[et] = mfma16(__builtin_bit_cast(bf16x8, vw), pf, nacc[et]);
                    }
                }
                __builtin_amdgcn_sched_barrier(0);
            }
            den = xor_add(den, 16); den = xor_add(den, 32);
            const float dd = fmaxf(fabsf(den + wint * qn), eml);
            const float invd = 1.0f / dd;
            float sm = 0.f;
#pragma unroll
            for (int et = 0; et < 8; ++et)
#pragma unroll
                for (int i = 0; i < 4; ++i) { nacc[et][i] *= invd; sm += nacc[et][i]; }
            sm = xor_add(sm, 16); sm = xor_add(sm, 32);
            const float mu = sm * (1.0f / 128.0f);
            float sq = 0.f;
#pragma unroll
            for (int et = 0; et < 8; ++et)
#pragma unroll
                for (int i = 0; i < 4; ++i) { const float dlt = nacc[et][i] - mu; sq += dlt * dlt; }
            sq = xor_add(sq, 16); sq = xor_add(sq, 32);
            const float rstd = rsqrtf(sq * (1.0f / 128.0f) + LN_EPS);
            const size_t trow = (size_t)(t0 + l);
            const bf16_t* og = projb + trow * LDP_ML + 3 * MIXW + h * 128;
            bf16_t* orow = hcat + trow * D + h * 128;
#pragma unroll
            for (int et = 0; et < 8; ++et) {
                const int e = et * 16 + 4 * g;
                const u32x2 ov = *(const u32x2*)(og + e);
                const f32x4 gv = *(const f32x4*)(ng_ + h * 128 + e);
                const float o0 = (nacc[et][0] - mu) * rstd * gv[0] * sigmoidf_(bflo(ov.x));
                const float o1 = (nacc[et][1] - mu) * rstd * gv[1] * sigmoidf_(bfhi(ov.x));
                const float o2 = (nacc[et][2] - mu) * rstd * gv[2] * sigmoidf_(bflo(ov.y));
                const float o3 = (nacc[et][3] - mu) * rstd * gv[3] * sigmoidf_(bfhi(ov.y));
                u32x2 w; w.x = cvtpk(o0, o1); w.y = cvtpk(o2, o3);
                *(u32x2*)(orow + e) = w;
                if (et & 1) __builtin_amdgcn_sched_barrier(0);
            }
        }
    }
}

constexpr int LN1_MAXT = 8;
DI void phase_ln1_route(const P& p, int layer, int bid, int nb, char* smem) {
    const bf16_t* z = (const bf16_t*)(p.ws + WS_Z);
    bf16_t* x1b = (bf16_t*)(p.ws + WS_X1B);
    float* gate = (float*)(p.ws + WS_GATE);
    int* list = (int*)(p.ws + WS_LIST);
    int* cnt = (int*)(p.ws + WS_CTL + CTL_CNT) + layer * 32 * CNT_STRIDE;
    const bf16_t* rwh = (const bf16_t*)(p.ws + WS_RWT);
    const bf16_t* rwl = rwh + NE * D;
    const float* lg = p.ln1_g + (size_t)layer * D;
    const float* lb = p.ln1_b + (size_t)layer * D;
    constexpr int XS = 1028;
    float* xs = (float*)smem;
    float* red = xs + 16 * XS;
    float* scs = red + 8 * 16 * 32;
    int* lcnt = (int*)(scs + 16 * 32);
    int* gbase = lcnt + 32;
    int* sel = gbase + 32;
    const int tid = tid_opaque(), lane = tid & 63, wid = tid >> 6, r = lane & 15, g = lane >> 4;
    __syncthreads();
    if (tid < 32) lcnt[tid] = 0;
    const float rb_e = p.router_b[tid & 31];
    bf16x8 wh[4][2], wl[4][2];
#pragma unroll
    for (int ks = 0; ks < 4; ++ks)
#pragma unroll
        for (int nt = 0; nt < 2; ++nt) {
            const size_t o = (size_t)(nt * 16 + r) * D + wid * 128 + ks * 32 + 8 * g;
            wh[ks][nt] = *(const bf16x8*)(rwh + o); wl[ks][nt] = *(const bf16x8*)(rwl + o);
        }
    f32x4 lgv[2][2], lbv[2][2];
#pragma unroll
    for (int i = 0; i < 2; ++i) { const int col = i * 512 + lane * 8; lgv[i][0] = *(const f32x4*)(lg + col); lgv[i][1] = *(const f32x4*)(lg + col + 4); lbv[i][0] = *(const f32x4*)(lb + col); lbv[i][1] = *(const f32x4*)(lb + col + 4); }
    u32x4 zn[2][2];
    if (bid < T / 16) {
#pragma unroll
        for (int rr = 0; rr < 2; ++rr)
#pragma unroll
            for (int i = 0; i < 2; ++i) zn[rr][i] = *(const u32x4*)(z + (size_t)(bid * 16 + wid * 2 + rr) * D + i * 512 + lane * 8);
    }
    int ti = 0;
    for (int task = bid; task < T / 16; task += nb, ++ti) {
        const int row0 = task * 16;
        u32x4 zc[2][2];
#pragma unroll
        for (int rr = 0; rr < 2; ++rr)
#pragma unroll
            for (int i = 0; i < 2; ++i) zc[rr][i] = zn[rr][i];
        if (task + nb < T / 16) {
#pragma unroll
            for (int rr = 0; rr < 2; ++rr)
#pragma unroll
                for (int i = 0; i < 2; ++i) zn[rr][i] = *(const u32x4*)(z + (size_t)((task + nb) * 16 + wid * 2 + rr) * D + i * 512 + lane * 8);
        }
        __syncthreads();
#pragma unroll
        for (int rr = 0; rr < 2; ++rr) {
            const int lr = wid * 2 + rr;
            const size_t t = (size_t)(row0 + lr);
            float v[2][8];
            float s = 0.f;
#pragma unroll
            for (int i = 0; i < 2; ++i) {
#pragma unroll
                for (int q = 0; q < 4; ++q) { v[i][2 * q] = bflo(zc[rr][i][q]); v[i][2 * q + 1] = bfhi(zc[rr][i][q]); s += v[i][2 * q] + v[i][2 * q + 1]; }
            }
            s = wave_sum(s);
            const float mu = s * (1.0f / D);
            float q2 = 0.f;
#pragma unroll
            for (int i = 0; i < 2; ++i)
#pragma unroll
                for (int k = 0; k < 8; ++k) { const float d = v[i][k] - mu; q2 += d * d; }
            q2 = wave_sum(q2);
            const float rstd = rsqrtf(q2 * (1.0f / D) + LN_EPS);
#pragma unroll
            for (int i = 0; i < 2; ++i) {
                const int col = i * 512 + lane * 8;
                const f32x4 g0 = lgv[i][0], g1 = lgv[i][1], b0 = lbv[i][0], b1 = lbv[i][1];
                f32x4 o0, o1;
#pragma unroll
                for (int k = 0; k < 4; ++k) { o0[k] = (v[i][k] - mu) * rstd * g0[k] + b0[k]; o1[k] = (v[i][4 + k] - mu) * rstd * g1[k] + b1[k]; }
                u32x4 w; w.x = cvtpk(o0[0], o0[1]); w.y = cvtpk(o0[2], o0[3]); w.z = cvtpk(o1[0], o1[1]); w.w = cvtpk(o1[2], o1[3]);
                *(u32x4*)(x1b + t * D + col) = w;
                *(f32x4*)(xs + lr * XS + col) = o0;
                *(f32x4*)(xs + lr * XS + col + 4) = o1;
            }
        }
        __syncthreads();
        {
            f32x4 acc0 = (f32x4){0.f, 0.f, 0.f, 0.f}, acc1 = (f32x4){0.f, 0.f, 0.f, 0.f};
#pragma unroll
            for (int ks = 0; ks < 4; ++ks) {
                const int k = wid * 128 + ks * 32 + 8 * g;
                const f32x4 xa0 = *(const f32x4*)(xs + r * XS + k), xa1 = *(const f32x4*)(xs + r * XS + k + 4);
                u32x4 hw, lw;
                hw.x = cvtpk(xa0[0], xa0[1]); hw.y = cvtpk(xa0[2], xa0[3]); hw.z = cvtpk(xa1[0], xa1[1]); hw.w = cvtpk(xa1[2], xa1[3]);
                lw.x = cvtpk(xa0[0] - bflo(hw.x), xa0[1] - bfhi(hw.x)); lw.y = cvtpk(xa0[2] - bflo(hw.y), xa0[3] - bfhi(hw.y));
                lw.z = cvtpk(xa1[0] - bflo(hw.z), xa1[1] - bfhi(hw.z)); lw.w = cvtpk(xa1[2] - bflo(hw.w), xa1[3] - bfhi(hw.w));
                const bf16x8 xh = __builtin_bit_cast(bf16x8, hw), xl = __builtin_bit_cast(bf16x8, lw);
                acc0 = mfma16(wh[ks][0], xh, acc0); acc0 = mfma16(wh[ks][0], xl, acc0); acc0 = mfma16(wl[ks][0], xh, acc0);
                acc1 = mfma16(wh[ks][1], xh, acc1); acc1 = mfma16(wh[ks][1], xl, acc1); acc1 = mfma16(wl[ks][1], xh, acc1);
            }
            *(f32x4*)(red + (wid * 16 + r) * 32 + 4 * g) = acc0;
            *(f32x4*)(red + (wid * 16 + r) * 32 + 16 + 4 * g) = acc1;
        }
        __syncthreads();
        {
            const int e = tid & 31, i = tid >> 5;
            float s = 0.f;
#pragma unroll
            for (int w = 0; w < 8; ++w) s += red[(w * 16 + i) * 32 + e];
            const float sc = sigmoidf_(s), sv = sc + rb_e;
            const float a1 = __shfl_xor(sv, 1, 64), a2 = __shfl_xor(sv, 2, 64), a3 = __shfl_xor(sv, 3, 64);
            const float c1 = __shfl_xor(sc, 1, 64), c2 = __shfl_xor(sc, 2, 64), c3 = __shfl_xor(sc, 3, 64);
            const float lo1 = fminf(sv, a1), hi1 = fmaxf(sv, a1), lo2 = fminf(a2, a3), hi2 = fmaxf(a2, a3);
            float bv = fmaxf(hi1, hi2) + fmaxf(fminf(hi1, hi2), fmaxf(lo1, lo2));
            int bg = e >> 2;
#pragma unroll
            for (int m = 4; m <= 16; m <<= 1) {
                const float ov = __shfl_xor(bv, m, 64); const int og = __shfl_xor(bg, m, 64);
                if (ov > bv || (ov == bv && og < bg)) { bv = ov; bg = og; }
            }
            if (e == bg * 4) {
                const float vv[4] = {sv, a1, a2, a3}, cc[4] = {sc, c1, c2, c3};
                int i1 = 0; float v1 = vv[0];
#pragma unroll
                for (int k = 1; k < 4; ++k) if (vv[k] > v1) { v1 = vv[k]; i1 = k; }
                int i2 = -1; float v2 = -3.0e38f, s1 = cc[0], s2 = 0.f;
#pragma unroll
                for (int k = 0; k < 4; ++k) { if (k == i1) s1 = cc[k]; }
#pragma unroll
                for (int k = 0; k < 4; ++k) if (k != i1 && vv[k] > v2) { v2 = vv[k]; i2 = k; s2 = cc[k]; }
                const int e1 = bg * 4 + i1, e2 = bg * 4 + i2;
                const float inv = 1.0f / (s1 + s2);
                const int t = row0 + i;
                gate[t * 2] = s1 * inv; gate[t * 2 + 1] = s2 * inv;
                const int lp1 = atomicAdd(&lcnt[e1], 1);
                const int lp2 = atomicAdd(&lcnt[e2], 1);
                if (ti < LN1_MAXT) { sel[(ti * 16 + i) * 2] = e1 | (lp1 << 8); sel[(ti * 16 + i) * 2 + 1] = e2 | (lp2 << 8); }
            }
        }
    }
    __syncthreads();
    const int tz = tid_opaque();
    if (tz < 32) { const int c = lcnt[tz]; gbase[tz] = c ? atomicAdd(&cnt[tz * CNT_STRIDE], c) : 0; }
    __syncthreads();
    if (tz < ti * 32) {
        const int tl = tz >> 5, rw = (tz >> 1) & 15, k = tz & 1;
        const int sv = sel[tz];
        const int e = sv & 255, lp = sv >> 8;
        list[(size_t)e * T + gbase[e] + lp] = ((bid + tl * nb) * 16 + rw) * 2 + k;
    }
}

DI void phase_ln2(const P& p, int layer, int bid, int nb) {
    const bf16_t* x1b = (const bf16_t*)(p.ws + WS_X1B);
    const bf16_t* yasg = (const bf16_t*)(p.ws + WS_YASG);
    bf16_t* xb = (bf16_t*)(p.ws + WS_XB);
    const float* lg = p.ln2_g + (size_t)layer * D;
    const float* lb = p.ln2_b + (size_t)layer * D;
    const int tid = tid_opaque(), lane = tid & 63, wid = tid >> 6;
    f32x4 lgv[2][2], lbv[2][2];
#pragma unroll
    for (int i = 0; i < 2; ++i) { const int col = i * 512 + lane * 8; lgv[i][0] = *(const f32x4*)(lg + col); lgv[i][1] = *(const f32x4*)(lg + col + 4); lbv[i][0] = *(const f32x4*)(lb + col); lbv[i][1] = *(const f32x4*)(lb + col + 4); }
    u32x4 nx_[2], ny0[2], ny1[2];
    {
        const int t = bid * NWAVES + wid;
        if (t < T) {
#pragma unroll
            for (int i = 0; i < 2; ++i) {
                const int col = i * 512 + lane * 8;
                nx_[i] = *(const u32x4*)(x1b + (size_t)t * D + col);
                ny0[i] = *(const u32x4*)(yasg + (size_t)(2 * t) * D + col);
                ny1[i] = *(const u32x4*)(yasg + (size_t)(2 * t + 1) * D + col);
            }
        }
    }
    for (int t = bid * NWAVES + wid; t < T; t += nb * NWAVES) {
        float v[2][8];
        float s = 0.f;
        u32x4 cx[2], cy0[2], cy1[2];
#pragma unroll
        for (int i = 0; i < 2; ++i) { cx[i] = nx_[i]; cy0[i] = ny0[i]; cy1[i] = ny1[i]; }
        {
            const int tn = t + nb * NWAVES;
            if (tn < T) {
#pragma unroll
                for (int i = 0; i < 2; ++i) {
                    const int col = i * 512 + lane * 8;
                    nx_[i] = *(const u32x4*)(x1b + (size_t)tn * D + col);
                    ny0[i] = *(const u32x4*)(yasg + (size_t)(2 * tn) * D + col);
                    ny1[i] = *(const u32x4*)(yasg + (size_t)(2 * tn + 1) * D + col);
                }
            }
        }
#pragma unroll
        for (int i = 0; i < 2; ++i) {
            const u32x4 xv = cx[i], y0 = cy0[i], y1 = cy1[i];
#pragma unroll
            for (int q = 0; q < 4; ++q) {
                v[i][2 * q] = bflo(xv[q]) * ALPHA + (bflo(y0[q]) + bflo(y1[q]));
                v[i][2 * q + 1] = bfhi(xv[q]) * ALPHA + (bfhi(y0[q]) + bfhi(y1[q]));
                s += v[i][2 * q] + v[i][2 * q + 1];
            }
        }
        s = wave_sum(s);
        const float mu = s * (1.0f / D);
        float q2 = 0.f;
#pragma unroll
        for (int i = 0; i < 2; ++i)
#pragma unroll
            for (int k = 0; k < 8; ++k) { const float d = v[i][k] - mu; q2 += d * d; }
        q2 = wave_sum(q2);
        const float rstd = rsqrtf(q2 * (1.0f / D) + LN_EPS);
#pragma unroll
        for (int i = 0; i < 2; ++i) {
            const int col = i * 512 + lane * 8;
            const f32x4 g0 = lgv[i][0], g1 = lgv[i][1], b0 = lbv[i][0], b1 = lbv[i][1];
            f32x4 o0, o1;
#pragma unroll
            for (int k = 0; k < 4; ++k) { o0[k] = (v[i][k] - mu) * rstd * g0[k] + b0[k]; o1[k] = (v[i][4 + k] - mu) * rstd * g1[k] + b1[k]; }
            if (layer == DEPTH - 1) {
                *(f32x4*)(p.out + (size_t)t * D + col) = o0;
                *(f32x4*)(p.out + (size_t)t * D + col + 4) = o1;
            } else {
                u32x4 w; w.x = cvtpk(o0[0], o0[1]); w.y = cvtpk(o0[2], o0[3]); w.z = cvtpk(o1[0], o1[1]); w.w = cvtpk(o1[2], o1[3]);
                *(u32x4*)(xb + (size_t)t * D + col) = w;
            }
        }
    }
}

#define XB_TMO      128
#define XB_XCNT(j)  (256  + 64 * (j))
#define XB_XSUB(j)  (1280 + 64 * (j))
#define XB_XGEN(j)  (2304 + 64 * (j))
#define XB_TOP      3328
#define XB_TOPGEN   3392
#define XCD_BAR_WORDS 3456
#define XB_SPIN_CAP (1u << 20)
DI unsigned xb_ld(unsigned* p_) { return __hip_atomic_load(p_, __ATOMIC_RELAXED, __HIP_MEMORY_SCOPE_AGENT); }
DI unsigned xb_add(unsigned* p_, unsigned v) { return __hip_atomic_fetch_add(p_, v, __ATOMIC_RELAXED, __HIP_MEMORY_SCOPE_AGENT); }
DI unsigned xb_xcc_id() { return (unsigned)__builtin_amdgcn_s_getreg((3 << 11) | 20) & 0xFu; }
#define XB_SPIN(cond, bar) do { unsigned _sp = 0; while (cond) { __builtin_amdgcn_s_sleep(1); \
    if ((++_sp & 255u) == 0u) { if (xb_ld(&(bar)[XB_TMO])) break; if (_sp > XB_SPIN_CAP) { atomicAdd(&(bar)[XB_TMO], 1u); break; } } } } while (0)
struct XcdBarrier { unsigned* bar; unsigned x; volatile LAS unsigned* st; };
DI XcdBarrier xcd_barrier_post(unsigned* bar, volatile LAS unsigned* st) {
    XcdBarrier b; b.bar = bar; b.x = xb_xcc_id(); b.st = st;
    if (threadIdx.x == 0) (void)xb_add(&bar[XB_XCNT(b.x)], 1u);
    return b;
}
DI void xcd_barrier_complete(unsigned* bar, unsigned x, unsigned& nloc, unsigned& nx) {
    const unsigned G = gridDim.x * gridDim.y * gridDim.z;
    unsigned sum, cnt, mine, sp = 0u;
    for (;;) {
        sum = 0u; cnt = 0u; mine = 0u;
#pragma unroll
        for (unsigned j = 0; j < 16; ++j) { const unsigned c = xb_ld(&bar[XB_XCNT(j)]); sum += c; cnt += (c > 0u) ? 1u : 0u; mine = (j == x) ? c : mine; }
        if (sum == G) break;
        __builtin_amdgcn_s_sleep(1);
        if ((++sp & 255u) == 0u) { if (xb_ld(&bar[XB_TMO])) break; if (sp > XB_SPIN_CAP) { atomicAdd(&bar[XB_TMO], 1u); break; } }
    }
    nloc = mine > 0u ? mine : 1u; nx = cnt > 0u ? cnt : 1u;
}
DI void xcd_barrier(const XcdBarrier& b) {
    asm volatile("s_waitcnt vmcnt(0)" ::: "memory");
    __syncthreads();
    if (tid_opaque() == 0) {
        unsigned* bar = b.bar;
        __builtin_amdgcn_s_waitcnt(0);
        unsigned nloc = b.st[0], nx = b.st[1];
        if (nloc == 0u) { xcd_barrier_complete(bar, b.x, nloc, nx); b.st[0] = nloc; b.st[1] = nx; }
        const unsigned old = xb_add(&bar[XB_XSUB(b.x)], 1u);
        const unsigned gen = old / nloc;
        if (old + 1u == (gen + 1u) * nloc) {
            __builtin_amdgcn_fence(__ATOMIC_RELEASE, "agent");
            asm volatile("s_waitcnt vmcnt(0)" ::: "memory");
            const unsigned og = xb_add(&bar[XB_TOP], 1u);
            const unsigned tg = og / nx;
            if (og + 1u == (tg + 1u) * nx) xb_add(&bar[XB_TOPGEN], 1u);
            else XB_SPIN(xb_ld(&bar[XB_TOPGEN]) == tg, bar);
            __builtin_amdgcn_fence(__ATOMIC_ACQUIRE, "agent");
            xb_add(&bar[XB_XGEN(b.x)], 1u);
            asm volatile("s_waitcnt vmcnt(0)" ::: "memory");
        } else {
            XB_SPIN(xb_ld(&bar[XB_XGEN(b.x)]) == gen, bar);
            __builtin_amdgcn_fence(__ATOMIC_ACQUIRE, "agent");
            asm volatile("s_waitcnt vmcnt(0)" ::: "memory");
        }
    }
    __syncthreads();
}

enum { PH_INPROJ = 0, PH_MIX1, PH_MIX2, PH_MIX3, PH_OUTPROJ, PH_LN1, PH_MOE, PH_LN2, PH_PER_LAYER, PH_PREP = 100, PH_KV = 101 };

DI void run_phase(const P& p, int ph, int layer, int bid, int nb, char* smem) {
    const bool conv = (layer & 1) == 0;
    if (ph == PH_PREP) phase_prep(p, bid, nb, smem);
    if (ph == PH_KV) phase_kv(p, bid, nb, smem);
    if (ph == PH_INPROJ) phase_inproj(p, layer, bid, nb, smem);
    if (ph == PH_MIX1) phase_ml_local(p, layer, bid, nb, smem);
    if (ph == PH_MIX2) phase_ml_scan(p, bid, nb);
    if (ph == PH_MIX3) {
        if (conv) phase_convmix(p, layer, bid, nb);
        else phase_ml_out(p, layer, bid, nb, smem);
    }
    if (ph == PH_MIX1 || (ph == PH_MIX3 && conv)) phase_xattn(p, layer, bid, nb, smem);
    if (ph == PH_OUTPROJ) phase_outproj(p, layer, bid, nb, smem);
    if (ph == PH_LN1) { phase_ln1_route(p, layer, bid, nb, smem); if (layer > 0) moe_steal(p, 1 << 20, (layer + 1) * MOE_TILES_PER_LAYER, nullptr, 0u, smem); }
    if (ph == PH_MOE) phase_moe(p, layer, bid, nb, smem);
    if (ph == PH_LN2) phase_ln2(p, layer, bid, nb);
}

__global__ void __launch_bounds__(NTHREADS, 2) mega(P p) {
    __shared__ __attribute__((aligned(16))) char smem[SMEM_BYTES];
    const int bid = blockIdx.x, nb = gridDim.x;
    volatile LAS unsigned* st = (volatile LAS unsigned*)(smem + SMEM_BYTES - 16);
    if (threadIdx.x == 0) { st[0] = 0u; st[1] = 0u; }
    __syncthreads();
    XcdBarrier xb = xcd_barrier_post((unsigned*)(p.ws + WS_CTL), st);
#pragma unroll 1
    for (int s = -2; s < DEPTH * PH_PER_LAYER; ++s) {
        int ph = (s == -2) ? (int)PH_PREP : (s == -1) ? (int)PH_KV : s % PH_PER_LAYER;
        int layer = (s < 0) ? 0 : s / PH_PER_LAYER;
        if ((layer & 1) == 0 && (ph == PH_MIX1 || ph == PH_MIX2)) continue;
        int b_ = bid, n_ = nb;
        asm volatile("" : "+s"(ph), "+s"(layer), "+s"(b_), "+s"(n_));
        P q = p;
        asm volatile("" : "+s"(q.ws));
        run_phase(q, ph, layer, b_, n_, smem);
#ifdef PROBE_MASK
        if (ph < 31 && ((PROBE_MASK >> ph) & 1)) { __syncthreads(); run_phase(q, ph, layer, b_, n_, smem); }
#endif
        if (ph != PH_KV) xcd_barrier(xb);
    }
}

extern "C" void kernel_launch(void* const* d_in, const int* in_sizes, int n_in, void* d_out, int out_size, void* d_ws, size_t ws_size,
                              hipStream_t stream) {
    if (ws_size < WS_TOTAL) { fprintf(stderr, "kernel_launch: workspace too small: %zu < %zu\n", ws_size, (size_t)WS_TOTAL); return; }
    static int grid_blocks = 0;
    if (!grid_blocks) {
        int dev = 0, cus = 0, per_cu = 0;
        (void)hipGetDevice(&dev);
        (void)hipDeviceGetAttribute(&cus, hipDeviceAttributeMultiprocessorCount, dev);
        if (hipOccupancyMaxActiveBlocksPerMultiprocessor(&per_cu, (const void*)mega, NTHREADS, 0) != hipSuccess) per_cu = 0;
        if (per_cu < 1 || cus < 1) { fprintf(stderr, "kernel_launch: occupancy query failed (per_cu=%d cus=%d)\n", per_cu, cus); return; }
        grid_blocks = cus;
    }
    P p{};
    p.x = (const float*)d_in[0]; p.mem = (const float*)d_in[1]; p.conv_w_in = (const float*)d_in[2]; p.conv_w = (const float*)d_in[3];
    p.ml_w_in = (const float*)d_in[4]; p.ml_gate_b = (const float*)d_in[5]; p.ml_norm_g = (const float*)d_in[6]; p.w_kv = (const float*)d_in[7];
    p.w_out = (const float*)d_in[8]; p.ln1_g = (const float*)d_in[9]; p.ln1_b = (const float*)d_in[10]; p.ln2_g = (const float*)d_in[11];
    p.ln2_b = (const float*)d_in[12]; p.router_w = (const float*)d_in[13]; p.router_b = (const float*)d_in[14]; p.w_gate = (const float*)d_in[15];
    p.w_up = (const float*)d_in[16]; p.w_down = (const float*)d_in[17];
    p.out = (float*)d_out; p.ws = (char*)d_ws;
    (void)hipMemsetAsync((char*)d_ws + WS_CTL, 0, CTL_BYTES, stream);
    void* args[] = {&p};
    hipError_t e = hipLaunchCooperativeKernel((const void*)mega, dim3(grid_blocks), dim3(NTHREADS), args, 0, stream);
    if (e != hipSuccess) fprintf(stderr, "kernel_launch: cooperative launch failed: %s (grid %d)\n", hipGetErrorString(e), grid_blocks);
}
```

```cpp
#include <hip/hip_runtime.h>
#include <stdint.h>
#include <stdio.h>

typedef unsigned short bf16_t;
typedef __attribute__((ext_vector_type(8))) short bf16x8;
typedef __attribute__((ext_vector_type(4))) float f32x4;
typedef __attribute__((ext_vector_type(4))) unsigned u32x4;
typedef __attribute__((ext_vector_type(2))) unsigned u32x2;

#define DI __device__ __forceinline__
#define LAS __attribute__((address_space(3)))

constexpr int D = 1024;
constexpr int NBATCH = 8;
constexpr int SEQ = 2048;
constexpr int T = NBATCH * SEQ;
constexpr int DEPTH = 4;
constexpr int MIXW = 768;
constexpr int XH = 4, XDH = 64, XW = 256, MEML = 256;
constexpr int MLH = 6, MLDH = 128, CHUNK = 128, NCH = SEQ / CHUNK;
constexpr int DIN_CONV = 2560, DIN_ML = 3340, LDP_ML = 3328, NV_ML = 3584;
constexpr int NE = 32, DFF = 512;
constexpr float ALPHA = 1.681792830507429f;
constexpr float LN_EPS = 1e-5f;

constexpr int NTHREADS = 512;
constexpr int NWAVES = 8;
constexpr int STAGE_BYTES = 131072;
constexpr int META_OFF = STAGE_BYTES;
constexpr int SMEM_BYTES = STAGE_BYTES + 4096;

constexpr size_t al256(size_t x) { return (x + 255) & ~(size_t)255; }
constexpr size_t WS_CTL   = 0;
constexpr size_t CTL_BYTES = 128 * 1024;
constexpr size_t CTL_CNT  = 32 * 1024;
constexpr int CNT_STRIDE = 64;
constexpr size_t CTL_READY = 64 * 1024;
constexpr size_t CTL_STOP = 14 * 1024;
constexpr size_t CTL_TMO  = 15 * 1024;
constexpr size_t CTL_TQ   = 16 * 1024;
constexpr size_t WS_XB    = WS_CTL + CTL_BYTES;
constexpr size_t WS_MEMB  = WS_XB + (size_t)T * D * 2;
constexpr size_t WS_KBUF  = WS_MEMB + (size_t)NBATCH * MEML * D * 2;
constexpr size_t WS_VT    = WS_KBUF + (size_t)DEPTH * NBATCH * MEML * XW * 2;
constexpr size_t WS_PROJ  = WS_VT + (size_t)DEPTH * NBATCH * MEML * XW * 2;
constexpr size_t WS_Z     = WS_PROJ;
constexpr size_t WS_LOGI  = WS_PROJ + (size_t)T * LDP_ML * 2;
constexpr size_t WS_CT    = WS_LOGI + (size_t)T * 16 * 4;
constexpr size_t WS_CPB   = WS_CT + (size_t)48 * NCH * 128 * 128 * 4;
constexpr size_t WS_NLOC  = WS_CPB + (size_t)48 * NCH * 128 * 128 * 2;
constexpr size_t WS_NPREV = WS_NLOC + (size_t)48 * NCH * 128 * 4;
constexpr size_t WS_MLOC  = WS_NPREV + (size_t)48 * NCH * 128 * 4;
constexpr size_t WS_GSUM  = WS_MLOC + al256(48 * NCH * 4);
constexpr size_t WS_MPREV = WS_GSUM + al256(48 * NCH * 4);
constexpr size_t WS_HCAT  = WS_MPREV + al256(48 * NCH * 4);
constexpr size_t WS_X1B   = WS_HCAT + (size_t)T * D * 2;
constexpr size_t WS_GATE  = WS_X1B + (size_t)T * D * 2;
constexpr size_t WS_LIST  = WS_GATE + (size_t)T * 2 * 4;
constexpr size_t WS_HBUF  = WS_LIST + (size_t)NE * T * 4;
constexpr size_t WS_YASG  = WS_HBUF + (size_t)T * 2 * DFF * 2;
constexpr size_t WS_WIN   = WS_YASG + (size_t)T * 2 * D * 2;
constexpr size_t WS_WKV   = WS_WIN + ((size_t)2 * DIN_CONV + (size_t)2 * NV_ML) * D * 2;
constexpr size_t WS_WOUT  = WS_WKV + (size_t)DEPTH * 512 * D * 2;
constexpr size_t WS_WGU   = WS_WOUT + (size_t)DEPTH * D * D * 2;
constexpr size_t WS_WD    = WS_WGU + (size_t)DEPTH * NE * 1024 * D * 2;
constexpr size_t WS_RWT   = WS_WD + (size_t)DEPTH * NE * D * DFF * 2;
constexpr size_t WS_TOTAL = WS_RWT + (size_t)2 * NE * D * 2;

struct P {
    const float *x, *mem, *conv_w_in, *conv_w, *ml_w_in, *ml_gate_b, *ml_norm_g, *w_kv, *w_out;
    const float *ln1_g, *ln1_b, *ln2_g, *ln2_b, *router_w, *router_b, *w_gate, *w_up, *w_down;
    float* out;
    char* ws;
};

DI unsigned cvtpk(float lo, float hi) { unsigned r; asm("v_cvt_pk_bf16_f32 %0, %1, %2" : "=v"(r) : "v"(lo), "v"(hi)); return r; }
DI float bf2f(bf16_t v) { return __uint_as_float(((unsigned)v) << 16); }
DI float bflo(unsigned v) { return __uint_as_float(v << 16); }
DI float bfhi(unsigned v) { return __uint_as_float(v & 0xffff0000u); }
DI bf16_t f2bf(float f) { return (bf16_t)(cvtpk(f, f) & 0xffffu); }
DI float sigmoidf_(float x) { return 1.0f / (1.0f + __expf(-x)); }
DI float logsigmoidf_(float x) { return fminf(x, 0.0f) - log1pf(__expf(-fabsf(x))); }
DI float xor_add(float v, int m) { return v + __shfl_xor(v, m, 64); }
DI float xor_max(float v, int m) { return fmaxf(v, __shfl_xor(v, m, 64)); }
DI float wave_sum(float v) { v = xor_add(v, 32); v = xor_add(v, 16); v = xor_add(v, 8); v = xor_add(v, 4); v = xor_add(v, 2); v = xor_add(v, 1); return v; }
DI int tid_opaque() { int t = threadIdx.x; asm volatile("" : "+v"(t)); return t; }
DI f32x4 mfma16(bf16x8 a, bf16x8 b, f32x4 c) { return __builtin_amdgcn_mfma_f32_16x16x32_bf16(a, b, c, 0, 0, 0); }

namespace g8 {
constexpr int BM = 256, BK = 64, HALF = 128, HTB = HALF * BK * 2, NXCD = 8, WGM = 4;
DI int lds_byte(int r, int c) { const int st = (r >> 4) * 2 + (c >> 5), rr = r & 15, cc = c & 31, ob = rr * 64 + cc * 2; return st * 1024 + (ob ^ (((ob >> 9) & 1) << 5)); }
DI void stage_rc(int b, int& R, int& C) { const int st = b / 1024, sb = b % 1024, swz = sb ^ (((sb >> 9) & 1) << 5); R = (st >> 1) * 16 + swz / 64; C = (st & 1) * 32 + (swz % 64) / 2; }
DI int perm32(int rho) { const int n = rho >> 4, i = rho & 15; return 8 * (i >> 2) + 4 * n + (i & 3); }
DI int xcd_remap(int L, int n) { const int q = n / NXCD, r = n % NXCD, xcd = L % NXCD, off = L / NXCD; return (xcd < r ? xcd * (q + 1) : r * (q + 1) + (xcd - r) * q) + off; }

struct Unit { int pm, pn, e, valid, rbase, rti; };
DI const char* uni(const char* p_) {
    const unsigned long long v = (unsigned long long)p_;
    const unsigned lo = (unsigned)__builtin_amdgcn_readfirstlane((int)(unsigned)v), hi = (unsigned)__builtin_amdgcn_readfirstlane((int)(unsigned)(v >> 32));
    return (const char*)(((unsigned long long)hi << 32) | lo);
}

template <bool GATHER, class Epi, class Sched>
DI void gemm_phase(LAS unsigned char* lds, const int K, const Sched& S, const Epi& E) {
    const int tid = tid_opaque(), wid = __builtin_amdgcn_readfirstlane(tid >> 6), lane = tid & 63, wr = wid >> 2, wc = wid & 3, fr = lane & 15, fq = lane >> 4;
    const int nt = K / BK;
    const size_t kstep = (size_t)(BK * 2);
    const size_t hstep = (size_t)HALF * K * 2;
    unsigned vB0, vB1;
    {
        int R0, C0, R1, C1;
        stage_rc(tid * 16, R0, C0); stage_rc(tid * 16 + 8192, R1, C1);
        const int Rb0 = Epi::PERM ? ((R0 & ~31) + perm32(R0 & 31)) : R0, Rb1 = Epi::PERM ? ((R1 & ~31) + perm32(R1 & 31)) : R1;
        vB0 = (unsigned)(Rb0 * K + C0) * 2u; vB1 = (unsigned)(Rb1 * K + C1) * 2u;
    }
    const unsigned ldsw = (unsigned)wid * 1024u;
    const int aoff = lds_byte(wr * 64 + fr, fq * 8), boff = lds_byte(wc * 32 + fr, fq * 8);
#define G8_SA(b, h) (((b) * 2 + (h)) * HTB)
#define G8_SB(b, h) ((4 + (b) * 2 + (h)) * HTB)
#define G8_STAGE(bufoff, gbase, v0, v1) do { unsigned _o0 = (v0), _o1 = (v1); asm volatile("" : "+v"(_o0), "+v"(_o1));     \
        __builtin_amdgcn_global_load_lds((const unsigned*)((const char*)(gbase) + _o0), (LAS unsigned*)(lds + (bufoff) + ldsw), 16, 0, 0); \
        __builtin_amdgcn_global_load_lds((const unsigned*)((const char*)(gbase) + _o1), (LAS unsigned*)(lds + (bufoff) + ldsw + 8192), 16, 0, 0); } while (0)
#define G8_LDA(dst, b, h) do { _Pragma("unroll") for (int m = 0; m < 4; ++m) _Pragma("unroll") for (int k = 0; k < 2; ++k) dst[m][k] = *(const LAS bf16x8*)(lds + G8_SA(b, h) + aoff + m * 2048 + k * 1024); } while (0)
#define G8_LDB(dst, b, h) do { _Pragma("unroll") for (int n = 0; n < 2; ++n) _Pragma("unroll") for (int k = 0; k < 2; ++k) dst[n][k] = *(const LAS bf16x8*)(lds + G8_SB(b, h) + boff + n * 2048 + k * 1024); } while (0)
#define G8_MMA(ai, bj, At, Bt) do { __builtin_amdgcn_s_setprio(1); _Pragma("unroll") for (int m = 0; m < 4; ++m) _Pragma("unroll") for (int n = 0; n < 2; ++n) _Pragma("unroll") for (int k = 0; k < 2; ++k) \
        acc[ai][bj][m][n] = __builtin_amdgcn_mfma_f32_16x16x32_bf16(Bt[n][k], At[m][k], acc[ai][bj][m][n], 0, 0, 0); __builtin_amdgcn_s_setprio(0); } while (0)
#define G8_WAIT_V(n) asm volatile("s_waitcnt vmcnt(" #n ")" ::: "memory")
#define G8_WAIT_L(n) asm volatile("s_waitcnt lgkmcnt(" #n ")" ::: "memory")
#define G8_BAR __builtin_amdgcn_s_barrier()
#define G8_SCHED __builtin_amdgcn_sched_barrier(0)
    Unit cur, nxt;
    int ui = 0;
    if (!S.next(0, cur)) return;
    f32x4 acc[2][2][4][2];
#pragma unroll
    for (int a = 0; a < 2; ++a)
#pragma unroll
        for (int b = 0; b < 2; ++b)
#pragma unroll
            for (int m = 0; m < 4; ++m)
#pragma unroll
                for (int n = 0; n < 2; ++n) acc[a][b][m][n] = (f32x4){0.f, 0.f, 0.f, 0.f};
    bf16x8 At[4][2], B0[2][2], B1[2][2];
    S.a_ready(cur);
    const char* cA = S.a_base(cur);
    const char* cB = S.b_base(cur);
    unsigned cv00, cv01, cv10, cv11, nv00, nv01, nv10, nv11;
    {
        int R0, C0, R1, C1;
        stage_rc(tid * 16, R0, C0); stage_rc(tid * 16 + 8192, R1, C1);
        int rows[2][2];
        S.a_rows(cur, R0, R1, rows);
        cv00 = (unsigned)(rows[0][0] * K + C0) * 2u; cv01 = (unsigned)(rows[0][1] * K + C1) * 2u;
        cv10 = (unsigned)(rows[1][0] * K + C0) * 2u; cv11 = (unsigned)(rows[1][1] * K + C1) * 2u;
        nv00 = cv00; nv01 = cv01; nv10 = cv10; nv11 = cv11;
    }
    G8_STAGE(G8_SB(0, 0), uni(cB), vB0, vB1); G8_STAGE(G8_SA(0, 0), uni(cA), cv00, cv01); G8_STAGE(G8_SB(0, 1), uni(cB + hstep), vB0, vB1); G8_STAGE(G8_SA(0, 1), uni(cA), cv10, cv11);
    if (wr == 1) G8_BAR;
    G8_WAIT_V(4); G8_BAR;
    G8_STAGE(G8_SB(1, 0), uni(cB + kstep), vB0, vB1); G8_STAGE(G8_SA(1, 0), uni(cA + kstep), cv00, cv01); G8_STAGE(G8_SB(1, 1), uni(cB + hstep + kstep), vB0, vB1);
    G8_WAIT_V(6); G8_BAR;
    for (;;) {
        const bool has_next = S.next(ui + 1, nxt);
        const char* nA = has_next ? S.a_base(nxt) : cA;
        const char* nB = has_next ? S.b_base(nxt) : cB;
        if (GATHER) {
            if (has_next) {
                const int tid2 = tid_opaque();
                int R0, C0, R1, C1;
                stage_rc(tid2 * 16, R0, C0); stage_rc(tid2 * 16 + 8192, R1, C1);
                int rows[2][2];
                S.a_rows(nxt, R0, R1, rows);
                nv00 = (unsigned)(rows[0][0] * K + C0) * 2u; nv01 = (unsigned)(rows[0][1] * K + C1) * 2u;
                nv10 = (unsigned)(rows[1][0] * K + C0) * 2u; nv11 = (unsigned)(rows[1][1] * K + C1) * 2u;
            } else { nv00 = cv00; nv01 = cv01; nv10 = cv10; nv11 = cv11; }
        }
        for (int t = 0; t < nt; t += 2) {
            const bool last = (t == nt - 2);
            if (last && has_next) S.a_ready(nxt);
            const char* a1 = uni(cA + (size_t)(t + 1) * kstep);
            const char* a2 = uni(last ? nA : cA + (size_t)(t + 2) * kstep);
            const char* b2 = uni(last ? nB : cB + (size_t)(t + 2) * kstep);
            const char* a3 = uni(a2 + kstep);
            const char* b3 = uni(b2 + kstep);
            const char* b2h = uni(b2 + hstep);
            const char* b3h = uni(b3 + hstep);
            unsigned x00 = cv00, x01 = cv01, x10 = cv10, x11 = cv11;
            if (GATHER) { x00 = last ? nv00 : cv00; x01 = last ? nv01 : cv01; x10 = last ? nv10 : cv10; x11 = last ? nv11 : cv11; }
            G8_LDB(B0, 0, 0); G8_SCHED; G8_LDA(At, 0, 0); G8_STAGE(G8_SA(1, 1), a1, cv10, cv11);
            G8_WAIT_L(8); G8_BAR; G8_WAIT_L(0); G8_MMA(0, 0, At, B0); G8_BAR; G8_SCHED;
            G8_LDB(B1, 0, 1); G8_STAGE(G8_SB(0, 0), b2, vB0, vB1);
            G8_BAR; G8_WAIT_L(0); G8_MMA(0, 1, At, B1); G8_BAR;
            G8_LDA(At, 0, 1); G8_STAGE(G8_SA(0, 0), a2, x00, x01);
            G8_BAR; G8_WAIT_L(0); G8_MMA(1, 0, At, B0); G8_BAR; G8_SCHED;
            G8_STAGE(G8_SB(0, 1), b2h, vB0, vB1);
            G8_WAIT_V(6);
            G8_BAR; G8_MMA(1, 1, At, B1); G8_BAR;
            G8_LDB(B0, 1, 0); G8_SCHED; G8_LDA(At, 1, 0); G8_STAGE(G8_SA(0, 1), a2, x10, x11);
            G8_WAIT_L(8); G8_BAR; G8_WAIT_L(0); G8_MMA(0, 0, At, B0); G8_BAR; G8_SCHED;
            G8_LDB(B1, 1, 1); G8_STAGE(G8_SB(1, 0), b3, vB0, vB1);
            G8_BAR; G8_WAIT_L(0); G8_MMA(0, 1, At, B1); G8_BAR;
            G8_LDA(At, 1, 1); G8_STAGE(G8_SA(1, 0), a3, x00, x01);
            G8_BAR; G8_WAIT_L(0); G8_MMA(1, 0, At, B0); G8_BAR; G8_SCHED;
            G8_STAGE(G8_SB(1, 1), b3h, vB0, vB1);
            G8_WAIT_V(6); G8_BAR; G8_MMA(1, 1, At, B1); G8_BAR;
        }
        E(acc, cur, wr, wc, fr, fq);
        if (!has_next) break;
#pragma unroll
        for (int a = 0; a < 2; ++a)
#pragma unroll
            for (int b = 0; b < 2; ++b)
#pragma unroll
                for (int m = 0; m < 4; ++m)
#pragma unroll
                    for (int n = 0; n < 2; ++n) acc[a][b][m][n] = (f32x4){0.f, 0.f, 0.f, 0.f};
        cur = nxt; cA = nA; cB = nB; ++ui;
        if (GATHER) { cv00 = nv00; cv01 = nv01; cv10 = nv10; cv11 = nv11; }
    }
    G8_WAIT_V(0);
    if (wr == 0) G8_BAR;
    G8_BAR;
#undef G8_SA
#undef G8_SB
#undef G8_STAGE
#undef G8_LDA
#undef G8_LDB
#undef G8_MMA
#undef G8_WAIT_V
#undef G8_WAIT_L
#undef G8_BAR
#undef G8_SCHED
}

struct DenseSched {
    const char* A; const char* Bt; int K, nM, nN, nwg, G, c;
    DI void init(const void* A_, const void* Bt_, int M, int N, int K_, int G_, int c_) { A = (const char*)A_; Bt = (const char*)Bt_; K = K_; nM = M / BM; nN = N / BM; nwg = nM * nN; G = G_; c = c_; }
    DI bool next(int i, Unit& u) const {
        const int L = i * G + c;
        if (L >= nwg) return false;
        const int wgid = xcd_remap(L, nwg);
        const int nig = WGM * nN, gid = wgid / nig, fm = gid * WGM, gsz = (nM - fm) < WGM ? (nM - fm) : WGM;
        u.pm = fm + ((wgid % nig) % gsz); u.pn = (wgid % nig) / gsz; u.e = 0; u.valid = 256; u.rbase = 0; u.rti = 0;
        return true;
    }
    DI const char* a_base(const Unit& u) const { return A + (size_t)u.pm * 256 * K * 2; }
    DI const char* b_base(const Unit& u) const { return Bt + (size_t)u.pn * 256 * K * 2; }
    DI void a_rows(const Unit&, int R0, int R1, int (&rows)[2][2]) const { rows[0][0] = R0; rows[0][1] = R1; rows[1][0] = 128 + R0; rows[1][1] = 128 + R1; }
    DI void a_ready(const Unit&) const {}
};
}


constexpr int TKT = 128;
struct TJ { const float* s[8]; float sc; bf16_t* d[4]; };
DI int tile_row(int kr) { return (kr >> 3) * 1060 + (kr & 7) * 129; }

template <class ColPtr>
DI void tj_make(TJ& j, ColPtr colptr, int ld, int k0, int v0, bf16_t* dst, int K, int tid) {
    float sc;
    const float* src = colptr(v0 + 4 * (tid & 31), sc);
    j.sc = sc;
#pragma unroll
    for (int i = 0; i < 8; ++i) j.s[i] = src + (size_t)(k0 + (tid >> 5) + 16 * i) * ld;
#pragma unroll
    for (int i = 0; i < 4; ++i) {
        const int ch = tid + NTHREADS * i, vr = ch >> 4, kc = ch & 15;
        j.d[i] = dst + (size_t)(v0 + vr) * K + k0 + kc * 8;
    }
}
DI void tj_load(const TJ& j, f32x4 (&v)[8]) {
#pragma unroll
    for (int i = 0; i < 8; ++i) v[i] = __builtin_nontemporal_load((const f32x4*)j.s[i]);
}
DI void tj_finish(const TJ& j, const f32x4 (&v)[8], float* tile, int tid) {
    __syncthreads();
#pragma unroll
    for (int i = 0; i < 8; ++i) {
        float* tp = tile + tile_row((tid >> 5) + 16 * i) + 4 * (tid & 31);
        tp[0] = v[i][0] * j.sc; tp[1] = v[i][1] * j.sc; tp[2] = v[i][2] * j.sc; tp[3] = v[i][3] * j.sc;
    }
    __syncthreads();
#pragma unroll
    for (int i = 0; i < 4; ++i) {
        const int ch = tid + NTHREADS * i, vr = ch >> 4, kc = ch & 15;
        const float* tp = tile + kc * 1060 + vr;
        u32x4 w;
        w.x = cvtpk(tp[0], tp[129]); w.y = cvtpk(tp[2 * 129], tp[3 * 129]); w.z = cvtpk(tp[4 * 129], tp[5 * 129]); w.w = cvtpk(tp[6 * 129], tp[7 * 129]);
        __builtin_nontemporal_store(w, (u32x4*)j.d[i]);
    }
}

constexpr int MOE_TILES_PER_LAYER = NE * (8 * 8 + 4 * 8);
DI void moe_tile_job(const P& p, int q, int tid, TJ& j) {
    const int layer = q / MOE_TILES_PER_LAYER, r = q % MOE_TILES_PER_LAYER;
    if (r < NE * 64) {
        const int le = layer * NE + (r >> 6), qq = r & 63, kt = qq >> 3, vt = qq & 7;
        const float* Wg = p.w_gate + (size_t)le * D * DFF;
        const float* Wu = p.w_up + (size_t)le * D * DFF;
        tj_make(j, [&](int v4, float& sc) { sc = 1.0f; const int grp = v4 >> 7; return ((grp & 1) ? Wu : Wg) + (grp >> 1) * 128 + (v4 & 127); },
                DFF, kt * TKT, vt * 128, (bf16_t*)(p.ws + WS_WGU) + (size_t)le * 1024 * D, D, tid);
    } else {
        const int r2 = r - NE * 64, le = layer * NE + (r2 >> 5), qq = r2 & 31, kt = qq >> 3, vt = qq & 7;
        const float* W = p.w_down + (size_t)le * DFF * D;
        tj_make(j, [&](int v4, float& sc) { sc = 1.0f; return W + v4; }, D, kt * TKT, vt * 128, (bf16_t*)(p.ws + WS_WD) + (size_t)le * D * DFF, DFF, tid);
    }
}

constexpr int PT_CONV = 8 * 20, PT_ML = 8 * 28, PT_KV = 8 * 4, PT_OUT = 8 * 8;
constexpr int PN0 = 2 * PT_CONV, PN1 = PN0 + 2 * PT_ML, PN2 = PN1 + 4 * PT_KV, PN3 = PN2 + 4 * PT_OUT, PN5 = PN3 + MOE_TILES_PER_LAYER;
DI void prep_tile_job(const P& p, int it, int tid, TJ& j) {
    if (it < PN0) {
        const int jj = it / PT_CONV, q = it % PT_CONV, kt = q / 20, vt = q % 20;
        const float* W = p.conv_w_in + (size_t)jj * D * DIN_CONV;
        tj_make(j, [&](int v4, float& sc) { sc = 1.0f; return W + v4; }, DIN_CONV, kt * TKT, vt * 128, (bf16_t*)(p.ws + WS_WIN) + (size_t)jj * DIN_CONV * D, D, tid);
    } else if (it < PN1) {
        const int r = it - PN0, jj = r / PT_ML, q = r % PT_ML, kt = q / 28, vt = q % 28;
        const float* W = p.ml_w_in + (size_t)jj * D * DIN_ML;
        tj_make(j, [&](int v4, float& sc) -> const float* {
                    sc = (v4 >= MIXW && v4 < 2 * MIXW) ? 0.08838834764831845f : 1.0f;
                    if (v4 < 3072) return W + v4;
                    if (v4 < 3328) return W + 3084 + (v4 - 3072);
                    if (v4 < 3340) return W + 3072 + (v4 - 3328);
                    sc = 0.0f; return W; },
                DIN_ML, kt * TKT, vt * 128, (bf16_t*)(p.ws + WS_WIN) + ((size_t)2 * DIN_CONV + (size_t)jj * NV_ML) * D, D, tid);
    } else if (it < PN2) {
        const int r = it - PN1, l = r / PT_KV, q = r % PT_KV, kt = q / 4, vt = q % 4;
        const float* W = p.w_kv + (size_t)l * D * 512;
        tj_make(j, [&](int v4, float& sc) { sc = 1.0f; return W + v4; }, 512, kt * TKT, vt * 128, (bf16_t*)(p.ws + WS_WKV) + (size_t)l * 512 * D, D, tid);
    } else if (it < PN3) {
        const int r = it - PN2, l = r / PT_OUT, q = r % PT_OUT, kt = q / 8, vt = q % 8;
        const float* W = p.w_out + (size_t)l * D * D;
        tj_make(j, [&](int v4, float& sc) { sc = 1.0f; return W + v4; }, D, kt * TKT, vt * 128, (bf16_t*)(p.ws + WS_WOUT) + (size_t)l * D * D, D, tid);
    } else {
        moe_tile_job(p, it - PN3, tid, j);
    }
}

DI void phase_prep(const P& p, int bid, int nb, char* smem) {
    const int tid = tid_opaque();
    bf16_t* xb = (bf16_t*)(p.ws + WS_XB);
    bf16_t* memb = (bf16_t*)(p.ws + WS_MEMB);
    {
        const size_t nx = (size_t)T * D / 4, nm = (size_t)NBATCH * MEML * D / 4, stride = (size_t)nb * NTHREADS;
        for (size_t i = (size_t)bid * NTHREADS + tid; i < nx; i += 4 * stride) {
            f32x4 v[4];
#pragma unroll
            for (int k = 0; k < 4; ++k) if (i + k * stride < nx) v[k] = __builtin_nontemporal_load((const f32x4*)p.x + i + k * stride);
#pragma unroll
            for (int k = 0; k < 4; ++k) if (i + k * stride < nx) { u32x2 w; w.x = cvtpk(v[k][0], v[k][1]); w.y = cvtpk(v[k][2], v[k][3]); ((u32x2*)xb)[i + k * stride] = w; }
        }
        for (size_t i = (size_t)bid * NTHREADS + tid; i < nm; i += stride) {
            const f32x4 v = ((const f32x4*)p.mem)[i]; u32x2 w; w.x = cvtpk(v[0], v[1]); w.y = cvtpk(v[2], v[3]); ((u32x2*)memb)[i] = w;
        }
    }
    {
        bf16_t* rwt = (bf16_t*)(p.ws + WS_RWT);
        for (int i = bid * NTHREADS + tid; i < NE * D; i += nb * NTHREADS) {
            const int e = i >> 10, d = i & 1023;
            const float w = p.router_w[(size_t)d * NE + e];
            const bf16_t hi = f2bf(w);
            rwt[i] = hi; rwt[NE * D + i] = f2bf(w - bf2f(hi));
        }
    }
    float* tile = (float*)smem;
    if (bid < PN5) {
        TJ j0, j1, j2; f32x4 v0[8], v1[8], v2[8];
        prep_tile_job(p, bid, tid, j0); tj_load(j0, v0);
        if (bid + nb < PN5) { prep_tile_job(p, bid + nb, tid, j1); tj_load(j1, v1); }
        for (int it = bid; it < PN5; it += nb) {
            const bool h2 = it + 2 * nb < PN5;
            if (h2) { prep_tile_job(p, it + 2 * nb, tid, j2); tj_load(j2, v2); }
            tj_finish(j0, v0, tile, tid);
            j0 = j1; j1 = j2;
#pragma unroll
            for (int i = 0; i < 8; ++i) { v0[i] = v1[i]; v1[i] = v2[i]; }
        }
    }
}

DI void moe_steal(const P& p, int budget, int limit, const unsigned* stop, unsigned stop_at, char* smem) {
    volatile int* qslot = (volatile int*)(smem + META_OFF + 2048);
    unsigned* tq = (unsigned*)(p.ws + WS_CTL + CTL_TQ);
    const int tid = tid_opaque();
    constexpr int QEND = DEPTH * MOE_TILES_PER_LAYER;
    if (budget <= 0) return;
    int nclaimed = 0, qlast = 0;
    auto claim = [&](int k) {
        if (tid == 0) {
            const bool halt = (nclaimed >= budget) || (qlast >= limit) || (stop && __hip_atomic_load(stop, __ATOMIC_RELAXED, __HIP_MEMORY_SCOPE_AGENT) >= stop_at);
            qslot[k] = halt ? QEND : (int)__hip_atomic_fetch_add(tq, 1u, __ATOMIC_RELAXED, __HIP_MEMORY_SCOPE_AGENT) + MOE_TILES_PER_LAYER;
        }
    };
    __syncthreads();
    claim(0);
    __syncthreads();
    int q0 = qslot[0];
    if (q0 >= QEND) return;
    nclaimed = 1; qlast = q0;
    TJ j0, j1, j2; f32x4 v0[8], v1[8], v2[8];
    moe_tile_job(p, q0, tid, j0); tj_load(j0, v0);
    claim(1);
    __syncthreads();
    int q1 = qslot[1];
    if (q1 < QEND) { nclaimed = 2; qlast = q1; moe_tile_job(p, q1, tid, j1); tj_load(j1, v1); }
    for (;;) {
        int q2 = QEND;
        if (q1 < QEND) {
            claim(2);
            __syncthreads();
            q2 = qslot[2];
            if (q2 < QEND) { ++nclaimed; qlast = q2; moe_tile_job(p, q2, tid, j2); tj_load(j2, v2); }
        }
        tj_finish(j0, v0, (float*)smem, tid);
        if (q1 >= QEND) break;
        j0 = j1; j1 = j2; q0 = q1; q1 = q2;
#pragma unroll
        for (int i = 0; i < 8; ++i) { v0[i] = v1[i]; v1[i] = v2[i]; }
    }
}
DI void steal_in_slack(const P& p, int slot, bool longest, int nlong, char* smem) {
    unsigned* stop = (unsigned*)(p.ws + WS_CTL + CTL_STOP) + slot;
    if (longest) { if (tid_opaque() == 0) __hip_atomic_fetch_add(stop, 1u, __ATOMIC_RELAXED, __HIP_MEMORY_SCOPE_AGENT); }
    else moe_steal(p, 64, DEPTH * MOE_TILES_PER_LAYER, stop, (unsigned)((nlong * 3 + 3) / 4), smem);
}

DI void store8_bf16(bf16_t* p8, const f32x4& v0, const f32x4& v1) {
    u32x4 w; w.x = cvtpk(v0[0], v0[1]); w.y = cvtpk(v0[2], v0[3]); w.z = cvtpk(v1[0], v1[1]); w.w = cvtpk(v1[2], v1[3]);
    *(u32x4*)p8 = w;
}

struct EpiTileBf16 {
    static constexpr bool PERM = true;
    bf16_t* O; int ldc; size_t pm_stride, pn_stride;
    DI void operator()(const f32x4 (&acc)[2][2][4][2], const g8::Unit& u, int wr, int wc, int fr, int fq) const {
        bf16_t* base = O + (size_t)u.pm * pm_stride + (size_t)u.pn * pn_stride + (size_t)(wr * 64 + fr) * ldc + wc * 32 + 8 * fq;
#pragma unroll
        for (int ai = 0; ai < 2; ++ai)
#pragma unroll
            for (int m = 0; m < 4; ++m)
                {
#pragma unroll
                    for (int bj = 0; bj < 2; ++bj) store8_bf16(base + (size_t)(ai * 128 + m * 16) * ldc + bj * 128, acc[ai][bj][m][0], acc[ai][bj][m][1]); __builtin_amdgcn_sched_barrier(0); }
    }
};

DI int units_of(int nunits, int G, int c) { return (c < nunits) ? (nunits - 1 - c) / G + 1 : 0; }

struct KSched {
    const char* memb; const char* wkv; int G, c;
    DI bool next(int i, g8::Unit& u) const { const int L = i * G + c; if (L >= 32) return false; u.pm = L & 7; u.pn = L >> 3; u.e = 0; u.valid = 256; u.rbase = 0; u.rti = 0; return true; }
    DI const char* a_base(const g8::Unit& u) const { return memb + (size_t)u.pm * 256 * D * 2; }
    DI const char* b_base(const g8::Unit& u) const { return wkv + (size_t)u.pn * 512 * D * 2; }
    DI void a_rows(const g8::Unit&, int R0, int R1, int (&rows)[2][2]) const { rows[0][0] = R0; rows[0][1] = R1; rows[1][0] = 128 + R0; rows[1][1] = 128 + R1; }
    DI void a_ready(const g8::Unit&) const {}
};
struct VSched {
    const char* memb; const char* wkv; int G, c;
    DI bool next(int i, g8::Unit& u) const { const int L = i * G + c - 32; if (L < 0 || L >= 32) return false; u.pm = L >> 3; u.pn = L & 7; u.e = 0; u.valid = 256; u.rbase = 0; u.rti = 0; return true; }
    DI const char* a_base(const g8::Unit& u) const { return wkv + ((size_t)u.pm * 512 + 256) * D * 2; }
    DI const char* b_base(const g8::Unit& u) const { return memb + (size_t)u.pn * 256 * D * 2; }
    DI void a_rows(const g8::Unit&, int R0, int R1, int (&rows)[2][2]) const { rows[0][0] = R0; rows[0][1] = R1; rows[1][0] = 128 + R0; rows[1][1] = 128 + R1; }
    DI void a_ready(const g8::Unit&) const {}
};
DI void phase_kv(const P& p, int bid, int nb, char* smem) {
    const char* memb = p.ws + WS_MEMB;
    const char* wkv = p.ws + WS_WKV;
    {
        KSched S{memb, wkv, nb, bid};
        EpiTileBf16 E{(bf16_t*)(p.ws + WS_KBUF), 256, (size_t)256 * 256, (size_t)2048 * 256};
        g8::gemm_phase<false>((LAS unsigned char*)smem, D, S, E);
    }
    {
        VSched S{memb, wkv, nb, bid};
        EpiTileBf16 E{(bf16_t*)(p.ws + WS_VT), 256, (size_t)8 * 256 * 256, (size_t)256 * 256};
        g8::gemm_phase<false>((LAS unsigned char*)smem, D, S, E);
    }
    steal_in_slack(p, 31, bid < 64, 64, smem);
}

struct EpiInproj {
    static constexpr bool PERM = true;
    bf16_t* projb; int ldp; int gate_pn; float* graw;
    DI void operator()(const f32x4 (&acc)[2][2][4][2], const g8::Unit& u, int wr, int wc, int fr, int fq) const {
        if (u.pn != gate_pn) {
            bf16_t* base = projb + (size_t)(u.pm * 256 + wr * 64 + fr) * ldp + u.pn * 256 + wc * 32 + 8 * fq;
#pragma unroll
            for (int ai = 0; ai < 2; ++ai)
#pragma unroll
                for (int m = 0; m < 4; ++m)
                    {
#pragma unroll
                        for (int bj = 0; bj < 2; ++bj) store8_bf16(base + (size_t)(ai * 128 + m * 16) * ldp + bj * 128, acc[ai][bj][m][0], acc[ai][bj][m][1]); __builtin_amdgcn_sched_barrier(0); }
        } else if (wc == 0 && fq < 2) {
#pragma unroll
            for (int ai = 0; ai < 2; ++ai)
#pragma unroll
                for (int m = 0; m < 4; ++m) {
                    float* dst = graw + (size_t)(u.pm * 256 + ai * 128 + wr * 64 + m * 16 + fr) * 16 + 8 * fq;
                    *(f32x4*)dst = acc[ai][0][m][0];
                    *(f32x4*)(dst + 4) = acc[ai][0][m][1];
                }
        }
    }
};
DI void phase_inproj(const P& p, int layer, int bid, int nb, char* smem) {
    const bool conv = (layer & 1) == 0;
    const int j = layer >> 1;
    const bf16_t* W = (const bf16_t*)(p.ws + WS_WIN) + (conv ? (size_t)j * DIN_CONV * D : ((size_t)2 * DIN_CONV + (size_t)j * NV_ML) * D);
    g8::DenseSched S; S.init(p.ws + WS_XB, W, T, conv ? DIN_CONV : NV_ML, D, nb, bid);
    EpiInproj E{(bf16_t*)(p.ws + WS_PROJ), conv ? DIN_CONV : LDP_ML, conv ? -1 : 13, (float*)(p.ws + WS_LOGI)};
    g8::gemm_phase<false>((LAS unsigned char*)smem, D, S, E);
    { const int most = (S.nwg + nb - 1) / nb, nlong = S.nwg - (most - 1) * nb; steal_in_slack(p, layer * 2, units_of(S.nwg, nb, bid) == most, nlong, smem); }
}

struct EpiOutproj {
    static constexpr bool PERM = true;
    const bf16_t* xres; bf16_t* z;
    DI void operator()(const f32x4 (&acc)[2][2][4][2], const g8::Unit& u, int wr, int wc, int fr, int fq) const {
        const size_t off0 = (size_t)(u.pm * 256 + wr * 64 + fr) * D + u.pn * 256 + wc * 32 + 8 * fq;
        u32x4 xr[2][4][2];
#pragma unroll
        for (int ai = 0; ai < 2; ++ai)
#pragma unroll
            for (int m = 0; m < 4; ++m)
#pragma unroll
                for (int bj = 0; bj < 2; ++bj) xr[ai][m][bj] = *(const u32x4*)(xres + off0 + (size_t)(ai * 128 + m * 16) * D + bj * 128);
#pragma unroll
        for (int ai = 0; ai < 2; ++ai)
#pragma unroll
            for (int m = 0; m < 4; ++m)
#pragma unroll
                for (int bj = 0; bj < 2; ++bj) {
                    const size_t off = off0 + (size_t)(ai * 128 + m * 16) * D + bj * 128;
                    const u32x4 r4 = xr[ai][m][bj];
                    f32x4 v0 = acc[ai][bj][m][0], v1 = acc[ai][bj][m][1];
                    v0[0] += ALPHA * bflo(r4.x); v0[1] += ALPHA * bfhi(r4.x); v0[2] += ALPHA * bflo(r4.y); v0[3] += ALPHA * bfhi(r4.y);
                    v1[0] += ALPHA * bflo(r4.z); v1[1] += ALPHA * bfhi(r4.z); v1[2] += ALPHA * bflo(r4.w); v1[3] += ALPHA * bfhi(r4.w);
                    store8_bf16(z + off, v0, v1);
                }
    }
};
DI void phase_outproj(const P& p, int layer, int bid, int nb, char* smem) {
    g8::DenseSched S; S.init(p.ws + WS_HCAT, (const bf16_t*)(p.ws + WS_WOUT) + (size_t)layer * D * D, T, D, D, nb, bid);
    EpiOutproj E{(const bf16_t*)(p.ws + WS_XB), (bf16_t*)(p.ws + WS_Z)};
    g8::gemm_phase<false>((LAS unsigned char*)smem, D, S, E);
}

DI void moe_meta(const int* cnt, int* meta) {
    __syncthreads();
    const int t = tid_opaque();
    if (t < NE) meta[65 + t] = __hip_atomic_load(cnt + t * CNT_STRIDE, __ATOMIC_RELAXED, __HIP_MEMORY_SCOPE_AGENT);
    __syncthreads();
    if (t == 0) {
        int base = 0, blk = 0;
#pragma unroll 1
        for (int e = 0; e < NE; ++e) {
            const int c = meta[65 + e];
            meta[e] = base; meta[32 + e] = blk;
            base += c; blk += (c + 255) >> 8;
        }
        meta[64] = blk;
    }
    __syncthreads();
    if (t < 160) {
        int e = 0;
#pragma unroll 1
        for (int q = 1; q < NE; ++q) e += (meta[32 + q] <= t) ? 1 : 0;
        meta[128 + t] = e;
    }
    __syncthreads();
}
struct MoeSched {
    const int* meta; const int* list; const char* A; const char* Bt; size_t b_estride; int K, G, c, nunits;
    DI bool next(int i, g8::Unit& u) const {
        const int L = i * G + c;
        if (L >= nunits) return false;
        const int w = g8::xcd_remap(L, nunits);
        const int rti = w >> 2;
        const int e = __builtin_amdgcn_readfirstlane(meta[128 + rti]);
        u.e = e; u.pm = rti - __builtin_amdgcn_readfirstlane(meta[32 + e]); u.pn = w & 3; u.rti = rti;
        const int left = __builtin_amdgcn_readfirstlane(meta[65 + e]) - u.pm * 256;
        u.valid = left < 256 ? left : 256;
        u.rbase = __builtin_amdgcn_readfirstlane(meta[e]);
        return true;
    }
    DI const char* b_base(const g8::Unit& u) const { return Bt + (size_t)u.e * b_estride + (size_t)u.pn * 256 * K * 2; }
};
struct MoeUpSched : MoeSched {
    DI const char* a_base(const g8::Unit&) const { return A; }
    DI void a_rows(const g8::Unit& u, int R0, int R1, int (&rows)[2][2]) const {
        const int* lst = list + (size_t)u.e * T + u.pm * 256;
        const int vm = u.valid - 1;
        rows[0][0] = lst[min(R0, vm)] >> 1; rows[0][1] = lst[min(R1, vm)] >> 1;
        rows[1][0] = lst[min(128 + R0, vm)] >> 1; rows[1][1] = lst[min(128 + R1, vm)] >> 1;
    }
    DI void a_ready(const g8::Unit&) const {}
};
struct MoeDownSched : MoeSched {
    unsigned* ready; unsigned* tmo;
    DI const char* a_base(const g8::Unit& u) const { return A + ((size_t)u.rbase + (size_t)u.pm * 256) * K * 2; }
    DI void a_rows(const g8::Unit&, int R0, int R1, int (&rows)[2][2]) const { rows[0][0] = R0; rows[0][1] = R1; rows[1][0] = 128 + R0; rows[1][1] = 128 + R1; }
    DI void a_ready(const g8::Unit& u) const {
        if (tid_opaque() < 64) {
            unsigned* w = ready + u.rti * 16;
            unsigned spins = 0;
            while ((unsigned)__builtin_amdgcn_readfirstlane((int)__hip_atomic_load(w, __ATOMIC_RELAXED, __HIP_MEMORY_SCOPE_AGENT)) < 32u) {
                __builtin_amdgcn_s_sleep(2);
                if ((++spins & 255u) == 0u) {
                    if (__builtin_amdgcn_readfirstlane((int)__hip_atomic_load(tmo, __ATOMIC_RELAXED, __HIP_MEMORY_SCOPE_AGENT)) != 0) break;
                    if (spins > (1u << 22)) { __hip_atomic_store(tmo, 1u, __ATOMIC_RELAXED, __HIP_MEMORY_SCOPE_AGENT); break; }
                }
            }
            __builtin_amdgcn_fence(__ATOMIC_ACQUIRE, "agent");
            asm volatile("s_waitcnt vmcnt(0)" ::: "memory");
        }
        asm volatile("" ::: "memory"); __builtin_amdgcn_s_barrier(); asm volatile("" ::: "memory");
    }
};

struct EpiMoeUp {
    static constexpr bool PERM = true;
    __amdgpu_buffer_rsrc_t hrs; unsigned* ready;
    DI void operator()(const f32x4 (&acc)[2][2][4][2], const g8::Unit& u, int wr, int wc, int fr, int fq) const {
        const unsigned hrow0 = (unsigned)u.rbase + (unsigned)u.pm * 256u;
#pragma unroll
        for (int ai = 0; ai < 2; ++ai)
#pragma unroll
            for (int m = 0; m < 4; ++m) {
                const int row = ai * 128 + wr * 64 + m * 16 + fr;
                if (row < u.valid) {
                    f32x4 h0, h1;
#pragma unroll
                    for (int i = 0; i < 4; ++i) {
                        const float g0 = acc[ai][0][m][0][i], g1 = acc[ai][0][m][1][i];
                        h0[i] = g0 * sigmoidf_(g0) * acc[ai][1][m][0][i];
                        h1[i] = g1 * sigmoidf_(g1) * acc[ai][1][m][1][i];
                    }
                    u32x4 w; w.x = cvtpk(h0[0], h0[1]); w.y = cvtpk(h0[2], h0[3]); w.z = cvtpk(h1[0], h1[1]); w.w = cvtpk(h1[2], h1[3]);
                    __builtin_amdgcn_raw_buffer_store_b128(w, hrs, ((hrow0 + (unsigned)row) * DFF + u.pn * 128 + wc * 32 + 8 * fq) * 2u, 0,   16);
                }
                __builtin_amdgcn_sched_barrier(0);
            }
        asm volatile("s_waitcnt vmcnt(0)" ::: "memory");
        if (fr == 0 && fq == 0) __hip_atomic_fetch_add(ready + u.rti * 16, 1u, __ATOMIC_RELAXED, __HIP_MEMORY_SCOPE_AGENT);
    }
};
struct EpiMoeDown {
    static constexpr bool PERM = true;
    const int* list; const float* gate; bf16_t* yasg;
    DI void operator()(const f32x4 (&acc)[2][2][4][2], const g8::Unit& u, int wr, int wc, int fr, int fq) const {
        const int* lst = list + (size_t)u.e * T + u.pm * 256;
        int aid[2][4]; float gt[2][4];
#pragma unroll
        for (int ai = 0; ai < 2; ++ai)
#pragma unroll
            for (int m = 0; m < 4; ++m) { const int row = ai * 128 + wr * 64 + m * 16 + fr; aid[ai][m] = lst[min(row, u.valid - 1)]; }
#pragma unroll
        for (int ai = 0; ai < 2; ++ai)
#pragma unroll
            for (int m = 0; m < 4; ++m) gt[ai][m] = gate[aid[ai][m]];
#pragma unroll
        for (int ai = 0; ai < 2; ++ai)
#pragma unroll
            for (int m = 0; m < 4; ++m) {
                const int row = ai * 128 + wr * 64 + m * 16 + fr;
                if (row < u.valid) {
                    bf16_t* dst = yasg + (size_t)aid[ai][m] * D + u.pn * 256 + wc * 32 + 8 * fq;
                    const float g_ = gt[ai][m];
#pragma unroll
                    for (int bj = 0; bj < 2; ++bj) store8_bf16(dst + bj * 128, acc[ai][bj][m][0] * g_, acc[ai][bj][m][1] * g_);
                }
                __builtin_amdgcn_sched_barrier(0);
            }
    }
};
DI void phase_moe(const P& p, int layer, int bid, int nb, char* smem) {
    int* meta = (int*)(smem + META_OFF);
    moe_meta((const int*)(p.ws + WS_CTL + CTL_CNT) + layer * 32 * CNT_STRIDE, meta);
    unsigned* ready = (unsigned*)(p.ws + WS_CTL + CTL_READY) + layer * 160 * 16;
    const int nunits = meta[64] * 4;
    {
        MoeUpSched S;
        S.meta = meta; S.list = (const int*)(p.ws + WS_LIST); S.A = p.ws + WS_X1B; S.Bt = p.ws + WS_WGU + (size_t)layer * NE * 1024 * D * 2;
        S.b_estride = (size_t)1024 * D * 2; S.K = D; S.G = nb; S.c = bid; S.nunits = nunits;
        EpiMoeUp E{__builtin_amdgcn_make_buffer_rsrc((void*)(p.ws + WS_HBUF), (short)0, (int)((size_t)T * 2 * DFF * 2), 0x00020000), ready};
        g8::gemm_phase<true>((LAS unsigned char*)smem, D, S, E);
    }
    {
        MoeDownSched S;
        S.meta = meta; S.list = (const int*)(p.ws + WS_LIST); S.A = p.ws + WS_HBUF; S.Bt = p.ws + WS_WD + (size_t)layer * NE * D * DFF * 2;
        S.b_estride = (size_t)D * DFF * 2; S.K = DFF; S.G = nb; S.c = nb - 1 - bid; S.nunits = nunits;
        S.ready = ready; S.tmo = (unsigned*)(p.ws + WS_CTL + CTL_TMO);
        EpiMoeDown E{(const int*)(p.ws + WS_LIST), (const float*)(p.ws + WS_GATE), (bf16_t*)(p.ws + WS_YASG)};
        g8::gemm_phase<false>((LAS unsigned char*)smem, DFF, S, E);
    }
    { const int most = (nunits + nb - 1) / nb, nlong = nunits - (most - 1) * nb; steal_in_slack(p, layer * 2 + 1, units_of(nunits, nb, bid) == most, nlong, smem); }
}

DI void phase_convmix(const P& p, int layer, int bid, int nb) {
    const int j = layer >> 1;
    const int tid = tid_opaque();
    const bf16_t* projb = (const bf16_t*)(p.ws + WS_PROJ);
    bf16_t* hcat = (bf16_t*)(p.ws + WS_HCAT);
    const float* cw = p.conv_w + (size_t)j * 3 * MIXW;
    const int nitem = T * (MIXW / 8);
#pragma unroll 2
    for (int it = bid * NTHREADS + tid; it < nitem; it += nb * NTHREADS) {
        const int t = it / 96, c8 = (it % 96) * 8;
        const int s = t & 2047;
        const bf16_t* row = projb + (size_t)t * DIN_CONV;
        const u32x4 bg = *(const u32x4*)(row + c8);
        float u[3][8];
#pragma unroll
        for (int d = 0; d < 3; ++d) {
            const int back = 2 - d;
            if (s - back >= 0) {
                const bf16_t* rw = row - (size_t)back * DIN_CONV;
                const u32x4 cg = *(const u32x4*)(rw + MIXW + c8);
                const u32x4 xi = *(const u32x4*)(rw + 2 * MIXW + c8);
#pragma unroll
                for (int q = 0; q < 4; ++q) { u[d][2 * q] = bflo(cg[q]) * bflo(xi[q]); u[d][2 * q + 1] = bfhi(cg[q]) * bfhi(xi[q]); }
            } else {
#pragma unroll
                for (int q = 0; q < 8; ++q) u[d][q] = 0.f;
            }
        }
        float o[8];
#pragma unroll
        for (int q = 0; q < 8; ++q) {
            const float c = cw[c8 + q] * u[0][q] + cw[MIXW + c8 + q] * u[1][q] + cw[2 * MIXW + c8 + q] * u[2][q];
            const float b = (q & 1) ? bfhi(bg[q >> 1]) : bflo(bg[q >> 1]);
            o[q] = b * c;
        }
        u32x4 w; w.x = cvtpk(o[0], o[1]); w.y = cvtpk(o[2], o[3]); w.z = cvtpk(o[4], o[5]); w.w = cvtpk(o[6], o[7]);
        *(u32x4*)(hcat + (size_t)t * D + c8) = w;
    }
}

DI void phase_xattn(const P& p, int layer, int bid, int nb, char* smem) {
    const bool conv = (layer & 1) == 0;
    const int ldp = conv ? DIN_CONV : LDP_ML;
    const int qoff = conv ? 3 * MIXW : 3072;
    const bf16_t* projb = (const bf16_t*)(p.ws + WS_PROJ);
    const bf16_t* kbuf = (const bf16_t*)(p.ws + WS_KBUF) + (size_t)layer * 2048 * 256;
    const bf16_t* vT = (const bf16_t*)(p.ws + WS_VT) + (size_t)layer * 8 * 256 * 256;
    bf16_t* hcat = (bf16_t*)(p.ws + WS_HCAT);
    constexpr int LK = 72, LV = 264;
    bf16_t* Ks = (bf16_t*)smem;
    bf16_t* Vs = Ks + 256 * LK;
    const int per = (NBATCH * XH * 16 + nb - 1) / nb;
    int staged = -1;
    for (int k = 0; k < per; ++k) {
        const int task = bid * per + k;
        if (task >= NBATCH * XH * 16) break;
        const int tid = tid_opaque(), lane = tid & 63, wid = tid >> 6, r = lane & 15, g = lane >> 4;
        const int b = task >> 6, h = (task >> 4) & 3, qt = task & 15;
        const bool restage = (task >> 4) != staged;
        staged = task >> 4;
        __syncthreads();
        if (restage) {
#pragma unroll
        for (int i = 0; i < 4; ++i) {
            const int key = (tid >> 3) + 64 * i, kc = tid & 7;
            *(u32x4*)&Ks[key * LK + kc * 8] = *(const u32x4*)(kbuf + ((size_t)b * 256 + key) * 256 + h * 64 + kc * 8);
            const int dv = (tid >> 5) + 16 * i, mc = tid & 31;
            *(u32x4*)&Vs[dv * LV + mc * 8] = *(const u32x4*)(vT + (((size_t)b * 4 + h) * 64 + dv) * 256 + mc * 8);
        }
        }
        __syncthreads();
        const int tq = b * SEQ + qt * 128 + wid * 16;
        const bf16_t* qrow = projb + (size_t)(tq + r) * ldp + qoff + h * 64;
        bf16x8 qf[2];
        qf[0] = *(const bf16x8*)(qrow + 8 * g);
        qf[1] = *(const bf16x8*)(qrow + 32 + 8 * g);
        f32x4 sacc[16];
#pragma unroll
        for (int kt = 0; kt < 16; ++kt) {
            f32x4 a = (f32x4){0.f, 0.f, 0.f, 0.f};
#pragma unroll
            for (int ks = 0; ks < 2; ++ks) {
                const bf16x8 kf = *(const bf16x8*)&Ks[(kt * 16 + r) * LK + ks * 32 + 8 * g];
                a = mfma16(kf, qf[ks], a);
            }
            sacc[kt] = a;
            if (kt & 1) __builtin_amdgcn_sched_barrier(0);
        }
        float mx = -3.0e38f;
#pragma unroll
        for (int kt = 0; kt < 16; ++kt)
#pragma unroll
            for (int i = 0; i < 4; ++i) { sacc[kt][i] *= 0.125f; mx = fmaxf(mx, sacc[kt][i]); }
        mx = xor_max(mx, 16); mx = xor_max(mx, 32);
        float sum = 0.f;
#pragma unroll
        for (int kt = 0; kt < 16; ++kt)
#pragma unroll
            for (int i = 0; i < 4; ++i) { const float e = __expf(sacc[kt][i] - mx); sacc[kt][i] = e; sum += e; }
        sum = xor_add(sum, 16); sum = xor_add(sum, 32);
        const float inv = 1.0f / sum;
        f32x4 oacc[4];
#pragma unroll
        for (int dt = 0; dt < 4; ++dt) oacc[dt] = (f32x4){0.f, 0.f, 0.f, 0.f};
#pragma unroll
        for (int s2 = 0; s2 < 8; ++s2) {
            u32x4 pw;
            pw.x = cvtpk(sacc[2 * s2][0], sacc[2 * s2][1]); pw.y = cvtpk(sacc[2 * s2][2], sacc[2 * s2][3]);
            pw.z = cvtpk(sacc[2 * s2 + 1][0], sacc[2 * s2 + 1][1]); pw.w = cvtpk(sacc[2 * s2 + 1][2], sacc[2 * s2 + 1][3]);
            const bf16x8 pf = __builtin_bit_cast(bf16x8, pw);
#pragma unroll
            for (int dt = 0; dt < 4; ++dt) {
                const bf16_t* vp = &Vs[(dt * 16 + r) * LV + s2 * 32 + 4 * g];
                const u32x2 v0 = *(const u32x2*)vp;
                const u32x2 v1 = *(const u32x2*)(vp + 16);
                u32x4 vw; vw.x = v0.x; vw.y = v0.y; vw.z = v1.x; vw.w = v1.y;
                oacc[dt] = mfma16(__builtin_bit_cast(bf16x8, vw), pf, oacc[dt]);
            }
            __builtin_amdgcn_sched_barrier(0);
        }
        bf16_t* orow = hcat + (size_t)(tq + r) * D + MIXW + h * 64;
#pragma unroll
        for (int dt = 0; dt < 4; ++dt) {
            u32x2 w; w.x = cvtpk(oacc[dt][0] * inv, oacc[dt][1] * inv); w.y = cvtpk(oacc[dt][2] * inv, oacc[dt][3] * inv);
            *(u32x2*)(orow + dt * 16 + 4 * g) = w;
        }
    }
}

DI void phase_ml_local(const P& p, int layer, int bid, int nb, char* smem) {
    const float* gate_b = p.ml_gate_b + (layer >> 1) * 12;
    const bf16_t* projb = (const bf16_t*)(p.ws + WS_PROJ);
    const float* graw = (const float*)(p.ws + WS_LOGI);
    float* CT = (float*)(p.ws + WS_CT);
    float* nloc = (float*)(p.ws + WS_NLOC);
    float* mloc = (float*)(p.ws + WS_MLOC);
    float* gsum = (float*)(p.ws + WS_GSUM);
    constexpr int LS = 136;
    bf16_t* kwT = (bf16_t*)smem;
    bf16_t* vTs = kwT + 128 * LS;
    float* fb = (float*)(vTs + 128 * LS);
    float* fw = fb + 128;
    float* fr = fw + 128;
    for (int task = bid; task < 48 * NCH; task += nb) {
        const int tid = tid_opaque(), lane = tid & 63, wid = tid >> 6, r = lane & 15, g = lane >> 4;
        const int bh = task >> 4, c = task & 15, b = bh / 6, h = bh % 6;
        const int t0 = b * SEQ + c * CHUNK;
        const float gbi = gate_b[h], gbf = gate_b[6 + h];
        __syncthreads();
        if (wid == 0) {
            const float* gp = graw + (size_t)(t0 + 2 * lane) * 16 + h;
            const float i0 = gp[0] + gbi, i1 = gp[16] + gbi;
            const float f0 = logsigmoidf_(gp[6] + gbf), f1 = logsigmoidf_(gp[22] + gbf);
            float ps = f0 + f1;
#pragma unroll
            for (int off = 1; off < 64; off <<= 1) { const float y = __shfl_up(ps, off, 64); if (lane >= off) ps += y; }
            const float gtot = __shfl(ps, 63, 64);
            const float b0 = ps - f1, b1 = ps;
            const float a0 = gtot - b0 + i0, a1 = gtot - b1 + i1;
            float mx = fmaxf(a0, a1);
            mx = xor_max(mx, 32); mx = xor_max(mx, 16); mx = xor_max(mx, 8); mx = xor_max(mx, 4); mx = xor_max(mx, 2); mx = xor_max(mx, 1);
            fw[2 * lane] = __expf(a0 - mx); fw[2 * lane + 1] = __expf(a1 - mx);
            if (lane == 0) { fr[0] = mx; fr[1] = gtot; }
        }
        __syncthreads();
        const float ml = fr[0], gtot = fr[1];
        {
            const int s = tid & 127, quarter = tid >> 7;
            const float w = fw[s];
            const bf16_t* krow = projb + (size_t)(t0 + s) * LDP_ML + MIXW + h * 128;
            const bf16_t* vrow = projb + (size_t)(t0 + s) * LDP_ML + 2 * MIXW + h * 128;
#pragma unroll
            for (int i = 0; i < 4; ++i) {
                const int dc = quarter * 4 + i;
                const u32x4 kk = *(const u32x4*)(krow + dc * 8);
                const u32x4 vv = *(const u32x4*)(vrow + dc * 8);
#pragma unroll
                for (int q = 0; q < 4; ++q) {
                    kwT[(dc * 8 + 2 * q) * LS + s] = f2bf(bflo(kk[q]) * w);
                    kwT[(dc * 8 + 2 * q + 1) * LS + s] = f2bf(bfhi(kk[q]) * w);
                    vTs[(dc * 8 + 2 * q) * LS + s] = (bf16_t)(vv[q] & 0xffffu);
                    vTs[(dc * 8 + 2 * q + 1) * LS + s] = (bf16_t)(vv[q] >> 16);
                }
            }
        }
        __syncthreads();
        float* ct = CT + (size_t)task * 128 * 128;
        {
            f32x4 acc[8];
#pragma unroll
            for (int dt = 0; dt < 8; ++dt) acc[dt] = (f32x4){0.f, 0.f, 0.f, 0.f};
#pragma unroll
            for (int ks = 0; ks < 4; ++ks) {
                const bf16x8 vf = *(const bf16x8*)&vTs[(wid * 16 + r) * LS + ks * 32 + 8 * g];
#pragma unroll
                for (int dt = 0; dt < 8; ++dt) {
                    const bf16x8 kf = *(const bf16x8*)&kwT[(dt * 16 + r) * LS + ks * 32 + 8 * g];
                    acc[dt] = mfma16(vf, kf, acc[dt]);
                }
                __builtin_amdgcn_sched_barrier(0);
            }
#pragma unroll
            for (int dt = 0; dt < 8; ++dt)
#pragma unroll
                for (int i = 0; i < 4; ++i) ct[(wid * 16 + 4 * g + i) * 128 + dt * 16 + r] = acc[dt][i];
        }
        {
            const bf16x8 ones = (bf16x8){0x3F80, 0x3F80, 0x3F80, 0x3F80, 0x3F80, 0x3F80, 0x3F80, 0x3F80};
            f32x4 an = (f32x4){0.f, 0.f, 0.f, 0.f};
#pragma unroll
            for (int ks = 0; ks < 4; ++ks) {
                const bf16x8 kf = *(const bf16x8*)&kwT[(wid * 16 + r) * LS + ks * 32 + 8 * g];
                an = mfma16(ones, kf, an);
            }
            if (g == 0) nloc[(size_t)task * 128 + wid * 16 + r] = an[0];
        }
        if (tid == 0) { mloc[task] = ml; gsum[task] = gtot; }
    }
}

DI void phase_ml_scan(const P& p, int bid, int nb) {
    const float* CT = (const float*)(p.ws + WS_CT);
    bf16_t* CPB = (bf16_t*)(p.ws + WS_CPB);
    const float* nloc = (const float*)(p.ws + WS_NLOC);
    float* nprev = (float*)(p.ws + WS_NPREV);
    const float* mloc = (const float*)(p.ws + WS_MLOC);
    const float* gsum = (const float*)(p.ws + WS_GSUM);
    float* mprev = (float*)(p.ws + WS_MPREV);
    const int tid = tid_opaque();
    for (int task = bid; task < 48 * 8; task += nb) {
        const int bh = task >> 3, sl = task & 7;
        const int idx = sl * 2048 + tid * 4;
        const bool don = (sl == 0 && tid < 128);
        f32x4 loc[NCH];
        float nl[NCH];
#pragma unroll
        for (int c = 0; c < NCH; ++c) loc[c] = *(const f32x4*)(CT + (size_t)(bh * NCH + c) * 16384 + idx);
#pragma unroll
        for (int c = 0; c < NCH; ++c) nl[c] = don ? nloc[(size_t)(bh * NCH + c) * 128 + tid] : 0.f;
        float m = 0.f;
        f32x4 st = (f32x4){0.f, 0.f, 0.f, 0.f};
        float nst = 0.f;
#pragma unroll
        for (int c = 0; c < NCH; ++c) {
            const int ch = bh * NCH + c;
            const float gg = gsum[ch], ml = mloc[ch];
            const float mnew = fmaxf(gg + m, ml);
            const float decay = __expf(gg + m - mnew), sc = __expf(ml - mnew);
            u32x2 w; w.x = cvtpk(st[0], st[1]); w.y = cvtpk(st[2], st[3]);
            *(u32x2*)(CPB + (size_t)ch * 16384 + idx) = w;
            st = st * decay + loc[c] * sc;
            if (don) { nprev[(size_t)ch * 128 + tid] = nst; nst = nst * decay + nl[c] * sc; }
            if (sl == 0 && tid == 0) mprev[ch] = m;
            m = mnew;
        }
    }
}

DI void phase_ml_out(const P& p, int layer, int bid, int nb, char* smem) {
    const int j = layer >> 1;
    const float* gate_b = p.ml_gate_b + j * 12;
    const bf16_t* projb = (const bf16_t*)(p.ws + WS_PROJ);
    const float* graw = (const float*)(p.ws + WS_LOGI);
    const bf16_t* CPB = (const bf16_t*)(p.ws + WS_CPB);
    const float* nprev = (const float*)(p.ws + WS_NPREV);
    const float* mprev = (const float*)(p.ws + WS_MPREV);
    bf16_t* hcat = (bf16_t*)(p.ws + WS_HCAT);
    const float* ng_ = p.ml_norm_g + (size_t)j * MIXW;
    constexpr int LS = 136;
    bf16_t* kS = (bf16_t*)smem;
    bf16_t* vTs = kS + 128 * LS;
    bf16_t* cS = vTs + 128 * LS;
    float* fb = (float*)(cS + 128 * LS);
    float* fB = fb + 128;
    float* fA = fB + 128;
    float* fW = fA + 128;
    float* fE = fW + 128;
    float* fN = fE + 128;
    for (int task = bid; task < 48 * NCH; task += nb) {
        const int tid = tid_opaque();
        const int lane = tid & 63, wid = __builtin_amdgcn_readfirstlane(tid >> 6), r = lane & 15, g = lane >> 4;
        const int bh = task >> 4, c = task & 15, b = bh / 6, h = bh % 6;
        const int t0 = b * SEQ + c * CHUNK;
        const float gbi = gate_b[h], gbf = gate_b[6 + h];
        __syncthreads();
        if (wid == 0) {
            const float* gp = graw + (size_t)(t0 + 2 * lane) * 16 + h;
            const float i0 = gp[0] + gbi, i1 = gp[16] + gbi;
            const float f0 = logsigmoidf_(gp[6] + gbf), f1 = logsigmoidf_(gp[22] + gbf);
            const float mp = mprev[task];
            float ps = f0 + f1;
#pragma unroll
            for (int off = 1; off < 64; off <<= 1) { const float y = __shfl_up(ps, off, 64); if (lane >= off) ps += y; }
            const float b0 = ps - f1, b1 = ps;
            const float B0 = i0 - b0, B1 = i1 - b1;
            float pm = fmaxf(B0, B1);
#pragma unroll
            for (int off = 1; off < 64; off <<= 1) { const float y = __shfl_up(pm, off, 64); if (lane >= off) pm = fmaxf(pm, y); }
            float pmx = __shfl_up(pm, 1, 64);
            if (lane == 0) pmx = -3.0e38f;
            const float pm0 = fmaxf(pmx, B0), pm1 = pm;
            const float in0 = b0 + mp, in1 = b1 + mp;
            const float m0 = fmaxf(b0 + pm0, in0), m1 = fmaxf(b1 + pm1, in1);
            fB[2 * lane] = B0; fB[2 * lane + 1] = B1;
            fA[2 * lane] = b0 - m0; fA[2 * lane + 1] = b1 - m1;
            fW[2 * lane] = __expf(in0 - m0); fW[2 * lane + 1] = __expf(in1 - m1);
            fE[2 * lane] = __expf(-m0); fE[2 * lane + 1] = __expf(-m1);
        } else if (wid == 1) {
            fN[2 * lane] = nprev[(size_t)task * 128 + 2 * lane]; fN[2 * lane + 1] = nprev[(size_t)task * 128 + 2 * lane + 1];
        }
        {
#pragma unroll
            for (int i = 0; i < 4; ++i) {
                const int s = (tid >> 4) + 32 * i, dc = tid & 15;
                *(u32x4*)&kS[s * LS + dc * 8] = *(const u32x4*)(projb + (size_t)(t0 + s) * LDP_ML + MIXW + h * 128 + dc * 8);
                *(u32x4*)&cS[s * LS + dc * 8] = *(const u32x4*)(CPB + (size_t)task * 16384 + s * 128 + dc * 8);
            }
            const int s = tid & 127, quarter = tid >> 7;
            const bf16_t* vrow = projb + (size_t)(t0 + s) * LDP_ML + 2 * MIXW + h * 128;
#pragma unroll
            for (int i = 0; i < 4; ++i) {
                const int dc = quarter * 4 + i;
                const u32x4 vv = *(const u32x4*)(vrow + dc * 8);
#pragma unroll
                for (int q = 0; q < 4; ++q) {
                    vTs[(dc * 8 + 2 * q) * LS + s] = (bf16_t)(vv[q] & 0xffffu);
                    vTs[(dc * 8 + 2 * q + 1) * LS + s] = (bf16_t)(vv[q] >> 16);
                }
            }
        }
        __syncthreads();
        {
            const int l = wid * 16 + r;
            bf16x8 qf[4];
            float qn;
            {
                const bf16_t* qrow = projb + (size_t)(t0 + l) * LDP_ML + h * 128;
                float part = 0.f;
#pragma unroll
                for (int ks = 0; ks < 4; ++ks) {
                    const u32x4 qq = *(const u32x4*)(qrow + ks * 32 + 8 * g);
                    qf[ks] = __builtin_bit_cast(bf16x8, qq);
#pragma unroll
                    for (int q = 0; q < 4; ++q) part += bflo(qq[q]) * fN[ks * 32 + 8 * g + 2 * q] + bfhi(qq[q]) * fN[ks * 32 + 8 * g + 2 * q + 1];
                }
                part = xor_add(part, 16); part = xor_add(part, 32);
                qn = part;
            }
            __builtin_amdgcn_sched_barrier(0);
            f32x4 nacc[8];
#pragma unroll
            for (int et = 0; et < 8; ++et) {
                f32x4 a = (f32x4){0.f, 0.f, 0.f, 0.f};
#pragma unroll
                for (int ks = 0; ks < 4; ++ks) {
                    const bf16x8 cf = *(const bf16x8*)&cS[(et * 16 + r) * LS + ks * 32 + 8 * g];
                    a = mfma16(cf, qf[ks], a);
                }
                nacc[et] = a;
                if (et & 1) __builtin_amdgcn_sched_barrier(0);
            }
            const float Al = fA[l], wint = fW[l], eml = fE[l];
#pragma unroll
            for (int et = 0; et < 8; ++et) nacc[et] *= wint;
            const int stmax = wid;
            float den = 0.f;
#pragma unroll
            for (int s2 = 0; s2 < 4; ++s2) {
                if (2 * s2 <= stmax) {
                    f32x4 sa = (f32x4){0.f, 0.f, 0.f, 0.f}, sb = (f32x4){0.f, 0.f, 0.f, 0.f};
#pragma unroll
                    for (int ks = 0; ks < 4; ++ks) {
                        const bf16x8 kf = *(const bf16x8*)&kS[(s2 * 32 + r) * LS + ks * 32 + 8 * g];
                        sa = mfma16(kf, qf[ks], sa);
                    }
                    if (2 * s2 + 1 <= stmax) {
#pragma unroll
                        for (int ks = 0; ks < 4; ++ks) {
                            const bf16x8 kf = *(const bf16x8*)&kS[(s2 * 32 + 16 + r) * LS + ks * 32 + 8 * g];
                            sb = mfma16(kf, qf[ks], sb);
                        }
                    }
#pragma unroll
                    for (int i = 0; i < 4; ++i) {
                        const int s = s2 * 32 + 4 * g + i;
                        const float va = (s <= l) ? sa[i] * __expf(Al + fB[s]) : 0.f;
                        const float vb = (s + 16 <= l) ? sb[i] * __expf(Al + fB[s + 16]) : 0.f;
                        sa[i] = va; sb[i] = vb; den += va + vb;
                    }
                    u32x4 pw;
                    pw.x = cvtpk(sa[0], sa[1]); pw.y = cvtpk(sa[2], sa[3]);
                    pw.z = cvtpk(sb[0], sb[1]); pw.w = cvtpk(sb[2], sb[3]);
                    const bf16x8 pf = __builtin_bit_cast(bf16x8, pw);
#pragma unroll
                    for (int et = 0; et < 8; ++et) {
                        const bf16_t* vp = &vTs[(et * 16 + r) * LS + s2 * 32 + 4 * g];
                        const u32x2 v0 = *(const u32x2*)vp;
                        const u32x2 v1 = *(const u32x2*)(vp + 16);
                        u32x4 vw; vw.x = v0.x; vw.y = v0.y; vw.z = v1.x; vw.w = v1.y;
                        nacc[et] = mfma16(__builtin_bit_cast(bf16x8, vw), pf, nacc[et]);
                    }
                }
                __builtin_amdgcn_sched_barrier(0);
            }
            den = xor_add(den, 16); den = xor_add(den, 32);
            const float dd = fmaxf(fabsf(den + wint * qn), eml);
            const float invd = 1.0f / dd;
            float sm = 0.f;
#pragma unroll
            for (int et = 0; et < 8; ++et)
#pragma unroll
                for (int i = 0; i < 4; ++i) { nacc[et][i] *= invd; sm += nacc[et][i]; }
            sm = xor_add(sm, 16); sm = xor_add(sm, 32);
            const float mu = sm * (1.0f / 128.0f);
            float sq = 0.f;
#pragma unroll
            for (int et = 0; et < 8; ++et)
#pragma unroll
                for (int i = 0; i < 4; ++i) { const float dlt = nacc[et][i] - mu; sq += dlt * dlt; }
            sq = xor_add(sq, 16); sq = xor_add(sq, 32);
            const float rstd = rsqrtf(sq * (1.0f / 128.0f) + LN_EPS);
            const size_t trow = (size_t)(t0 + l);
            const bf16_t* og = projb + trow * LDP_ML + 3 * MIXW + h * 128;
            bf16_t* orow = hcat + trow * D + h * 128;
#pragma unroll
            for (int et = 0; et < 8; ++et) {
                const int e = et * 16 + 4 * g;
                const u32x2 ov = *(const u32x2*)(og + e);
                const f32x4 gv = *(const f32x4*)(ng_ + h * 128 + e);
                const float o0 = (nacc[et][0] - mu) * rstd * gv[0] * sigmoidf_(bflo(ov.x));
                const float o1 = (nacc[et][1] - mu) * rstd * gv[1] * sigmoidf_(bfhi(ov.x));
                const float o2 = (nacc[et][2] - mu) * rstd * gv[2] * sigmoidf_(bflo(ov.y));
                const float o3 = (nacc[et][3] - mu) * rstd * gv[3] * sigmoidf_(bfhi(ov.y));
                u32x2 w; w.x = cvtpk(o0, o1); w.y = cvtpk(o2, o3);
                *(u32x2*)(orow + e) = w;
                if (et & 1) __builtin_amdgcn_sched_barrier(0);
            }
        }
    }
}

constexpr int LN1_MAXT = 8;
DI void phase_ln1_route(const P& p, int layer, int bid, int nb, char* smem) {
    const bf16_t* z = (const bf16_t*)(p.ws + WS_Z);
    bf16_t* x1b = (bf16_t*)(p.ws + WS_X1B);
    float* gate = (float*)(p.ws + WS_GATE);
    int* list = (int*)(p.ws + WS_LIST);
    int* cnt = (int*)(p.ws + WS_CTL + CTL_CNT) + layer * 32 * CNT_STRIDE;
    const bf16_t* rwh = (const bf16_t*)(p.ws + WS_RWT);
    const bf16_t* rwl = rwh + NE * D;
    const float* lg = p.ln1_g + (size_t)layer * D;
    const float* lb = p.ln1_b + (size_t)layer * D;
    constexpr int XS = 1028;
    float* xs = (float*)smem;
    float* red = xs + 16 * XS;
    float* scs = red + 8 * 16 * 32;
    int* lcnt = (int*)(scs + 16 * 32);
    int* gbase = lcnt + 32;
    int* sel = gbase + 32;
    const int tid = tid_opaque(), lane = tid & 63, wid = tid >> 6, r = lane & 15, g = lane >> 4;
    __syncthreads();
    if (tid < 32) lcnt[tid] = 0;
    const float rb_e = p.router_b[tid & 31];
    bf16x8 wh[4][2], wl[4][2];
#pragma unroll
    for (int ks = 0; ks < 4; ++ks)
#pragma unroll
        for (int nt = 0; nt < 2; ++nt) {
            const size_t o = (size_t)(nt * 16 + r) * D + wid * 128 + ks * 32 + 8 * g;
            wh[ks][nt] = *(const bf16x8*)(rwh + o); wl[ks][nt] = *(const bf16x8*)(rwl + o);
        }
    f32x4 lgv[2][2], lbv[2][2];
#pragma unroll
    for (int i = 0; i < 2; ++i) { const int col = i * 512 + lane * 8; lgv[i][0] = *(const f32x4*)(lg + col); lgv[i][1] = *(const f32x4*)(lg + col + 4); lbv[i][0] = *(const f32x4*)(lb + col); lbv[i][1] = *(const f32x4*)(lb + col + 4); }
    u32x4 zn[2][2];
    if (bid < T / 16) {
#pragma unroll
        for (int rr = 0; rr < 2; ++rr)
#pragma unroll
            for (int i = 0; i < 2; ++i) zn[rr][i] = *(const u32x4*)(z + (size_t)(bid * 16 + wid * 2 + rr) * D + i * 512 + lane * 8);
    }
    int ti = 0;
    for (int task = bid; task < T / 16; task += nb, ++ti) {
        const int row0 = task * 16;
        u32x4 zc[2][2];
#pragma unroll
        for (int rr = 0; rr < 2; ++rr)
#pragma unroll
            for (int i = 0; i < 2; ++i) zc[rr][i] = zn[rr][i];
        if (task + nb < T / 16) {
#pragma unroll
            for (int rr = 0; rr < 2; ++rr)
#pragma unroll
                for (int i = 0; i < 2; ++i) zn[rr][i] = *(const u32x4*)(z + (size_t)((task + nb) * 16 + wid * 2 + rr) * D + i * 512 + lane * 8);
        }
        __syncthreads();
#pragma unroll
        for (int rr = 0; rr < 2; ++rr) {
            const int lr = wid * 2 + rr;
            const size_t t = (size_t)(row0 + lr);
            float v[2][8];
            float s = 0.f;
#pragma unroll
            for (int i = 0; i < 2; ++i) {
#pragma unroll
                for (int q = 0; q < 4; ++q) { v[i][2 * q] = bflo(zc[rr][i][q]); v[i][2 * q + 1] = bfhi(zc[rr][i][q]); s += v[i][2 * q] + v[i][2 * q + 1]; }
            }
            s = wave_sum(s);
            const float mu = s * (1.0f / D);
            float q2 = 0.f;
#pragma unroll
            for (int i = 0; i < 2; ++i)
#pragma unroll
                for (int k = 0; k < 8; ++k) { const float d = v[i][k] - mu; q2 += d * d; }
            q2 = wave_sum(q2);
            const float rstd = rsqrtf(q2 * (1.0f / D) + LN_EPS);
#pragma unroll
            for (int i = 0; i < 2; ++i) {
                const int col = i * 512 + lane * 8;
                const f32x4 g0 = lgv[i][0], g1 = lgv[i][1], b0 = lbv[i][0], b1 = lbv[i][1];
                f32x4 o0, o1;
#pragma unroll
                for (int k = 0; k < 4; ++k) { o0[k] = (v[i][k] - mu) * rstd * g0[k] + b0[k]; o1[k] = (v[i][4 + k] - mu) * rstd * g1[k] + b1[k]; }
                u32x4 w; w.x = cvtpk(o0[0], o0[1]); w.y = cvtpk(o0[2], o0[3]); w.z = cvtpk(o1[0], o1[1]); w.w = cvtpk(o1[2], o1[3]);
                *(u32x4*)(x1b + t * D + col) = w;
                *(f32x4*)(xs + lr * XS + col) = o0;
                *(f32x4*)(xs + lr * XS + col + 4) = o1;
            }
        }
        __syncthreads();
        {
            f32x4 acc0 = (f32x4){0.f, 0.f, 0.f, 0.f}, acc1 = (f32x4){0.f, 0.f, 0.f, 0.f};
#pragma unroll
            for (int ks = 0; ks < 4; ++ks) {
                const int k = wid * 128 + ks * 32 + 8 * g;
                const f32x4 xa0 = *(const f32x4*)(xs + r * XS + k), xa1 = *(const f32x4*)(xs + r * XS + k + 4);
                u32x4 hw, lw;
                hw.x = cvtpk(xa0[0], xa0[1]); hw.y = cvtpk(xa0[2], xa0[3]); hw.z = cvtpk(xa1[0], xa1[1]); hw.w = cvtpk(xa1[2], xa1[3]);
                lw.x = cvtpk(xa0[0] - bflo(hw.x), xa0[1] - bfhi(hw.x)); lw.y = cvtpk(xa0[2] - bflo(hw.y), xa0[3] - bfhi(hw.y));
                lw.z = cvtpk(xa1[0] - bflo(hw.z), xa1[1] - bfhi(hw.z)); lw.w = cvtpk(xa1[2] - bflo(hw.w), xa1[3] - bfhi(hw.w));
                const bf16x8 xh = __builtin_bit_cast(bf16x8, hw), xl = __builtin_bit_cast(bf16x8, lw);
                acc0 = mfma16(wh[ks][0], xh, acc0); acc0 = mfma16(wh[ks][0], xl, acc0); acc0 = mfma16(wl[ks][0], xh, acc0);
                acc1 = mfma16(wh[ks][1], xh, acc1); acc1 = mfma16(wh[ks][1], xl, acc1); acc1 = mfma16(wl[ks][1], xh, acc1);
            }
            *(f32x4*)(red + (wid * 16 + r) * 32 + 4 * g) = acc0;
            *(f32x4*)(red + (wid * 16 + r) * 32 + 16 + 4 * g) = acc1;
        }
        __syncthreads();
        {
            const int e = tid & 31, i = tid >> 5;
            float s = 0.f;
#pragma unroll
            for (int w = 0; w < 8; ++w) s += red[(w * 16 + i) * 32 + e];
            const float sc = sigmoidf_(s), sv = sc + rb_e;
            const float a1 = __shfl_xor(sv, 1, 64), a2 = __shfl_xor(sv, 2, 64), a3 = __shfl_xor(sv, 3, 64);
            const float c1 = __shfl_xor(sc, 1, 64), c2 = __shfl_xor(sc, 2, 64), c3 = __shfl_xor(sc, 3, 64);
            const float lo1 = fminf(sv, a1), hi1 = fmaxf(sv, a1), lo2 = fminf(a2, a3), hi2 = fmaxf(a2, a3);
            float bv = fmaxf(hi1, hi2) + fmaxf(fminf(hi1, hi2), fmaxf(lo1, lo2));
            int bg = e >> 2;
#pragma unroll
            for (int m = 4; m <= 16; m <<= 1) {
                const float ov = __shfl_xor(bv, m, 64); const int og = __shfl_xor(bg, m, 64);
                if (ov > bv || (ov == bv && og < bg)) { bv = ov; bg = og; }
            }
            if (e == bg * 4) {
                const float vv[4] = {sv, a1, a2, a3}, cc[4] = {sc, c1, c2, c3};
                int i1 = 0; float v1 = vv[0];
#pragma unroll
                for (int k = 1; k < 4; ++k) if (vv[k] > v1) { v1 = vv[k]; i1 = k; }
                int i2 = -1; float v2 = -3.0e38f, s1 = cc[0], s2 = 0.f;
#pragma unroll
                for (int k = 0; k < 4; ++k) { if (k == i1) s1 = cc[k]; }
#pragma unroll
                for (int k = 0; k < 4; ++k) if (k != i1 && vv[k] > v2) { v2 = vv[k]; i2 = k; s2 = cc[k]; }
                const int e1 = bg * 4 + i1, e2 = bg * 4 + i2;
                const float inv = 1.0f / (s1 + s2);
                const int t = row0 + i;
                gate[t * 2] = s1 * inv; gate[t * 2 + 1] = s2 * inv;
                const int lp1 = atomicAdd(&lcnt[e1], 1);
                const int lp2 = atomicAdd(&lcnt[e2], 1);
                if (ti < LN1_MAXT) { sel[(ti * 16 + i) * 2] = e1 | (lp1 << 8); sel[(ti * 16 + i) * 2 + 1] = e2 | (lp2 << 8); }
            }
        }
    }
    __syncthreads();
    const int tz = tid_opaque();
    if (tz < 32) { const int c = lcnt[tz]; gbase[tz] = c ? atomicAdd(&cnt[tz * CNT_STRIDE], c) : 0; }
    __syncthreads();
    if (tz < ti * 32) {
        const int tl = tz >> 5, rw = (tz >> 1) & 15, k = tz & 1;
        const int sv = sel[tz];
        const int e = sv & 255, lp = sv >> 8;
        list[(size_t)e * T + gbase[e] + lp] = ((bid + tl * nb) * 16 + rw) * 2 + k;
    }
}

DI void phase_ln2(const P& p, int layer, int bid, int nb) {
    const bf16_t* x1b = (const bf16_t*)(p.ws + WS_X1B);
    const bf16_t* yasg = (const bf16_t*)(p.ws + WS_YASG);
    bf16_t* xb = (bf16_t*)(p.ws + WS_XB);
    const float* lg = p.ln2_g + (size_t)layer * D;
    const float* lb = p.ln2_b + (size_t)layer * D;
    const int tid = tid_opaque(), lane = tid & 63, wid = tid >> 6;
    f32x4 lgv[2][2], lbv[2][2];
#pragma unroll
    for (int i = 0; i < 2; ++i) { const int col = i * 512 + lane * 8; lgv[i][0] = *(const f32x4*)(lg + col); lgv[i][1] = *(const f32x4*)(lg + col + 4); lbv[i][0] = *(const f32x4*)(lb + col); lbv[i][1] = *(const f32x4*)(lb + col + 4); }
    u32x4 nx_[2], ny0[2], ny1[2];
    {
        const int t = bid * NWAVES + wid;
        if (t < T) {
#pragma unroll
            for (int i = 0; i < 2; ++i) {
                const int col = i * 512 + lane * 8;
                nx_[i] = *(const u32x4*)(x1b + (size_t)t * D + col);
                ny0[i] = *(const u32x4*)(yasg + (size_t)(2 * t) * D + col);
                ny1[i] = *(const u32x4*)(yasg + (size_t)(2 * t + 1) * D + col);
            }
        }
    }
    for (int t = bid * NWAVES + wid; t < T; t += nb * NWAVES) {
        float v[2][8];
        float s = 0.f;
        u32x4 cx[2], cy0[2], cy1[2];
#pragma unroll
        for (int i = 0; i < 2; ++i) { cx[i] = nx_[i]; cy0[i] = ny0[i]; cy1[i] = ny1[i]; }
        {
            const int tn = t + nb * NWAVES;
            if (tn < T) {
#pragma unroll
                for (int i = 0; i < 2; ++i) {
                    const int col = i * 512 + lane * 8;
                    nx_[i] = *(const u32x4*)(x1b + (size_t)tn * D + col);
                    ny0[i] = *(const u32x4*)(yasg + (size_t)(2 * tn) * D + col);
                    ny1[i] = *(const u32x4*)(yasg + (size_t)(2 * tn + 1) * D + col);
                }
            }
        }
#pragma unroll
        for (int i = 0; i < 2; ++i) {
            const u32x4 xv = cx[i], y0 = cy0[i], y1 = cy1[i];
#pragma unroll
            for (int q = 0; q < 4; ++q) {
                v[i][2 * q] = bflo(xv[q]) * ALPHA + (bflo(y0[q]) + bflo(y1[q]));
                v[i][2 * q + 1] = bfhi(xv[q]) * ALPHA + (bfhi(y0[q]) + bfhi(y1[q]));
                s += v[i][2 * q] + v[i][2 * q + 1];
            }
        }
        s = wave_sum(s);
        const float mu = s * (1.0f / D);
        float q2 = 0.f;
#pragma unroll
        for (int i = 0; i < 2; ++i)
#pragma unroll
            for (int k = 0; k < 8; ++k) { const float d = v[i][k] - mu; q2 += d * d; }
        q2 = wave_sum(q2);
        const float rstd = rsqrtf(q2 * (1.0f / D) + LN_EPS);
#pragma unroll
        for (int i = 0; i < 2; ++i) {
            const int col = i * 512 + lane * 8;
            const f32x4 g0 = lgv[i][0], g1 = lgv[i][1], b0 = lbv[i][0], b1 = lbv[i][1];
            f32x4 o0, o1;
#pragma unroll
            for (int k = 0; k < 4; ++k) { o0[k] = (v[i][k] - mu) * rstd * g0[k] + b0[k]; o1[k] = (v[i][4 + k] - mu) * rstd * g1[k] + b1[k]; }
            if (layer == DEPTH - 1) {
                *(f32x4*)(p.out + (size_t)t * D + col) = o0;
                *(f32x4*)(p.out + (size_t)t * D + col + 4) = o1;
            } else {
                u32x4 w; w.x = cvtpk(o0[0], o0[1]); w.y = cvtpk(o0[2], o0[3]); w.z = cvtpk(o1[0], o1[1]); w.w = cvtpk(o1[2], o1[3]);
                *(u32x4*)(xb + (size_t)t * D + col) = w;
            }
        }
    }
}

#define XB_TMO      128
#define XB_XCNT(j)  (256  + 64 * (j))
#define XB_XSUB(j)  (1280 + 64 * (j))
#define XB_XGEN(j)  (2304 + 64 * (j))
#define XB_TOP      3328
#define XB_TOPGEN   3392
#define XCD_BAR_WORDS 3456
#define XB_SPIN_CAP (1u << 20)
DI unsigned xb_ld(unsigned* p_) { return __hip_atomic_load(p_, __ATOMIC_RELAXED, __HIP_MEMORY_SCOPE_AGENT); }
DI unsigned xb_add(unsigned* p_, unsigned v) { return __hip_atomic_fetch_add(p_, v, __ATOMIC_RELAXED, __HIP_MEMORY_SCOPE_AGENT); }
DI unsigned xb_xcc_id() { return (unsigned)__builtin_amdgcn_s_getreg((3 << 11) | 20) & 0xFu; }
#define XB_SPIN(cond, bar) do { unsigned _sp = 0; while (cond) { __builtin_amdgcn_s_sleep(1); \
    if ((++_sp & 255u) == 0u) { if (xb_ld(&(bar)[XB_TMO])) break; if (_sp > XB_SPIN_CAP) { atomicAdd(&(bar)[XB_TMO], 1u); break; } } } } while (0)
struct XcdBarrier { unsigned* bar; unsigned x; volatile LAS unsigned* st; };
DI XcdBarrier xcd_barrier_post(unsigned* bar, volatile LAS unsigned* st) {
    XcdBarrier b; b.bar = bar; b.x = xb_xcc_id(); b.st = st;
    if (threadIdx.x == 0) (void)xb_add(&bar[XB_XCNT(b.x)], 1u);
    return b;
}
DI void xcd_barrier_complete(unsigned* bar, unsigned x, unsigned& nloc, unsigned& nx) {
    const unsigned G = gridDim.x * gridDim.y * gridDim.z;
    unsigned sum, cnt, mine, sp = 0u;
    for (;;) {
        sum = 0u; cnt = 0u; mine = 0u;
#pragma unroll
        for (unsigned j = 0; j < 16; ++j) { const unsigned c = xb_ld(&bar[XB_XCNT(j)]); sum += c; cnt += (c > 0u) ? 1u : 0u; mine = (j == x) ? c : mine; }
        if (sum == G) break;
        __builtin_amdgcn_s_sleep(1);
        if ((++sp & 255u) == 0u) { if (xb_ld(&bar[XB_TMO])) break; if (sp > XB_SPIN_CAP) { atomicAdd(&bar[XB_TMO], 1u); break; } }
    }
    nloc = mine > 0u ? mine : 1u; nx = cnt > 0u ? cnt : 1u;
}
DI void xcd_barrier(const XcdBarrier& b) {
    asm volatile("s_waitcnt vmcnt(0)" ::: "memory");
    __syncthreads();
    if (tid_opaque() == 0) {
        unsigned* bar = b.bar;
        __builtin_amdgcn_s_waitcnt(0);
        unsigned nloc = b.st[0], nx = b.st[1];
        if (nloc == 0u) { xcd_barrier_complete(bar, b.x, nloc, nx); b.st[0] = nloc; b.st[1] = nx; }
        const unsigned old = xb_add(&bar[XB_XSUB(b.x)], 1u);
        const unsigned gen = old / nloc;
        if (old + 1u == (gen + 1u) * nloc) {
            __builtin_amdgcn_fence(__ATOMIC_RELEASE, "agent");
            asm volatile("s_waitcnt vmcnt(0)" ::: "memory");
            const unsigned og = xb_add(&bar[XB_TOP], 1u);
            const unsigned tg = og / nx;
            if (og + 1u == (tg + 1u) * nx) xb_add(&bar[XB_TOPGEN], 1u);
            else XB_SPIN(xb_ld(&bar[XB_TOPGEN]) == tg, bar);
            __builtin_amdgcn_fence(__ATOMIC_ACQUIRE, "agent");
            xb_add(&bar[XB_XGEN(b.x)], 1u);
            asm volatile("s_waitcnt vmcnt(0)" ::: "memory");
        } else {
            XB_SPIN(xb_ld(&bar[XB_XGEN(b.x)]) == gen, bar);
            __builtin_amdgcn_fence(__ATOMIC_ACQUIRE, "agent");
            asm volatile("s_waitcnt vmcnt(0)" ::: "memory");
        }
    }
    __syncthreads();
}

enum { PH_INPROJ = 0, PH_MIX1, PH_MIX2, PH_MIX3, PH_OUTPROJ, PH_LN1, PH_MOE, PH_LN2, PH_PER_LAYER, PH_PREP = 100, PH_KV = 101 };

DI void run_phase(const P& p, int ph, int layer, int bid, int nb, char* smem) {
    const bool conv = (layer & 1) == 0;
    if (ph == PH_PREP) phase_prep(p, bid, nb, smem);
    if (ph == PH_KV) phase_kv(p, bid, nb, smem);
    if (ph == PH_INPROJ) phase_inproj(p, layer, bid, nb, smem);
    if (ph == PH_MIX1) phase_ml_local(p, layer, bid, nb, smem);
    if (ph == PH_MIX2) phase_ml_scan(p, bid, nb);
    if (ph == PH_MIX3) {
        if (conv) phase_convmix(p, layer, bid, nb);
        else phase_ml_out(p, layer, bid, nb, smem);
    }
    if (ph == PH_MIX1 || (ph == PH_MIX3 && conv)) phase_xattn(p, layer, bid, nb, smem);
    if (ph == PH_OUTPROJ) phase_outproj(p, layer, bid, nb, smem);
    if (ph == PH_LN1) { phase_ln1_route(p, layer, bid, nb, smem); if (layer > 0) moe_steal(p, 1 << 20, (layer + 1) * MOE_TILES_PER_LAYER, nullptr, 0u, smem); }
    if (ph == PH_MOE) phase_moe(p, layer, bid, nb, smem);
    if (ph == PH_LN2) phase_ln2(p, layer, bid, nb);
}

__global__ void __launch_bounds__(NTHREADS, 2) mega(P p) {
    __shared__ __attribute__((aligned(16))) char smem[SMEM_BYTES];
    const int bid = blockIdx.x, nb = gridDim.x;
    volatile LAS unsigned* st = (volatile LAS unsigned*)(smem + SMEM_BYTES - 16);
    if (threadIdx.x == 0) { st[0] = 0u; st[1] = 0u; }
    __syncthreads();
    XcdBarrier xb = xcd_barrier_post((unsigned*)(p.ws + WS_CTL), st);
#pragma unroll 1
    for (int s = -2; s < DEPTH * PH_PER_LAYER; ++s) {
        int ph = (s == -2) ? (int)PH_PREP : (s == -1) ? (int)PH_KV : s % PH_PER_LAYER;
        int layer = (s < 0) ? 0 : s / PH_PER_LAYER;
        if ((layer & 1) == 0 && (ph == PH_MIX1 || ph == PH_MIX2)) continue;
        int b_ = bid, n_ = nb;
        asm volatile("" : "+s"(ph), "+s"(layer), "+s"(b_), "+s"(n_));
        P q = p;
        asm volatile("" : "+s"(q.ws));
        run_phase(q, ph, layer, b_, n_, smem);
#ifdef PROBE_MASK
        if (ph < 31 && ((PROBE_MASK >> ph) & 1)) { __syncthreads(); run_phase(q, ph, layer, b_, n_, smem); }
#endif
        if (ph != PH_KV) xcd_barrier(xb);
    }
}

extern "C" void kernel_launch(void* const* d_in, const int* in_sizes, int n_in, void* d_out, int out_size, void* d_ws, size_t ws_size,
                              hipStream_t stream) {
    if (ws_size < WS_TOTAL) { fprintf(stderr, "kernel_launch: workspace too small: %zu < %zu\n", ws_size, (size_t)WS_TOTAL); return; }
    static int grid_blocks = 0;
    if (!grid_blocks) {
        int dev = 0, cus = 0, per_cu = 0;
        (void)hipGetDevice(&dev);
        (void)hipDeviceGetAttribute(&cus, hipDeviceAttributeMultiprocessorCount, dev);
        if (hipOccupancyMaxActiveBlocksPerMultiprocessor(&per_cu, (const void*)mega, NTHREADS, 0) != hipSuccess) per_cu = 0;
        if (per_cu < 1 || cus < 1) { fprintf(stderr, "kernel_launch: occupancy query failed (per_cu=%d cus=%d)\n", per_cu, cus); return; }
        grid_blocks = cus;
    }
    P p{};
    p.x = (const float*)d_in[0]; p.mem = (const float*)d_in[1]; p.conv_w_in = (const float*)d_in[2]; p.conv_w = (const float*)d_in[3];
    p.ml_w_in = (const float*)d_in[4]; p.ml_gate_b = (const float*)d_in[5]; p.ml_norm_g = (const float*)d_in[6]; p.w_kv = (const float*)d_in[7];
    p.w_out = (const float*)d_in[8]; p.ln1_g = (const float*)d_in[9]; p.ln1_b = (const float*)d_in[10]; p.ln2_g = (const float*)d_in[11];
    p.ln2_b = (const float*)d_in[12]; p.router_w = (const float*)d_in[13]; p.router_b = (const float*)d_in[14]; p.w_gate = (const float*)d_in[15];
    p.w_up = (const float*)d_in[16]; p.w_down = (const float*)d_in[17];
    p.out = (float*)d_out; p.ws = (char*)d_ws;
    (void)hipMemsetAsync((char*)d_ws + WS_CTL, 0, CTL_BYTES, stream);
    void* args[] = {&p};
    hipError_t e = hipLaunchCooperativeKernel((const void*)mega, dim3(grid_blocks), dim3(NTHREADS), args, 0, stream);
    if (e != hipSuccess) fprintf(stderr, "kernel_launch: cooperative launch failed: %s (grid %d)\n", hipGetErrorString(e), grid_blocks);
}
```
